# Optimizing an MI355X kernel written in HIP

```python
import functools
import jax, jax.numpy as jnp
from jax import lax
import numpy as np

D_MODEL = 1024
BATCH = 4
SEQ = 4096
DEPTH = 2

GRID_W = 64
CTX_LEN = 256
MLSTM_HEADS = 8
MLSTM_DQK = 64
MLSTM_DV = 128
MLSTM_CHUNK = 64
GATE_SOFT_CAP = 15.0
RWKV_HEADS = 16
RWKV_N = 64
RWKV_DIM = RWKV_HEADS * RWKV_N
DECAY_LORA = 64
AAA_LORA = 64
GATE_LORA = 128
GN_EPS = 64e-5
D_FF = 2816
N_EXPERTS = 8
TOP_K = 2
D_FF_EXPERT = 3584
NORM_EPS = 1e-6

MLSTM_QK_W = MLSTM_HEADS * MLSTM_DQK
MLSTM_V_W = MLSTM_HEADS * MLSTM_DV
RWKV_IN_W = 3 * RWKV_DIM + 2 * DECAY_LORA + 2 * AAA_LORA + GATE_LORA
IN_SIZES = (MLSTM_QK_W, MLSTM_QK_W, MLSTM_V_W, MLSTM_V_W, 4 * MLSTM_HEADS, RWKV_IN_W, 2 * D_MODEL)
D_IN = sum(IN_SIZES)
RWKV_SIZES = (RWKV_DIM, RWKV_DIM, RWKV_DIM, DECAY_LORA, DECAY_LORA, AAA_LORA, AAA_LORA, GATE_LORA)
N_DENSE = (DEPTH + 1) // 2
N_MOE = DEPTH // 2

kernel_name = 'hybrid_mlstm_rwkv7_moe_prefix_dit'


def _split(a, sizes):
    idx = np.cumsum(sizes)[:-1].tolist()
    return jnp.split(a, idx, axis=-1)


def rmsnorm(x, g):
    xf = x.astype(jnp.float32)
    y = xf * lax.rsqrt(jnp.mean(xf * xf, axis=-1, keepdims=True) + NORM_EPS)
    return (y * g.astype(jnp.float32)).astype(x.dtype)


def modulate(h, shift, scale):
    return h * (1 + scale) + shift


def soft_cap(a):
    return GATE_SOFT_CAP * jnp.tanh(a / GATE_SOFT_CAP)


def heads(a, n_heads):
    B, T, _ = a.shape
    return a.reshape(B, T, n_heads, -1).transpose(0, 2, 1, 3)


def grid_shift(x):
    B, T, C = x.shape
    rows = T // GRID_W
    g = x.reshape(B, rows, GRID_W, C)
    q = C // 4
    left = jnp.pad(g[:, :, :-1, :q], ((0, 0), (0, 0), (1, 0), (0, 0)))
    right = jnp.pad(g[:, :, 1:, q:2 * q], ((0, 0), (0, 0), (0, 1), (0, 0)))
    up = jnp.pad(g[:, :-1, :, 2 * q:3 * q], ((0, 0), (1, 0), (0, 0), (0, 0)))
    down = jnp.pad(g[:, 1:, :, 3 * q:], ((0, 0), (0, 1), (0, 0), (0, 0)))
    return jnp.concatenate([left, right, up, down], axis=-1).reshape(B, T, C)


def seq_shift(x):
    h = x.shape[-1] // 2
    prev = jnp.pad(x[:, :-1, :h], ((0, 0), (1, 0), (0, 0)))
    nxt = jnp.pad(x[:, 1:, h:], ((0, 0), (0, 1), (0, 0)))
    return jnp.concatenate([prev, nxt], axis=-1)


def mlstm_chunkwise(q, k, v, i_pre, f_pre, state):
    B, H, T, dk = q.shape
    L = MLSTM_CHUNK
    nc = T // L
    q = q * (dk ** -0.5)
    logf = jax.nn.log_sigmoid(f_pre)
    causal = jnp.tril(jnp.ones((L, L), dtype=bool))

    def to_chunks(a):
        return jnp.moveaxis(a.reshape(B, H, nc, L, *a.shape[3:]), 2, 0)

    def step(carry, inp):
        C, n, m = carry
        qc, kc, vc, ic, lf = inp
        b = jnp.cumsum(lf, axis=-1)
        d = jnp.where(causal, b[..., :, None] - b[..., None, :] + ic[..., None, :], -jnp.inf)
        inter = b + m[..., None]
        m_t = jnp.maximum(inter, jnp.max(d, axis=-1))
        w_intra = jnp.exp(d - m_t[..., None])
        w_inter = jnp.exp(inter - m_t)
        s = jnp.einsum('bhtd,bhsd->bhts', qc, kc) * w_intra
        num = jnp.einsum('bhts,bhsv->bhtv', s, vc) + w_inter[..., None] * jnp.einsum('bhvd,bhtd->bhtv', C, qc)
        den = jnp.sum(s, axis=-1) + w_inter * jnp.einsum('bhd,bhtd->bht', n, qc)
        h = num / jnp.maximum(jnp.abs(den), jnp.exp(-m_t))[..., None]
        b_last = b[..., -1]
        w_src = b_last[..., None] - b + ic
        m_new = jnp.maximum(b_last + m, jnp.max(w_src, axis=-1))
        a_src = jnp.exp(w_src - m_new[..., None])
        a_old = jnp.exp(b_last + m - m_new)
        C = a_old[..., None, None] * C + jnp.einsum('bhs,bhsv,bhsd->bhvd', a_src, vc, kc)
        n = a_old[..., None] * n + jnp.einsum('bhs,bhsd->bhd', a_src, kc)
        return (C, n, m_new), h

    xs = (to_chunks(q), to_chunks(k), to_chunks(v), to_chunks(i_pre), to_chunks(logf))
    state, h = lax.scan(step, state, xs)
    h = jnp.moveaxis(h, 0, 2).reshape(B, H, T, -1)
    return h, state


def mlstm_mixer(q, k, v, gates, qc, kc, vc, gatesc, b_gate):
    def prep(q, k, v, gates):
        B, T, _ = q.shape
        pre = soft_cap(gates.astype(jnp.float32).reshape(B, T, 4, MLSTM_HEADS) + b_gate).transpose(2, 0, 3, 1)
        f32 = lambda a: a.astype(jnp.float32)
        return heads(f32(q), MLSTM_HEADS), heads(f32(k), MLSTM_HEADS), heads(f32(v), MLSTM_HEADS), pre

    ql, kl, vl, pl = prep(q, k, v, gates)
    qx, kx, vx, px = prep(qc, kc, vc, gatesc)
    B = q.shape[0]
    zero = (jnp.zeros((B, MLSTM_HEADS, MLSTM_DV, MLSTM_DQK), jnp.float32),
            jnp.zeros((B, MLSTM_HEADS, MLSTM_DQK), jnp.float32),
            jnp.zeros((B, MLSTM_HEADS), jnp.float32))
    fl = lambda a: jnp.flip(a, axis=2)
    hc_f, st_f = mlstm_chunkwise(qx, kx, vx, px[0], px[1], zero)
    h_f, _ = mlstm_chunkwise(ql, kl, vl, pl[0], pl[1], st_f)
    hc_b, st_b = mlstm_chunkwise(fl(qx), fl(kx), fl(vx), fl(px[2]), fl(px[3]), zero)
    h_b, _ = mlstm_chunkwise(fl(ql), fl(kl), fl(vl), fl(pl[2]), fl(pl[3]), st_b)
    return h_f + fl(h_b), hc_f + fl(hc_b)


def mlstm_out(h, o, g_norm):
    B, H, T, DV = h.shape
    h = h.transpose(0, 2, 1, 3)
    h = h * lax.rsqrt(jnp.mean(h * h, axis=-1, keepdims=True) + NORM_EPS)
    h = h.reshape(B, T, H * DV) * g_norm
    return (h * jax.nn.sigmoid(o.astype(jnp.float32))).astype(o.dtype)


def rwkv7_prepare(p, p_shift, mu, w0, w2, a0, a2, g2, k_k, k_a):
    B, T, _ = p.shape
    pf = p.astype(jnp.float32)
    xm = pf + (p_shift.astype(jnp.float32) - pf) * mu
    r, k, v, wd_f, wd_b, ad_f, ad_b, gd = _split(xm, RWKV_SIZES)
    hd = lambda a: a.reshape(B, T, RWKV_HEADS, RWKV_N)
    kk = hd(k * k_k)
    kk = kk / jnp.maximum(jnp.sqrt(jnp.sum(kk * kk, axis=-1, keepdims=True)), 1e-12)
    dirs = []
    for d, (wd, ad) in enumerate(((wd_f, ad_f), (wd_b, ad_b))):
        w = -jax.nn.softplus(-(w0[d] + jnp.tanh(wd) @ w2[d])) - 0.5
        decay = jnp.exp(-jnp.exp(w))
        a = jax.nn.sigmoid(a0[d] + ad @ a2[d])
        kd = k * (1 + (a - 1) * k_a)
        dirs.append((hd(decay), hd(a), hd(kd)))
    g = jax.nn.sigmoid(gd) @ g2
    return hd(r), hd(v), kk, g, dirs


def rwkv7_scan(r, w, k, v, kk, a, state, reverse):
    def step(S, inp):
        r_t, w_t, k_t, v_t, kk_t, a_t = inp
        sa = jnp.einsum('bhvk,bhk->bhv', S, kk_t)
        S = (S * w_t[:, :, None, :] - sa[..., None] * (kk_t * a_t)[:, :, None, :]
             + v_t[..., None] * k_t[:, :, None, :])
        return S, jnp.einsum('bhvk,bhk->bhv', S, r_t)
    xs = tuple(jnp.moveaxis(t, 1, 0) for t in (r, w, k, v, kk, a))
    state, y = lax.scan(step, state, xs, reverse=reverse)
    return jnp.moveaxis(y, 0, 1), state


def rwkv7_mixer(p, pc, need_ctx, mu, w0, w2, a0, a2, g2, k_k, k_a, r_k, ln_w, ln_b):
    prm = (mu, w0, w2, a0, a2, g2, k_k, k_a)
    lat = rwkv7_prepare(p, grid_shift(p), *prm)
    ctxp = rwkv7_prepare(pc, seq_shift(pc), *prm)
    zero = jnp.zeros((p.shape[0], RWKV_HEADS, RWKV_N, RWKV_N), jnp.float32)

    def run(prep, s_f, s_b):
        r, v, kk, g, ((dec_f, a_f, k_f), (dec_b, a_b, k_b)) = prep
        y_f, s_f = rwkv7_scan(r, dec_f, k_f, v, kk, a_f, s_f, False)
        y_b, s_b = rwkv7_scan(r, dec_b, k_b, v, kk, a_b, s_b, True)
        return y_f + y_b, s_f, s_b

    def finish(y, prep):
        r, v, kk, g, dirs = prep
        B, T = y.shape[:2]
        mean = jnp.mean(y, axis=-1, keepdims=True)
        var = jnp.mean(jnp.square(y - mean), axis=-1, keepdims=True)
        yn = ((y - mean) * lax.rsqrt(var + GN_EPS)).reshape(B, T, -1) * ln_w + ln_b
        bonus = sum(jnp.sum(r * kd * r_k, axis=-1, keepdims=True) * v for (_, _, kd) in dirs)
        return (yn + bonus.reshape(B, T, -1)) * g

    yc, s_f, s_b = run(ctxp, zero, zero)
    y, _, _ = run(lat, s_f, s_b)
    out = finish(y, lat).astype(p.dtype)
    out_c = finish(yc, ctxp).astype(pc.dtype) if need_ctx else None
    return out, out_c


def hybrid_mixer(h, hc, need_ctx, w_in, b_gate, g_mnorm, mu, w0, w2, a0, a2, g2, k_k, k_a, r_k,
                 ln_w, ln_b, w_pm, w_pr, w_out):
    q, k, v, o, gates, prw, mg = _split(h @ w_in, IN_SIZES)
    qc, kc, vc, oc, gatesc, prwc, mgc = _split(hc @ w_in, IN_SIZES)
    hm, hmc = mlstm_mixer(q, k, v, gates, qc, kc, vc, gatesc, b_gate)
    yr, yrc = rwkv7_mixer(prw, prwc, need_ctx, mu, w0, w2, a0, a2, g2, k_k, k_a, r_k, ln_w, ln_b)

    def merge(hm, o, yr, mg):
        ym = mlstm_out(hm, o, g_mnorm) @ w_pm
        yr = yr @ w_pr
        g_m, g_r = jnp.split(jax.nn.sigmoid(mg), 2, axis=-1)
        return (g_m * ym + g_r * yr) @ w_out

    y = merge(hm, o, yr, mg)
    yc = merge(hmc, oc, yrc, mgc) if need_ctx else None
    return y, yc


def swiglu(h, wg, wu, wd):
    return (jax.nn.silu(h @ wg) * (h @ wu)) @ wd


def moe_swiglu(h, w_router, wg, wu, wd):
    logits = (h @ w_router).astype(jnp.float32)
    top_v, top_i = lax.top_k(logits, TOP_K)
    probs = jax.nn.softmax(top_v, axis=-1)
    gates = jnp.einsum('btk,btke->bte', probs, jax.nn.one_hot(top_i, N_EXPERTS, dtype=jnp.float32)).astype(h.dtype)
    out = jnp.zeros_like(h)
    for e in range(N_EXPERTS):
        out = out + gates[..., e:e + 1] * swiglu(h, wg[e], wu[e], wd[e])
    return out


def setup_inputs(seed: int = 0) -> dict:
    key = jax.random.key(seed)
    ks = iter(jax.random.split(key, 40))
    nrm = lambda shape, s: s * jax.random.normal(next(ks), shape, jnp.float32)
    D, Dr, Dv = D_MODEL, RWKV_DIM, MLSTM_V_W
    gate_base = jnp.array([-2.0, 3.0, -2.0, 3.0], jnp.float32)[None, :, None]
    return {
        'x': nrm((BATCH, SEQ, D), 1.0),
        'c': nrm((BATCH, D), 1.0),
        'ctx': nrm((BATCH, CTX_LEN, D), 1.0),
        'c_ctx': nrm((D,), 1.0),
        'w_ada': nrm((DEPTH, D, 6 * D), 0.5 * D ** -0.5),
        'b_ada': nrm((DEPTH, 6 * D), 0.01),
        'g_norm_mix': 1.0 + nrm((DEPTH, D), 0.02),
        'g_norm_ffn': 1.0 + nrm((DEPTH, D), 0.02),
        'w_in': nrm((DEPTH, D, D_IN), D ** -0.5),
        'b_mlstm_gate': gate_base + nrm((DEPTH, 4, MLSTM_HEADS), 0.5),
        'g_mlstm_norm': 1.0 + nrm((DEPTH, Dv), 0.02),
        'mu_shift': jax.random.uniform(next(ks), (DEPTH, RWKV_IN_W), jnp.float32),
        'w0': jax.random.uniform(next(ks), (DEPTH, 2, Dr), jnp.float32, -5.5, -0.5),
        'w2': nrm((DEPTH, 2, DECAY_LORA, Dr), 0.1 * DECAY_LORA ** -0.5),
        'a0': nrm((DEPTH, 2, Dr), 0.3),
        'a2': nrm((DEPTH, 2, AAA_LORA, Dr), 0.5 * AAA_LORA ** -0.5),
        'g2': nrm((DEPTH, GATE_LORA, Dr), GATE_LORA ** -0.5),
        'k_k': 0.85 + nrm((DEPTH, Dr), 0.1),
        'k_a': 1.0 + nrm((DEPTH, Dr), 0.1),
        'r_k': nrm((DEPTH, RWKV_HEADS, RWKV_N), 0.1),
        'ln_w': 1.0 + nrm((DEPTH, Dr), 0.02),
        'ln_b': nrm((DEPTH, Dr), 0.01),
        'w_proj_mlstm': nrm((DEPTH, Dv, D), Dv ** -0.5),
        'w_proj_rwkv': nrm((DEPTH, Dr, D), Dr ** -0.5),
        'w_out': nrm((DEPTH, D, D), D ** -0.5),
        'w_ff_gate': nrm((N_DENSE, D, D_FF), D ** -0.5),
        'w_ff_up': nrm((N_DENSE, D, D_FF), D ** -0.5),
        'w_ff_down': nrm((N_DENSE, D_FF, D), D_FF ** -0.5),
        'w_router': nrm((N_MOE, D, N_EXPERTS), D ** -0.5),
        'w_exp_gate': nrm((N_MOE, N_EXPERTS, D, D_FF_EXPERT), D ** -0.5),
        'w_exp_up': nrm((N_MOE, N_EXPERTS, D, D_FF_EXPERT), D ** -0.5),
        'w_exp_down': nrm((N_MOE, N_EXPERTS, D_FF_EXPERT, D), D_FF_EXPERT ** -0.5),
        'g_final': 1.0 + nrm((D,), 0.02),
    }


def reference(x, c, ctx, c_ctx, w_ada, b_ada, g_norm_mix, g_norm_ffn, w_in, b_mlstm_gate, g_mlstm_norm,
              mu_shift, w0, w2, a0, a2, g2, k_k, k_a, r_k, ln_w, ln_b, w_proj_mlstm, w_proj_rwkv, w_out,
              w_ff_gate, w_ff_up, w_ff_down, w_router, w_exp_gate, w_exp_up, w_exp_down, g_final):
    xc = ctx
    s_lat = jax.nn.silu(c)
    s_ctx = jax.nn.silu(c_ctx)
    for l in range(DEPTH):
        need_ctx = l < DEPTH - 1
        mod = (s_lat @ w_ada[l] + b_ada[l])[:, None, :]
        mod_c = s_ctx @ w_ada[l] + b_ada[l]
        sh1, sc1, gt1, sh2, sc2, gt2 = jnp.split(mod, 6, axis=-1)
        sh1c, sc1c, gt1c, sh2c, sc2c, gt2c = jnp.split(mod_c, 6, axis=-1)
        h = modulate(rmsnorm(x, g_norm_mix[l]), sh1, sc1)
        hc = modulate(rmsnorm(xc, g_norm_mix[l]), sh1c, sc1c)
        y, yc = hybrid_mixer(h, hc, need_ctx, w_in[l], b_mlstm_gate[l], g_mlstm_norm[l], mu_shift[l],
                             w0[l], w2[l], a0[l], a2[l], g2[l], k_k[l], k_a[l], r_k[l], ln_w[l], ln_b[l],
                             w_proj_mlstm[l], w_proj_rwkv[l], w_out[l])
        x = x + gt1 * y
        i = l // 2
        if l % 2 == 0:
            ffn = functools.partial(swiglu, wg=w_ff_gate[i], wu=w_ff_up[i], wd=w_ff_down[i])
        else:
            ffn = functools.partial(moe_swiglu, w_router=w_router[i], wg=w_exp_gate[i], wu=w_exp_up[i],
                                    wd=w_exp_down[i])
        x = x + gt2 * ffn(modulate(rmsnorm(x, g_norm_ffn[l]), sh2, sc2))
        if need_ctx:
            xc = xc + gt1c * yc
            xc = xc + gt2c * ffn(modulate(rmsnorm(xc, g_norm_ffn[l]), sh2c, sc2c))
    return rmsnorm(x, g_final)
```

```cpp
#include <hip/hip_runtime.h>
#include <cstdio>
#include <cstdint>

#define GAS __attribute__((address_space(1)))
#define LAS __attribute__((address_space(3)))
typedef unsigned short bf16;
typedef unsigned v4u __attribute__((ext_vector_type(4)));
typedef unsigned v2u __attribute__((ext_vector_type(2)));
typedef float f32x4 __attribute__((ext_vector_type(4)));
typedef float f32x2 __attribute__((ext_vector_type(2)));
typedef short bf16x8 __attribute__((ext_vector_type(8)));
typedef GAS unsigned gu32;
#define RLX_AGENT __ATOMIC_RELAXED, __HIP_MEMORY_SCOPE_AGENT
#define LDS_WAIT() asm volatile("s_waitcnt lgkmcnt(0)" ::: "memory")
#define VM_WAIT() asm volatile("s_waitcnt vmcnt(0)" ::: "memory")

constexpr int D = 1024, NB = 4, T = 4096, GW = 64, TC = 256, NL = 2;
constexpr int RL = NB * T, RC = NB * TC, R = RL + RC;
constexpr int MH = 8, DQK = 64, DV = 128, LCH = 64;
constexpr int RH = 16, RN = 64, RD = 1024;
constexpr int RW = 3456, DIN = 8608, NPAD = 8704;
constexpr int FF = 2816, NE = 8, FE = 3584;
constexpr int TB = T + TC, NCH = TB / LCH;
constexpr int SMW = 512;
constexpr float NORM_EPS = 1e-6f, GN_EPS = 64e-5f, CAP = 15.0f;
constexpr int MAXSLOT = 2 * RL + NE * 256;

constexpr size_t MiB = 1u << 20;
constexpr size_t WS_CTL = 0, CTL_ZERO_BYTES = 1 * MiB;
constexpr size_t WS_MOD = 1 * MiB, WS_XC = 2 * MiB, WS_META = 6 * MiB, WS_BON = 7 * MiB, WS_SG = 10 * MiB;
constexpr size_t WS_WIN = 19 * MiB, WS_WPM = 36 * MiB, WS_WPR = 38 * MiB, WS_WOUT = 40 * MiB, WS_WG2 = 42 * MiB, WS_WLORA = 43 * MiB, WS_WGU = 44 * MiB, WS_WDN = 55 * MiB;
constexpr size_t WS_H = 61 * MiB;
constexpr size_t WS_Q = 95 * MiB, WS_K = 112 * MiB, WS_V = 129 * MiB, WS_O = 163 * MiB, WS_RKV = 197 * MiB, WS_MGT = 299 * MiB, WS_SM = 367 * MiB;
constexpr size_t WS_HF = 401 * MiB, WS_YS = 469 * MiB, WS_END = 537 * MiB;
constexpr size_t WS_HM = WS_Q, WS_YR = WS_V, WS_T1 = WS_SM;
constexpr size_t WS_HH0 = WS_Q;
constexpr size_t WS_WEGU = 95 * MiB, WS_WEDN = 151 * MiB, WS_HG = 179 * MiB, WS_Y2 = 213 * MiB, WS_HHE = 281 * MiB;
static_assert(WS_HHE + (size_t)MAXSLOT * FE <= 401 * MiB && WS_Y2 + (size_t)MAXSLOT * D * 2 <= WS_HHE && WS_HG + (size_t)MAXSLOT * D <= WS_Y2, "ws map");
constexpr float W8S = 64.0f;
constexpr size_t WS_NEED = 540 * MiB;
constexpr int CW_BAR = 4096;
constexpr int CW_ECNT = 16384;
constexpr int CW_SUB = 20480;
constexpr int LDS_BYTES = 159744;
constexpr int MISC_OFF = LDS_BYTES - 256;

__device__ __forceinline__ unsigned cvt_pk_bf16(float lo, float hi) { unsigned r; asm volatile("v_cvt_pk_bf16_f32 %0, %1, %2" : "=v"(r) : "v"(lo), "v"(hi)); return r; }
__device__ __forceinline__ float bflo(unsigned w) { return __uint_as_float(w << 16); }
__device__ __forceinline__ float bfhi(unsigned w) { return __uint_as_float(w & 0xffff0000u); }
__device__ __forceinline__ void unpack8(const v4u w, float (&f)[8]) { f[0] = bflo(w.x); f[1] = bfhi(w.x); f[2] = bflo(w.y); f[3] = bfhi(w.y); f[4] = bflo(w.z); f[5] = bfhi(w.z); f[6] = bflo(w.w); f[7] = bfhi(w.w); }
__device__ __forceinline__ v4u pack8(const float (&f)[8]) { v4u w; w.x = cvt_pk_bf16(f[0], f[1]); w.y = cvt_pk_bf16(f[2], f[3]); w.z = cvt_pk_bf16(f[4], f[5]); w.w = cvt_pk_bf16(f[6], f[7]); return w; }
__device__ __forceinline__ float sigmoidf_(float x) { return __builtin_amdgcn_rcpf(1.0f + __expf(-x)); }
__device__ __forceinline__ float siluf_(float x) { return x * sigmoidf_(x); }
__device__ __forceinline__ float softplusf_(float x) { return fmaxf(x, 0.f) + log1pf(expf(-fabsf(x))); }
__device__ __forceinline__ float fast_tanh(float x) { const float e = __expf(2.0f * x); return 1.0f - 2.0f * __builtin_amdgcn_rcpf(1.0f + e); }
__device__ __forceinline__ float fast_softplus(float x) { return fmaxf(x, 0.f) + __logf(1.0f + __expf(-fabsf(x))); }
template <int CTRL> __device__ __forceinline__ float dpp_add(float v) { const int t = __builtin_amdgcn_update_dpp(0, __float_as_int(v), CTRL, 0xf, 0xf, false); return v + __int_as_float(t); }
__device__ __forceinline__ float red4(float v) { v = dpp_add<0xB1>(v); return dpp_add<0x4E>(v); }
__device__ __forceinline__ float red8(float v) { return dpp_add<0x141>(red4(v)); }
__device__ __forceinline__ float red16(float v) { return dpp_add<0x140>(red8(v)); }
__device__ __forceinline__ float wave_sum(float v) { v = red16(v); v += __shfl_xor(v, 16); return v + __shfl_xor(v, 32); }
__device__ __forceinline__ int row_of(int b, int lr) { return lr < T ? b * T + lr : RL + b * TC + (lr - T); }
__device__ __forceinline__ int tok(int dir, int u) { if (u < TC) return T + (dir ? TC - 1 - u : u); const int tt = u - TC; return dir ? T - 1 - tt : tt; }
__device__ __forceinline__ int nbrow(int g, int rwidx) {
    if (g < RL) { const int t = g & (T - 1), row = t >> 6, col = t & 63, q = rwidx / (RW / 4);
        if (q == 0) return col > 0 ? g - 1 : -1; if (q == 1) return col < GW - 1 ? g + 1 : -1; if (q == 2) return row > 0 ? g - GW : -1; return row < T / GW - 1 ? g + GW : -1; }
    const int t = (g - RL) & (TC - 1); if (rwidx < RW / 2) return t > 0 ? g - 1 : -1; return t < TC - 1 ? g + 1 : -1;
}

#define XB_TMO      128
#define XB_XCNT(j)  (256  + 64 * (j))
#define XB_XSUB(j)  (1280 + 64 * (j))
#define XB_XGEN(j)  (2304 + 64 * (j))
#define XB_TOP      3328
#define XB_TOPGEN   3392
#define XCD_BAR_WORDS 3456
#define XB_SPIN_CAP (1u << 18)
__device__ __forceinline__ unsigned xb_ld(unsigned* p)              { return __hip_atomic_load(p, __ATOMIC_RELAXED, __HIP_MEMORY_SCOPE_AGENT); }
__device__ __forceinline__ unsigned xb_add(unsigned* p, unsigned v) { return __hip_atomic_fetch_add(p, v, __ATOMIC_RELAXED, __HIP_MEMORY_SCOPE_AGENT); }
__device__ __forceinline__ unsigned xb_xcc_id() { return (unsigned)__builtin_amdgcn_s_getreg((3 << 11) | 20) & 0xFu; }
#define XB_SPIN(cond, bar) do { unsigned _sp = 0; while (cond) { __builtin_amdgcn_s_sleep(1); \
    if ((++_sp & 255u) == 0u) { if (xb_ld(&(bar)[XB_TMO])) break; if (_sp > XB_SPIN_CAP) { atomicAdd(&(bar)[XB_TMO], 1u); break; } } } } while (0)
struct XcdBarrier { unsigned* bar; unsigned x; volatile LAS unsigned* st; };
__device__ __forceinline__ XcdBarrier xcd_barrier_post(unsigned* bar, volatile LAS unsigned* st) {
    XcdBarrier b; b.bar = bar; b.x = xb_xcc_id(); b.st = st;
    if (threadIdx.x == 0) (void)xb_add(&bar[XB_XCNT(b.x)], 1u);
    return b;
}
__device__ __forceinline__ void xcd_barrier_complete(unsigned* bar, unsigned x, unsigned& nloc, unsigned& nx) {
    const unsigned G = gridDim.x * gridDim.y * gridDim.z;
    unsigned sum, cnt, mine, sp = 0u;
    for (;;) {
        sum = 0u; cnt = 0u; mine = 0u;
#pragma unroll
        for (unsigned j = 0; j < 16; ++j) { const unsigned c = xb_ld(&bar[XB_XCNT(j)]); sum += c; cnt += (c > 0u) ? 1u : 0u; mine = (j == x) ? c : mine; }
        if (sum == G) break;
        __builtin_amdgcn_s_sleep(1);
        if ((++sp & 255u) == 0u) { if (xb_ld(&bar[XB_TMO])) break; if (sp > XB_SPIN_CAP) { atomicAdd(&bar[XB_TMO], 1u); break; } }
    }
    nloc = mine > 0u ? mine : 1u; nx = cnt > 0u ? cnt : 1u;
}
__device__ __forceinline__ void xcd_barrier(const XcdBarrier& b) {
    asm volatile("s_waitcnt vmcnt(0)" ::: "memory");
    __syncthreads();
    if (threadIdx.x == 0) {
        unsigned* bar = b.bar;
        __builtin_amdgcn_s_waitcnt(0);
        unsigned nloc = b.st[0], nx = b.st[1];
        if (nloc == 0u) { xcd_barrier_complete(bar, b.x, nloc, nx); b.st[0] = nloc; b.st[1] = nx; }
        const unsigned old = xb_add(&bar[XB_XSUB(b.x)], 1u);
        const unsigned gen = old / nloc;
        if (old + 1u == (gen + 1u) * nloc) {
            __builtin_amdgcn_fence(__ATOMIC_RELEASE, "agent");
            asm volatile("s_waitcnt vmcnt(0)" ::: "memory");
            const unsigned og = xb_add(&bar[XB_TOP], 1u);
            const unsigned tg = og / nx;
            if (og + 1u == (tg + 1u) * nx) xb_add(&bar[XB_TOPGEN], 1u);
            else XB_SPIN(xb_ld(&bar[XB_TOPGEN]) == tg, bar);
            __builtin_amdgcn_fence(__ATOMIC_ACQUIRE, "agent");
            xb_add(&bar[XB_XGEN(b.x)], 1u);
            asm volatile("s_waitcnt vmcnt(0)" ::: "memory");
        } else {
            XB_SPIN(xb_ld(&bar[XB_XGEN(b.x)]) == gen, bar);
            __builtin_amdgcn_fence(__ATOMIC_ACQUIRE, "agent");
            asm volatile("s_waitcnt vmcnt(0)" ::: "memory");
        }
    }
    __syncthreads();
}

namespace pg8 {
#define PG8_LAS __attribute__((address_space(3)))
typedef unsigned short bf16_t;
typedef unsigned u32x4 __attribute__((ext_vector_type(4)));
constexpr int BM = 256, BK = 64, HALF = 128, HTB = HALF * BK * 2, STAGE_BYTES = 8 * HTB, NXCD = 8, WGM = 8;
__host__ __device__ __forceinline__ int lds_byte(int r, int c) { const int st = (r >> 4) * 2 + (c >> 5), rr = r & 15, cc = c & 31, ob = rr * 64 + cc * 2; return st * 1024 + (ob ^ (((ob >> 9) & 1) << 5)); }
__host__ __device__ __forceinline__ void stage_rc(int b, int& R_, int& C) { const int st = b / 1024, sb = b % 1024, swz = sb ^ (((sb >> 9) & 1) << 5); R_ = (st >> 1) * 16 + swz / 64; C = (st & 1) * 32 + (swz % 64) / 2; }
__host__ __device__ __forceinline__ int perm32(int rho) { const int n = rho >> 4, i = rho & 15; return 8 * (i >> 2) + 4 * n + (i & 3); }
typedef int i32x8 __attribute__((ext_vector_type(8))); typedef int i32x4 __attribute__((ext_vector_type(4)));
__device__ __forceinline__ i32x8 cat8(bf16x8 lo, bf16x8 hi) { return __builtin_shufflevector(__builtin_bit_cast(i32x4, lo), __builtin_bit_cast(i32x4, hi), 0, 1, 2, 3, 4, 5, 6, 7); }
__device__ __forceinline__ void mfma8_acc(f32x4& acc, const i32x8 a, const i32x8 b) {
#if defined(__HIP_DEVICE_COMPILE__)
    const int one = 0x7F7F7F7F;
    asm volatile("v_mfma_scale_f32_16x16x128_f8f6f4 %0, %1, %2, %0, %3, %3 op_sel_hi:[0,0,0]" : "+v"(acc) : "v"(a), "v"(b), "v"(one));
#endif
}
struct Unit { int pm, pn, pb; };
struct Gemm { const bf16_t* A; const bf16_t* Bt; int M, N, K; };
struct StaticOrder {
    int nM, nN, nwg, G, c;
    __device__ void init(int M, int N, int G_, int c_) { nM = M / BM; nN = N / BM; nwg = nM * nN; G = G_; c = c_; }
    __device__ bool next(int i, Unit& u) const {
        const long L = (long)i * G + c; if (L >= nwg) return false;
        int wgid = (int)L; { const int q = nwg / NXCD, r = nwg % NXCD, xcd = wgid % NXCD, off = wgid / NXCD; wgid = (xcd < r ? xcd * (q + 1) : r * (q + 1) + (xcd - r) * q) + off; }
        const int nig = WGM * nN, gid = wgid / nig, fm = gid * WGM, gsz = (nM - fm) < WGM ? (nM - fm) : WGM;
        u.pm = fm + ((wgid % nig) % gsz); u.pn = (wgid % nig) / gsz; u.pb = u.pn; return true;
    }
    __device__ __forceinline__ void a_ready(const Unit&) const {}
    __device__ __forceinline__ void done(const Unit&) const {}
};
struct InprojLastOrder {
    int G, c;
    __device__ bool next(int i, Unit& u) const {
        const int L = i * G + c; if (L >= 64 * 34 + 4 * 22) return false;
        if (L < 64 * 34) { const int g8 = L / (8 * 34), r = L % (8 * 34); u.pm = g8 * 8 + (r % 8); u.pn = r / 8; }
        else { const int r = L - 64 * 34; u.pm = 64 + (r & 3); int q = r >> 2; q += (q >= 8) ? 4 : 0; q += (q >= 24) ? 8 : 0; u.pn = q; }
        u.pb = u.pn; return true;
    }
    __device__ __forceinline__ void a_ready(const Unit&) const {}
    __device__ __forceinline__ void done(const Unit&) const {}
};
struct MoeOrder {
    int ntiles, nN, nwg, G, c; const int* texp;
    __device__ bool next(int i, Unit& u) const {
        const long L = (long)i * G + c; if (L >= nwg) return false;
        u.pm = (int)(L / nN); u.pn = (int)(L % nN); u.pb = __builtin_amdgcn_readfirstlane(texp[u.pm]) * nN + u.pn; return true;
    }
    __device__ __forceinline__ void a_ready(const Unit&) const {}
    __device__ __forceinline__ void done(const Unit&) const {}
};
template <class Epi, class Sched, bool ALIGN_EPI = false, bool SP2 = false, bool FP8 = false>
__device__ __forceinline__ void gemm_phase(PG8_LAS unsigned char* lds, const Gemm g, const Sched& S, const Epi& E) {
    int tid_ = threadIdx.x; asm volatile("" : "+v"(tid_));
    const int tid = tid_, wid = __builtin_amdgcn_readfirstlane(tid >> 6), lane = tid & 63, wr = wid >> 2, wc = wid & 3, fr = lane & 15, fq = lane >> 4;
    const int K = g.K, nt = K / BK;
    unsigned voffA[2], voffB[2];
#pragma unroll
    for (int i = 0; i < 2; ++i) { int R, C; stage_rc(tid * 16 + i * 8192, R, C); const int Rb = Epi::PERM ? ((R & ~31) + perm32(R & 31)) : R;
        voffA[i] = (unsigned)(R * K + C) * 2u; voffB[i] = (unsigned)(Rb * K + C) * 2u; }
    const size_t kstep = (size_t)(BK * 2);
    const size_t hstep = (size_t)HALF * K * 2;
    const size_t tstep = 2 * hstep;
    const unsigned ldsw = (unsigned)wid * 1024u;
    const int aoff = lds_byte(wr * 64 + fr, fq * 8), boff = lds_byte(wc * 32 + fr, fq * 8);
#define PG8_SA(b, h) (((b) * 2 + (h)) * HTB)
#define PG8_SB(b, h) ((4 + (b) * 2 + (h)) * HTB)
#define PG8_STAGE(bufoff, gbase, voff) do { _Pragma("unroll") for (int _i = 0; _i < 2; ++_i) \
        __builtin_amdgcn_global_load_lds((const unsigned*)((const char*)(gbase) + (voff)[_i]), (PG8_LAS unsigned*)(lds + (bufoff) + ldsw + _i * 8192), 16, 0, 0); } while (0)
#define PG8_LDA(dst, b, h) do { _Pragma("unroll") for (int m = 0; m < 4; ++m) { if constexpr (FP8) dst##8[m] = cat8(*(const PG8_LAS bf16x8*)(lds + PG8_SA(b, h) + aoff + m * 2048), *(const PG8_LAS bf16x8*)(lds + PG8_SA(b, h) + aoff + m * 2048 + 1024)); \
        else { _Pragma("unroll") for (int k = 0; k < 2; ++k) dst[m][k] = *(const PG8_LAS bf16x8*)(lds + PG8_SA(b, h) + aoff + m * 2048 + k * 1024); } } } while (0)
#define PG8_LDB(dst, b, h) do { _Pragma("unroll") for (int n = 0; n < 2; ++n) { if constexpr (FP8) dst##8[n] = cat8(*(const PG8_LAS bf16x8*)(lds + PG8_SB(b, h) + boff + n * 2048), *(const PG8_LAS bf16x8*)(lds + PG8_SB(b, h) + boff + n * 2048 + 1024)); \
        else { _Pragma("unroll") for (int k = 0; k < 2; ++k) dst[n][k] = *(const PG8_LAS bf16x8*)(lds + PG8_SB(b, h) + boff + n * 2048 + k * 1024); } } } while (0)
#define PG8_MMA(ai, bj, At, Bt) do { __builtin_amdgcn_s_setprio(1); if constexpr (FP8) { _Pragma("unroll") for (int m = 0; m < 4; ++m) _Pragma("unroll") for (int n = 0; n < 2; ++n) \
        mfma8_acc(acc[ai][bj][m][n], Bt##8[n], At##8[m]); } else { \
        _Pragma("unroll") for (int m = 0; m < 4; ++m) _Pragma("unroll") for (int n = 0; n < 2; ++n) _Pragma("unroll") for (int k = 0; k < 2; ++k) \
        acc[ai][bj][m][n] = __builtin_amdgcn_mfma_f32_16x16x32_bf16(Bt[n][k], At[m][k], acc[ai][bj][m][n], 0, 0, 0); } __builtin_amdgcn_s_setprio(0); } while (0)
#define PG8_WAIT_V(n) asm volatile("s_waitcnt vmcnt(" #n ")" ::: "memory")
#define PG8_WAIT_L(n) asm volatile("s_waitcnt lgkmcnt(" #n ")" ::: "memory")
#define PG8_BAR __builtin_amdgcn_s_barrier()
#define PG8_SCHED __builtin_amdgcn_sched_barrier(0)
    Unit cur, nxt; int ui = 0;
    if (!S.next(0, cur)) return;
    f32x4 acc[2][2][4][2];
#pragma unroll
    for (int a = 0; a < 2; ++a)
#pragma unroll
        for (int b = 0; b < 2; ++b)
#pragma unroll
            for (int m = 0; m < 4; ++m)
#pragma unroll
                for (int n = 0; n < 2; ++n) acc[a][b][m][n] = (f32x4){0.f, 0.f, 0.f, 0.f};
    bf16x8 At[4][2], B0[2][2], B1[2][2]; i32x8 At8[4], B08[2], B18[2];
    const char* cA = (const char*)g.A + (size_t)cur.pm * tstep; const char* cB = (const char*)g.Bt + (size_t)cur.pb * tstep;
    S.a_ready(cur);
    if constexpr (SP2) {
        PG8_STAGE(PG8_SB(0, 0), cB, voffB); PG8_STAGE(PG8_SB(0, 1), cB + hstep, voffB); PG8_STAGE(PG8_SA(0, 0), cA, voffA); PG8_STAGE(PG8_SA(0, 1), cA + hstep, voffA);
        if (wr == 1) PG8_BAR;
        PG8_WAIT_V(2); PG8_BAR;
        PG8_STAGE(PG8_SB(1, 0), cB + kstep, voffB); PG8_STAGE(PG8_SA(1, 0), cA + kstep, voffA); PG8_STAGE(PG8_SB(1, 1), cB + hstep + kstep, voffB);
        PG8_WAIT_V(6); PG8_BAR;
    } else {
        PG8_STAGE(PG8_SB(0, 0), cB, voffB); PG8_STAGE(PG8_SA(0, 0), cA, voffA); PG8_STAGE(PG8_SB(0, 1), cB + hstep, voffB); PG8_STAGE(PG8_SA(0, 1), cA + hstep, voffA);
        if (wr == 1) PG8_BAR;
        PG8_WAIT_V(4); PG8_BAR;
        PG8_STAGE(PG8_SB(1, 0), cB + kstep, voffB); PG8_STAGE(PG8_SA(1, 0), cA + kstep, voffA); PG8_STAGE(PG8_SB(1, 1), cB + hstep + kstep, voffB);
        PG8_WAIT_V(6); PG8_BAR;
    }
    for (;;) {
        const bool has_next = S.next(ui + 1, nxt);
        const char* nA = has_next ? (const char*)g.A + (size_t)nxt.pm * tstep : cA; const char* nB = has_next ? (const char*)g.Bt + (size_t)nxt.pb * tstep : cB;
        for (int t = 0; t < nt; t += 2) {
            const bool last = (t == nt - 2);
            const char* a1 = cA + (size_t)(t + 1) * kstep;
            const char* a2 = last ? nA : cA + (size_t)(t + 2) * kstep; const char* b2 = last ? nB : cB + (size_t)(t + 2) * kstep;
            const char* a3 = a2 + kstep; const char* b3 = b2 + kstep;
            if (last && has_next) S.a_ready(nxt);
            if constexpr (SP2) {
            PG8_LDB(B0, 0, 0); PG8_LDB(B1, 0, 1); PG8_SCHED; PG8_LDA(At, 0, 0); PG8_STAGE(PG8_SA(1, 1), a1 + hstep, voffA);
            PG8_WAIT_V(8); PG8_WAIT_L(0); PG8_BAR; PG8_MMA(0, 0, At, B0); PG8_MMA(0, 1, At, B1); PG8_BAR; PG8_SCHED;
            PG8_LDA(At, 0, 1); PG8_STAGE(PG8_SB(0, 0), b2, voffB); PG8_STAGE(PG8_SB(0, 1), b2 + hstep, voffB); PG8_STAGE(PG8_SA(0, 0), a2, voffA);
            PG8_WAIT_V(8); PG8_WAIT_L(0); PG8_BAR; PG8_MMA(1, 0, At, B0); PG8_MMA(1, 1, At, B1); PG8_BAR; PG8_SCHED;
            PG8_LDB(B0, 1, 0); PG8_LDB(B1, 1, 1); PG8_SCHED; PG8_LDA(At, 1, 0); PG8_STAGE(PG8_SA(0, 1), a2 + hstep, voffA);
            PG8_WAIT_V(8); PG8_WAIT_L(0); PG8_BAR; PG8_MMA(0, 0, At, B0); PG8_MMA(0, 1, At, B1); PG8_BAR; PG8_SCHED;
            PG8_LDA(At, 1, 1); PG8_STAGE(PG8_SB(1, 0), b3, voffB); PG8_STAGE(PG8_SB(1, 1), b3 + hstep, voffB); PG8_STAGE(PG8_SA(1, 0), a3, voffA);
            PG8_WAIT_V(8); PG8_WAIT_L(0); PG8_BAR; PG8_MMA(1, 0, At, B0); PG8_MMA(1, 1, At, B1); PG8_BAR; PG8_SCHED;
            } else {
            PG8_LDB(B0, 0, 0); PG8_SCHED; PG8_LDA(At, 0, 0); PG8_STAGE(PG8_SA(1, 1), a1 + hstep, voffA);
            PG8_WAIT_L(8); PG8_BAR; PG8_WAIT_L(0); PG8_MMA(0, 0, At, B0); PG8_BAR; PG8_SCHED;
            PG8_LDB(B1, 0, 1); PG8_STAGE(PG8_SB(0, 0), b2, voffB);
            PG8_BAR; PG8_WAIT_L(0); PG8_MMA(0, 1, At, B1); PG8_BAR;
            PG8_LDA(At, 0, 1); PG8_STAGE(PG8_SA(0, 0), a2, voffA);
            PG8_BAR; PG8_WAIT_L(0); PG8_MMA(1, 0, At, B0); PG8_BAR; PG8_SCHED;
            PG8_STAGE(PG8_SB(0, 1), b2 + hstep, voffB);
            PG8_WAIT_V(6); PG8_BAR; PG8_MMA(1, 1, At, B1); PG8_BAR;
            PG8_LDB(B0, 1, 0); PG8_SCHED; PG8_LDA(At, 1, 0); PG8_STAGE(PG8_SA(0, 1), a2 + hstep, voffA);
            PG8_WAIT_L(8); PG8_BAR; PG8_WAIT_L(0); PG8_MMA(0, 0, At, B0); PG8_BAR; PG8_SCHED;
            PG8_LDB(B1, 1, 1); PG8_STAGE(PG8_SB(1, 0), b3, voffB);
            PG8_BAR; PG8_WAIT_L(0); PG8_MMA(0, 1, At, B1); PG8_BAR;
            PG8_LDA(At, 1, 1); PG8_STAGE(PG8_SA(1, 0), a3, voffA);
            PG8_BAR; PG8_WAIT_L(0); PG8_MMA(1, 0, At, B0); PG8_BAR; PG8_SCHED;
            PG8_STAGE(PG8_SB(1, 1), b3 + hstep, voffB);
            PG8_WAIT_V(6); PG8_BAR; PG8_MMA(1, 1, At, B1); PG8_BAR;
            }
        }
        if constexpr (ALIGN_EPI) { if (wr == 0) PG8_BAR; }
        if constexpr (FP8) asm volatile("s_nop 15\n\ts_nop 15\n\ts_nop 15\n\ts_nop 15" ::: "memory");
        if constexpr (!Epi::AFTER_DRAIN) { E(acc, cur, wr, wc, fr, fq); S.done(cur); }
        if (!has_next) break;
#pragma unroll
        for (int a = 0; a < 2; ++a)
#pragma unroll
            for (int b = 0; b < 2; ++b)
#pragma unroll
                for (int m = 0; m < 4; ++m)
#pragma unroll
                    for (int n = 0; n < 2; ++n) acc[a][b][m][n] = (f32x4){0.f, 0.f, 0.f, 0.f};
        cur = nxt; cA = nA; cB = nB; ++ui;
        if constexpr (ALIGN_EPI) { if (wr == 1) PG8_BAR; }
    }
    PG8_WAIT_V(0);
    if constexpr (!ALIGN_EPI) { if (wr == 0) PG8_BAR; }
    PG8_BAR;
    if constexpr (Epi::AFTER_DRAIN) { E.fused(acc, cur, wr, wc, fr, fq, lds, wid, lane); S.done(cur); }
#undef PG8_SA
#undef PG8_SB
#undef PG8_STAGE
#undef PG8_LDA
#undef PG8_LDB
#undef PG8_MMA
#undef PG8_WAIT_V
#undef PG8_WAIT_L
#undef PG8_BAR
#undef PG8_SCHED
}

__device__ __forceinline__ u32x4 pack_acc8(const f32x4 v0, const f32x4 v1) { u32x4 w; w.x = cvt_pk_bf16(v0[0], v0[1]); w.y = cvt_pk_bf16(v0[2], v0[3]); w.z = cvt_pk_bf16(v1[0], v1[1]); w.w = cvt_pk_bf16(v1[2], v1[3]); return w; }
#define EPI_LOOP_BEGIN  _Pragma("unroll") for (int ai = 0; ai < 2; ++ai) _Pragma("unroll") for (int m = 0; m < 4; ++m) { const int rloc = ai * HALF + wr * 64 + m * 16 + fr; \
                        _Pragma("unroll") for (int bj = 0; bj < 2; ++bj) { const int cloc = bj * HALF + wc * 32 + 8 * fq; const f32x4 v0 = acc[ai][bj][m][0], v1 = acc[ai][bj][m][1];
#define EPI_LOOP_END    } asm volatile("" ::: "memory"); }

struct EpiInproj {
    static constexpr bool PERM = true, AFTER_DRAIN = false;
    GAS unsigned char* ws;
    __device__ __forceinline__ void operator()(const f32x4 (&acc)[2][2][4][2], const Unit& u, int wr, int wc, int fr, int fq) const {
        const int pn = u.pn; size_t off; int ld, ct;
        if (pn < 2) { off = WS_Q; ld = 512; ct = pn; } else if (pn < 4) { off = WS_K; ld = 512; ct = pn - 2; } else if (pn < 8) { off = WS_V; ld = 1024; ct = pn - 4; }
        else if (pn < 12) { off = WS_O; ld = 1024; ct = pn - 8; } else if (pn < 24) { off = WS_RKV; ld = 3072; ct = pn - 12; } else if (pn < 32) { off = WS_MGT; ld = 2048; ct = pn - 24; } else { off = WS_SM; ld = SMW * 2; ct = pn - 32; }
        const size_t row0 = (size_t)u.pm * BM;
        if (pn < 32) {
            bf16_t* base = (bf16_t*)(ws + off) + row0 * ld + ct * BM;
            EPI_LOOP_BEGIN
                *(u32x4*)(base + (size_t)rloc * ld + cloc) = pack_acc8(v0, v1);
            EPI_LOOP_END
        } else {
            float* sb = (float*)(ws + off) + row0 * SMW + ct * BM;
            EPI_LOOP_BEGIN
                float* p = sb + (size_t)rloc * SMW + cloc; *(f32x4*)p = v0; *(f32x4*)(p + 4) = v1;
            EPI_LOOP_END
        }
    }
};
struct EpiStore {
    static constexpr bool PERM = true, AFTER_DRAIN = false;
    bf16_t* C; int ldc;
    __device__ __forceinline__ void operator()(const f32x4 (&acc)[2][2][4][2], const Unit& u, int wr, int wc, int fr, int fq) const {
        const size_t row0 = (size_t)u.pm * BM; const int col0 = u.pn * BM;
        EPI_LOOP_BEGIN
            *(u32x4*)(C + (row0 + rloc) * ldc + col0 + cloc) = pack_acc8(v0, v1);
        EPI_LOOP_END
    }
};
template <int STEP> struct EpiMerge {
    static constexpr bool PERM = true, AFTER_DRAIN = false;
    const bf16_t* MGT; bf16_t* T1; bf16_t* OUT;
    __device__ __forceinline__ void operator()(const f32x4 (&acc)[2][2][4][2], const Unit& u, int wr, int wc, int fr, int fq) const {
        const size_t row0 = (size_t)u.pm * BM; const int col0 = u.pn * BM;
        EPI_LOOP_BEGIN
            const size_t row = row0 + rloc; const int col = col0 + cloc;
            const u32x4 gw = *(const u32x4*)(MGT + row * 2048 + (STEP ? 1024 : 0) + col); float g[8]; unpack8(gw, g);
            float o[8] = {v0[0], v0[1], v0[2], v0[3], v1[0], v1[1], v1[2], v1[3]};
#pragma unroll
            for (int j = 0; j < 8; ++j) o[j] *= sigmoidf_(g[j]);
            if (STEP) { const u32x4 tw = *(const u32x4*)(T1 + row * 1024 + col); float tt[8]; unpack8(tw, tt);
#pragma unroll
                for (int j = 0; j < 8; ++j) o[j] += tt[j]; }
            *(u32x4*)((STEP ? OUT : T1) + row * 1024 + col) = pack8(o);
        EPI_LOOP_END
    }
};
struct EpiResid {
    static constexpr bool PERM = true, AFTER_DRAIN = false;
    const float* src_lat; const float* src_ctx; float* dst_lat; float* dst_ctx; const float* gate;
    __device__ __forceinline__ void operator()(const f32x4 (&acc)[2][2][4][2], const Unit& u, int wr, int wc, int fr, int fq) const {
        const int row0 = u.pm * BM, col0 = u.pn * BM; const bool lat = row0 < RL;
        const float* sb = lat ? src_lat : src_ctx - (size_t)RL * D; float* db = lat ? dst_lat : dst_ctx - (size_t)RL * D;
        const float* gt = gate + (lat ? row0 / T : 4) * 6 * D;
        EPI_LOOP_BEGIN
            const size_t off = (size_t)(row0 + rloc) * D + col0 + cloc; const int col = col0 + cloc;
            const f32x4 g0 = *(const f32x4*)(gt + col), g1 = *(const f32x4*)(gt + col + 4), s0 = *(const f32x4*)(sb + off), s1 = *(const f32x4*)(sb + off + 4);
            *(f32x4*)(db + off) = s0 + g0 * v0; *(f32x4*)(db + off + 4) = s1 + g1 * v1;
        EPI_LOOP_END
    }
};
struct EpiSwiglu {
    static constexpr bool PERM = true, AFTER_DRAIN = false;
    bf16_t* HH; int ldc;
    __device__ __forceinline__ void operator()(const f32x4 (&acc)[2][2][4][2], const Unit& u, int wr, int wc, int fr, int fq) const {
        const size_t row0 = (size_t)u.pm * BM; const int col0 = u.pn * HALF + wc * 32 + 8 * fq;
#pragma unroll
        for (int ai = 0; ai < 2; ++ai)
#pragma unroll
            for (int m = 0; m < 4; ++m) { const int rloc = ai * HALF + wr * 64 + m * 16 + fr; float o[8];
#pragma unroll
                for (int n = 0; n < 2; ++n)
#pragma unroll
                    for (int j = 0; j < 4; ++j) o[4 * n + j] = siluf_(acc[ai][0][m][n][j]) * acc[ai][1][m][n][j];
                *(u32x4*)(HH + (row0 + rloc) * ldc + col0) = pack8(o); asm volatile("" ::: "memory"); }
    }
};

struct EpiSwiglu8 {
    static constexpr bool PERM = true, AFTER_DRAIN = false;
    unsigned char* HH; int ldc;
    __device__ __forceinline__ void operator()(const f32x4 (&acc)[2][2][4][2], const Unit& u, int wr, int wc, int fr, int fq) const {
        const size_t row0 = (size_t)u.pm * BM; const int col0 = u.pn * HALF + wc * 32 + 8 * fq; const float is = 1.0f / W8S;
#pragma unroll
        for (int ai = 0; ai < 2; ++ai)
#pragma unroll
            for (int m = 0; m < 4; ++m) { const int rloc = ai * HALF + wr * 64 + m * 16 + fr; float o[8];
#pragma unroll
                for (int n = 0; n < 2; ++n)
#pragma unroll
                    for (int j = 0; j < 4; ++j) o[4 * n + j] = siluf_(acc[ai][0][m][n][j] * is) * (acc[ai][1][m][n][j] * is);
                v2u w; w.x = (unsigned)__builtin_amdgcn_cvt_pk_fp8_f32(o[0], o[1], 0, false); w.x = (unsigned)__builtin_amdgcn_cvt_pk_fp8_f32(o[2], o[3], (int)w.x, true);
                w.y = (unsigned)__builtin_amdgcn_cvt_pk_fp8_f32(o[4], o[5], 0, false); w.y = (unsigned)__builtin_amdgcn_cvt_pk_fp8_f32(o[6], o[7], (int)w.y, true);
                *(v2u*)(HH + (row0 + rloc) * ldc + col0) = w; asm volatile("" ::: "memory"); }
    }
};
struct EpiStoreScaled {
    static constexpr bool PERM = true, AFTER_DRAIN = false;
    bf16_t* C; int ldc; float s;
    __device__ __forceinline__ void operator()(const f32x4 (&acc)[2][2][4][2], const Unit& u, int wr, int wc, int fr, int fq) const {
        const size_t row0 = (size_t)u.pm * BM; const int col0 = u.pn * BM;
        EPI_LOOP_BEGIN
            *(u32x4*)(C + (row0 + rloc) * ldc + col0 + cloc) = pack_acc8(v0 * s, v1 * s);
        EPI_LOOP_END
    }
};

}

struct Args { const GAS float* in[33]; GAS float* out; GAS unsigned char* ws; int ph_lo, ph_hi, li, pad; };
#define CAS __attribute__((address_space(4)))
#define INP(i) ((const float*)F.A->in[i])
constexpr int NWAVES = 8, NTHREADS = 512;
struct Frame {
    LAS unsigned char* lds; volatile LAS unsigned* MISC; gu32* ctl;
    int tid, lane, wave, G, bid;
    int cb, cg;
    GAS unsigned char* ws; GAS float* out;
    const CAS Args* A;
};
enum { I_X = 0, I_C, I_CTX, I_CCTX, I_WADA, I_BADA, I_GNM, I_GNF, I_WIN, I_BG, I_GMN, I_MU, I_W0, I_W2, I_A0, I_A2, I_G2, I_KK, I_KA, I_RK, I_LNW, I_LNB, I_WPM, I_WPR, I_WOUT,
       I_FFG, I_FFU, I_FFD, I_WR, I_EG, I_EU, I_ED, I_GF };

__device__ __forceinline__ void conv_item(const float* W, int ldw, int c0, int k0, bf16* dst, int ldd, int r0, LAS float* scr, int lane) {
#pragma unroll 8
    for (int i = 0; i < 32; ++i) { const int kk = 2 * i + (lane >> 5); scr[kk * 33 + (lane & 31)] = W[(size_t)(k0 + kk) * ldw + c0 + (lane & 31)]; }
    LDS_WAIT(); asm volatile("" ::: "memory");
    const int c = lane & 7;
#pragma unroll
    for (int j = 0; j < 4; ++j) { const int n = (lane >> 3) + 8 * j; const LAS float* s = scr + (8 * c) * 33 + n;
        v4u o; o.x = cvt_pk_bf16(s[0 * 33], s[1 * 33]); o.y = cvt_pk_bf16(s[2 * 33], s[3 * 33]); o.z = cvt_pk_bf16(s[4 * 33], s[5 * 33]); o.w = cvt_pk_bf16(s[6 * 33], s[7 * 33]);
        *(v4u*)(dst + (size_t)(r0 + n) * ldd + k0 + 8 * c) = o; }
    LDS_WAIT(); asm volatile("" ::: "memory");
}
__device__ __forceinline__ unsigned pk4_fp8(float a, float b, float c, float d) { int w = __builtin_amdgcn_cvt_pk_fp8_f32(a, b, 0, false); w = __builtin_amdgcn_cvt_pk_fp8_f32(c, d, w, true); return (unsigned)w; }
__device__ __forceinline__ void conv_item8(const float* W, int ldw, int c0, int k0, unsigned char* dst, int ldd, int r0, float scale, LAS float* scr, int lane) {
#pragma unroll 8
    for (int i = 0; i < 32; ++i) { const int kk = 2 * i + (lane >> 5); scr[kk * 33 + (lane & 31)] = W[(size_t)(k0 + kk) * ldw + c0 + (lane & 31)] * scale; }
    LDS_WAIT(); asm volatile("" ::: "memory");
    const int c = lane & 3;
#pragma unroll
    for (int j = 0; j < 2; ++j) { const int n = (lane >> 2) + 16 * j; const LAS float* s = scr + (16 * c) * 33 + n;
        v4u o; o.x = pk4_fp8(s[0 * 33], s[1 * 33], s[2 * 33], s[3 * 33]); o.y = pk4_fp8(s[4 * 33], s[5 * 33], s[6 * 33], s[7 * 33]);
        o.z = pk4_fp8(s[8 * 33], s[9 * 33], s[10 * 33], s[11 * 33]); o.w = pk4_fp8(s[12 * 33], s[13 * 33], s[14 * 33], s[15 * 33]);
        *(v4u*)(dst + (size_t)(r0 + n) * ldd + k0 + 16 * c) = o; }
    LDS_WAIT(); asm volatile("" ::: "memory");
}
__device__ __forceinline__ void conv_seg8(Frame& F, const float* W, int ldw, int K, int c0, int ncols, unsigned char* dst, int ldd, int r0, float scale, int& rot) {
    LAS float* scr = (LAS float*)(F.lds + F.wave * 16384);
    const int NGW = F.cg * NWAVES, nblk = ncols / 32, nitems = (K / 64) * nblk;
    int gw = (F.cb * NWAVES + F.wave + rot) % NGW;
    for (int it = gw; it < nitems; it += NGW) { const int kb = it / nblk, nb = it % nblk; conv_item8(W, ldw, c0 + 32 * nb, 64 * kb, dst, ldd, r0 + 32 * nb, scale, scr, F.lane); }
    rot = (rot + nitems) % NGW;
}
__device__ __forceinline__ void conv_gu8(Frame& F, const float* Wg, const float* Wu, int ldw, int K, int ngroups, unsigned char* dst, float scale, int& rot) {
    LAS float* scr = (LAS float*)(F.lds + F.wave * 16384);
    const int NGW = F.cg * NWAVES, kblk = K / 64, nitems = ngroups * 2 * 4 * kblk;
    int gw = (F.cb * NWAVES + F.wave + rot) % NGW;
    for (int it = gw; it < nitems; it += NGW) { const int kb = it % kblk, r = it / kblk, nb = r & 3, which = (r >> 2) & 1, p = r >> 3;
        conv_item8(which ? Wu : Wg, ldw, 128 * p + 32 * nb, 64 * kb, dst, K, 256 * p + 128 * which + 32 * nb, scale, scr, F.lane); }
    rot = (rot + nitems) % NGW;
}
__device__ __forceinline__ void conv_seg(Frame& F, const float* W, int ldw, int K, int c0, int ncols, bf16* dst, int ldd, int r0, int& rot) {
    LAS float* scr = (LAS float*)(F.lds + F.wave * 16384);
    const int NGW = F.cg * NWAVES, nblk = ncols / 32, nitems = (K / 64) * nblk;
    int gw = (F.cb * NWAVES + F.wave + rot) % NGW;
    for (int it = gw; it < nitems; it += NGW) { const int kb = it / nblk, nb = it % nblk; conv_item(W, ldw, c0 + 32 * nb, 64 * kb, dst, ldd, r0 + 32 * nb, scr, F.lane); }
    rot = (rot + nitems) % NGW;
}
__device__ __forceinline__ void conv_gu(Frame& F, const float* Wg, const float* Wu, int ldw, int K, int ngroups, bf16* dst, int& rot) {
    LAS float* scr = (LAS float*)(F.lds + F.wave * 16384);
    const int NGW = F.cg * NWAVES, kblk = K / 64, nitems = ngroups * 2 * 4 * kblk;
    int gw = (F.cb * NWAVES + F.wave + rot) % NGW;
    for (int it = gw; it < nitems; it += NGW) { const int kb = it % kblk, r = it / kblk, nb = r & 3, which = (r >> 2) & 1, p = r >> 3;
        conv_item(which ? Wu : Wg, ldw, 128 * p + 32 * nb, 64 * kb, dst, K, 256 * p + 128 * which + 32 * nb, scr, F.lane); }
    rot = (rot + nitems) % NGW;
}
__device__ __forceinline__ void zero_bf16_rows(Frame& F, bf16* dst, size_t n16) {
    const v4u z = {0u, 0u, 0u, 0u};
    for (size_t i = (size_t)F.cb * NTHREADS + F.tid; i < n16; i += (size_t)F.cg * NTHREADS) ((v4u*)dst)[i] = z;
}
__device__ __forceinline__ void conv_win(Frame& F, int l) {
    int rot = 0; GAS unsigned char* ws = F.ws;
    bf16* WIN = (bf16*)(ws + WS_WIN); const float* win = INP(I_WIN) + (size_t)l * D * DIN;
    conv_seg(F, win, DIN, D, 0, 3072, WIN, D, 0, rot);
    conv_seg(F, win, DIN, D, 3104, 3072, WIN, D, 3072, rot);
    conv_seg(F, win, DIN, D, 6560, 2048, WIN, D, 6144, rot);
    conv_seg(F, win, DIN, D, 3072, 32, WIN, D, 8192, rot);
    conv_seg(F, win, DIN, D, 6176, 384, WIN, D, 8192 + 32, rot);
    zero_bf16_rows(F, WIN + (size_t)(8192 + 416) * D, (size_t)96 * D * 2 / 16);
}
__device__ __forceinline__ void conv_rest(Frame& F, int l) {
    int rot = 0; GAS unsigned char* ws = F.ws;
    conv_seg(F, INP(I_WPM) + (size_t)l * D * D, D, D, 0, D, (bf16*)(ws + WS_WPM), D, 0, rot);
    conv_seg(F, INP(I_WPR) + (size_t)l * D * D, D, D, 0, D, (bf16*)(ws + WS_WPR), D, 0, rot);
    conv_seg(F, INP(I_WOUT) + (size_t)l * D * D, D, D, 0, D, (bf16*)(ws + WS_WOUT), D, 0, rot);
    { bf16* WG2 = (bf16*)(ws + WS_WG2);
      conv_seg(F, INP(I_G2) + (size_t)l * 128 * RD, RD, 128, 0, RD, WG2, 256, 0, rot);
      for (int i = F.cb * NTHREADS + F.tid; i < 1024 * 16; i += F.cg * NTHREADS) { const int r = i >> 4, p = i & 15; *(v4u*)(WG2 + (size_t)r * 256 + 128 + 8 * p) = (v4u){0u, 0u, 0u, 0u}; } }
    { bf16* WL = (bf16*)(ws + WS_WLORA);
      for (int d = 0; d < 2; ++d) { conv_seg(F, INP(I_W2) + ((size_t)l * 2 + d) * 64 * RD, RD, 64, 0, RD, WL + (size_t)(0 * 2 + d) * RD * 64, 64, 0, rot);
                                    conv_seg(F, INP(I_A2) + ((size_t)l * 2 + d) * 64 * RD, RD, 64, 0, RD, WL + (size_t)(1 * 2 + d) * RD * 64, 64, 0, rot); } }
}
__device__ __forceinline__ void conv_ffn0(Frame& F) {
    int rot = 0; GAS unsigned char* ws = F.ws;
    conv_gu(F, INP(I_FFG), INP(I_FFU), FF, D, FF / 128, (bf16*)(ws + WS_WGU), rot);
    conv_seg(F, INP(I_FFD), D, FF, 0, D, (bf16*)(ws + WS_WDN), FF, 0, rot);
}
__device__ __forceinline__ void conv_experts(Frame& F) {
    int rot = 0;
    for (int e = 0; e < NE; ++e) {
        conv_gu8(F, INP(I_EG) + (size_t)e * D * FE, INP(I_EU) + (size_t)e * D * FE, FE, D, FE / 128, (unsigned char*)(F.ws + WS_WEGU) + (size_t)e * 2 * FE * D, W8S, rot);
        conv_seg8(F, INP(I_ED) + (size_t)e * FE * D, D, FE, 0, D, (unsigned char*)(F.ws + WS_WEDN) + (size_t)e * D * FE, FE, 0, W8S, rot);
    }
}
__device__ __forceinline__ void mod_phase(Frame& F) {
    LAS float* sl = (LAS float*)F.lds;
    LAS float* part = sl + 5 * D;
    for (int i = F.tid; i < 5 * D; i += NTHREADS) { const int bb = i / D, k = i % D; const float v = bb < 4 ? INP(I_C)[bb * D + k] : INP(I_CCTX)[k]; sl[i] = siluf_(v); }
    __syncthreads();
    float* MOD = (float*)(F.ws + WS_MOD);
    for (int item = F.bid; item < NL * 6 * D / 64; item += F.G) {
        const int l = item / (6 * D / 64), c0 = (item % (6 * D / 64)) * 64; const float* w = INP(I_WADA) + (size_t)l * D * 6 * D + c0 + F.lane;
        float a[5] = {0.f, 0.f, 0.f, 0.f, 0.f};
        for (int k = F.wave * 128; k < F.wave * 128 + 128; ++k) { const float wv = w[(size_t)k * 6 * D];
#pragma unroll
            for (int bb = 0; bb < 5; ++bb) a[bb] += sl[bb * D + k] * wv; }
#pragma unroll
        for (int bb = 0; bb < 5; ++bb) part[(F.wave * 5 + bb) * 64 + F.lane] = a[bb];
        __syncthreads();
        if (F.tid < 5 * 64) { const int bb = F.tid / 64, c = F.tid % 64; float s = INP(I_BADA)[l * 6 * D + c0 + c];
#pragma unroll
            for (int w8 = 0; w8 < 8; ++w8) s += part[(w8 * 5 + bb) * 64 + c];
            MOD[((size_t)l * 5 + bb) * 6 * D + c0 + c] = s; }
        __syncthreads();
    }
}
__device__ __forceinline__ const float* xrow(const float* lat, const float* ctx, int g) { return g < RL ? lat + (size_t)g * D : ctx + (size_t)(g - RL) * D; }
template <bool ROUTER> __device__ __forceinline__ void normmod_phase(Frame& F, const float* lat, const float* ctx, const float* gain, const float* MODl, int off_sh, int off_sc, int nrows, const float* wrt) {
    bf16* H = (bf16*)(F.ws + WS_H);
    LAS unsigned* lcnt = (LAS unsigned*)F.lds;
    LAS int* rec = (LAS int*)(F.lds + 64);
    LAS float* recp = (LAS float*)(F.lds + 64 + 1024);
    const int ngroups = nrows / 64;
    for (int grp = F.bid; grp < ngroups; grp += F.G) {
        if (ROUTER) { if (F.tid < 16) lcnt[F.tid] = 0u; __syncthreads(); }
        f32x4 vnx[4];
        { const float* x0 = xrow(lat, ctx, grp * 64 + F.wave * 8);
#pragma unroll
          for (int j = 0; j < 4; ++j) vnx[j] = *(const f32x4*)(x0 + 256 * j + 4 * F.lane); }
        for (int rr = 0; rr < 8; ++rr) {
            const int lrow = F.wave * 8 + rr, g = grp * 64 + lrow; const float* md = MODl + (g < RL ? g / T : 4) * 6 * D;
            f32x4 v[4]; float ss = 0.f;
#pragma unroll
            for (int j = 0; j < 4; ++j) v[j] = vnx[j];
            if (rr + 1 < 8) { const float* x1 = xrow(lat, ctx, g + 1);
#pragma unroll
                for (int j = 0; j < 4; ++j) vnx[j] = *(const f32x4*)(x1 + 256 * j + 4 * F.lane); }
#pragma unroll
            for (int j = 0; j < 4; ++j) ss += (v[j].x * v[j].x + v[j].y * v[j].y) + (v[j].z * v[j].z + v[j].w * v[j].w);
            const float rstd = 1.0f / sqrtf(wave_sum(ss) * (1.0f / D) + NORM_EPS);
            float lg[NE];
            if (ROUTER) {
#pragma unroll
                for (int e = 0; e < NE; ++e) lg[e] = 0.f; }
#pragma unroll
            for (int j = 0; j < 4; ++j) { const int c = 256 * j + 4 * F.lane;
                const f32x4 gn = *(const f32x4*)(gain + c), sc = *(const f32x4*)(md + off_sc + c), sh = *(const f32x4*)(md + off_sh + c);
                const f32x4 h = v[j] * rstd * gn * (1.0f + sc) + sh;
                v2u o; o.x = cvt_pk_bf16(h.x, h.y); o.y = cvt_pk_bf16(h.z, h.w); *(v2u*)(H + (size_t)g * D + c) = o;
                if (ROUTER) {
#pragma unroll
                    for (int q = 0; q < 4; ++q) { const f32x4 w0 = *(const f32x4*)(wrt + (size_t)(c + q) * NE), w1 = *(const f32x4*)(wrt + (size_t)(c + q) * NE + 4); const float hv = h[q];
                        lg[0] += hv * w0.x; lg[1] += hv * w0.y; lg[2] += hv * w0.z; lg[3] += hv * w0.w; lg[4] += hv * w1.x; lg[5] += hv * w1.y; lg[6] += hv * w1.z; lg[7] += hv * w1.w; } }
            }
            if (ROUTER) {
#pragma unroll
                for (int e = 0; e < NE; ++e) lg[e] = wave_sum(lg[e]);
                int i0 = 0;
#pragma unroll
                for (int e = 1; e < NE; ++e) if (lg[e] > lg[i0]) i0 = e;
                int i1 = i0 == 0 ? 1 : 0;
#pragma unroll
                for (int e = 0; e < NE; ++e) if (e != i0 && lg[e] > lg[i1]) i1 = e;
                if (F.lane == 0) { const float e1 = __expf(lg[i1] - lg[i0]); const float p0 = 1.0f / (1.0f + e1);
                    rec[lrow * 4 + 0] = i0; rec[lrow * 4 + 1] = i1; rec[lrow * 4 + 2] = (int)atomicAdd((unsigned*)&lcnt[i0], 1u); rec[lrow * 4 + 3] = (int)atomicAdd((unsigned*)&lcnt[i1], 1u);
                    recp[lrow * 2 + 0] = p0; recp[lrow * 2 + 1] = e1 * p0; }
            }
        }
        if (ROUTER) {
            __syncthreads();
            if (F.tid < NE) lcnt[8 + F.tid] = __hip_atomic_fetch_add((unsigned*)(F.ctl + CW_ECNT + 64 * F.tid), lcnt[F.tid], RLX_AGENT);
            __syncthreads();
            if (F.tid < 64) { const int g = grp * 64 + F.tid; int* tk = (int*)(F.ws + WS_META) + (size_t)g * 8; const int e0 = rec[F.tid * 4], e1 = rec[F.tid * 4 + 1];
                tk[0] = e0; tk[1] = e1; tk[2] = (int)lcnt[8 + e0] + rec[F.tid * 4 + 2]; tk[3] = (int)lcnt[8 + e1] + rec[F.tid * 4 + 3];
                ((float*)tk)[4] = recp[F.tid * 2]; ((float*)tk)[5] = recp[F.tid * 2 + 1]; }
            __syncthreads();
        }
    }
}
__device__ __forceinline__ void subgrid_arrive(Frame& F, gu32* cnt) {
    asm volatile("s_waitcnt vmcnt(0)" ::: "memory"); __syncthreads();
    if (F.tid == 0) { __builtin_amdgcn_fence(__ATOMIC_RELEASE, "agent"); asm volatile("s_waitcnt vmcnt(0)" ::: "memory"); __hip_atomic_fetch_add(cnt, 1u, RLX_AGENT); }
}
__device__ __forceinline__ void subgrid_wait(Frame& F, gu32* cnt, unsigned n) {
    if (F.tid == 0) { unsigned sp = 0; while (__hip_atomic_load(cnt, RLX_AGENT) < n) { __builtin_amdgcn_s_sleep(2); if (++sp > (1u << 20)) break; }
        __builtin_amdgcn_fence(__ATOMIC_ACQUIRE, "agent"); asm volatile("s_waitcnt vmcnt(0)" ::: "memory"); }
    __syncthreads();
}
__device__ __forceinline__ void sg_phase(Frame& F, int l) {
    const float* SM = (const float*)(F.ws + WS_SM); bf16* SG = (bf16*)(F.ws + WS_SG); const float* mu = INP(I_MU) + l * RW + 3328;
    for (int i = F.cb * NTHREADS + F.tid; i < R * 32; i += F.cg * NTHREADS) { const int g = i >> 5, p = i & 31; float o[8];
        if (p < 16) { const int nb = nbrow(g, 3328); const float* a = SM + (size_t)g * SMW + 288 + 8 * p;
            const f32x4 a0 = *(const f32x4*)a, a1 = *(const f32x4*)(a + 4); f32x4 b0 = {0.f, 0.f, 0.f, 0.f}, b1 = b0;
            if (nb >= 0) { const float* bq = SM + (size_t)nb * SMW + 288 + 8 * p; b0 = *(const f32x4*)bq; b1 = *(const f32x4*)(bq + 4); }
#pragma unroll
            for (int j = 0; j < 4; ++j) { o[j] = sigmoidf_(a0[j] + (b0[j] - a0[j]) * mu[8 * p + j]); o[4 + j] = sigmoidf_(a1[j] + (b1[j] - a1[j]) * mu[8 * p + 4 + j]); }
        } else {
#pragma unroll
            for (int j = 0; j < 8; ++j) o[j] = 0.f; }
        *(v4u*)(SG + (size_t)g * 256 + 8 * p) = pack8(o); }
}

constexpr int ML_P = 72, ML_QS = 0, ML_KS = 64 * ML_P * 2, ML_KT = 2 * ML_KS, ML_PS = 3 * ML_KS, ML_VT = 4 * ML_KS, ML_CB = ML_VT + 48 * ML_P * 2, ML_GT = ML_CB + 48 * ML_P * 2, ML_END = ML_GT + 2 * 6 * 64 * 4;
template <int CTRL, int RMASK> __device__ __forceinline__ float dpp_get(float v, float old) { return __int_as_float(__builtin_amdgcn_update_dpp(__float_as_int(old), __float_as_int(v), CTRL, RMASK, 0xf, false)); }
__device__ __forceinline__ float wave_scan_add(float x) {
    x += dpp_get<0x111, 0xf>(x, 0.f); x += dpp_get<0x112, 0xf>(x, 0.f); x += dpp_get<0x114, 0xf>(x, 0.f); x += dpp_get<0x118, 0xf>(x, 0.f);
    x += dpp_get<0x142, 0xa>(x, 0.f); x += dpp_get<0x143, 0xc>(x, 0.f); return x;
}
__device__ __forceinline__ float wave_scan_max(float x) {
    const float ninf = -__builtin_inff();
    x = fmaxf(x, dpp_get<0x111, 0xf>(x, ninf)); x = fmaxf(x, dpp_get<0x112, 0xf>(x, ninf)); x = fmaxf(x, dpp_get<0x114, 0xf>(x, ninf)); x = fmaxf(x, dpp_get<0x118, 0xf>(x, ninf));
    x = fmaxf(x, dpp_get<0x142, 0xa>(x, ninf)); x = fmaxf(x, dpp_get<0x143, 0xc>(x, ninf)); return x;
}
__device__ __forceinline__ float lane63(float x) { return __int_as_float(__builtin_amdgcn_readlane(__float_as_int(x), 63)); }
__device__ __forceinline__ void mlstm_phase(Frame& F, int l, int first, int stride) {
    LAS unsigned char* L = F.lds;
    LAS bf16* Qs = (LAS bf16*)(L + ML_QS); LAS bf16* Ks = (LAS bf16*)(L + ML_KS); LAS bf16* Kt = (LAS bf16*)(L + ML_KT); LAS bf16* Ps = (LAS bf16*)(L + ML_PS);
    LAS bf16* Vt = (LAS bf16*)(L + ML_VT); LAS bf16* Cb = (LAS bf16*)(L + ML_CB); LAS float* GT = (LAS float*)(L + ML_GT);
    const bf16* Qg = (const bf16*)(F.ws + WS_Q); const bf16* Kg = (const bf16*)(F.ws + WS_K); const bf16* Vg = (const bf16*)(F.ws + WS_V); const float* SM = (const float*)(F.ws + WS_SM);
    bf16* HF = (bf16*)(F.ws + WS_HF); const float* bgate = INP(I_BG) + l * 4 * MH;
    const int tid = F.tid, lane = F.lane, wave = F.wave, r16 = lane & 15, quad = lane >> 4;
    for (int item = first; item < NB * 2 * MH * 4; item += stride) {
        const int vq = item & 3, h = (item >> 2) & 7, dir = (item >> 5) & 1, b = item >> 6;
        __syncthreads();
        for (int i = tid; i < 48 * ML_P; i += NTHREADS) { Cb[i] = 0; Vt[i] = (i >= 32 * ML_P) ? (bf16)0x3F80 : (bf16)0; }
        const float bgi = bgate[(2 * dir) * MH + h], bgf = bgate[(2 * dir + 1) * MH + h];
        const int ss_ = tid & 63, pc = tid >> 6;
        v4u rq, rk, rv = {0u, 0u, 0u, 0u};
        { const int g = row_of(b, tok(dir, ss_)); rq = *(const v4u*)(Qg + (size_t)g * 512 + h * 64 + pc * 8); rk = *(const v4u*)(Kg + (size_t)g * 512 + h * 64 + pc * 8);
          if (pc < 4) rv = *(const v4u*)(Vg + (size_t)g * 1024 + h * 128 + vq * 32 + pc * 8); }
        float m_run = 0.f, gi = 0.f, gf = 0.f;
        auto gate_tables = [&](int buf) {
            LAS float* G = GT + buf * 384;
            const float iv = CAP * fast_tanh((gi + bgi) * (1.0f / CAP)), lf = -fast_softplus(-CAP * fast_tanh((gf + bgf) * (1.0f / CAP)));
            const float bsum = wave_scan_add(lf), pmx = wave_scan_max(iv - bsum);
            const float inter = bsum + m_run, mt = fmaxf(inter, bsum + pmx);
            G[lane] = bsum - mt; G[64 + lane] = iv - bsum; G[128 + lane] = __expf(inter - mt); G[192 + lane] = __expf(-mt);
            const float blast = lane63(bsum), mnew = fmaxf(blast + m_run, blast + lane63(pmx));
            G[256 + lane] = __expf(blast - bsum + iv - mnew);
            if (lane == 0) G[320] = __expf(blast + m_run - mnew);
            m_run = mnew;
        };
        if (wave == 1) { { const int g = row_of(b, tok(dir, lane)); gi = SM[(size_t)g * SMW + (2 * dir) * MH + h]; gf = SM[(size_t)g * SMW + (2 * dir + 1) * MH + h]; }
            gate_tables(0);
            { const int g = row_of(b, tok(dir, 64 + lane)); gi = SM[(size_t)g * SMW + (2 * dir) * MH + h]; gf = SM[(size_t)g * SMW + (2 * dir + 1) * MH + h]; } }
        f32x4 Cacc = {0.f, 0.f, 0.f, 0.f}, Cacc2 = {0.f, 0.f, 0.f, 0.f};
        __syncthreads();
        for (int j = 0; j < NCH; ++j) {
            const LAS float* G = GT + (j & 1) * 384;
            { *(v4u*)(Qs + ss_ * ML_P + pc * 8) = rq; *(v4u*)(Ks + ss_ * ML_P + pc * 8) = rk;
              const unsigned kw[4] = {rk.x, rk.y, rk.z, rk.w};
#pragma unroll
              for (int i = 0; i < 4; ++i) { Kt[(pc * 8 + 2 * i) * ML_P + ss_] = (bf16)(kw[i] & 0xffffu); Kt[(pc * 8 + 2 * i + 1) * ML_P + ss_] = (bf16)(kw[i] >> 16); }
              if (pc < 4) { const unsigned vw[4] = {rv.x, rv.y, rv.z, rv.w};
#pragma unroll
                  for (int i = 0; i < 4; ++i) { Vt[(pc * 8 + 2 * i) * ML_P + ss_] = (bf16)(vw[i] & 0xffffu); Vt[(pc * 8 + 2 * i + 1) * ML_P + ss_] = (bf16)(vw[i] >> 16); } } }
            if (j + 1 < NCH) { const int g = row_of(b, tok(dir, (j + 1) * 64 + ss_)); rq = *(const v4u*)(Qg + (size_t)g * 512 + h * 64 + pc * 8); rk = *(const v4u*)(Kg + (size_t)g * 512 + h * 64 + pc * 8);
                if (pc < 4) rv = *(const v4u*)(Vg + (size_t)g * 1024 + h * 128 + vq * 32 + pc * 8); }
            __syncthreads();
            const int mt = wave >> 1, vnt = wave & 1;
            if (wave == 1 && j + 1 < NCH) { gate_tables((j + 1) & 1);
                if (j + 2 < NCH) { const int g = row_of(b, tok(dir, (j + 2) * 64 + lane)); gi = SM[(size_t)g * SMW + (2 * dir) * MH + h]; gf = SM[(size_t)g * SMW + (2 * dir + 1) * MH + h]; } }
            const bf16x8 qa0 = *(const LAS bf16x8*)(Qs + (16 * mt + r16) * ML_P + quad * 8), qa1 = *(const LAS bf16x8*)(Qs + (16 * mt + r16) * ML_P + 32 + quad * 8);
            f32x4 accq = {0.f, 0.f, 0.f, 0.f}, accqn = {0.f, 0.f, 0.f, 0.f};
            { const bf16x8 c0 = *(const LAS bf16x8*)(Cb + (16 * vnt + r16) * ML_P + quad * 8), c1 = *(const LAS bf16x8*)(Cb + (16 * vnt + r16) * ML_P + 32 + quad * 8);
              const bf16x8 n0 = *(const LAS bf16x8*)(Cb + (32 + r16) * ML_P + quad * 8), n1 = *(const LAS bf16x8*)(Cb + (32 + r16) * ML_P + 32 + quad * 8);
              accq = __builtin_amdgcn_mfma_f32_16x16x32_bf16(qa0, c0, accq, 0, 0, 0); accq = __builtin_amdgcn_mfma_f32_16x16x32_bf16(qa1, c1, accq, 0, 0, 0);
              accqn = __builtin_amdgcn_mfma_f32_16x16x32_bf16(qa0, n0, accqn, 0, 0, 0); accqn = __builtin_amdgcn_mfma_f32_16x16x32_bf16(qa1, n1, accqn, 0, 0, 0); }
#pragma unroll
            for (int nn = 0; nn < 2; ++nn) { const int nt = 2 * (wave & 1) + nn; f32x4 sacc = {0.f, 0.f, 0.f, 0.f};
                if (nt <= mt) { const bf16x8 k0 = *(const LAS bf16x8*)(Ks + (16 * nt + r16) * ML_P + quad * 8), k1 = *(const LAS bf16x8*)(Ks + (16 * nt + r16) * ML_P + 32 + quad * 8);
                    sacc = __builtin_amdgcn_mfma_f32_16x16x32_bf16(qa0, k0, sacc, 0, 0, 0); sacc = __builtin_amdgcn_mfma_f32_16x16x32_bf16(qa1, k1, sacc, 0, 0, 0); }
                const int s = 16 * nt + r16; const float wc_ = G[64 + s];
#pragma unroll
                for (int i = 0; i < 4; ++i) { const int t = 16 * mt + 4 * quad + i; const float p = (s <= t) ? sacc[i] * 0.125f * __expf(G[t] + wc_) : 0.f;
                    Ps[t * ML_P + s] = (bf16)(cvt_pk_bf16(p, 0.f) & 0xffffu); } }
            __syncthreads();
            { f32x4 acc = {0.f, 0.f, 0.f, 0.f}, accn = {0.f, 0.f, 0.f, 0.f};
#pragma unroll
              for (int ks = 0; ks < 2; ++ks) { if (ks == 1 && mt < 2) break;
                  const bf16x8 pa = *(const LAS bf16x8*)(Ps + (16 * mt + r16) * ML_P + 32 * ks + quad * 8);
                  const bf16x8 vb = *(const LAS bf16x8*)(Vt + (16 * vnt + r16) * ML_P + 32 * ks + quad * 8), ob = *(const LAS bf16x8*)(Vt + (32 + r16) * ML_P + 32 * ks + quad * 8);
                  acc = __builtin_amdgcn_mfma_f32_16x16x32_bf16(pa, vb, acc, 0, 0, 0); accn = __builtin_amdgcn_mfma_f32_16x16x32_bf16(pa, ob, accn, 0, 0, 0); }
#pragma unroll
              for (int i = 0; i < 4; ++i) { const int t = 16 * mt + 4 * quad + i; const float wi = G[128 + t] * 0.125f, dn = accn[i] + wi * accqn[i], inv = 1.0f / fmaxf(fabsf(dn), G[192 + t]);
                  const int g = row_of(b, tok(dir, j * 64 + t));
                  HF[((size_t)dir * R + g) * 1024 + h * 128 + vq * 32 + 16 * vnt + r16] = (bf16)(cvt_pk_bf16((acc[i] + wi * accq[i]) * inv, 0.f) & 0xffffu); } }
            { const float aold = G[320]; const int vmt = wave >> 2, dnt = wave & 3;
              f32x4 d1 = {0.f, 0.f, 0.f, 0.f}, d2 = {0.f, 0.f, 0.f, 0.f};
#pragma unroll
              for (int ks = 0; ks < 2; ++ks) {
                  const v4u kraw = *(const LAS v4u*)(Kt + (16 * dnt + r16) * ML_P + 32 * ks + quad * 8); float kf[8]; unpack8(kraw, kf);
                  const f32x4 a0 = *(const LAS f32x4*)&G[256 + 32 * ks + quad * 8], a1 = *(const LAS f32x4*)&G[256 + 32 * ks + quad * 8 + 4];
                  kf[0] *= a0.x; kf[1] *= a0.y; kf[2] *= a0.z; kf[3] *= a0.w; kf[4] *= a1.x; kf[5] *= a1.y; kf[6] *= a1.z; kf[7] *= a1.w;
                  const v4u kp = pack8(kf); const bf16x8 kb = __builtin_bit_cast(bf16x8, kp);
                  const bf16x8 va = *(const LAS bf16x8*)(Vt + (16 * vmt + r16) * ML_P + 32 * ks + quad * 8);
                  d1 = __builtin_amdgcn_mfma_f32_16x16x32_bf16(va, kb, d1, 0, 0, 0);
                  if (wave < 4) { const bf16x8 oa = *(const LAS bf16x8*)(Vt + (32 + r16) * ML_P + 32 * ks + quad * 8); d2 = __builtin_amdgcn_mfma_f32_16x16x32_bf16(oa, kb, d2, 0, 0, 0); } }
              Cacc = Cacc * aold + d1;
#pragma unroll
              for (int i = 0; i < 4; ++i) Cb[(16 * vmt + 4 * quad + i) * ML_P + 16 * dnt + r16] = (bf16)(cvt_pk_bf16(Cacc[i], 0.f) & 0xffffu);
              if (wave < 4) { Cacc2 = Cacc2 * aold + d2;
#pragma unroll
                  for (int i = 0; i < 4; ++i) Cb[(32 + 4 * quad + i) * ML_P + 16 * dnt + r16] = (bf16)(cvt_pk_bf16(Cacc2[i], 0.f) & 0xffffu); } }
            __syncthreads();
        }
    }
}

constexpr int RP = 72;
constexpr int RC_AB = 0, RC_BB = 9216, RC_KB = 18432, RC_RB = 27648, RC_BHT = 36864, RC_KHT = 46080, RC_ABT = 55296, RC_GAKT = 64512, RC_BONP = 67584;
constexpr int RC_TW = 0, RC_AD = 9216;
constexpr int RC_KK16 = 71680, RC_K16 = 80896, RC_R16 = 99328;
constexpr int RC_GAB = 71680, RC_GAK = 75776, RC_HRB = 78848, RC_HRK = 81920, RC_TT = 84992, RC_SAT = 88064, RC_YO = 93184;
constexpr int RC_GL = 109568, RC_VT = 110592, RC_SB = 119808, RC_CONST = 129024, RC_W2T = 133120, RC_A2T = 142336, RC_END = 151552;
static_assert(RC_END <= MISC_OFF && RC_YO + 16384 <= RC_GL && RC_BONP + 1024 <= RC_KK16 && RC_TT + 3072 <= RC_SAT && RC_SAT + 5120 <= RC_YO, "rwkv LDS map");
struct RwPre { f32x4 lw[2], lwn[2], la[2], lan[2]; v4u r, rn, k, kn, v, vn; };
__device__ __forceinline__ void rw_prefetch(RwPre& P, const float* SM, const bf16* RKV, int b, int dir, int h, int j, int tid) {
    const int s = tid >> 3, p8 = (tid & 7) * 8, g = row_of(b, tok(dir, j * 64 + s));
    { const int nb = nbrow(g, 3072); const float* a = SM + (size_t)g * SMW + 32 + 64 * dir + p8; const float* c = SM + (size_t)g * SMW + 160 + 64 * dir + p8;
      P.lw[0] = *(const f32x4*)a; P.lw[1] = *(const f32x4*)(a + 4); P.la[0] = *(const f32x4*)c; P.la[1] = *(const f32x4*)(c + 4);
      const f32x4 z = {0.f, 0.f, 0.f, 0.f}; P.lwn[0] = z; P.lwn[1] = z; P.lan[0] = z; P.lan[1] = z;
      if (nb >= 0) { const float* an = SM + (size_t)nb * SMW + 32 + 64 * dir + p8; const float* cn = SM + (size_t)nb * SMW + 160 + 64 * dir + p8;
          P.lwn[0] = *(const f32x4*)an; P.lwn[1] = *(const f32x4*)(an + 4); P.lan[0] = *(const f32x4*)cn; P.lan[1] = *(const f32x4*)(cn + 4); } }
    const v4u z4 = {0u, 0u, 0u, 0u};
    { const int rw = h * 64 + p8, nb = nbrow(g, rw); P.r = *(const v4u*)(RKV + (size_t)g * 3072 + rw); P.rn = nb >= 0 ? *(const v4u*)(RKV + (size_t)nb * 3072 + rw) : z4; }
    { const int rw = 1024 + h * 64 + p8, nb = nbrow(g, rw); P.k = *(const v4u*)(RKV + (size_t)g * 3072 + rw); P.kn = nb >= 0 ? *(const v4u*)(RKV + (size_t)nb * 3072 + rw) : z4; }
    { const int rw = 2048 + h * 64 + p8, nb = nbrow(g, rw); P.v = *(const v4u*)(RKV + (size_t)g * 3072 + rw); P.vn = nb >= 0 ? *(const v4u*)(RKV + (size_t)nb * 3072 + rw) : z4; }
}
__device__ __forceinline__ bf16x8 lds_frag(const LAS bf16* p) { return *(const LAS bf16x8*)p; }
__device__ __forceinline__ bf16x8 lds_frag_k16(const LAS bf16* p, int quad) { const bf16x8 v = *(const LAS bf16x8*)p; const bf16x8 z = {0, 0, 0, 0, 0, 0, 0, 0}; return quad < 2 ? v : z; }
__device__ __forceinline__ bf16x8 lds_frag_perm(const LAS bf16* p) { const v2u lo = *(const LAS v2u*)p, hi = *(const LAS v2u*)(p + 16); const v4u w = {lo.x, lo.y, hi.x, hi.y}; return __builtin_bit_cast(bf16x8, w); }
__device__ __forceinline__ bf16x8 lds_frag_lo4(const LAS bf16* p) { const v2u lo = *(const LAS v2u*)p; const v4u w = {lo.x, lo.y, 0u, 0u}; return __builtin_bit_cast(bf16x8, w); }
__device__ __forceinline__ unsigned pk2(float lo, float hi) { typedef __bf16 bf2 __attribute__((ext_vector_type(2))); const bf2 v = {(__bf16)lo, (__bf16)hi}; return __builtin_bit_cast(unsigned, v); }
__device__ __forceinline__ bf16 f2b(float x) { return __builtin_bit_cast(unsigned short, (__bf16)x); }
__device__ __forceinline__ float b2f(bf16 x) { return __uint_as_float((unsigned)x << 16); }
#define MFMA16(a, b, c) __builtin_amdgcn_mfma_f32_16x16x32_bf16(a, b, c, 0, 0, 0)
__device__ __forceinline__ void rwkv_phase(Frame& F, int l, int first, int stride) {
    LAS unsigned char* L = F.lds;
    LAS bf16* Ab = (LAS bf16*)(L + RC_AB); LAS bf16* Bb = (LAS bf16*)(L + RC_BB); LAS bf16* Kb = (LAS bf16*)(L + RC_KB); LAS bf16* Rb = (LAS bf16*)(L + RC_RB);
    LAS bf16* BhT = (LAS bf16*)(L + RC_BHT); LAS bf16* KhT = (LAS bf16*)(L + RC_KHT); LAS bf16* AbT = (LAS bf16*)(L + RC_ABT); LAS bf16* GAKT = (LAS bf16*)(L + RC_GAKT); LAS float* BONP = (LAS float*)(L + RC_BONP);
    LAS bf16* TW = (LAS bf16*)(L + RC_TW); LAS bf16* AD = (LAS bf16*)(L + RC_AD);
    LAS bf16* KK16 = (LAS bf16*)(L + RC_KK16); LAS bf16* K16 = (LAS bf16*)(L + RC_K16); LAS bf16* R16 = (LAS bf16*)(L + RC_R16);
    LAS float* GAB = (LAS float*)(L + RC_GAB); LAS bf16* GAK = (LAS bf16*)(L + RC_GAK); LAS bf16* HRB = (LAS bf16*)(L + RC_HRB); LAS bf16* HRK = (LAS bf16*)(L + RC_HRK); LAS bf16* TT = (LAS bf16*)(L + RC_TT);
    LAS bf16* SAt = (LAS bf16*)(L + RC_SAT); LAS float* YO = (LAS float*)(L + RC_YO); LAS float* GL = (LAS float*)(L + RC_GL);
    LAS bf16* Vt = (LAS bf16*)(L + RC_VT); LAS bf16* Sb = (LAS bf16*)(L + RC_SB); LAS float* CN = (LAS float*)(L + RC_CONST); LAS bf16* W2T = (LAS bf16*)(L + RC_W2T); LAS bf16* A2T = (LAS bf16*)(L + RC_A2T);
    const float* SM = (const float*)(F.ws + WS_SM); const bf16* RKV = (const bf16*)(F.ws + WS_RKV); bf16* YS = (bf16*)(F.ws + WS_YS); float* BON = (float*)(F.ws + WS_BON);
    const bf16* WL = (const bf16*)(F.ws + WS_WLORA);
    const int tid = F.tid, lane = F.lane, wave = F.wave;
    for (int item = first; item < NB * 2 * RH; item += stride) {
        const int h = item & 15, dir = (item >> 4) & 1, b = item >> 5;
        __syncthreads();
        if (tid < 64) { const float* mu = INP(I_MU) + l * RW; CN[tid] = mu[h * 64 + tid]; CN[64 + tid] = mu[1024 + h * 64 + tid]; CN[128 + tid] = mu[2048 + h * 64 + tid];
            CN[192 + tid] = mu[3072 + 64 * dir + tid]; CN[256 + tid] = mu[3200 + 64 * dir + tid];
            CN[320 + tid] = INP(I_KK)[l * RD + h * 64 + tid]; CN[384 + tid] = INP(I_KA)[l * RD + h * 64 + tid]; CN[448 + tid] = INP(I_RK)[l * RD + h * 64 + tid];
            CN[512 + tid] = INP(I_W0)[(l * 2 + dir) * RD + h * 64 + tid]; CN[576 + tid] = INP(I_A0)[(l * 2 + dir) * RD + h * 64 + tid]; }
        { const int n = tid >> 3, p8 = (tid & 7) * 8;
          *(v4u*)(W2T + n * 72 + p8) = *(const v4u*)(WL + ((size_t)(0 * 2 + dir) * RD + h * 64 + n) * 64 + p8);
          *(v4u*)(A2T + n * 72 + p8) = *(const v4u*)(WL + ((size_t)(1 * 2 + dir) * RD + h * 64 + n) * 64 + p8); }
        for (int i = tid; i < (RC_CONST - RC_GL) / 4; i += NTHREADS) ((LAS unsigned*)(L + RC_GL))[i] = 0u;
        f32x4 ST[4]; for (int kt = 0; kt < 4; ++kt) ST[kt] = (f32x4){0.f, 0.f, 0.f, 0.f};
        RwPre P; rw_prefetch(P, SM, RKV, b, dir, h, 0, tid);
        __syncthreads();
        for (int j = 0; j < NCH; ++j) {
            { int tl = tid; asm volatile("" : "+v"(tl)); const int s = tl >> 3, p8 = (tl & 7) * 8;
              { float tw[8], ad[8]; const f32x4 muw[2] = {*(const f32x4*)&CN[192 + p8], *(const f32x4*)&CN[196 + p8]}, mua[2] = {*(const f32x4*)&CN[256 + p8], *(const f32x4*)&CN[260 + p8]};
#pragma unroll
                for (int i = 0; i < 8; ++i) { const float pw = P.lw[i >> 2][i & 3], pwn = P.lwn[i >> 2][i & 3], pa = P.la[i >> 2][i & 3], pan = P.lan[i >> 2][i & 3];
                    tw[i] = fast_tanh(pw + (pwn - pw) * muw[i >> 2][i & 3]); ad[i] = pa + (pan - pa) * mua[i >> 2][i & 3]; }
                *(v4u*)(TW + s * 72 + p8) = pack8(tw); *(v4u*)(AD + s * 72 + p8) = pack8(ad); }
              { float a[8], bq[8], o[8]; const f32x4 mur[2] = {*(const f32x4*)&CN[p8], *(const f32x4*)&CN[4 + p8]}, muk[2] = {*(const f32x4*)&CN[64 + p8], *(const f32x4*)&CN[68 + p8]};
                unpack8(P.r, a); unpack8(P.rn, bq);
#pragma unroll
                for (int i = 0; i < 8; ++i) o[i] = a[i] + (bq[i] - a[i]) * mur[i >> 2][i & 3];
                *(v4u*)(R16 + s * RP + p8) = pack8(o);
                unpack8(P.k, a); unpack8(P.kn, bq); float ssq = 0.f; const f32x4 kkc[2] = {*(const f32x4*)&CN[320 + p8], *(const f32x4*)&CN[324 + p8]};
#pragma unroll
                for (int i = 0; i < 8; ++i) { o[i] = a[i] + (bq[i] - a[i]) * muk[i >> 2][i & 3]; a[i] = o[i] * kkc[i >> 2][i & 3]; ssq += a[i] * a[i]; }
                *(v4u*)(K16 + s * RP + p8) = pack8(o);
                const float inv = 1.0f / fmaxf(sqrtf(red8(ssq)), 1e-12f);
#pragma unroll
                for (int i = 0; i < 8; ++i) a[i] *= inv;
                *(v4u*)(KK16 + s * RP + p8) = pack8(a);
                { unpack8(P.v, a); unpack8(P.vn, bq); const f32x4 muv[2] = {*(const f32x4*)&CN[128 + p8], *(const f32x4*)&CN[132 + p8]};
#pragma unroll
                  for (int i = 0; i < 8; ++i) Vt[(p8 + i) * RP + s] = f2b(a[i] + (bq[i] - a[i]) * muv[i >> 2][i & 3]); } } }
            __syncthreads();
            if (j + 1 < NCH) rw_prefetch(P, SM, RKV, b, dir, h, j + 1, tid);
            { int lb = lane; asm volatile("" : "+v"(lb)); const int r16 = lb & 15, quad = lb >> 4; const int c = wave >> 1;
              const bf16x8 a0 = lds_frag(TW + (16 * c + r16) * 72 + quad * 8), a1 = lds_frag(TW + (16 * c + r16) * 72 + 32 + quad * 8);
              const bf16x8 d0 = lds_frag(AD + (16 * c + r16) * 72 + quad * 8), d1 = lds_frag(AD + (16 * c + r16) * 72 + 32 + quad * 8);
              f32x4 cw[2], ca[2];
#pragma unroll
              for (int nn = 0; nn < 2; ++nn) { const int nt = 2 * (wave & 1) + nn; const f32x4 z = {0.f, 0.f, 0.f, 0.f};
                  cw[nn] = MFMA16(a0, lds_frag(W2T + (16 * nt + r16) * 72 + quad * 8), z); cw[nn] = MFMA16(a1, lds_frag(W2T + (16 * nt + r16) * 72 + 32 + quad * 8), cw[nn]);
                  ca[nn] = MFMA16(d0, lds_frag(A2T + (16 * nt + r16) * 72 + quad * 8), z); ca[nn] = MFMA16(d1, lds_frag(A2T + (16 * nt + r16) * 72 + 32 + quad * 8), ca[nn]); }
              __syncthreads();
              float bsum[4] = {0.f, 0.f, 0.f, 0.f};
#pragma unroll
              for (int nn = 0; nn < 2; ++nn) { const int nt = 2 * (wave & 1) + nn, n = 16 * nt + r16; const float w0c = CN[512 + n], a0c = CN[576 + n], kac = CN[384 + n], rkc = CN[448 + n];
                  float wv[4], av[4], pin[4], pex[4];
#pragma unroll
                  for (int i = 0; i < 4; ++i) { wv[i] = __expf(-0.60653066f * sigmoidf_(w0c + cw[nn][i])); av[i] = sigmoidf_(a0c + ca[nn][i]); }
                  pin[0] = wv[0]; pin[1] = pin[0] * wv[1]; pin[2] = pin[1] * wv[2]; pin[3] = pin[2] * wv[3];
                  float x = pin[3], y = __shfl_up(x, 16); if (quad >= 1) x *= y; y = __shfl_up(x, 32); if (quad >= 2) x *= y;
                  float ex = __shfl_up(x, 16); if (quad == 0) ex = 1.0f; const float gl = __shfl(x, 48 + r16);
                  pex[0] = ex; pex[1] = ex * pin[0]; pex[2] = ex * pin[1]; pex[3] = ex * pin[2];
#pragma unroll
                  for (int i = 0; i < 4; ++i) pin[i] *= ex;
                  float abv[4], bhv[4], khv[4];
#pragma unroll
                  for (int i = 0; i < 4; ++i) { const int t = 16 * c + 4 * quad + i; const float kk = b2f(KK16[t * RP + n]), kx = b2f(K16[t * RP + n]), rr = b2f(R16[t * RP + n]);
                      const float kka = kk * av[i], kd = kx * (1.0f + (av[i] - 1.0f) * kac), gi_ = __builtin_amdgcn_rcpf(pin[i]), bb = kka * gi_, kb = kd * gi_;
                      abv[i] = kk * pex[i]; bhv[i] = bb * gl; khv[i] = kb * gl; bsum[i] += rr * kd * rkc;
                      Ab[t * RP + n] = f2b(abv[i]); Rb[t * RP + n] = f2b(rr * pin[i]); Bb[t * RP + n] = f2b(bb); Kb[t * RP + n] = f2b(kb); }
                  { v2u o; o.x = cvt_pk_bf16(abv[0], abv[1]); o.y = cvt_pk_bf16(abv[2], abv[3]); *(v2u*)(AbT + n * RP + 16 * c + 4 * quad) = o;
                    o.x = cvt_pk_bf16(bhv[0], bhv[1]); o.y = cvt_pk_bf16(bhv[2], bhv[3]); *(v2u*)(BhT + n * RP + 16 * c + 4 * quad) = o;
                    o.x = cvt_pk_bf16(khv[0], khv[1]); o.y = cvt_pk_bf16(khv[2], khv[3]); *(v2u*)(KhT + n * RP + 16 * c + 4 * quad) = o; }
                  if (quad == 3) GL[c * 64 + n] = gl;
              }
#pragma unroll
              for (int i = 0; i < 4; ++i) { const float tot = red16(bsum[i]); if (r16 == 0) BONP[(16 * c + 4 * quad + i) * 2 + (wave & 1)] = tot; } }
            __syncthreads();
            { int lf_ = lane; asm volatile("" : "+v"(lf_)); const int r16 = lf_ & 15, quad = lf_ >> 4; const int c = wave & 3, odd = wave >> 2; const LAS bf16* Asrc = odd ? Rb : Ab;     const f32x4 z = {0.f, 0.f, 0.f, 0.f};
              const bf16x8 a0 = lds_frag(Asrc + (16 * c + r16) * RP + quad * 8), a1 = lds_frag(Asrc + (16 * c + r16) * RP + 32 + quad * 8);
              f32x4 g1 = MFMA16(a0, lds_frag(Bb + (16 * c + r16) * RP + quad * 8), z); g1 = MFMA16(a1, lds_frag(Bb + (16 * c + r16) * RP + 32 + quad * 8), g1);
              f32x4 g2 = MFMA16(a0, lds_frag(Kb + (16 * c + r16) * RP + quad * 8), z); g2 = MFMA16(a1, lds_frag(Kb + (16 * c + r16) * RP + 32 + quad * 8), g2);
              if (wave == 7) { const float bs = BONP[lf_ * 2] + BONP[lf_ * 2 + 1]; BON[((size_t)dir * R + row_of(b, tok(dir, j * 64 + lf_))) * RH + h] = bs; }
              float v2m[4];
#pragma unroll
              for (int i = 0; i < 4; ++i) { const int t = 4 * quad + i; const bool keep = odd ? (r16 <= t) : (r16 < t); const float v1 = keep ? g1[i] : 0.f; v2m[i] = keep ? g2[i] : 0.f;
                  if (odd) { HRB[c * 384 + t * 24 + r16] = f2b(v1); HRK[c * 384 + t * 24 + r16] = f2b(v2m[i]); } else { GAB[c * 256 + t * 16 + r16] = v1; GAK[c * 384 + t * 24 + r16] = f2b(v2m[i]); } }
              if (!odd) { { v2u o; o.x = cvt_pk_bf16(v2m[0], v2m[1]); o.y = cvt_pk_bf16(v2m[2], v2m[3]); *(v2u*)(GAKT + c * 384 + r16 * 24 + 4 * quad) = o; }
                  LDS_WAIT(); __builtin_amdgcn_wave_barrier();
                  float tj[16];
                  tj[0] = (r16 == 0) ? 1.0f : 0.f;
#pragma unroll
                  for (int i = 1; i < 16; ++i) { const LAS f32x4* gr = (const LAS f32x4*)(GAB + c * 256 + i * 16); float acc0 = (r16 == i) ? 1.0f : 0.f, acc1 = 0.f;
#pragma unroll
                      for (int q = 0; q < (i + 3) / 4; ++q) { const f32x4 g4 = gr[q];
#pragma unroll
                          for (int e = 0; e < 4; ++e) { const int jj = 4 * q + e; if (jj < i) { if (jj & 1) acc1 -= g4[e] * tj[jj]; else acc0 -= g4[e] * tj[jj]; } } }
                      tj[i] = acc0 + acc1; }
                  if (quad == 0) {
#pragma unroll
                      for (int i = 0; i < 16; ++i) TT[c * 384 + i * 24 + r16] = f2b(tj[i]); } } }
            __syncthreads();
            { int lg = lane; asm volatile("" : "+v"(lg)); const int r16 = lg & 15, quad = lg >> 4; const int c = wave & 3, half = wave >> 2; const f32x4 z = {0.f, 0.f, 0.f, 0.f};
              const bf16x8 ta = lds_frag_k16(TT + c * 384 + r16 * 24 + quad * 8, quad);
              f32x4 o0 = MFMA16(ta, lds_frag(AbT + (16 * (2 * half) + r16) * RP + 16 * c + (quad & 1) * 8), z), o1 = MFMA16(ta, lds_frag(AbT + (16 * (2 * half + 1) + r16) * RP + 16 * c + (quad & 1) * 8), z);
              f32x4 og = z; if (!half) og = MFMA16(ta, lds_frag(GAKT + c * 384 + r16 * 24 + (quad & 1) * 8), z);
#pragma unroll
              for (int i = 0; i < 4; ++i) { const int t = 4 * quad + i; Ab[(16 * c + t) * RP + 16 * (2 * half) + r16] = f2b(o0[i]); Ab[(16 * c + t) * RP + 16 * (2 * half + 1) + r16] = f2b(o1[i]); if (!half) GAK[c * 384 + t * 24 + r16] = f2b(og[i]); } }
            __syncthreads();
            if (wave < 4) {
                int lc = lane; asm volatile("" : "+v"(lc)); const int r16 = lc & 15, quad = lc >> 4, vnt = wave;
#pragma unroll 1
                for (int c = 0; c < 4; ++c) {
                    bf16x8 sb[2];
#pragma unroll
                    for (int ks = 0; ks < 2; ++ks) { v4u w; w.x = pk2(ST[2 * ks][0], ST[2 * ks][1]); w.y = pk2(ST[2 * ks][2], ST[2 * ks][3]); w.z = pk2(ST[2 * ks + 1][0], ST[2 * ks + 1][1]); w.w = pk2(ST[2 * ks + 1][2], ST[2 * ks + 1][3]); sb[ks] = __builtin_bit_cast(bf16x8, w); }
                    const v2u vmw = *(const LAS v2u*)(Vt + (16 * vnt + r16) * RP + 16 * c + 4 * quad); const v4u vm4 = {vmw.x, vmw.y, 0u, 0u}; const bf16x8 vmb = __builtin_bit_cast(bf16x8, vm4);
                    f32x4 sa = {0.f, 0.f, 0.f, 0.f}, yy = {0.f, 0.f, 0.f, 0.f};
#pragma unroll
                    for (int ks = 0; ks < 2; ++ks) { sa = MFMA16(lds_frag_perm(Ab + (16 * c + r16) * RP + 32 * ks + 4 * quad), sb[ks], sa); yy = MFMA16(lds_frag_perm(Rb + (16 * c + r16) * RP + 32 * ks + 4 * quad), sb[ks], yy); }
                    sa = MFMA16(lds_frag_lo4(GAK + c * 384 + r16 * 24 + 4 * quad), vmb, sa); yy = MFMA16(lds_frag_lo4(HRK + c * 384 + r16 * 24 + 4 * quad), vmb, yy);
                    const v4u sa4 = {pk2(sa[0], sa[1]), pk2(sa[2], sa[3]), 0u, 0u}; const bf16x8 sab = __builtin_bit_cast(bf16x8, sa4);
                    const f32x4 z = {0.f, 0.f, 0.f, 0.f};
                    const f32x4 dy = MFMA16(lds_frag_lo4(HRB + c * 384 + r16 * 24 + 4 * quad), sab, z);
#pragma unroll
                    for (int i = 0; i < 4; ++i) YO[(16 * c + 4 * quad + i) * 64 + 16 * vnt + r16] = yy[i] - dy[i];
#pragma unroll
                    for (int kt = 0; kt < 4; ++kt) { const f32x4 e_ = MFMA16(lds_frag_lo4(BhT + (16 * kt + r16) * RP + 16 * c + 4 * quad), sab, z), d_ = MFMA16(lds_frag_lo4(KhT + (16 * kt + r16) * RP + 16 * c + 4 * quad), vmb, z);
                        const f32x4 gl4 = *(const LAS f32x4*)&GL[c * 64 + 16 * kt + 4 * quad]; ST[kt] = ST[kt] * gl4 + d_ - e_; }
                }
            }
            __syncthreads();
            { int to = tid; asm volatile("" : "+v"(to)); const int s4 = to >> 3, q8 = (to & 7) * 8; const f32x4 y0 = *(const f32x4*)&YO[s4 * 64 + q8], y1 = *(const f32x4*)&YO[s4 * 64 + q8 + 4];
              v4u o; o.x = cvt_pk_bf16(y0.x, y0.y); o.y = cvt_pk_bf16(y0.z, y0.w); o.z = cvt_pk_bf16(y1.x, y1.y); o.w = cvt_pk_bf16(y1.z, y1.w);
              *(v4u*)(YS + ((size_t)dir * R + row_of(b, tok(dir, j * 64 + s4))) * RD + h * 64 + q8) = o; }
            __syncthreads();
        }
    }
}
template <int PART> __device__ __forceinline__ void finish_phase(Frame& F, int l, int nrows, int first, int stride) {
    const bf16* HF = (const bf16*)(F.ws + WS_HF); const bf16* O = (const bf16*)(F.ws + WS_O); bf16* HM = (bf16*)(F.ws + WS_HM);
    const bf16* YS = (const bf16*)(F.ws + WS_YS); const bf16* RKV = (const bf16*)(F.ws + WS_RKV); const bf16* Gb = (const bf16*)(F.ws + WS_H); const float* BON = (const float*)(F.ws + WS_BON); bf16* YR = (bf16*)(F.ws + WS_YR);
    const int lane = F.lane, c0 = lane * 16;
    float k1[16], k2[16], k3[16];
    { const float* p1 = PART == 0 ? INP(I_GMN) + l * 1024 + c0 : INP(I_LNW) + l * RD + c0; const float* p2 = INP(I_LNB) + l * RD + c0; const float* p3 = INP(I_MU) + l * RW + 2048 + c0;
#pragma unroll
      for (int q = 0; q < 4; ++q) { const f32x4 t1 = *(const f32x4*)(p1 + 4 * q); k1[4 * q] = t1.x; k1[4 * q + 1] = t1.y; k1[4 * q + 2] = t1.z; k1[4 * q + 3] = t1.w;
          if (PART == 1) { const f32x4 t2 = *(const f32x4*)(p2 + 4 * q), t3 = *(const f32x4*)(p3 + 4 * q); k2[4 * q] = t2.x; k2[4 * q + 1] = t2.y; k2[4 * q + 2] = t2.z; k2[4 * q + 3] = t2.w; k3[4 * q] = t3.x; k3[4 * q + 1] = t3.y; k3[4 * q + 2] = t3.z; k3[4 * q + 3] = t3.w; } } }
    const bf16* S0 = PART == 0 ? HF : YS;
    int g = first * NWAVES + F.wave; const int gstep = stride * NWAVES;
    v4u n0 = {0u, 0u, 0u, 0u}, n1 = n0, n2 = n0, n3 = n0;
    if (g < nrows) { n0 = *(const v4u*)(S0 + (size_t)g * 1024 + c0); n1 = *(const v4u*)(S0 + ((size_t)R + g) * 1024 + c0); n2 = *(const v4u*)(S0 + (size_t)g * 1024 + c0 + 8); n3 = *(const v4u*)(S0 + ((size_t)R + g) * 1024 + c0 + 8); }
    for (; g < nrows; g += gstep) {
        const v4u c_0 = n0, c_1 = n1, c_2 = n2, c_3 = n3;
        { const int gn = g + gstep; if (gn < nrows) { n0 = *(const v4u*)(S0 + (size_t)gn * 1024 + c0); n1 = *(const v4u*)(S0 + ((size_t)R + gn) * 1024 + c0); n2 = *(const v4u*)(S0 + (size_t)gn * 1024 + c0 + 8); n3 = *(const v4u*)(S0 + ((size_t)R + gn) * 1024 + c0 + 8); } }
        float y[16], a[8], bq[8];
        unpack8(c_0, a); unpack8(c_1, bq);
#pragma unroll
        for (int i = 0; i < 8; ++i) y[i] = a[i] + bq[i];
        unpack8(c_2, a); unpack8(c_3, bq);
#pragma unroll
        for (int i = 0; i < 8; ++i) y[8 + i] = a[i] + bq[i];
        if (PART == 0) {
            float ss = 0.f;
#pragma unroll
            for (int i = 0; i < 16; ++i) ss += y[i] * y[i];
            const float rs = 1.0f / sqrtf(red8(ss) * (1.0f / DV) + NORM_EPS);
            float og[16]; unpack8(*(const v4u*)(O + (size_t)g * 1024 + c0), a); unpack8(*(const v4u*)(O + (size_t)g * 1024 + c0 + 8), bq);
#pragma unroll
            for (int i = 0; i < 8; ++i) { og[i] = a[i]; og[8 + i] = bq[i]; }
            float o1[8], o2[8];
#pragma unroll
            for (int i = 0; i < 8; ++i) { o1[i] = y[i] * rs * k1[i] * sigmoidf_(og[i]); o2[i] = y[8 + i] * rs * k1[8 + i] * sigmoidf_(og[8 + i]); }
            *(v4u*)(HM + (size_t)g * 1024 + c0) = pack8(o1); *(v4u*)(HM + (size_t)g * 1024 + c0 + 8) = pack8(o2);
        }
        if (PART == 1) {
            float sm_ = 0.f;
#pragma unroll
            for (int i = 0; i < 16; ++i) sm_ += y[i];
            const float mean = red4(sm_) * (1.0f / RN); float vs = 0.f;
#pragma unroll
            for (int i = 0; i < 16; ++i) { const float dl = y[i] - mean; vs += dl * dl; }
            const float rs = 1.0f / sqrtf(red4(vs) * (1.0f / RN) + GN_EPS);
            const int hh = lane >> 2; const float bon = BON[(size_t)g * RH + hh] + BON[((size_t)R + g) * RH + hh];
            float vm[16], gg[16];
#pragma unroll
            for (int half = 0; half < 2; ++half) { const int rw = 2048 + c0 + 8 * half, nb = nbrow(g, rw); unpack8(*(const v4u*)(RKV + (size_t)g * 3072 + rw), a);
                if (nb >= 0) unpack8(*(const v4u*)(RKV + (size_t)nb * 3072 + rw), bq); else {
#pragma unroll
                    for (int i = 0; i < 8; ++i) bq[i] = 0.f; }
#pragma unroll
                for (int i = 0; i < 8; ++i) vm[8 * half + i] = a[i] + (bq[i] - a[i]) * k3[8 * half + i];
                unpack8(*(const v4u*)(Gb + (size_t)g * RD + c0 + 8 * half), a);
#pragma unroll
                for (int i = 0; i < 8; ++i) gg[8 * half + i] = a[i]; }
            float o1[8], o2[8];
#pragma unroll
            for (int i = 0; i < 8; ++i) { o1[i] = ((y[i] - mean) * rs * k1[i] + k2[i] + bon * vm[i]) * gg[i]; o2[i] = ((y[8 + i] - mean) * rs * k1[8 + i] + k2[8 + i] + bon * vm[8 + i]) * gg[8 + i]; }
            *(v4u*)(YR + (size_t)g * RD + c0) = pack8(o1); *(v4u*)(YR + (size_t)g * RD + c0 + 8) = pack8(o2);
        }
    }
}
struct MoeMeta { int off[NE + 1]; };
__device__ __forceinline__ MoeMeta moe_meta(Frame& F) {
    MoeMeta m; int o = 0;
#pragma unroll
    for (int e = 0; e < NE; ++e) { m.off[e] = o; const unsigned c = __hip_atomic_load((unsigned*)(F.ctl + CW_ECNT + 64 * e), RLX_AGENT); o += (int)((c + 255u) & ~255u); }
    m.off[NE] = o; return m;
}
__device__ __forceinline__ void gather_phase(Frame& F) {
    const MoeMeta m = moe_meta(F);
    if (F.bid == 0 && F.tid < MAXSLOT / 256) { int e = 0;
#pragma unroll
        for (int q = 1; q <= NE - 1; ++q) e += ((int)F.tid * 256 >= m.off[q]) ? 1 : 0;
        ((int*)(F.ws + WS_META + 768 * 1024))[F.tid] = e; }
    const bf16* H = (const bf16*)(F.ws + WS_H); unsigned char* HG = (unsigned char*)(F.ws + WS_HG);
    for (int w = F.bid * NWAVES + F.wave; w < RL * 2; w += F.G * NWAVES) { const int g = w >> 1, k = w & 1; int* tk = (int*)(F.ws + WS_META) + (size_t)g * 8; const int e = tk[k], pos = tk[2 + k];
        int base = 0;
#pragma unroll
        for (int q = 0; q < NE; ++q) base = (e == q) ? m.off[q] : base;
        const int slot = base + pos; if (F.lane == 0) tk[6 + k] = slot;
        const v4u* src = (const v4u*)(H + (size_t)g * D); float a[8], c8[8];
        unpack8(src[2 * F.lane], a); unpack8(src[2 * F.lane + 1], c8);
        v4u o; o.x = pk4_fp8(a[0], a[1], a[2], a[3]); o.y = pk4_fp8(a[4], a[5], a[6], a[7]); o.z = pk4_fp8(c8[0], c8[1], c8[2], c8[3]); o.w = pk4_fp8(c8[4], c8[5], c8[6], c8[7]);
        *(v4u*)(HG + (size_t)slot * D + 16 * F.lane) = o; }
}
__device__ __forceinline__ void final_phase(Frame& F, const float* MODl) {
    const bf16* Y2 = (const bf16*)(F.ws + WS_Y2); const float* gfp = INP(I_GF);
    f32x4 gf[4];
#pragma unroll
    for (int j = 0; j < 4; ++j) gf[j] = *(const f32x4*)(gfp + 256 * j + 4 * F.lane);
    int g = F.bid * NWAVES + F.wave; const int gstep = F.G * NWAVES;
    int s0n = 0, s1n = 0; float p0n = 0.f, p1n = 0.f;
    if (g < RL) { const int* tk = (const int*)(F.ws + WS_META) + (size_t)g * 8; s0n = tk[6]; s1n = tk[7]; p0n = ((const float*)tk)[4]; p1n = ((const float*)tk)[5]; }
    for (; g < RL; g += gstep) {
        const int s0 = s0n, s1 = s1n; const float p0 = p0n, p1 = p1n;
        float* xr = (float*)F.out + (size_t)g * D; const float* gt = MODl + (g / T) * 6 * D + 5 * D; f32x4 x[4], gq[4]; v2u ya[4], yb[4];
#pragma unroll
        for (int j = 0; j < 4; ++j) { const int c = 256 * j + 4 * F.lane; x[j] = *(const f32x4*)(xr + c); gq[j] = *(const f32x4*)(gt + c); ya[j] = *(const v2u*)(Y2 + (size_t)s0 * D + c); yb[j] = *(const v2u*)(Y2 + (size_t)s1 * D + c); }
        { const int gn = g + gstep; if (gn < RL) { const int* tk = (const int*)(F.ws + WS_META) + (size_t)gn * 8; s0n = tk[6]; s1n = tk[7]; p0n = ((const float*)tk)[4]; p1n = ((const float*)tk)[5]; } }
        f32x4 v[4]; float ss = 0.f;
#pragma unroll
        for (int j = 0; j < 4; ++j) { const v2u a = ya[j], bq = yb[j];
            f32x4 y; y.x = p0 * bflo(a.x) + p1 * bflo(bq.x); y.y = p0 * bfhi(a.x) + p1 * bfhi(bq.x); y.z = p0 * bflo(a.y) + p1 * bflo(bq.y); y.w = p0 * bfhi(a.y) + p1 * bfhi(bq.y);
            v[j] = x[j] + gq[j] * y; ss += (v[j].x * v[j].x + v[j].y * v[j].y) + (v[j].z * v[j].z + v[j].w * v[j].w); }
        const float rstd = 1.0f / sqrtf(wave_sum(ss) * (1.0f / D) + NORM_EPS);
#pragma unroll
        for (int j = 0; j < 4; ++j) { const int c = 256 * j + 4 * F.lane; *(f32x4*)(xr + c) = v[j] * rstd * gf[j]; }
    }
}

#ifndef MK_SPLIT
#define MK_SPLIT 0
#endif
constexpr int PPL = 12, NPHASE = 1 + NL * PPL + 1;
__device__ __forceinline__ GAS unsigned char* launder_ws(GAS unsigned char* p) { asm volatile("" : "+s"(p)); return p; }
__device__ __forceinline__ const CAS Args* launder_args(const CAS Args* p) { asm volatile("" : "+s"(p)); return p; }
__device__ __forceinline__ void grid_barrier(unsigned* barw, unsigned x, volatile LAS unsigned* st) { XcdBarrier b; b.bar = barw; b.x = x; b.st = st; xcd_barrier(b); }
#define IN(k) (lo <= (k) && (k) < hi)
#define SEAM(k) do { if (IN(k) && IN((k) + 1)) grid_barrier(bar.bar, bar.x, bar.st); } while (0)
#define PH_BEGIN { int t_ = threadIdx.x; asm volatile("" : "+v"(t_)); F.tid = t_; F.lane = t_ & 63; F.wave = __builtin_amdgcn_readfirstlane(t_ >> 6); int b_ = blockIdx.x; asm volatile("" : "+s"(b_)); F.bid = b_; F.cb = b_; F.cg = F.G; } \
        GAS unsigned char* ws = launder_ws(args.ws); F.ws = ws; F.A = launder_args((const CAS Args*)__builtin_amdgcn_kernarg_segment_ptr()); float* MOD = (float*)(ws + WS_MOD); float* XC = (float*)(ws + WS_XC); bf16* Hb = (bf16*)(ws + WS_H); \
        const float* MODl = MOD + (size_t)l * 5 * 6 * D; const float* xl = l == 0 ? INP(I_X) : (const float*)F.out; const float* xc = l == 0 ? INP(I_CTX) : XC; (void)MODl; (void)xl; (void)xc; (void)Hb;
template <int l> __device__ __forceinline__ void layer_body(Frame& F, const Args& args, const int lo, const int hi, const XcdBarrier& bar) {
        const int p0 = 1 + l * PPL; const bool last = (l == NL - 1);
        const int Mrows = last ? RL : R;
        if (IN(p0 + 0)) { PH_BEGIN normmod_phase<false>(F, xl, xc, INP(I_GNM) + l * D, MODl, 0, D, R, nullptr); if (l > 0) conv_rest(F, l); }
        SEAM(p0 + 0);
        if (IN(p0 + 1)) { PH_BEGIN pg8::Gemm g{Hb, (const bf16*)(ws + WS_WIN), R, NPAD, D}; pg8::EpiInproj E{ws};
            if (!last) { pg8::StaticOrder S; S.init(R, NPAD, F.G, F.bid); pg8::gemm_phase<pg8::EpiInproj, pg8::StaticOrder, true, true>(F.lds, g, S, E); }
            else { pg8::InprojLastOrder S; S.G = F.G; S.c = F.bid; pg8::gemm_phase<pg8::EpiInproj, pg8::InprojLastOrder, true, true>(F.lds, g, S, E); } }
        if (IN(p0 + 1) && IN(p0 + 3)) grid_barrier(bar.bar, bar.x, bar.st);
        if (IN(p0 + 3)) { PH_BEGIN const int nR = F.G / 2;
            if (F.bid < nR) rwkv_phase(F, l, F.bid, nR);
            else { F.cb = F.bid - nR; F.cg = F.G - nR; gu32* sub = F.ctl + CW_SUB + 64 * l;
                   sg_phase(F, l); subgrid_arrive(F, sub);
                   mlstm_phase(F, l, F.cb, F.cg); __syncthreads();
                   if (!last) { conv_ffn0(F); conv_win(F, l + 1); }
                   subgrid_arrive(F, sub + 128);
                   subgrid_wait(F, sub, (unsigned)F.cg); subgrid_wait(F, sub + 128, (unsigned)F.cg);
                   finish_phase<0>(F, l, Mrows, F.cb, F.cg); } }
        if (IN(p0 + 3)) { PH_BEGIN const int nR = F.G / 2;
            if (F.bid >= nR) { int kg = 256; asm volatile("" : "+s"(kg));
                pg8::Gemm g{(const bf16*)(ws + WS_SG), (const bf16*)(ws + WS_WG2), R, RD, kg}; pg8::StaticOrder S; S.init(Mrows, RD, F.G - nR, F.bid - nR);
                pg8::EpiStore E{Hb, RD};
                pg8::gemm_phase<pg8::EpiStore, pg8::StaticOrder, true, true>(F.lds, g, S, E); } }
        SEAM(p0 + 3);
        if (IN(p0 + 4)) { PH_BEGIN finish_phase<1>(F, l, Mrows, F.bid, F.G); }
        SEAM(p0 + 4);
        if (IN(p0 + 5)) { PH_BEGIN pg8::Gemm g{(const bf16*)(ws + WS_HM), (const bf16*)(ws + WS_WPM), Mrows, D, D}; pg8::StaticOrder S; S.init(Mrows, D, F.G, F.bid);
            pg8::EpiMerge<0> E{(const bf16*)(ws + WS_MGT), (bf16*)(ws + WS_T1), nullptr};
            pg8::gemm_phase<pg8::EpiMerge<0>, pg8::StaticOrder, true, true>(F.lds, g, S, E); }
        SEAM(p0 + 5);
        if (IN(p0 + 6)) { PH_BEGIN pg8::Gemm g{(const bf16*)(ws + WS_YR), (const bf16*)(ws + WS_WPR), Mrows, D, D}; pg8::StaticOrder S; S.init(Mrows, D, F.G, F.bid);
            pg8::EpiMerge<1> E{(const bf16*)(ws + WS_MGT), (bf16*)(ws + WS_T1), Hb};
            pg8::gemm_phase<pg8::EpiMerge<1>, pg8::StaticOrder, true, true>(F.lds, g, S, E); }
        SEAM(p0 + 6);
        if (IN(p0 + 7)) { PH_BEGIN pg8::Gemm g{Hb, (const bf16*)(ws + WS_WOUT), Mrows, D, D}; pg8::StaticOrder S; S.init(Mrows, D, F.G, F.bid);
            pg8::EpiResid E{xl, xc, (float*)F.out, XC, MODl + 2 * D};
            pg8::gemm_phase<pg8::EpiResid, pg8::StaticOrder, true, true>(F.lds, g, S, E); }
        SEAM(p0 + 7);
        if (IN(p0 + 8)) { PH_BEGIN if (!last) normmod_phase<false>(F, (const float*)F.out, XC, INP(I_GNF) + l * D, MODl, 3 * D, 4 * D, Mrows, nullptr);
                          else normmod_phase<true>(F, (const float*)F.out, XC, INP(I_GNF) + l * D, MODl, 3 * D, 4 * D, Mrows, INP(I_WR)); }
        SEAM(p0 + 8);
        if (!last) {
            if (IN(p0 + 9)) { PH_BEGIN pg8::Gemm g{Hb, (const bf16*)(ws + WS_WGU), Mrows, 2 * FF, D}; pg8::StaticOrder S; S.init(Mrows, 2 * FF, F.G, F.bid);
                pg8::EpiSwiglu E{(bf16*)(ws + WS_HH0), FF};
                pg8::gemm_phase<pg8::EpiSwiglu, pg8::StaticOrder, true, true>(F.lds, g, S, E); }
            SEAM(p0 + 9);
            if (IN(p0 + 10)) { PH_BEGIN pg8::Gemm g{(const bf16*)(ws + WS_HH0), (const bf16*)(ws + WS_WDN), Mrows, D, FF}; pg8::StaticOrder S; S.init(Mrows, D, F.G, F.bid);
                pg8::EpiResid E{(const float*)F.out, XC, (float*)F.out, XC, MODl + 5 * D};
                pg8::gemm_phase<pg8::EpiResid, pg8::StaticOrder, true, true>(F.lds, g, S, E); }
            if (IN(p0 + 10) && IN(p0 + 12)) grid_barrier(bar.bar, bar.x, bar.st);
        } else {
            if (IN(p0 + 9)) { PH_BEGIN conv_experts(F); gather_phase(F); }
            SEAM(p0 + 9);
            if (IN(p0 + 10)) { PH_BEGIN const MoeMeta mm = moe_meta(F); pg8::MoeOrder S; S.ntiles = mm.off[NE] / 256; S.nN = 2 * FE / 256; S.nwg = S.ntiles * S.nN; S.G = F.G; S.c = F.bid; S.texp = (const int*)(ws + WS_META + 768 * 1024);
                int ke = D / 2; asm volatile("" : "+s"(ke));
                pg8::Gemm g{(const bf16*)(ws + WS_HG), (const bf16*)(ws + WS_WEGU), 0, 2 * FE, ke}; pg8::EpiSwiglu8 E{(unsigned char*)(ws + WS_HHE), FE};
                pg8::gemm_phase<pg8::EpiSwiglu8, pg8::MoeOrder, true, true, true>(F.lds, g, S, E); }
            SEAM(p0 + 10);
            if (IN(p0 + 11)) { PH_BEGIN const MoeMeta mm = moe_meta(F); pg8::MoeOrder S; S.ntiles = mm.off[NE] / 256; S.nN = D / 256; S.nwg = S.ntiles * S.nN; S.G = F.G; S.c = F.bid; S.texp = (const int*)(ws + WS_META + 768 * 1024);
                int ke = FE / 2; asm volatile("" : "+s"(ke));
                pg8::Gemm g{(const bf16*)(ws + WS_HHE), (const bf16*)(ws + WS_WEDN), 0, D, ke}; pg8::EpiStoreScaled E{(bf16*)(ws + WS_Y2), D, 1.0f / W8S};
                pg8::gemm_phase<pg8::EpiStoreScaled, pg8::MoeOrder, true, true, true>(F.lds, g, S, E); }
            SEAM(p0 + 11);
        }
    }
__global__ void __launch_bounds__(NTHREADS, 2) mk_fwd(Args args) {
    extern __shared__ __attribute__((aligned(16))) unsigned char lds[];
    Frame F;
    F.lds = (LAS unsigned char*)lds; F.MISC = (volatile LAS unsigned*)(F.lds + MISC_OFF);
    F.tid = threadIdx.x; F.lane = F.tid & 63; F.wave = __builtin_amdgcn_readfirstlane(F.tid >> 6); F.G = gridDim.x; F.bid = blockIdx.x;
    F.ws = args.ws; F.out = args.out; F.ctl = (gu32*)(args.ws + WS_CTL);
    F.A = (const CAS Args*)__builtin_amdgcn_kernarg_segment_ptr();
    if (F.tid < 64) F.MISC[F.tid] = 0u;
    __syncthreads();
    const int lo = args.ph_lo, hi = args.ph_hi;
    XcdBarrier bar; bar.bar = (unsigned*)(F.ctl + CW_BAR) + args.li * XCD_BAR_WORDS; bar.x = 0; bar.st = nullptr;
    if (hi - lo > 1) bar = xcd_barrier_post((unsigned*)(F.ctl + CW_BAR) + args.li * XCD_BAR_WORDS, F.MISC + 8);

    if (IN(0)) { const int l = 0; PH_BEGIN mod_phase(F); conv_win(F, 0); conv_rest(F, 0); }
    SEAM(0);

    layer_body<0>(F, args, lo, hi, bar);
    layer_body<1>(F, args, lo, hi, bar);
    if (IN(NPHASE - 1)) { const int l = NL - 1; PH_BEGIN final_phase(F, MODl); }
#undef IN
#undef SEAM
}

extern "C" void kernel_launch(void* const* d_in, const int* in_sizes, int n_in, void* d_out, int out_size, void* d_ws, size_t ws_size, hipStream_t stream) {
    static int grid = 0;
    if (grid == 0) {
        if (n_in != 33 || out_size != RL * D || ws_size < WS_NEED) { fprintf(stderr, "kernel_launch: unexpected problem (n_in %d, out %d, ws %zu < %zu)\n", n_in, out_size, ws_size, (size_t)WS_NEED); grid = -1; return; }
        int dev = 0, cus = 0, per_cu = 0;
        if (hipGetDevice(&dev) != hipSuccess || hipDeviceGetAttribute(&cus, hipDeviceAttributeMultiprocessorCount, dev) != hipSuccess) { grid = -1; return; }
        if (hipFuncSetAttribute((const void*)mk_fwd, hipFuncAttributeMaxDynamicSharedMemorySize, LDS_BYTES) != hipSuccess) { fprintf(stderr, "kernel_launch: hipFuncSetAttribute failed\n"); grid = -1; return; }
        if (hipOccupancyMaxActiveBlocksPerMultiprocessor(&per_cu, (const void*)mk_fwd, NTHREADS, LDS_BYTES) != hipSuccess || per_cu < 1) { fprintf(stderr, "kernel_launch: occupancy query says %d\n", per_cu); grid = -1; (void)hipGetLastError(); return; }
        grid = cus;
    }
    if (grid < 0) return;
    (void)hipMemsetAsync((char*)d_ws + WS_CTL, 0, CTL_ZERO_BYTES, stream);
    Args a{};
    for (int i = 0; i < 33; ++i) a.in[i] = (const GAS float*)d_in[i];
    a.out = (GAS float*)d_out; a.ws = (GAS unsigned char*)d_ws;
#if MK_SPLIT
    for (int p = 0; p < NPHASE; ++p) { a.ph_lo = p; a.ph_hi = p + 1; hipLaunchKernelGGL(mk_fwd, dim3(grid), dim3(NTHREADS), LDS_BYTES, stream, a); }
#elif defined(PROBE_PH)
    a.ph_lo = 0; a.ph_hi = PROBE_PH + 1; a.li = 0; hipLaunchKernelGGL(mk_fwd, dim3(grid), dim3(NTHREADS), LDS_BYTES, stream, a);
    for (int r = 0; r < PROBE_N; ++r) { a.ph_lo = PROBE_PH; a.ph_hi = PROBE_PH + 1; hipLaunchKernelGGL(mk_fwd, dim3(grid), dim3(NTHREADS), LDS_BYTES, stream, a); }
    a.ph_lo = PROBE_PH + 1; a.ph_hi = NPHASE; a.li = 1; hipLaunchKernelGGL(mk_fwd, dim3(grid), dim3(NTHREADS), LDS_BYTES, stream, a);
#else
    a.ph_lo = 0; a.ph_hi = NPHASE;
    hipLaunchKernelGGL(mk_fwd, dim3(grid), dim3(NTHREADS), LDS_BYTES, stream, a);
#endif
}
```

```cpp
#include <hip/hip_runtime.h>
#include <cstdio>
#include <cstdint>

#define GAS __attribute__((address_space(1)))
#define LAS __attribute__((address_space(3)))
typedef unsigned short bf16;
typedef unsigned v4u __attribute__((ext_vector_type(4)));
typedef unsigned v2u __attribute__((ext_vector_type(2)));
typedef float f32x4 __attribute__((ext_vector_type(4)));
typedef float f32x2 __attribute__((ext_vector_type(2)));
typedef short bf16x8 __attribute__((ext_vector_type(8)));
typedef GAS unsigned gu32;
#define RLX_AGENT __ATOMIC_RELAXED, __HIP_MEMORY_SCOPE_AGENT
#define LDS_WAIT() asm volatile("s_waitcnt lgkmcnt(0)" ::: "memory")
#define VM_WAIT() asm volatile("s_waitcnt vmcnt(0)" ::: "memory")

constexpr int D = 1024, NB = 4, T = 4096, GW = 64, TC = 256, NL = 2;
constexpr int RL = NB * T, RC = NB * TC, R = RL + RC;
constexpr int MH = 8, DQK = 64, DV = 128, LCH = 64;
constexpr int RH = 16, RN = 64, RD = 1024;
constexpr int RW = 3456, DIN = 8608, NPAD = 8704;
constexpr int FF = 2816, NE = 8, FE = 3584;
constexpr int TB = T + TC, NCH = TB / LCH;
constexpr int SMW = 512;
constexpr float NORM_EPS = 1e-6f, GN_EPS = 64e-5f, CAP = 15.0f;
constexpr int MAXSLOT = 2 * RL + NE * 256;

constexpr size_t MiB = 1u << 20;
constexpr size_t WS_CTL = 0, CTL_ZERO_BYTES = 1 * MiB;
constexpr size_t WS_MOD = 1 * MiB, WS_XC = 2 * MiB, WS_META = 6 * MiB, WS_BON = 7 * MiB, WS_SG = 10 * MiB;
constexpr size_t WS_WIN = 19 * MiB, WS_WPM = 36 * MiB, WS_WPR = 38 * MiB, WS_WOUT = 40 * MiB, WS_WG2 = 42 * MiB, WS_WLORA = 43 * MiB, WS_WGU = 44 * MiB, WS_WDN = 55 * MiB;
constexpr size_t WS_H = 61 * MiB;
constexpr size_t WS_Q = 95 * MiB, WS_K = 112 * MiB, WS_V = 129 * MiB, WS_O = 163 * MiB, WS_RKV = 197 * MiB, WS_MGT = 299 * MiB, WS_SM = 367 * MiB;
constexpr size_t WS_HF = 401 * MiB, WS_YS = 469 * MiB, WS_END = 537 * MiB;
constexpr size_t WS_HM = WS_Q, WS_YR = WS_V, WS_T1 = WS_SM;
constexpr size_t WS_HH0 = WS_Q;
constexpr size_t WS_WEGU = 95 * MiB, WS_WEDN = 151 * MiB, WS_HG = 179 * MiB, WS_Y2 = 213 * MiB, WS_HHE = 281 * MiB;
static_assert(WS_HHE + (size_t)MAXSLOT * FE <= 401 * MiB && WS_Y2 + (size_t)MAXSLOT * D * 2 <= WS_HHE && WS_HG + (size_t)MAXSLOT * D <= WS_Y2, "ws map");
constexpr float W8S = 64.0f;
constexpr size_t WS_NEED = 540 * MiB;
constexpr int CW_BAR = 4096;
constexpr int CW_ECNT = 16384;
constexpr int CW_SUB = 20480;
constexpr int LDS_BYTES = 159744;
constexpr int MISC_OFF = LDS_BYTES - 256;

__device__ __forceinline__ unsigned cvt_pk_bf16(float lo, float hi) { unsigned r; asm volatile("v_cvt_pk_bf16_f32 %0, %1, %2" : "=v"(r) : "v"(lo), "v"(hi)); return r; }
__device__ __forceinline__ float bflo(unsigned w) { return __uint_as_float(w << 16); }
__device__ __forceinline__ float bfhi(unsigned w) { return __uint_as_float(w & 0xffff0000u); }
__device__ __forceinline__ void unpack8(const v4u w, float (&f)[8]) { f[0] = bflo(w.x); f[1] = bfhi(w.x); f[2] = bflo(w.y); f[3] = bfhi(w.y); f[4] = bflo(w.z); f[5] = bfhi(w.z); f[6] = bflo(w.w); f[7] = bfhi(w.w); }
__device__ __forceinline__ v4u pack8(const float (&f)[8]) { v4u w; w.x = cvt_pk_bf16(f[0], f[1]); w.y = cvt_pk_bf16(f[2], f[3]); w.z = cvt_pk_bf16(f[4], f[5]); w.w = cvt_pk_bf16(f[6], f[7]); return w; }
__device__ __forceinline__ float sigmoidf_(float x) { return __builtin_amdgcn_rcpf(1.0f + __expf(-x)); }
__device__ __forceinline__ float siluf_(float x) { return x * sigmoidf_(x); }
__device__ __forceinline__ float softplusf_(float x) { return fmaxf(x, 0.f) + log1pf(expf(-fabsf(x))); }
__device__ __forceinline__ float fast_tanh(float x) { const float e = __expf(2.0f * x); return 1.0f - 2.0f * __builtin_amdgcn_rcpf(1.0f + e); }
__device__ __forceinline__ float fast_softplus(float x) { return fmaxf(x, 0.f) + __logf(1.0f + __expf(-fabsf(x))); }
template <int CTRL> __device__ __forceinline__ float dpp_add(float v) { const int t = __builtin_amdgcn_update_dpp(0, __float_as_int(v), CTRL, 0xf, 0xf, false); return v + __int_as_float(t); }
__device__ __forceinline__ float red4(float v) { v = dpp_add<0xB1>(v); return dpp_add<0x4E>(v); }
__device__ __forceinline__ float red8(float v) { return dpp_add<0x141>(red4(v)); }
__device__ __forceinline__ float red16(float v) { return dpp_add<0x140>(red8(v)); }
__device__ __forceinline__ float wave_sum(float v) { v = red16(v); v += __shfl_xor(v, 16); return v + __shfl_xor(v, 32); }
__device__ __forceinline__ int row_of(int b, int lr) { return lr < T ? b * T + lr : RL + b * TC + (lr - T); }
__device__ __forceinline__ int tok(int dir, int u) { if (u < TC) return T + (dir ? TC - 1 - u : u); const int tt = u - TC; return dir ? T - 1 - tt : tt; }
__device__ __forceinline__ int nbrow(int g, int rwidx) {
    if (g < RL) { const int t = g & (T - 1), row = t >> 6, col = t & 63, q = rwidx / (RW / 4);
        if (q == 0) return col > 0 ? g - 1 : -1; if (q == 1) return col < GW - 1 ? g + 1 : -1; if (q == 2) return row > 0 ? g - GW : -1; return row < T / GW - 1 ? g + GW : -1; }
    const int t = (g - RL) & (TC - 1); if (rwidx < RW / 2) return t > 0 ? g - 1 : -1; return t < TC - 1 ? g + 1 : -1;
}

#define XB_TMO      128
#define XB_XCNT(j)  (256  + 64 * (j))
#define XB_XSUB(j)  (1280 + 64 * (j))
#define XB_XGEN(j)  (2304 + 64 * (j))
#define XB_TOP      3328
#define XB_TOPGEN   3392
#define XCD_BAR_WORDS 3456
#define XB_SPIN_CAP (1u << 18)
__device__ __forceinline__ unsigned xb_ld(unsigned* p)              { return __hip_atomic_load(p, __ATOMIC_RELAXED, __HIP_MEMORY_SCOPE_AGENT); }
__device__ __forceinline__ unsigned xb_add(unsigned* p, unsigned v) { return __hip_atomic_fetch_add(p, v, __ATOMIC_RELAXED, __HIP_MEMORY_SCOPE_AGENT); }
__device__ __forceinline__ unsigned xb_xcc_id() { return (unsigned)__builtin_amdgcn_s_getreg((3 << 11) | 20) & 0xFu; }
#define XB_SPIN(cond, bar) do { unsigned _sp = 0; while (cond) { __builtin_amdgcn_s_sleep(1); \
    if ((++_sp & 255u) == 0u) { if (xb_ld(&(bar)[XB_TMO])) break; if (_sp > XB_SPIN_CAP) { atomicAdd(&(bar)[XB_TMO], 1u); break; } } } } while (0)
struct XcdBarrier { unsigned* bar; unsigned x; volatile LAS unsigned* st; };
__device__ __forceinline__ XcdBarrier xcd_barrier_post(unsigned* bar, volatile LAS unsigned* st) {
    XcdBarrier b; b.bar = bar; b.x = xb_xcc_id(); b.st = st;
    if (threadIdx.x == 0) (void)xb_add(&bar[XB_XCNT(b.x)], 1u);
    return b;
}
__device__ __forceinline__ void xcd_barrier_complete(unsigned* bar, unsigned x, unsigned& nloc, unsigned& nx) {
    const unsigned G = gridDim.x * gridDim.y * gridDim.z;
    unsigned sum, cnt, mine, sp = 0u;
    for (;;) {
        sum = 0u; cnt = 0u; mine = 0u;
#pragma unroll
        for (unsigned j = 0; j < 16; ++j) { const unsigned c = xb_ld(&bar[XB_XCNT(j)]); sum += c; cnt += (c > 0u) ? 1u : 0u; mine = (j == x) ? c : mine; }
        if (sum == G) break;
        __builtin_amdgcn_s_sleep(1);
        if ((++sp & 255u) == 0u) { if (xb_ld(&bar[XB_TMO])) break; if (sp > XB_SPIN_CAP) { atomicAdd(&bar[XB_TMO], 1u); break; } }
    }
    nloc = mine > 0u ? mine : 1u; nx = cnt > 0u ? cnt : 1u;
}
__device__ __forceinline__ void xcd_barrier(const XcdBarrier& b) {
    asm volatile("s_waitcnt vmcnt(0)" ::: "memory");
    __syncthreads();
    if (threadIdx.x == 0) {
        unsigned* bar = b.bar;
        __builtin_amdgcn_s_waitcnt(0);
        unsigned nloc = b.st[0], nx = b.st[1];
        if (nloc == 0u) { xcd_barrier_complete(bar, b.x, nloc, nx); b.st[0] = nloc; b.st[1] = nx; }
        const unsigned old = xb_add(&bar[XB_XSUB(b.x)], 1u);
        const unsigned gen = old / nloc;
        if (old + 1u == (gen + 1u) * nloc) {
            __builtin_amdgcn_fence(__ATOMIC_RELEASE, "agent");
            asm volatile("s_waitcnt vmcnt(0)" ::: "memory");
            const unsigned og = xb_add(&bar[XB_TOP], 1u);
            const unsigned tg = og / nx;
            if (og + 1u == (tg + 1u) * nx) xb_add(&bar[XB_TOPGEN], 1u);
            else XB_SPIN(xb_ld(&bar[XB_TOPGEN]) == tg, bar);
            __builtin_amdgcn_fence(__ATOMIC_ACQUIRE, "agent");
            xb_add(&bar[XB_XGEN(b.x)], 1u);
            asm volatile("s_waitcnt vmcnt(0)" ::: "memory");
        } else {
            XB_SPIN(xb_ld(&bar[XB_XGEN(b.x)]) == gen, bar);
            __builtin_amdgcn_fence(__ATOMIC_ACQUIRE, "agent");
            asm volatile("s_waitcnt vmcnt(0)" ::: "memory");
        }
    }
    __syncthreads();
}

namespace pg8 {
#define PG8_LAS __attribute__((address_space(3)))
typedef unsigned short bf16_t;
typedef unsigned u32x4 __attribute__((ext_vector_type(4)));
constexpr int BM = 256, BK = 64, HALF = 128, HTB = HALF * BK * 2, STAGE_BYTES = 8 * HTB, NXCD = 8, WGM = 8;
__host__ __device__ __forceinline__ int lds_byte(int r, int c) { const int st = (r >> 4) * 2 + (c >> 5), rr = r & 15, cc = c & 31, ob = rr * 64 + cc * 2; return st * 1024 + (ob ^ (((ob >> 9) & 1) << 5)); }
__host__ __device__ __forceinline__ void stage_rc(int b, int& R_, int& C) { const int st = b / 1024, sb = b % 1024, swz = sb ^ (((sb >> 9) & 1) << 5); R_ = (st >> 1) * 16 + swz / 64; C = (st & 1) * 32 + (swz % 64) / 2; }
__host__ __device__ __forceinline__ int perm32(int rho) { const int n = rho >> 4, i = rho & 15; return 8 * (i >> 2) + 4 * n + (i & 3); }
typedef int i32x8 __attribute__((ext_vector_type(8))); typedef int i32x4 __attribute__((ext_vector_type(4)));
__device__ __forceinline__ i32x8 cat8(bf16x8 lo, bf16x8 hi) { return __builtin_shufflevector(__builtin_bit_cast(i32x4, lo), __builtin_bit_cast(i32x4, hi), 0, 1, 2, 3, 4, 5, 6, 7); }
__device__ __forceinline__ void mfma8_acc(f32x4& acc, const i32x8 a, const i32x8 b) {
#if defined(__HIP_DEVICE_COMPILE__)
    const int one = 0x7F7F7F7F;
    asm volatile("v_mfma_scale_f32_16x16x128_f8f6f4 %0, %1, %2, %0, %3, %3 op_sel_hi:[0,0,0]" : "+v"(acc) : "v"(a), "v"(b), "v"(one));
#endif
}
struct Unit { int pm, pn, pb; };
struct Gemm { const bf16_t* A; const bf16_t* Bt; int M, N, K; };
struct StaticOrder {
    int nM, nN, nwg, G, c;
    __device__ void init(int M, int N, int G_, int c_) { nM = M / BM; nN = N / BM; nwg = nM * nN; G = G_; c = c_; }
    __device__ bool next(int i, Unit& u) const {
        const long L = (long)i * G + c; if (L >= nwg) return false;
        int wgid = (int)L; { const int q = nwg / NXCD, r = nwg % NXCD, xcd = wgid % NXCD, off = wgid / NXCD; wgid = (xcd < r ? xcd * (q + 1) : r * (q + 1) + (xcd - r) * q) + off; }
        const int nig = WGM * nN, gid = wgid / nig, fm = gid * WGM, gsz = (nM - fm) < WGM ? (nM - fm) : WGM;
        u.pm = fm + ((wgid % nig) % gsz); u.pn = (wgid % nig) / gsz; u.pb = u.pn; return true;
    }
    __device__ __forceinline__ void a_ready(const Unit&) const {}
    __device__ __forceinline__ void done(const Unit&) const {}
};
struct InprojLastOrder {
    int G, c;
    __device__ bool next(int i, Unit& u) const {
        const int L = i * G + c; if (L >= 64 * 34 + 4 * 22) return false;
        if (L < 64 * 34) { const int g8 = L / (8 * 34), r = L % (8 * 34); u.pm = g8 * 8 + (r % 8); u.pn = r / 8; }
        else { const int r = L - 64 * 34; u.pm = 64 + (r & 3); int q = r >> 2; q += (q >= 8) ? 4 : 0; q += (q >= 24) ? 8 : 0; u.pn = q; }
        u.pb = u.pn; return true;
    }
    __device__ __forceinline__ void a_ready(const Unit&) const {}
    __device__ __forceinline__ void done(const Unit&) const {}
};
struct MoeOrder {
    int ntiles, nN, nwg, G, c; const int* texp;
    __device__ bool next(int i, Unit& u) const {
        const long L = (long)i * G + c; if (L >= nwg) return false;
        u.pm = (int)(L / nN); u.pn = (int)(L % nN); u.pb = __builtin_amdgcn_readfirstlane(texp[u.pm]) * nN + u.pn; return true;
    }
    __device__ __forceinline__ void a_ready(const Unit&) const {}
    __device__ __forceinline__ void done(const Unit&) const {}
};
template <class Epi, class Sched, bool ALIGN_EPI = false, bool SP2 = false, bool FP8 = false>
__device__ __forceinline__ void gemm_phase(PG8_LAS unsigned char* lds, const Gemm g, const Sched& S, const Epi& E) {
    int tid_ = threadIdx.x; asm volatile("" : "+v"(tid_));
    const int tid = tid_, wid = __builtin_amdgcn_readfirstlane(tid >> 6), lane = tid & 63, wr = wid >> 2, wc = wid & 3, fr = lane & 15, fq = lane >> 4;
    const int K = g.K, nt = K / BK;
    unsigned voffA[2], voffB[2];
#pragma unroll
    for (int i = 0; i < 2; ++i) { int R, C; stage_rc(tid * 16 + i * 8192, R, C); const int Rb = Epi::PERM ? ((R & ~31) + perm32(R & 31)) : R;
        voffA[i] = (unsigned)(R * K + C) * 2u; voffB[i] = (unsigned)(Rb * K + C) * 2u; }
    const size_t kstep = (size_t)(BK * 2);
    const size_t hstep = (size_t)HALF * K * 2;
    const size_t tstep = 2 * hstep;
    const unsigned ldsw = (unsigned)wid * 1024u;
    const int aoff = lds_byte(wr * 64 + fr, fq * 8), boff = lds_byte(wc * 32 + fr, fq * 8);
#define PG8_SA(b, h) (((b) * 2 + (h)) * HTB)
#define PG8_SB(b, h) ((4 + (b) * 2 + (h)) * HTB)
#define PG8_STAGE(bufoff, gbase, voff) do { _Pragma("unroll") for (int _i = 0; _i < 2; ++_i) \
        __builtin_amdgcn_global_load_lds((const unsigned*)((const char*)(gbase) + (voff)[_i]), (PG8_LAS unsigned*)(lds + (bufoff) + ldsw + _i * 8192), 16, 0, 0); } while (0)
#define PG8_LDA(dst, b, h) do { _Pragma("unroll") for (int m = 0; m < 4; ++m) { if constexpr (FP8) dst##8[m] = cat8(*(const PG8_LAS bf16x8*)(lds + PG8_SA(b, h) + aoff + m * 2048), *(const PG8_LAS bf16x8*)(lds + PG8_SA(b, h) + aoff + m * 2048 + 1024)); \
        else { _Pragma("unroll") for (int k = 0; k < 2; ++k) dst[m][k] = *(const PG8_LAS bf16x8*)(lds + PG8_SA(b, h) + aoff + m * 2048 + k * 1024); } } } while (0)
#define PG8_LDB(dst, b, h) do { _Pragma("unroll") for (int n = 0; n < 2; ++n) { if constexpr (FP8) dst##8[n] = cat8(*(const PG8_LAS bf16x8*)(lds + PG8_SB(b, h) + boff + n * 2048), *(const PG8_LAS bf16x8*)(lds + PG8_SB(b, h) + boff + n * 2048 + 1024)); \
        else { _Pragma("unroll") for (int k = 0; k < 2; ++k) dst[n][k] = *(const PG8_LAS bf16x8*)(lds + PG8_SB(b, h) + boff + n * 2048 + k * 1024); } } } while (0)
#define PG8_MMA(ai, bj, At, Bt) do { __builtin_amdgcn_s_setprio(1); if constexpr (FP8) { _Pragma("unroll") for (int m = 0; m < 4; ++m) _Pragma("unroll") for (int n = 0; n < 2; ++n) \
        mfma8_acc(acc[ai][bj][m][n], Bt##8[n], At##8[m]); } else { \
        _Pragma("unroll") for (int m = 0; m < 4; ++m) _Pragma("unroll") for (int n = 0; n < 2; ++n) _Pragma("unroll") for (int k = 0; k < 2; ++k) \
        acc[ai][bj][m][n] = __builtin_amdgcn_mfma_f32_16x16x32_bf16(Bt[n][k], At[m][k], acc[ai][bj][m][n], 0, 0, 0); } __builtin_amdgcn_s_setprio(0); } while (0)
#define PG8_WAIT_V(n) asm volatile("s_waitcnt vmcnt(" #n ")" ::: "memory")
#define PG8_WAIT_L(n) asm volatile("s_waitcnt lgkmcnt(" #n ")" ::: "memory")
#define PG8_BAR __builtin_amdgcn_s_barrier()
#define PG8_SCHED __builtin_amdgcn_sched_barrier(0)
    Unit cur, nxt; int ui = 0;
    if (!S.next(0, cur)) return;
    f32x4 acc[2][2][4][2];
#pragma unroll
    for (int a = 0; a < 2; ++a)
#pragma unroll
        for (int b = 0; b < 2; ++b)
#pragma unroll
            for (int m = 0; m < 4; ++m)
#pragma unroll
                for (int n = 0; n < 2; ++n) acc[a][b][m][n] = (f32x4){0.f, 0.f, 0.f, 0.f};
    bf16x8 At[4][2], B0[2][2], B1[2][2]; i32x8 At8[4], B08[2], B18[2];
    const char* cA = (const char*)g.A + (size_t)cur.pm * tstep; const char* cB = (const char*)g.Bt + (size_t)cur.pb * tstep;
    S.a_ready(cur);
    if constexpr (SP2) {
        PG8_STAGE(PG8_SB(0, 0), cB, voffB); PG8_STAGE(PG8_SB(0, 1), cB + hstep, voffB); PG8_STAGE(PG8_SA(0, 0), cA, voffA); PG8_STAGE(PG8_SA(0, 1), cA + hstep, voffA);
        if (wr == 1) PG8_BAR;
        PG8_WAIT_V(2); PG8_BAR;
        PG8_STAGE(PG8_SB(1, 0), cB + kstep, voffB); PG8_STAGE(PG8_SA(1, 0), cA + kstep, voffA); PG8_STAGE(PG8_SB(1, 1), cB + hstep + kstep, voffB);
        PG8_WAIT_V(6); PG8_BAR;
    } else {
        PG8_STAGE(PG8_SB(0, 0), cB, voffB); PG8_STAGE(PG8_SA(0, 0), cA, voffA); PG8_STAGE(PG8_SB(0, 1), cB + hstep, voffB); PG8_STAGE(PG8_SA(0, 1), cA + hstep, voffA);
        if (wr == 1) PG8_BAR;
        PG8_WAIT_V(4); PG8_BAR;
        PG8_STAGE(PG8_SB(1, 0), cB + kstep, voffB); PG8_STAGE(PG8_SA(1, 0), cA + kstep, voffA); PG8_STAGE(PG8_SB(1, 1), cB + hstep + kstep, voffB);
        PG8_WAIT_V(6); PG8_BAR;
    }
    for (;;) {
        const bool has_next = S.next(ui + 1, nxt);
        const char* nA = has_next ? (const char*)g.A + (size_t)nxt.pm * tstep : cA; const char* nB = has_next ? (const char*)g.Bt + (size_t)nxt.pb * tstep : cB;
        for (int t = 0; t < nt; t += 2) {
            const bool last = (t == nt - 2);
            const char* a1 = cA + (size_t)(t + 1) * kstep;
            const char* a2 = last ? nA : cA + (size_t)(t + 2) * kstep; const char* b2 = last ? nB : cB + (size_t)(t + 2) * kstep;
            const char* a3 = a2 + kstep; const char* b3 = b2 + kstep;
            if (last && has_next) S.a_ready(nxt);
            if constexpr (SP2) {
            PG8_LDB(B0, 0, 0); PG8_LDB(B1, 0, 1); PG8_SCHED; PG8_LDA(At, 0, 0); PG8_STAGE(PG8_SA(1, 1), a1 + hstep, voffA);
            PG8_WAIT_V(8); PG8_WAIT_L(0); PG8_BAR; PG8_MMA(0, 0, At, B0); PG8_MMA(0, 1, At, B1); PG8_BAR; PG8_SCHED;
            PG8_LDA(At, 0, 1); PG8_STAGE(PG8_SB(0, 0), b2, voffB); PG8_STAGE(PG8_SB(0, 1), b2 + hstep, voffB); PG8_STAGE(PG8_SA(0, 0), a2, voffA);
            PG8_WAIT_V(8); PG8_WAIT_L(0); PG8_BAR; PG8_MMA(1, 0, At, B0); PG8_MMA(1, 1, At, B1); PG8_BAR; PG8_SCHED;
            PG8_LDB(B0, 1, 0); PG8_LDB(B1, 1, 1); PG8_SCHED; PG8_LDA(At, 1, 0); PG8_STAGE(PG8_SA(0, 1), a2 + hstep, voffA);
            PG8_WAIT_V(8); PG8_WAIT_L(0); PG8_BAR; PG8_MMA(0, 0, At, B0); PG8_MMA(0, 1, At, B1); PG8_BAR; PG8_SCHED;
            PG8_LDA(At, 1, 1); PG8_STAGE(PG8_SB(1, 0), b3, voffB); PG8_STAGE(PG8_SB(1, 1), b3 + hstep, voffB); PG8_STAGE(PG8_SA(1, 0), a3, voffA);
            PG8_WAIT_V(8); PG8_WAIT_L(0); PG8_BAR; PG8_MMA(1, 0, At, B0); PG8_MMA(1, 1, At, B1); PG8_BAR; PG8_SCHED;
            } else {
            PG8_LDB(B0, 0, 0); PG8_SCHED; PG8_LDA(At, 0, 0); PG8_STAGE(PG8_SA(1, 1), a1 + hstep, voffA);
            PG8_WAIT_L(8); PG8_BAR; PG8_WAIT_L(0); PG8_MMA(0, 0, At, B0); PG8_BAR; PG8_SCHED;
            PG8_LDB(B1, 0, 1); PG8_STAGE(PG8_SB(0, 0), b2, voffB);
            PG8_BAR; PG8_WAIT_L(0); PG8_MMA(0, 1, At, B1); PG8_BAR;
            PG8_LDA(At, 0, 1); PG8_STAGE(PG8_SA(0, 0), a2, voffA);
            PG8_BAR; PG8_WAIT_L(0); PG8_MMA(1, 0, At, B0); PG8_BAR; PG8_SCHED;
            PG8_STAGE(PG8_SB(0, 1), b2 + hstep, voffB);
            PG8_WAIT_V(6); PG8_BAR; PG8_MMA(1, 1, At, B1); PG8_BAR;
            PG8_LDB(B0, 1, 0); PG8_SCHED; PG8_LDA(At, 1, 0); PG8_STAGE(PG8_SA(0, 1), a2 + hstep, voffA);
            PG8_WAIT_L(8); PG8_BAR; PG8_WAIT_L(0); PG8_MMA(0, 0, At, B0); PG8_BAR; PG8_SCHED;
            PG8_LDB(B1, 1, 1); PG8_STAGE(PG8_SB(1, 0), b3, voffB);
            PG8_BAR; PG8_WAIT_L(0); PG8_MMA(0, 1, At, B1); PG8_BAR;
            PG8_LDA(At, 1, 1); PG8_STAGE(PG8_SA(1, 0), a3, voffA);
            PG8_BAR; PG8_WAIT_L(0); PG8_MMA(1, 0, At, B0); PG8_BAR; PG8_SCHED;
            PG8_STAGE(PG8_SB(1, 1), b3 + hstep, voffB);
            PG8_WAIT_V(6); PG8_BAR; PG8_MMA(1, 1, At, B1); PG8_BAR;
            }
        }
        if constexpr (ALIGN_EPI) { if (wr == 0) PG8_BAR; }
        if constexpr (FP8) asm volatile("s_nop 15\n\ts_nop 15\n\ts_nop 15\n\ts_nop 15" ::: "memory");
        if constexpr (!Epi::AFTER_DRAIN) { E(acc, cur, wr, wc, fr, fq); S.done(cur); }
        if (!has_next) break;
#pragma unroll
        for (int a = 0; a < 2; ++a)
#pragma unroll
            for (int b = 0; b < 2; ++b)
#pragma unroll
                for (int m = 0; m < 4; ++m)
#pragma unroll
                    for (int n = 0; n < 2; ++n) acc[a][b][m][n] = (f32x4){0.f, 0.f, 0.f, 0.f};
        cur = nxt; cA = nA; cB = nB; ++ui;
        if constexpr (ALIGN_EPI) { if (wr == 1) PG8_BAR; }
    }
    PG8_WAIT_V(0);
    if constexpr (!ALIGN_EPI) { if (wr == 0) PG8_BAR; }
    PG8_BAR;
    if constexpr (Epi::AFTER_DRAIN) { E.fused(acc, cur, wr, wc, fr, fq, lds, wid, lane); S.done(cur); }
#undef PG8_SA
#undef PG8_SB
#undef PG8_STAGE
#undef PG8_LDA
#undef PG8_LDB
#undef PG8_MMA
#undef PG8_WAIT_V
#undef PG8_WAIT_L
#undef PG8_BAR
#undef PG8_SCHED
}

__device__ __forceinline__ u32x4 pack_acc8(const f32x4 v0, const f32x4 v1) { u32x4 w; w.x = cvt_pk_bf16(v0[0], v0[1]); w.y = cvt_pk_bf16(v0[2], v0[3]); w.z = cvt_pk_bf16(v1[0], v1[1]); w.w = cvt_pk_bf16(v1[2], v1[3]); return w; }
#define EPI_LOOP_BEGIN  _Pragma("unroll") for (int ai = 0; ai < 2; ++ai) _Pragma("unroll") for (int m = 0; m < 4; ++m) { const int rloc = ai * HALF + wr * 64 + m * 16 + fr; \
                        _Pragma("unroll") for (int bj = 0; bj < 2; ++bj) { const int cloc = bj * HALF + wc * 32 + 8 * fq; const f32x4 v0 = acc[ai][bj][m][0], v1 = acc[ai][bj][m][1];
#define EPI_LOOP_END    } asm volatile("" ::: "memory"); }

struct EpiInproj {
    static constexpr bool PERM = true, AFTER_DRAIN = false;
    GAS unsigned char* ws;
    __device__ __forceinline__ void operator()(const f32x4 (&acc)[2][2][4][2], const Unit& u, int wr, int wc, int fr, int fq) const {
        const int pn = u.pn; size_t off; int ld, ct;
        if (pn < 2) { off = WS_Q; ld = 512; ct = pn; } else if (pn < 4) { off = WS_K; ld = 512; ct = pn - 2; } else if (pn < 8) { off = WS_V; ld = 1024; ct = pn - 4; }
        else if (pn < 12) { off = WS_O; ld = 1024; ct = pn - 8; } else if (pn < 24) { off = WS_RKV; ld = 3072; ct = pn - 12; } else if (pn < 32) { off = WS_MGT; ld = 2048; ct = pn - 24; } else { off = WS_SM; ld = SMW * 2; ct = pn - 32; }
        const size_t row0 = (size_t)u.pm * BM;
        if (pn < 32) {
            bf16_t* base = (bf16_t*)(ws + off) + row0 * ld + ct * BM;
            EPI_LOOP_BEGIN
                *(u32x4*)(base + (size_t)rloc * ld + cloc) = pack_acc8(v0, v1);
            EPI_LOOP_END
        } else {
            float* sb = (float*)(ws + off) + row0 * SMW + ct * BM;
            EPI_LOOP_BEGIN
                float* p = sb + (size_t)rloc * SMW + cloc; *(f32x4*)p = v0; *(f32x4*)(p + 4) = v1;
            EPI_LOOP_END
        }
    }
};
struct EpiStore {
    static constexpr bool PERM = true, AFTER_DRAIN = false;
    bf16_t* C; int ldc;
    __device__ __forceinline__ void operator()(const f32x4 (&acc)[2][2][4][2], const Unit& u, int wr, int wc, int fr, int fq) const {
        const size_t row0 = (size_t)u.pm * BM; const int col0 = u.pn * BM;
        EPI_LOOP_BEGIN
            *(u32x4*)(C + (row0 + rloc) * ldc + col0 + cloc) = pack_acc8(v0, v1);
        EPI_LOOP_END
    }
};
template <int STEP> struct EpiMerge {
    static constexpr bool PERM = true, AFTER_DRAIN = false;
    const bf16_t* MGT; bf16_t* T1; bf16_t* OUT;
    __device__ __forceinline__ void operator()(const f32x4 (&acc)[2][2][4][2], const Unit& u, int wr, int wc, int fr, int fq) const {
        const size_t row0 = (size_t)u.pm * BM; const int col0 = u.pn * BM;
        EPI_LOOP_BEGIN
            const size_t row = row0 + rloc; const int col = col0 + cloc;
            const u32x4 gw = *(const u32x4*)(MGT + row * 2048 + (STEP ? 1024 : 0) + col); float g[8]; unpack8(gw, g);
            float o[8] = {v0[0], v0[1], v0[2], v0[3], v1[0], v1[1], v1[2], v1[3]};
#pragma unroll
            for (int j = 0; j < 8; ++j) o[j] *= sigmoidf_(g[j]);
            if (STEP) { const u32x4 tw = *(const u32x4*)(T1 + row * 1024 + col); float tt[8]; unpack8(tw, tt);
#pragma unroll
                for (int j = 0; j < 8; ++j) o[j] += tt[j]; }
            *(u32x4*)((STEP ? OUT : T1) + row * 1024 + col) = pack8(o);
        EPI_LOOP_END
    }
};
struct EpiResid {
    static constexpr bool PERM = true, AFTER_DRAIN = false;
    const float* src_lat; const float* src_ctx; float* dst_lat; float* dst_ctx; const float* gate;
    __device__ __forceinline__ void operator()(const f32x4 (&acc)[2][2][4][2], const Unit& u, int wr, int wc, int fr, int fq) const {
        const int row0 = u.pm * BM, col0 = u.pn * BM; const bool lat = row0 < RL;
        const float* sb = lat ? src_lat : src_ctx - (size_t)RL * D; float* db = lat ? dst_lat : dst_ctx - (size_t)RL * D;
        const float* gt = gate + (lat ? row0 / T : 4) * 6 * D;
        EPI_LOOP_BEGIN
            const size_t off = (size_t)(row0 + rloc) * D + col0 + cloc; const int col = col0 + cloc;
            const f32x4 g0 = *(const f32x4*)(gt + col), g1 = *(const f32x4*)(gt + col + 4), s0 = *(const f32x4*)(sb + off), s1 = *(const f32x4*)(sb + off + 4);
            *(f32x4*)(db + off) = s0 + g0 * v0; *(f32x4*)(db + off + 4) = s1 + g1 * v1;
        EPI_LOOP_END
    }
};
struct EpiSwiglu {
    static constexpr bool PERM = true, AFTER_DRAIN = false;
    bf16_t* HH; int ldc;
    __device__ __forceinline__ void operator()(const f32x4 (&acc)[2][2][4][2], const Unit& u, int wr, int wc, int fr, int fq) const {
        const size_t row0 = (size_t)u.pm * BM; const int col0 = u.pn * HALF + wc * 32 + 8 * fq;
#pragma unroll
        for (int ai = 0; ai < 2; ++ai)
#pragma unroll
            for (int m = 0; m < 4; ++m) { const int rloc = ai * HALF + wr * 64 + m * 16 + fr; float o[8];
#pragma unroll
                for (int n = 0; n < 2; ++n)
#pragma unroll
                    for (int j = 0; j < 4; ++j) o[4 * n + j] = siluf_(acc[ai][0][m][n][j]) * acc[ai][1][m][n][j];
                *(u32x4*)(HH + (row0 + rloc) * ldc + col0) = pack8(o); asm volatile("" ::: "memory"); }
    }
};

struct EpiSwiglu8 {
    static constexpr bool PERM = true, AFTER_DRAIN = false;
    unsigned char* HH; int ldc;
    __device__ __forceinline__ void operator()(const f32x4 (&acc)[2][2][4][2], const Unit& u, int wr, int wc, int fr, int fq) const {
        const size_t row0 = (size_t)u.pm * BM; const int col0 = u.pn * HALF + wc * 32 + 8 * fq; const float is = 1.0f / W8S;
#pragma unroll
        for (int ai = 0; ai < 2; ++ai)
#pragma unroll
            for (int m = 0; m < 4; ++m) { const int rloc = ai * HALF + wr * 64 + m * 16 + fr; float o[8];
#pragma unroll
                for (int n = 0; n < 2; ++n)
#pragma unroll
                    for (int j = 0; j < 4; ++j) o[4 * n + j] = __builtin_amdgcn_fmed3f(siluf_(acc[ai][0][m][n][j] * is) * (acc[ai][1][m][n][j] * is), -448.0f, 448.0f);
                v2u w; w.x = (unsigned)__builtin_amdgcn_cvt_pk_fp8_f32(o[0], o[1], 0, false); w.x = (unsigned)__builtin_amdgcn_cvt_pk_fp8_f32(o[2], o[3], (int)w.x, true);
                w.y = (unsigned)__builtin_amdgcn_cvt_pk_fp8_f32(o[4], o[5], 0, false); w.y = (unsigned)__builtin_amdgcn_cvt_pk_fp8_f32(o[6], o[7], (int)w.y, true);
                *(v2u*)(HH + (row0 + rloc) * ldc + col0) = w; asm volatile("" ::: "memory"); }
    }
};
struct EpiStoreScaled {
    static constexpr bool PERM = true, AFTER_DRAIN = false;
    bf16_t* C; int ldc; float s;
    __device__ __forceinline__ void operator()(const f32x4 (&acc)[2][2][4][2], const Unit& u, int wr, int wc, int fr, int fq) const {
        const size_t row0 = (size_t)u.pm * BM; const int col0 = u.pn * BM;
        EPI_LOOP_BEGIN
            *(u32x4*)(C + (row0 + rloc) * ldc + col0 + cloc) = pack_acc8(v0 * s, v1 * s);
        EPI_LOOP_END
    }
};

}

struct Args { const GAS float* in[33]; GAS float* out; GAS unsigned char* ws; int ph_lo, ph_hi, li, pad; };
#define CAS __attribute__((address_space(4)))
#define INP(i) ((const float*)F.A->in[i])
constexpr int NWAVES = 8, NTHREADS = 512;
struct Frame {
    LAS unsigned char* lds; volatile LAS unsigned* MISC; gu32* ctl;
    int tid, lane, wave, G, bid;
    int cb, cg;
    GAS unsigned char* ws; GAS float* out;
    const CAS Args* A;
};
enum { I_X = 0, I_C, I_CTX, I_CCTX, I_WADA, I_BADA, I_GNM, I_GNF, I_WIN, I_BG, I_GMN, I_MU, I_W0, I_W2, I_A0, I_A2, I_G2, I_KK, I_KA, I_RK, I_LNW, I_LNB, I_WPM, I_WPR, I_WOUT,
       I_FFG, I_FFU, I_FFD, I_WR, I_EG, I_EU, I_ED, I_GF };

__device__ __forceinline__ void conv_item(const float* W, int ldw, int c0, int k0, bf16* dst, int ldd, int r0, LAS float* scr, int lane) {
#pragma unroll 8
    for (int i = 0; i < 32; ++i) { const int kk = 2 * i + (lane >> 5); scr[kk * 33 + (lane & 31)] = W[(size_t)(k0 + kk) * ldw + c0 + (lane & 31)]; }
    LDS_WAIT(); asm volatile("" ::: "memory");
    const int c = lane & 7;
#pragma unroll
    for (int j = 0; j < 4; ++j) { const int n = (lane >> 3) + 8 * j; const LAS float* s = scr + (8 * c) * 33 + n;
        v4u o; o.x = cvt_pk_bf16(s[0 * 33], s[1 * 33]); o.y = cvt_pk_bf16(s[2 * 33], s[3 * 33]); o.z = cvt_pk_bf16(s[4 * 33], s[5 * 33]); o.w = cvt_pk_bf16(s[6 * 33], s[7 * 33]);
        *(v4u*)(dst + (size_t)(r0 + n) * ldd + k0 + 8 * c) = o; }
    LDS_WAIT(); asm volatile("" ::: "memory");
}
__device__ __forceinline__ unsigned pk4_fp8(float a, float b, float c, float d) { int w = __builtin_amdgcn_cvt_pk_fp8_f32(a, b, 0, false); w = __builtin_amdgcn_cvt_pk_fp8_f32(c, d, w, true); return (unsigned)w; }
__device__ __forceinline__ void conv_item8(const float* W, int ldw, int c0, int k0, unsigned char* dst, int ldd, int r0, float scale, LAS float* scr, int lane) {
#pragma unroll 8
    for (int i = 0; i < 32; ++i) { const int kk = 2 * i + (lane >> 5); scr[kk * 33 + (lane & 31)] = __builtin_amdgcn_fmed3f(W[(size_t)(k0 + kk) * ldw + c0 + (lane & 31)] * scale, -448.0f, 448.0f); }
    LDS_WAIT(); asm volatile("" ::: "memory");
    const int c = lane & 3;
#pragma unroll
    for (int j = 0; j < 2; ++j) { const int n = (lane >> 2) + 16 * j; const LAS float* s = scr + (16 * c) * 33 + n;
        v4u o; o.x = pk4_fp8(s[0 * 33], s[1 * 33], s[2 * 33], s[3 * 33]); o.y = pk4_fp8(s[4 * 33], s[5 * 33], s[6 * 33], s[7 * 33]);
        o.z = pk4_fp8(s[8 * 33], s[9 * 33], s[10 * 33], s[11 * 33]); o.w = pk4_fp8(s[12 * 33], s[13 * 33], s[14 * 33], s[15 * 33]);
        *(v4u*)(dst + (size_t)(r0 + n) * ldd + k0 + 16 * c) = o; }
    LDS_WAIT(); asm volatile("" ::: "memory");
}
__device__ __forceinline__ void conv_seg8(Frame& F, const float* W, int ldw, int K, int c0, int ncols, unsigned char* dst, int ldd, int r0, float scale, int& rot) {
    LAS float* scr = (LAS float*)(F.lds + F.wave * 16384);
    const int NGW = F.cg * NWAVES, nblk = ncols / 32, nitems = (K / 64) * nblk;
    int gw = (F.cb * NWAVES + F.wave + rot) % NGW;
    for (int it = gw; it < nitems; it += NGW) { const int kb = it / nblk, nb = it % nblk; conv_item8(W, ldw, c0 + 32 * nb, 64 * kb, dst, ldd, r0 + 32 * nb, scale, scr, F.lane); }
    rot = (rot + nitems) % NGW;
}
__device__ __forceinline__ void conv_gu8(Frame& F, const float* Wg, const float* Wu, int ldw, int K, int ngroups, unsigned char* dst, float scale, int& rot) {
    LAS float* scr = (LAS float*)(F.lds + F.wave * 16384);
    const int NGW = F.cg * NWAVES, kblk = K / 64, nitems = ngroups * 2 * 4 * kblk;
    int gw = (F.cb * NWAVES + F.wave + rot) % NGW;
    for (int it = gw; it < nitems; it += NGW) { const int kb = it % kblk, r = it / kblk, nb = r & 3, which = (r >> 2) & 1, p = r >> 3;
        conv_item8(which ? Wu : Wg, ldw, 128 * p + 32 * nb, 64 * kb, dst, K, 256 * p + 128 * which + 32 * nb, scale, scr, F.lane); }
    rot = (rot + nitems) % NGW;
}
__device__ __forceinline__ void conv_seg(Frame& F, const float* W, int ldw, int K, int c0, int ncols, bf16* dst, int ldd, int r0, int& rot) {
    LAS float* scr = (LAS float*)(F.lds + F.wave * 16384);
    const int NGW = F.cg * NWAVES, nblk = ncols / 32, nitems = (K / 64) * nblk;
    int gw = (F.cb * NWAVES + F.wave + rot) % NGW;
    for (int it = gw; it < nitems; it += NGW) { const int kb = it / nblk, nb = it % nblk; conv_item(W, ldw, c0 + 32 * nb, 64 * kb, dst, ldd, r0 + 32 * nb, scr, F.lane); }
    rot = (rot + nitems) % NGW;
}
__device__ __forceinline__ void conv_gu(Frame& F, const float* Wg, const float* Wu, int ldw, int K, int ngroups, bf16* dst, int& rot) {
    LAS float* scr = (LAS float*)(F.lds + F.wave * 16384);
    const int NGW = F.cg * NWAVES, kblk = K / 64, nitems = ngroups * 2 * 4 * kblk;
    int gw = (F.cb * NWAVES + F.wave + rot) % NGW;
    for (int it = gw; it < nitems; it += NGW) { const int kb = it % kblk, r = it / kblk, nb = r & 3, which = (r >> 2) & 1, p = r >> 3;
        conv_item(which ? Wu : Wg, ldw, 128 * p + 32 * nb, 64 * kb, dst, K, 256 * p + 128 * which + 32 * nb, scr, F.lane); }
    rot = (rot + nitems) % NGW;
}
__device__ __forceinline__ void zero_bf16_rows(Frame& F, bf16* dst, size_t n16) {
    const v4u z = {0u, 0u, 0u, 0u};
    for (size_t i = (size_t)F.cb * NTHREADS + F.tid; i < n16; i += (size_t)F.cg * NTHREADS) ((v4u*)dst)[i] = z;
}
__device__ __forceinline__ void conv_win(Frame& F, int l) {
    int rot = 0; GAS unsigned char* ws = F.ws;
    bf16* WIN = (bf16*)(ws + WS_WIN); const float* win = INP(I_WIN) + (size_t)l * D * DIN;
    conv_seg(F, win, DIN, D, 0, 3072, WIN, D, 0, rot);
    conv_seg(F, win, DIN, D, 3104, 3072, WIN, D, 3072, rot);
    conv_seg(F, win, DIN, D, 6560, 2048, WIN, D, 6144, rot);
    conv_seg(F, win, DIN, D, 3072, 32, WIN, D, 8192, rot);
    conv_seg(F, win, DIN, D, 6176, 384, WIN, D, 8192 + 32, rot);
    zero_bf16_rows(F, WIN + (size_t)(8192 + 416) * D, (size_t)96 * D * 2 / 16);
}
__device__ __forceinline__ void conv_rest(Frame& F, int l) {
    int rot = 0; GAS unsigned char* ws = F.ws;
    conv_seg(F, INP(I_WPM) + (size_t)l * D * D, D, D, 0, D, (bf16*)(ws + WS_WPM), D, 0, rot);
    conv_seg(F, INP(I_WPR) + (size_t)l * D * D, D, D, 0, D, (bf16*)(ws + WS_WPR), D, 0, rot);
    conv_seg(F, INP(I_WOUT) + (size_t)l * D * D, D, D, 0, D, (bf16*)(ws + WS_WOUT), D, 0, rot);
    { bf16* WG2 = (bf16*)(ws + WS_WG2);
      conv_seg(F, INP(I_G2) + (size_t)l * 128 * RD, RD, 128, 0, RD, WG2, 256, 0, rot);
      for (int i = F.cb * NTHREADS + F.tid; i < 1024 * 16; i += F.cg * NTHREADS) { const int r = i >> 4, p = i & 15; *(v4u*)(WG2 + (size_t)r * 256 + 128 + 8 * p) = (v4u){0u, 0u, 0u, 0u}; } }
    { bf16* WL = (bf16*)(ws + WS_WLORA);
      for (int d = 0; d < 2; ++d) { conv_seg(F, INP(I_W2) + ((size_t)l * 2 + d) * 64 * RD, RD, 64, 0, RD, WL + (size_t)(0 * 2 + d) * RD * 64, 64, 0, rot);
                                    conv_seg(F, INP(I_A2) + ((size_t)l * 2 + d) * 64 * RD, RD, 64, 0, RD, WL + (size_t)(1 * 2 + d) * RD * 64, 64, 0, rot); } }
}
__device__ __forceinline__ void conv_ffn0(Frame& F) {
    int rot = 0; GAS unsigned char* ws = F.ws;
    conv_gu(F, INP(I_FFG), INP(I_FFU), FF, D, FF / 128, (bf16*)(ws + WS_WGU), rot);
    conv_seg(F, INP(I_FFD), D, FF, 0, D, (bf16*)(ws + WS_WDN), FF, 0, rot);
}
__device__ __forceinline__ void conv_experts(Frame& F) {
    int rot = 0;
    for (int e = 0; e < NE; ++e) {
        conv_gu8(F, INP(I_EG) + (size_t)e * D * FE, INP(I_EU) + (size_t)e * D * FE, FE, D, FE / 128, (unsigned char*)(F.ws + WS_WEGU) + (size_t)e * 2 * FE * D, W8S, rot);
        conv_seg8(F, INP(I_ED) + (size_t)e * FE * D, D, FE, 0, D, (unsigned char*)(F.ws + WS_WEDN) + (size_t)e * D * FE, FE, 0, W8S, rot);
    }
}
__device__ __forceinline__ void mod_phase(Frame& F) {
    LAS float* sl = (LAS float*)F.lds;
    LAS float* part = sl + 5 * D;
    for (int i = F.tid; i < 5 * D; i += NTHREADS) { const int bb = i / D, k = i % D; const float v = bb < 4 ? INP(I_C)[bb * D + k] : INP(I_CCTX)[k]; sl[i] = siluf_(v); }
    __syncthreads();
    float* MOD = (float*)(F.ws + WS_MOD);
    for (int item = F.bid; item < NL * 6 * D / 64; item += F.G) {
        const int l = item / (6 * D / 64), c0 = (item % (6 * D / 64)) * 64; const float* w = INP(I_WADA) + (size_t)l * D * 6 * D + c0 + F.lane;
        float a[5] = {0.f, 0.f, 0.f, 0.f, 0.f};
        for (int k = F.wave * 128; k < F.wave * 128 + 128; ++k) { const float wv = w[(size_t)k * 6 * D];
#pragma unroll
            for (int bb = 0; bb < 5; ++bb) a[bb] += sl[bb * D + k] * wv; }
#pragma unroll
        for (int bb = 0; bb < 5; ++bb) part[(F.wave * 5 + bb) * 64 + F.lane] = a[bb];
        __syncthreads();
        if (F.tid < 5 * 64) { const int bb = F.tid / 64, c = F.tid % 64; float s = INP(I_BADA)[l * 6 * D + c0 + c];
#pragma unroll
            for (int w8 = 0; w8 < 8; ++w8) s += part[(w8 * 5 + bb) * 64 + c];
            MOD[((size_t)l * 5 + bb) * 6 * D + c0 + c] = s; }
        __syncthreads();
    }
}
__device__ __forceinline__ const float* xrow(const float* lat, const float* ctx, int g) { return g < RL ? lat + (size_t)g * D : ctx + (size_t)(g - RL) * D; }
template <bool ROUTER> __device__ __forceinline__ void normmod_phase(Frame& F, const float* lat, const float* ctx, const float* gain, const float* MODl, int off_sh, int off_sc, int nrows, const float* wrt) {
    bf16* H = (bf16*)(F.ws + WS_H);
    LAS unsigned* lcnt = (LAS unsigned*)F.lds;
    LAS int* rec = (LAS int*)(F.lds + 64);
    LAS float* recp = (LAS float*)(F.lds + 64 + 1024);
    const int ngroups = nrows / 64;
    for (int grp = F.bid; grp < ngroups; grp += F.G) {
        if (ROUTER) { if (F.tid < 16) lcnt[F.tid] = 0u; __syncthreads(); }
        f32x4 vnx[4];
        { const float* x0 = xrow(lat, ctx, grp * 64 + F.wave * 8);
#pragma unroll
          for (int j = 0; j < 4; ++j) vnx[j] = *(const f32x4*)(x0 + 256 * j + 4 * F.lane); }
        for (int rr = 0; rr < 8; ++rr) {
            const int lrow = F.wave * 8 + rr, g = grp * 64 + lrow; const float* md = MODl + (g < RL ? g / T : 4) * 6 * D;
            f32x4 v[4]; float ss = 0.f;
#pragma unroll
            for (int j = 0; j < 4; ++j) v[j] = vnx[j];
            if (rr + 1 < 8) { const float* x1 = xrow(lat, ctx, g + 1);
#pragma unroll
                for (int j = 0; j < 4; ++j) vnx[j] = *(const f32x4*)(x1 + 256 * j + 4 * F.lane); }
#pragma unroll
            for (int j = 0; j < 4; ++j) ss += (v[j].x * v[j].x + v[j].y * v[j].y) + (v[j].z * v[j].z + v[j].w * v[j].w);
            const float rstd = 1.0f / sqrtf(wave_sum(ss) * (1.0f / D) + NORM_EPS);
            float lg[NE];
            if (ROUTER) {
#pragma unroll
                for (int e = 0; e < NE; ++e) lg[e] = 0.f; }
#pragma unroll
            for (int j = 0; j < 4; ++j) { const int c = 256 * j + 4 * F.lane;
                const f32x4 gn = *(const f32x4*)(gain + c), sc = *(const f32x4*)(md + off_sc + c), sh = *(const f32x4*)(md + off_sh + c);
                const f32x4 h = v[j] * rstd * gn * (1.0f + sc) + sh;
                v2u o; o.x = cvt_pk_bf16(h.x, h.y); o.y = cvt_pk_bf16(h.z, h.w); *(v2u*)(H + (size_t)g * D + c) = o;
                if (ROUTER) {
#pragma unroll
                    for (int q = 0; q < 4; ++q) { const f32x4 w0 = *(const f32x4*)(wrt + (size_t)(c + q) * NE), w1 = *(const f32x4*)(wrt + (size_t)(c + q) * NE + 4); const float hv = h[q];
                        lg[0] += hv * w0.x; lg[1] += hv * w0.y; lg[2] += hv * w0.z; lg[3] += hv * w0.w; lg[4] += hv * w1.x; lg[5] += hv * w1.y; lg[6] += hv * w1.z; lg[7] += hv * w1.w; } }
            }
            if (ROUTER) {
#pragma unroll
                for (int e = 0; e < NE; ++e) lg[e] = wave_sum(lg[e]);
                int i0 = 0;
#pragma unroll
                for (int e = 1; e < NE; ++e) if (lg[e] > lg[i0]) i0 = e;
                int i1 = i0 == 0 ? 1 : 0;
#pragma unroll
                for (int e = 0; e < NE; ++e) if (e != i0 && lg[e] > lg[i1]) i1 = e;
                if (F.lane == 0) { const float e1 = __expf(lg[i1] - lg[i0]); const float p0 = 1.0f / (1.0f + e1);
                    rec[lrow * 4 + 0] = i0; rec[lrow * 4 + 1] = i1; rec[lrow * 4 + 2] = (int)atomicAdd((unsigned*)&lcnt[i0], 1u); rec[lrow * 4 + 3] = (int)atomicAdd((unsigned*)&lcnt[i1], 1u);
                    recp[lrow * 2 + 0] = p0; recp[lrow * 2 + 1] = e1 * p0; }
            }
        }
        if (ROUTER) {
            __syncthreads();
            if (F.tid < NE) lcnt[8 + F.tid] = __hip_atomic_fetch_add((unsigned*)(F.ctl + CW_ECNT + 64 * F.tid), lcnt[F.tid], RLX_AGENT);
            __syncthreads();
            if (F.tid < 64) { const int g = grp * 64 + F.tid; int* tk = (int*)(F.ws + WS_META) + (size_t)g * 8; const int e0 = rec[F.tid * 4], e1 = rec[F.tid * 4 + 1];
                tk[0] = e0; tk[1] = e1; tk[2] = (int)lcnt[8 + e0] + rec[F.tid * 4 + 2]; tk[3] = (int)lcnt[8 + e1] + rec[F.tid * 4 + 3];
                ((float*)tk)[4] = recp[F.tid * 2]; ((float*)tk)[5] = recp[F.tid * 2 + 1]; }
            __syncthreads();
        }
    }
}
__device__ __forceinline__ void subgrid_arrive(Frame& F, gu32* cnt) {
    asm volatile("s_waitcnt vmcnt(0)" ::: "memory"); __syncthreads();
    if (F.tid == 0) { __builtin_amdgcn_fence(__ATOMIC_RELEASE, "agent"); asm volatile("s_waitcnt vmcnt(0)" ::: "memory"); __hip_atomic_fetch_add(cnt, 1u, RLX_AGENT); }
}
__device__ __forceinline__ void subgrid_wait(Frame& F, gu32* cnt, unsigned n) {
    if (F.tid == 0) { unsigned sp = 0; while (__hip_atomic_load(cnt, RLX_AGENT) < n) { __builtin_amdgcn_s_sleep(2); if (++sp > (1u << 20)) break; }
        __builtin_amdgcn_fence(__ATOMIC_ACQUIRE, "agent"); asm volatile("s_waitcnt vmcnt(0)" ::: "memory"); }
    __syncthreads();
}
__device__ __forceinline__ void sg_phase(Frame& F, int l) {
    const float* SM = (const float*)(F.ws + WS_SM); bf16* SG = (bf16*)(F.ws + WS_SG); const float* mu = INP(I_MU) + l * RW + 3328;
    for (int i = F.cb * NTHREADS + F.tid; i < R * 32; i += F.cg * NTHREADS) { const int g = i >> 5, p = i & 31; float o[8];
        if (p < 16) { const int nb = nbrow(g, 3328); const float* a = SM + (size_t)g * SMW + 288 + 8 * p;
            const f32x4 a0 = *(const f32x4*)a, a1 = *(const f32x4*)(a + 4); f32x4 b0 = {0.f, 0.f, 0.f, 0.f}, b1 = b0;
            if (nb >= 0) { const float* bq = SM + (size_t)nb * SMW + 288 + 8 * p; b0 = *(const f32x4*)bq; b1 = *(const f32x4*)(bq + 4); }
#pragma unroll
            for (int j = 0; j < 4; ++j) { o[j] = sigmoidf_(a0[j] + (b0[j] - a0[j]) * mu[8 * p + j]); o[4 + j] = sigmoidf_(a1[j] + (b1[j] - a1[j]) * mu[8 * p + 4 + j]); }
        } else {
#pragma unroll
            for (int j = 0; j < 8; ++j) o[j] = 0.f; }
        *(v4u*)(SG + (size_t)g * 256 + 8 * p) = pack8(o); }
}

constexpr int ML_P = 72, ML_QS = 0, ML_KS = 64 * ML_P * 2, ML_KT = 2 * ML_KS, ML_PS = 3 * ML_KS, ML_VT = 4 * ML_KS, ML_CB = ML_VT + 48 * ML_P * 2, ML_GT = ML_CB + 48 * ML_P * 2, ML_END = ML_GT + 2 * 6 * 64 * 4;
template <int CTRL, int RMASK> __device__ __forceinline__ float dpp_get(float v, float old) { return __int_as_float(__builtin_amdgcn_update_dpp(__float_as_int(old), __float_as_int(v), CTRL, RMASK, 0xf, false)); }
__device__ __forceinline__ float wave_scan_add(float x) {
    x += dpp_get<0x111, 0xf>(x, 0.f); x += dpp_get<0x112, 0xf>(x, 0.f); x += dpp_get<0x114, 0xf>(x, 0.f); x += dpp_get<0x118, 0xf>(x, 0.f);
    x += dpp_get<0x142, 0xa>(x, 0.f); x += dpp_get<0x143, 0xc>(x, 0.f); return x;
}
__device__ __forceinline__ float wave_scan_max(float x) {
    const float ninf = -__builtin_inff();
    x = fmaxf(x, dpp_get<0x111, 0xf>(x, ninf)); x = fmaxf(x, dpp_get<0x112, 0xf>(x, ninf)); x = fmaxf(x, dpp_get<0x114, 0xf>(x, ninf)); x = fmaxf(x, dpp_get<0x118, 0xf>(x, ninf));
    x = fmaxf(x, dpp_get<0x142, 0xa>(x, ninf)); x = fmaxf(x, dpp_get<0x143, 0xc>(x, ninf)); return x;
}
__device__ __forceinline__ float lane63(float x) { return __int_as_float(__builtin_amdgcn_readlane(__float_as_int(x), 63)); }
__device__ __forceinline__ void mlstm_phase(Frame& F, int l, int first, int stride) {
    LAS unsigned char* L = F.lds;
    LAS bf16* Qs = (LAS bf16*)(L + ML_QS); LAS bf16* Ks = (LAS bf16*)(L + ML_KS); LAS bf16* Kt = (LAS bf16*)(L + ML_KT); LAS bf16* Ps = (LAS bf16*)(L + ML_PS);
    LAS bf16* Vt = (LAS bf16*)(L + ML_VT); LAS bf16* Cb = (LAS bf16*)(L + ML_CB); LAS float* GT = (LAS float*)(L + ML_GT);
    const bf16* Qg = (const bf16*)(F.ws + WS_Q); const bf16* Kg = (const bf16*)(F.ws + WS_K); const bf16* Vg = (const bf16*)(F.ws + WS_V); const float* SM = (const float*)(F.ws + WS_SM);
    bf16* HF = (bf16*)(F.ws + WS_HF); const float* bgate = INP(I_BG) + l * 4 * MH;
    const int tid = F.tid, lane = F.lane, wave = F.wave, r16 = lane & 15, quad = lane >> 4;
    for (int item = first; item < NB * 2 * MH * 4; item += stride) {
        const int vq = item & 3, h = (item >> 2) & 7, dir = (item >> 5) & 1, b = item >> 6;
        __syncthreads();
        for (int i = tid; i < 48 * ML_P; i += NTHREADS) { Cb[i] = 0; Vt[i] = (i >= 32 * ML_P) ? (bf16)0x3F80 : (bf16)0; }
        const float bgi = bgate[(2 * dir) * MH + h], bgf = bgate[(2 * dir + 1) * MH + h];
        const int ss_ = tid & 63, pc = tid >> 6;
        v4u rq, rk, rv = {0u, 0u, 0u, 0u};
        { const int g = row_of(b, tok(dir, ss_)); rq = *(const v4u*)(Qg + (size_t)g * 512 + h * 64 + pc * 8); rk = *(const v4u*)(Kg + (size_t)g * 512 + h * 64 + pc * 8);
          if (pc < 4) rv = *(const v4u*)(Vg + (size_t)g * 1024 + h * 128 + vq * 32 + pc * 8); }
        float m_run = 0.f, gi = 0.f, gf = 0.f;
        auto gate_tables = [&](int buf) {
            LAS float* G = GT + buf * 384;
            const float iv = CAP * fast_tanh((gi + bgi) * (1.0f / CAP)), lf = -fast_softplus(-CAP * fast_tanh((gf + bgf) * (1.0f / CAP)));
            const float bsum = wave_scan_add(lf), pmx = wave_scan_max(iv - bsum);
            const float inter = bsum + m_run, mt = fmaxf(inter, bsum + pmx);
            G[lane] = bsum - mt; G[64 + lane] = iv - bsum; G[128 + lane] = __expf(inter - mt); G[192 + lane] = __expf(-mt);
            const float blast = lane63(bsum), mnew = fmaxf(blast + m_run, blast + lane63(pmx));
            G[256 + lane] = __expf(blast - bsum + iv - mnew);
            if (lane == 0) G[320] = __expf(blast + m_run - mnew);
            m_run = mnew;
        };
        if (wave == 1) { { const int g = row_of(b, tok(dir, lane)); gi = SM[(size_t)g * SMW + (2 * dir) * MH + h]; gf = SM[(size_t)g * SMW + (2 * dir + 1) * MH + h]; }
            gate_tables(0);
            { const int g = row_of(b, tok(dir, 64 + lane)); gi = SM[(size_t)g * SMW + (2 * dir) * MH + h]; gf = SM[(size_t)g * SMW + (2 * dir + 1) * MH + h]; } }
        f32x4 Cacc = {0.f, 0.f, 0.f, 0.f}, Cacc2 = {0.f, 0.f, 0.f, 0.f};
        __syncthreads();
        for (int j = 0; j < NCH; ++j) {
            const LAS float* G = GT + (j & 1) * 384;
            { *(v4u*)(Qs + ss_ * ML_P + pc * 8) = rq; *(v4u*)(Ks + ss_ * ML_P + pc * 8) = rk;
              const unsigned kw[4] = {rk.x, rk.y, rk.z, rk.w};
#pragma unroll
              for (int i = 0; i < 4; ++i) { Kt[(pc * 8 + 2 * i) * ML_P + ss_] = (bf16)(kw[i] & 0xffffu); Kt[(pc * 8 + 2 * i + 1) * ML_P + ss_] = (bf16)(kw[i] >> 16); }
              if (pc < 4) { const unsigned vw[4] = {rv.x, rv.y, rv.z, rv.w};
#pragma unroll
                  for (int i = 0; i < 4; ++i) { Vt[(pc * 8 + 2 * i) * ML_P + ss_] = (bf16)(vw[i] & 0xffffu); Vt[(pc * 8 + 2 * i + 1) * ML_P + ss_] = (bf16)(vw[i] >> 16); } } }
            if (j + 1 < NCH) { const int g = row_of(b, tok(dir, (j + 1) * 64 + ss_)); rq = *(const v4u*)(Qg + (size_t)g * 512 + h * 64 + pc * 8); rk = *(const v4u*)(Kg + (size_t)g * 512 + h * 64 + pc * 8);
                if (pc < 4) rv = *(const v4u*)(Vg + (size_t)g * 1024 + h * 128 + vq * 32 + pc * 8); }
            __syncthreads();
            const int mt = wave >> 1, vnt = wave & 1;
            if (wave == 1 && j + 1 < NCH) { gate_tables((j + 1) & 1);
                if (j + 2 < NCH) { const int g = row_of(b, tok(dir, (j + 2) * 64 + lane)); gi = SM[(size_t)g * SMW + (2 * dir) * MH + h]; gf = SM[(size_t)g * SMW + (2 * dir + 1) * MH + h]; } }
            const bf16x8 qa0 = *(const LAS bf16x8*)(Qs + (16 * mt + r16) * ML_P + quad * 8), qa1 = *(const LAS bf16x8*)(Qs + (16 * mt + r16) * ML_P + 32 + quad * 8);
            f32x4 accq = {0.f, 0.f, 0.f, 0.f}, accqn = {0.f, 0.f, 0.f, 0.f};
            { const bf16x8 c0 = *(const LAS bf16x8*)(Cb + (16 * vnt + r16) * ML_P + quad * 8), c1 = *(const LAS bf16x8*)(Cb + (16 * vnt + r16) * ML_P + 32 + quad * 8);
              const bf16x8 n0 = *(const LAS bf16x8*)(Cb + (32 + r16) * ML_P + quad * 8), n1 = *(const LAS bf16x8*)(Cb + (32 + r16) * ML_P + 32 + quad * 8);
              accq = __builtin_amdgcn_mfma_f32_16x16x32_bf16(qa0, c0, accq, 0, 0, 0); accq = __builtin_amdgcn_mfma_f32_16x16x32_bf16(qa1, c1, accq, 0, 0, 0);
              accqn = __builtin_amdgcn_mfma_f32_16x16x32_bf16(qa0, n0, accqn, 0, 0, 0); accqn = __builtin_amdgcn_mfma_f32_16x16x32_bf16(qa1, n1, accqn, 0, 0, 0); }
#pragma unroll
            for (int nn = 0; nn < 2; ++nn) { const int nt = 2 * (wave & 1) + nn; f32x4 sacc = {0.f, 0.f, 0.f, 0.f};
                if (nt <= mt) { const bf16x8 k0 = *(const LAS bf16x8*)(Ks + (16 * nt + r16) * ML_P + quad * 8), k1 = *(const LAS bf16x8*)(Ks + (16 * nt + r16) * ML_P + 32 + quad * 8);
                    sacc = __builtin_amdgcn_mfma_f32_16x16x32_bf16(qa0, k0, sacc, 0, 0, 0); sacc = __builtin_amdgcn_mfma_f32_16x16x32_bf16(qa1, k1, sacc, 0, 0, 0); }
                const int s = 16 * nt + r16; const float wc_ = G[64 + s];
#pragma unroll
                for (int i = 0; i < 4; ++i) { const int t = 16 * mt + 4 * quad + i; const float p = (s <= t) ? sacc[i] * 0.125f * __expf(G[t] + wc_) : 0.f;
                    Ps[t * ML_P + s] = (bf16)(cvt_pk_bf16(p, 0.f) & 0xffffu); } }
            __syncthreads();
            { f32x4 acc = {0.f, 0.f, 0.f, 0.f}, accn = {0.f, 0.f, 0.f, 0.f};
#pragma unroll
              for (int ks = 0; ks < 2; ++ks) { if (ks == 1 && mt < 2) break;
                  const bf16x8 pa = *(const LAS bf16x8*)(Ps + (16 * mt + r16) * ML_P + 32 * ks + quad * 8);
                  const bf16x8 vb = *(const LAS bf16x8*)(Vt + (16 * vnt + r16) * ML_P + 32 * ks + quad * 8), ob = *(const LAS bf16x8*)(Vt + (32 + r16) * ML_P + 32 * ks + quad * 8);
                  acc = __builtin_amdgcn_mfma_f32_16x16x32_bf16(pa, vb, acc, 0, 0, 0); accn = __builtin_amdgcn_mfma_f32_16x16x32_bf16(pa, ob, accn, 0, 0, 0); }
#pragma unroll
              for (int i = 0; i < 4; ++i) { const int t = 16 * mt + 4 * quad + i; const float wi = G[128 + t] * 0.125f, dn = accn[i] + wi * accqn[i], inv = 1.0f / fmaxf(fabsf(dn), G[192 + t]);
                  const int g = row_of(b, tok(dir, j * 64 + t));
                  HF[((size_t)dir * R + g) * 1024 + h * 128 + vq * 32 + 16 * vnt + r16] = (bf16)(cvt_pk_bf16((acc[i] + wi * accq[i]) * inv, 0.f) & 0xffffu); } }
            { const float aold = G[320]; const int vmt = wave >> 2, dnt = wave & 3;
              f32x4 d1 = {0.f, 0.f, 0.f, 0.f}, d2 = {0.f, 0.f, 0.f, 0.f};
#pragma unroll
              for (int ks = 0; ks < 2; ++ks) {
                  const v4u kraw = *(const LAS v4u*)(Kt + (16 * dnt + r16) * ML_P + 32 * ks + quad * 8); float kf[8]; unpack8(kraw, kf);
                  const f32x4 a0 = *(const LAS f32x4*)&G[256 + 32 * ks + quad * 8], a1 = *(const LAS f32x4*)&G[256 + 32 * ks + quad * 8 + 4];
                  kf[0] *= a0.x; kf[1] *= a0.y; kf[2] *= a0.z; kf[3] *= a0.w; kf[4] *= a1.x; kf[5] *= a1.y; kf[6] *= a1.z; kf[7] *= a1.w;
                  const v4u kp = pack8(kf); const bf16x8 kb = __builtin_bit_cast(bf16x8, kp);
                  const bf16x8 va = *(const LAS bf16x8*)(Vt + (16 * vmt + r16) * ML_P + 32 * ks + quad * 8);
                  d1 = __builtin_amdgcn_mfma_f32_16x16x32_bf16(va, kb, d1, 0, 0, 0);
                  if (wave < 4) { const bf16x8 oa = *(const LAS bf16x8*)(Vt + (32 + r16) * ML_P + 32 * ks + quad * 8); d2 = __builtin_amdgcn_mfma_f32_16x16x32_bf16(oa, kb, d2, 0, 0, 0); } }
              Cacc = Cacc * aold + d1;
#pragma unroll
              for (int i = 0; i < 4; ++i) Cb[(16 * vmt + 4 * quad + i) * ML_P + 16 * dnt + r16] = (bf16)(cvt_pk_bf16(Cacc[i], 0.f) & 0xffffu);
              if (wave < 4) { Cacc2 = Cacc2 * aold + d2;
#pragma unroll
                  for (int i = 0; i < 4; ++i) Cb[(32 + 4 * quad + i) * ML_P + 16 * dnt + r16] = (bf16)(cvt_pk_bf16(Cacc2[i], 0.f) & 0xffffu); } }
            __syncthreads();
        }
    }
}

constexpr int RP = 72;
constexpr int RC_AB = 0, RC_BB = 9216, RC_KB = 18432, RC_RB = 27648, RC_BHT = 36864, RC_KHT = 46080, RC_ABT = 55296, RC_GAKT = 64512, RC_BONP = 67584;
constexpr int RC_TW = 0, RC_AD = 9216;
constexpr int RC_KK16 = 71680, RC_K16 = 80896, RC_R16 = 99328;
constexpr int RC_GAB = 71680, RC_GAK = 75776, RC_HRB = 78848, RC_HRK = 81920, RC_TT = 84992, RC_SAT = 88064, RC_YO = 93184;
constexpr int RC_GL = 109568, RC_VT = 110592, RC_SB = 119808, RC_CONST = 129024, RC_W2T = 133120, RC_A2T = 142336, RC_END = 151552;
static_assert(RC_END <= MISC_OFF && RC_YO + 16384 <= RC_GL && RC_BONP + 1024 <= RC_KK16 && RC_TT + 3072 <= RC_SAT && RC_SAT + 5120 <= RC_YO, "rwkv LDS map");
struct RwPre { f32x4 lw[2], lwn[2], la[2], lan[2]; v4u r, rn, k, kn, v, vn; };
__device__ __forceinline__ void rw_prefetch(RwPre& P, const float* SM, const bf16* RKV, int b, int dir, int h, int j, int tid) {
    const int s = tid >> 3, p8 = (tid & 7) * 8, g = row_of(b, tok(dir, j * 64 + s));
    { const int nb = nbrow(g, 3072); const float* a = SM + (size_t)g * SMW + 32 + 64 * dir + p8; const float* c = SM + (size_t)g * SMW + 160 + 64 * dir + p8;
      P.lw[0] = *(const f32x4*)a; P.lw[1] = *(const f32x4*)(a + 4); P.la[0] = *(const f32x4*)c; P.la[1] = *(const f32x4*)(c + 4);
      const f32x4 z = {0.f, 0.f, 0.f, 0.f}; P.lwn[0] = z; P.lwn[1] = z; P.lan[0] = z; P.lan[1] = z;
      if (nb >= 0) { const float* an = SM + (size_t)nb * SMW + 32 + 64 * dir + p8; const float* cn = SM + (size_t)nb * SMW + 160 + 64 * dir + p8;
          P.lwn[0] = *(const f32x4*)an; P.lwn[1] = *(const f32x4*)(an + 4); P.lan[0] = *(const f32x4*)cn; P.lan[1] = *(const f32x4*)(cn + 4); } }
    const v4u z4 = {0u, 0u, 0u, 0u};
    { const int rw = h * 64 + p8, nb = nbrow(g, rw); P.r = *(const v4u*)(RKV + (size_t)g * 3072 + rw); P.rn = nb >= 0 ? *(const v4u*)(RKV + (size_t)nb * 3072 + rw) : z4; }
    { const int rw = 1024 + h * 64 + p8, nb = nbrow(g, rw); P.k = *(const v4u*)(RKV + (size_t)g * 3072 + rw); P.kn = nb >= 0 ? *(const v4u*)(RKV + (size_t)nb * 3072 + rw) : z4; }
    { const int rw = 2048 + h * 64 + p8, nb = nbrow(g, rw); P.v = *(const v4u*)(RKV + (size_t)g * 3072 + rw); P.vn = nb >= 0 ? *(const v4u*)(RKV + (size_t)nb * 3072 + rw) : z4; }
}
__device__ __forceinline__ bf16x8 lds_frag(const LAS bf16* p) { return *(const LAS bf16x8*)p; }
__device__ __forceinline__ bf16x8 lds_frag_k16(const LAS bf16* p, int quad) { const bf16x8 v = *(const LAS bf16x8*)p; const bf16x8 z = {0, 0, 0, 0, 0, 0, 0, 0}; return quad < 2 ? v : z; }
__device__ __forceinline__ bf16x8 lds_frag_perm(const LAS bf16* p) { const v2u lo = *(const LAS v2u*)p, hi = *(const LAS v2u*)(p + 16); const v4u w = {lo.x, lo.y, hi.x, hi.y}; return __builtin_bit_cast(bf16x8, w); }
__device__ __forceinline__ bf16x8 lds_frag_lo4(const LAS bf16* p) { const v2u lo = *(const LAS v2u*)p; const v4u w = {lo.x, lo.y, 0u, 0u}; return __builtin_bit_cast(bf16x8, w); }
__device__ __forceinline__ unsigned pk2(float lo, float hi) { typedef __bf16 bf2 __attribute__((ext_vector_type(2))); const bf2 v = {(__bf16)lo, (__bf16)hi}; return __builtin_bit_cast(unsigned, v); }
__device__ __forceinline__ bf16 f2b(float x) { return __builtin_bit_cast(unsigned short, (__bf16)x); }
__device__ __forceinline__ float b2f(bf16 x) { return __uint_as_float((unsigned)x << 16); }
#define MFMA16(a, b, c) __builtin_amdgcn_mfma_f32_16x16x32_bf16(a, b, c, 0, 0, 0)
__device__ __forceinline__ void rwkv_phase(Frame& F, int l, int first, int stride) {
    LAS unsigned char* L = F.lds;
    LAS bf16* Ab = (LAS bf16*)(L + RC_AB); LAS bf16* Bb = (LAS bf16*)(L + RC_BB); LAS bf16* Kb = (LAS bf16*)(L + RC_KB); LAS bf16* Rb = (LAS bf16*)(L + RC_RB);
    LAS bf16* BhT = (LAS bf16*)(L + RC_BHT); LAS bf16* KhT = (LAS bf16*)(L + RC_KHT); LAS bf16* AbT = (LAS bf16*)(L + RC_ABT); LAS bf16* GAKT = (LAS bf16*)(L + RC_GAKT); LAS float* BONP = (LAS float*)(L + RC_BONP);
    LAS bf16* TW = (LAS bf16*)(L + RC_TW); LAS bf16* AD = (LAS bf16*)(L + RC_AD);
    LAS bf16* KK16 = (LAS bf16*)(L + RC_KK16); LAS bf16* K16 = (LAS bf16*)(L + RC_K16); LAS bf16* R16 = (LAS bf16*)(L + RC_R16);
    LAS float* GAB = (LAS float*)(L + RC_GAB); LAS bf16* GAK = (LAS bf16*)(L + RC_GAK); LAS bf16* HRB = (LAS bf16*)(L + RC_HRB); LAS bf16* HRK = (LAS bf16*)(L + RC_HRK); LAS bf16* TT = (LAS bf16*)(L + RC_TT);
    LAS bf16* SAt = (LAS bf16*)(L + RC_SAT); LAS float* YO = (LAS float*)(L + RC_YO); LAS float* GL = (LAS float*)(L + RC_GL);
    LAS bf16* Vt = (LAS bf16*)(L + RC_VT); LAS bf16* Sb = (LAS bf16*)(L + RC_SB); LAS float* CN = (LAS float*)(L + RC_CONST); LAS bf16* W2T = (LAS bf16*)(L + RC_W2T); LAS bf16* A2T = (LAS bf16*)(L + RC_A2T);
    const float* SM = (const float*)(F.ws + WS_SM); const bf16* RKV = (const bf16*)(F.ws + WS_RKV); bf16* YS = (bf16*)(F.ws + WS_YS); float* BON = (float*)(F.ws + WS_BON);
    const bf16* WL = (const bf16*)(F.ws + WS_WLORA);
    const int tid = F.tid, lane = F.lane, wave = F.wave;
    for (int item = first; item < NB * 2 * RH; item += stride) {
        const int h = item & 15, dir = (item >> 4) & 1, b = item >> 5;
        __syncthreads();
        if (tid < 64) { const float* mu = INP(I_MU) + l * RW; CN[tid] = mu[h * 64 + tid]; CN[64 + tid] = mu[1024 + h * 64 + tid]; CN[128 + tid] = mu[2048 + h * 64 + tid];
            CN[192 + tid] = mu[3072 + 64 * dir + tid]; CN[256 + tid] = mu[3200 + 64 * dir + tid];
            CN[320 + tid] = INP(I_KK)[l * RD + h * 64 + tid]; CN[384 + tid] = INP(I_KA)[l * RD + h * 64 + tid]; CN[448 + tid] = INP(I_RK)[l * RD + h * 64 + tid];
            CN[512 + tid] = INP(I_W0)[(l * 2 + dir) * RD + h * 64 + tid]; CN[576 + tid] = INP(I_A0)[(l * 2 + dir) * RD + h * 64 + tid]; }
        { const int n = tid >> 3, p8 = (tid & 7) * 8;
          *(v4u*)(W2T + n * 72 + p8) = *(const v4u*)(WL + ((size_t)(0 * 2 + dir) * RD + h * 64 + n) * 64 + p8);
          *(v4u*)(A2T + n * 72 + p8) = *(const v4u*)(WL + ((size_t)(1 * 2 + dir) * RD + h * 64 + n) * 64 + p8); }
        for (int i = tid; i < (RC_CONST - RC_GL) / 4; i += NTHREADS) ((LAS unsigned*)(L + RC_GL))[i] = 0u;
        f32x4 ST[4]; for (int kt = 0; kt < 4; ++kt) ST[kt] = (f32x4){0.f, 0.f, 0.f, 0.f};
        RwPre P; rw_prefetch(P, SM, RKV, b, dir, h, 0, tid);
        __syncthreads();
        for (int j = 0; j < NCH; ++j) {
            { int tl = tid; asm volatile("" : "+v"(tl)); const int s = tl >> 3, p8 = (tl & 7) * 8;
              { float tw[8], ad[8]; const f32x4 muw[2] = {*(const f32x4*)&CN[192 + p8], *(const f32x4*)&CN[196 + p8]}, mua[2] = {*(const f32x4*)&CN[256 + p8], *(const f32x4*)&CN[260 + p8]};
#pragma unroll
                for (int i = 0; i < 8; ++i) { const float pw = P.lw[i >> 2][i & 3], pwn = P.lwn[i >> 2][i & 3], pa = P.la[i >> 2][i & 3], pan = P.lan[i >> 2][i & 3];
                    tw[i] = fast_tanh(pw + (pwn - pw) * muw[i >> 2][i & 3]); ad[i] = pa + (pan - pa) * mua[i >> 2][i & 3]; }
                *(v4u*)(TW + s * 72 + p8) = pack8(tw); *(v4u*)(AD + s * 72 + p8) = pack8(ad); }
              { float a[8], bq[8], o[8]; const f32x4 mur[2] = {*(const f32x4*)&CN[p8], *(const f32x4*)&CN[4 + p8]}, muk[2] = {*(const f32x4*)&CN[64 + p8], *(const f32x4*)&CN[68 + p8]};
                unpack8(P.r, a); unpack8(P.rn, bq);
#pragma unroll
                for (int i = 0; i < 8; ++i) o[i] = a[i] + (bq[i] - a[i]) * mur[i >> 2][i & 3];
                *(v4u*)(R16 + s * RP + p8) = pack8(o);
                unpack8(P.k, a); unpack8(P.kn, bq); float ssq = 0.f; const f32x4 kkc[2] = {*(const f32x4*)&CN[320 + p8], *(const f32x4*)&CN[324 + p8]};
#pragma unroll
                for (int i = 0; i < 8; ++i) { o[i] = a[i] + (bq[i] - a[i]) * muk[i >> 2][i & 3]; a[i] = o[i] * kkc[i >> 2][i & 3]; ssq += a[i] * a[i]; }
                *(v4u*)(K16 + s * RP + p8) = pack8(o);
                const float inv = 1.0f / fmaxf(sqrtf(red8(ssq)), 1e-12f);
#pragma unroll
                for (int i = 0; i < 8; ++i) a[i] *= inv;
                *(v4u*)(KK16 + s * RP + p8) = pack8(a);
                { unpack8(P.v, a); unpack8(P.vn, bq); const f32x4 muv[2] = {*(const f32x4*)&CN[128 + p8], *(const f32x4*)&CN[132 + p8]};
#pragma unroll
                  for (int i = 0; i < 8; ++i) Vt[(p8 + i) * RP + s] = f2b(a[i] + (bq[i] - a[i]) * muv[i >> 2][i & 3]); } } }
            __syncthreads();
            if (j + 1 < NCH) rw_prefetch(P, SM, RKV, b, dir, h, j + 1, tid);
            { int lb = lane; asm volatile("" : "+v"(lb)); const int r16 = lb & 15, quad = lb >> 4; const int c = wave >> 1;
              const bf16x8 a0 = lds_frag(TW + (16 * c + r16) * 72 + quad * 8), a1 = lds_frag(TW + (16 * c + r16) * 72 + 32 + quad * 8);
              const bf16x8 d0 = lds_frag(AD + (16 * c + r16) * 72 + quad * 8), d1 = lds_frag(AD + (16 * c + r16) * 72 + 32 + quad * 8);
              f32x4 cw[2], ca[2];
#pragma unroll
              for (int nn = 0; nn < 2; ++nn) { const int nt = 2 * (wave & 1) + nn; const f32x4 z = {0.f, 0.f, 0.f, 0.f};
                  cw[nn] = MFMA16(a0, lds_frag(W2T + (16 * nt + r16) * 72 + quad * 8), z); cw[nn] = MFMA16(a1, lds_frag(W2T + (16 * nt + r16) * 72 + 32 + quad * 8), cw[nn]);
                  ca[nn] = MFMA16(d0, lds_frag(A2T + (16 * nt + r16) * 72 + quad * 8), z); ca[nn] = MFMA16(d1, lds_frag(A2T + (16 * nt + r16) * 72 + 32 + quad * 8), ca[nn]); }
              __syncthreads();
              float bsum[4] = {0.f, 0.f, 0.f, 0.f};
#pragma unroll
              for (int nn = 0; nn < 2; ++nn) { const int nt = 2 * (wave & 1) + nn, n = 16 * nt + r16; const float w0c = CN[512 + n], a0c = CN[576 + n], kac = CN[384 + n], rkc = CN[448 + n];
                  float wv[4], av[4], pin[4], pex[4];
#pragma unroll
                  for (int i = 0; i < 4; ++i) { wv[i] = __expf(-0.60653066f * sigmoidf_(w0c + cw[nn][i])); av[i] = sigmoidf_(a0c + ca[nn][i]); }
                  pin[0] = wv[0]; pin[1] = pin[0] * wv[1]; pin[2] = pin[1] * wv[2]; pin[3] = pin[2] * wv[3];
                  float x = pin[3], y = __shfl_up(x, 16); if (quad >= 1) x *= y; y = __shfl_up(x, 32); if (quad >= 2) x *= y;
                  float ex = __shfl_up(x, 16); if (quad == 0) ex = 1.0f; const float gl = __shfl(x, 48 + r16);
                  pex[0] = ex; pex[1] = ex * pin[0]; pex[2] = ex * pin[1]; pex[3] = ex * pin[2];
#pragma unroll
                  for (int i = 0; i < 4; ++i) pin[i] *= ex;
                  float abv[4], bhv[4], khv[4];
#pragma unroll
                  for (int i = 0; i < 4; ++i) { const int t = 16 * c + 4 * quad + i; const float kk = b2f(KK16[t * RP + n]), kx = b2f(K16[t * RP + n]), rr = b2f(R16[t * RP + n]);
                      const float kka = kk * av[i], kd = kx * (1.0f + (av[i] - 1.0f) * kac), gi_ = __builtin_amdgcn_rcpf(pin[i]), bb = kka * gi_, kb = kd * gi_;
                      abv[i] = kk * pex[i]; bhv[i] = bb * gl; khv[i] = kb * gl; bsum[i] += rr * kd * rkc;
                      Ab[t * RP + n] = f2b(abv[i]); Rb[t * RP + n] = f2b(rr * pin[i]); Bb[t * RP + n] = f2b(bb); Kb[t * RP + n] = f2b(kb); }
                  { v2u o; o.x = cvt_pk_bf16(abv[0], abv[1]); o.y = cvt_pk_bf16(abv[2], abv[3]); *(v2u*)(AbT + n * RP + 16 * c + 4 * quad) = o;
                    o.x = cvt_pk_bf16(bhv[0], bhv[1]); o.y = cvt_pk_bf16(bhv[2], bhv[3]); *(v2u*)(BhT + n * RP + 16 * c + 4 * quad) = o;
                    o.x = cvt_pk_bf16(khv[0], khv[1]); o.y = cvt_pk_bf16(khv[2], khv[3]); *(v2u*)(KhT + n * RP + 16 * c + 4 * quad) = o; }
                  if (quad == 3) GL[c * 64 + n] = gl;
              }
#pragma unroll
              for (int i = 0; i < 4; ++i) { const float tot = red16(bsum[i]); if (r16 == 0) BONP[(16 * c + 4 * quad + i) * 2 + (wave & 1)] = tot; } }
            __syncthreads();
            { int lf_ = lane; asm volatile("" : "+v"(lf_)); const int r16 = lf_ & 15, quad = lf_ >> 4; const int c = wave & 3, odd = wave >> 2; const LAS bf16* Asrc = odd ? Rb : Ab;     const f32x4 z = {0.f, 0.f, 0.f, 0.f};
              const bf16x8 a0 = lds_frag(Asrc + (16 * c + r16) * RP + quad * 8), a1 = lds_frag(Asrc + (16 * c + r16) * RP + 32 + quad * 8);
              f32x4 g1 = MFMA16(a0, lds_frag(Bb + (16 * c + r16) * RP + quad * 8), z); g1 = MFMA16(a1, lds_frag(Bb + (16 * c + r16) * RP + 32 + quad * 8), g1);
              f32x4 g2 = MFMA16(a0, lds_frag(Kb + (16 * c + r16) * RP + quad * 8), z); g2 = MFMA16(a1, lds_frag(Kb + (16 * c + r16) * RP + 32 + quad * 8), g2);
              if (wave == 7) { const float bs = BONP[lf_ * 2] + BONP[lf_ * 2 + 1]; BON[((size_t)dir * R + row_of(b, tok(dir, j * 64 + lf_))) * RH + h] = bs; }
              float v2m[4];
#pragma unroll
              for (int i = 0; i < 4; ++i) { const int t = 4 * quad + i; const bool keep = odd ? (r16 <= t) : (r16 < t); const float v1 = keep ? g1[i] : 0.f; v2m[i] = keep ? g2[i] : 0.f;
                  if (odd) { HRB[c * 384 + t * 24 + r16] = f2b(v1); HRK[c * 384 + t * 24 + r16] = f2b(v2m[i]); } else { GAB[c * 256 + t * 16 + r16] = v1; GAK[c * 384 + t * 24 + r16] = f2b(v2m[i]); } }
              if (!odd) { { v2u o; o.x = cvt_pk_bf16(v2m[0], v2m[1]); o.y = cvt_pk_bf16(v2m[2], v2m[3]); *(v2u*)(GAKT + c * 384 + r16 * 24 + 4 * quad) = o; }
                  LDS_WAIT(); __builtin_amdgcn_wave_barrier();
                  float tj[16];
                  tj[0] = (r16 == 0) ? 1.0f : 0.f;
#pragma unroll
                  for (int i = 1; i < 16; ++i) { const LAS f32x4* gr = (const LAS f32x4*)(GAB + c * 256 + i * 16); float acc0 = (r16 == i) ? 1.0f : 0.f, acc1 = 0.f;
#pragma unroll
                      for (int q = 0; q < (i + 3) / 4; ++q) { const f32x4 g4 = gr[q];
#pragma unroll
                          for (int e = 0; e < 4; ++e) { const int jj = 4 * q + e; if (jj < i) { if (jj & 1) acc1 -= g4[e] * tj[jj]; else acc0 -= g4[e] * tj[jj]; } } }
                      tj[i] = acc0 + acc1; }
                  if (quad == 0) {
#pragma unroll
                      for (int i = 0; i < 16; ++i) TT[c * 384 + i * 24 + r16] = f2b(tj[i]); } } }
            __syncthreads();
            { int lg = lane; asm volatile("" : "+v"(lg)); const int r16 = lg & 15, quad = lg >> 4; const int c = wave & 3, half = wave >> 2; const f32x4 z = {0.f, 0.f, 0.f, 0.f};
              const bf16x8 ta = lds_frag_k16(TT + c * 384 + r16 * 24 + quad * 8, quad);
              f32x4 o0 = MFMA16(ta, lds_frag(AbT + (16 * (2 * half) + r16) * RP + 16 * c + (quad & 1) * 8), z), o1 = MFMA16(ta, lds_frag(AbT + (16 * (2 * half + 1) + r16) * RP + 16 * c + (quad & 1) * 8), z);
              f32x4 og = z; if (!half) og = MFMA16(ta, lds_frag(GAKT + c * 384 + r16 * 24 + (quad & 1) * 8), z);
#pragma unroll
              for (int i = 0; i < 4; ++i) { const int t = 4 * quad + i; Ab[(16 * c + t) * RP + 16 * (2 * half) + r16] = f2b(o0[i]); Ab[(16 * c + t) * RP + 16 * (2 * half + 1) + r16] = f2b(o1[i]); if (!half) GAK[c * 384 + t * 24 + r16] = f2b(og[i]); } }
            __syncthreads();
            if (wave < 4) {
                int lc = lane; asm volatile("" : "+v"(lc)); const int r16 = lc & 15, quad = lc >> 4, vnt = wave;
#pragma unroll 1
                for (int c = 0; c < 4; ++c) {
                    bf16x8 sb[2];
#pragma unroll
                    for (int ks = 0; ks < 2; ++ks) { v4u w; w.x = pk2(ST[2 * ks][0], ST[2 * ks][1]); w.y = pk2(ST[2 * ks][2], ST[2 * ks][3]); w.z = pk2(ST[2 * ks + 1][0], ST[2 * ks + 1][1]); w.w = pk2(ST[2 * ks + 1][2], ST[2 * ks + 1][3]); sb[ks] = __builtin_bit_cast(bf16x8, w); }
                    const v2u vmw = *(const LAS v2u*)(Vt + (16 * vnt + r16) * RP + 16 * c + 4 * quad); const v4u vm4 = {vmw.x, vmw.y, 0u, 0u}; const bf16x8 vmb = __builtin_bit_cast(bf16x8, vm4);
                    f32x4 sa = {0.f, 0.f, 0.f, 0.f}, yy = {0.f, 0.f, 0.f, 0.f};
#pragma unroll
                    for (int ks = 0; ks < 2; ++ks) { sa = MFMA16(lds_frag_perm(Ab + (16 * c + r16) * RP + 32 * ks + 4 * quad), sb[ks], sa); yy = MFMA16(lds_frag_perm(Rb + (16 * c + r16) * RP + 32 * ks + 4 * quad), sb[ks], yy); }
                    sa = MFMA16(lds_frag_lo4(GAK + c * 384 + r16 * 24 + 4 * quad), vmb, sa); yy = MFMA16(lds_frag_lo4(HRK + c * 384 + r16 * 24 + 4 * quad), vmb, yy);
                    const v4u sa4 = {pk2(sa[0], sa[1]), pk2(sa[2], sa[3]), 0u, 0u}; const bf16x8 sab = __builtin_bit_cast(bf16x8, sa4);
                    const f32x4 z = {0.f, 0.f, 0.f, 0.f};
                    const f32x4 dy = MFMA16(lds_frag_lo4(HRB + c * 384 + r16 * 24 + 4 * quad), sab, z);
#pragma unroll
                    for (int i = 0; i < 4; ++i) YO[(16 * c + 4 * quad + i) * 64 + 16 * vnt + r16] = yy[i] - dy[i];
#pragma unroll
                    for (int kt = 0; kt < 4; ++kt) { const f32x4 e_ = MFMA16(lds_frag_lo4(BhT + (16 * kt + r16) * RP + 16 * c + 4 * quad), sab, z), d_ = MFMA16(lds_frag_lo4(KhT + (16 * kt + r16) * RP + 16 * c + 4 * quad), vmb, z);
                        const f32x4 gl4 = *(const LAS f32x4*)&GL[c * 64 + 16 * kt + 4 * quad]; ST[kt] = ST[kt] * gl4 + d_ - e_; }
                }
            }
            __syncthreads();
            { int to = tid; asm volatile("" : "+v"(to)); const int s4 = to >> 3, q8 = (to & 7) * 8; const f32x4 y0 = *(const f32x4*)&YO[s4 * 64 + q8], y1 = *(const f32x4*)&YO[s4 * 64 + q8 + 4];
              v4u o; o.x = cvt_pk_bf16(y0.x, y0.y); o.y = cvt_pk_bf16(y0.z, y0.w); o.z = cvt_pk_bf16(y1.x, y1.y); o.w = cvt_pk_bf16(y1.z, y1.w);
              *(v4u*)(YS + ((size_t)dir * R + row_of(b, tok(dir, j * 64 + s4))) * RD + h * 64 + q8) = o; }
            __syncthreads();
        }
    }
}
template <int PART> __device__ __forceinline__ void finish_phase(Frame& F, int l, int nrows, int first, int stride) {
    const bf16* HF = (const bf16*)(F.ws + WS_HF); const bf16* O = (const bf16*)(F.ws + WS_O); bf16* HM = (bf16*)(F.ws + WS_HM);
    const bf16* YS = (const bf16*)(F.ws + WS_YS); const bf16* RKV = (const bf16*)(F.ws + WS_RKV); const bf16* Gb = (const bf16*)(F.ws + WS_H); const float* BON = (const float*)(F.ws + WS_BON); bf16* YR = (bf16*)(F.ws + WS_YR);
    const int lane = F.lane, c0 = lane * 16;
    float k1[16], k2[16], k3[16];
    { const float* p1 = PART == 0 ? INP(I_GMN) + l * 1024 + c0 : INP(I_LNW) + l * RD + c0; const float* p2 = INP(I_LNB) + l * RD + c0; const float* p3 = INP(I_MU) + l * RW + 2048 + c0;
#pragma unroll
      for (int q = 0; q < 4; ++q) { const f32x4 t1 = *(const f32x4*)(p1 + 4 * q); k1[4 * q] = t1.x; k1[4 * q + 1] = t1.y; k1[4 * q + 2] = t1.z; k1[4 * q + 3] = t1.w;
          if (PART == 1) { const f32x4 t2 = *(const f32x4*)(p2 + 4 * q), t3 = *(const f32x4*)(p3 + 4 * q); k2[4 * q] = t2.x; k2[4 * q + 1] = t2.y; k2[4 * q + 2] = t2.z; k2[4 * q + 3] = t2.w; k3[4 * q] = t3.x; k3[4 * q + 1] = t3.y; k3[4 * q + 2] = t3.z; k3[4 * q + 3] = t3.w; } } }
    const bf16* S0 = PART == 0 ? HF : YS;
    int g = first * NWAVES + F.wave; const int gstep = stride * NWAVES;
    v4u n0 = {0u, 0u, 0u, 0u}, n1 = n0, n2 = n0, n3 = n0;
    if (g < nrows) { n0 = *(const v4u*)(S0 + (size_t)g * 1024 + c0); n1 = *(const v4u*)(S0 + ((size_t)R + g) * 1024 + c0); n2 = *(const v4u*)(S0 + (size_t)g * 1024 + c0 + 8); n3 = *(const v4u*)(S0 + ((size_t)R + g) * 1024 + c0 + 8); }
    for (; g < nrows; g += gstep) {
        const v4u c_0 = n0, c_1 = n1, c_2 = n2, c_3 = n3;
        { const int gn = g + gstep; if (gn < nrows) { n0 = *(const v4u*)(S0 + (size_t)gn * 1024 + c0); n1 = *(const v4u*)(S0 + ((size_t)R + gn) * 1024 + c0); n2 = *(const v4u*)(S0 + (size_t)gn * 1024 + c0 + 8); n3 = *(const v4u*)(S0 + ((size_t)R + gn) * 1024 + c0 + 8); } }
        float y[16], a[8], bq[8];
        unpack8(c_0, a); unpack8(c_1, bq);
#pragma unroll
        for (int i = 0; i < 8; ++i) y[i] = a[i] + bq[i];
        unpack8(c_2, a); unpack8(c_3, bq);
#pragma unroll
        for (int i = 0; i < 8; ++i) y[8 + i] = a[i] + bq[i];
        if (PART == 0) {
            float ss = 0.f;
#pragma unroll
            for (int i = 0; i < 16; ++i) ss += y[i] * y[i];
            const float rs = 1.0f / sqrtf(red8(ss) * (1.0f / DV) + NORM_EPS);
            float og[16]; unpack8(*(const v4u*)(O + (size_t)g * 1024 + c0), a); unpack8(*(const v4u*)(O + (size_t)g * 1024 + c0 + 8), bq);
#pragma unroll
            for (int i = 0; i < 8; ++i) { og[i] = a[i]; og[8 + i] = bq[i]; }
            float o1[8], o2[8];
#pragma unroll
            for (int i = 0; i < 8; ++i) { o1[i] = y[i] * rs * k1[i] * sigmoidf_(og[i]); o2[i] = y[8 + i] * rs * k1[8 + i] * sigmoidf_(og[8 + i]); }
            *(v4u*)(HM + (size_t)g * 1024 + c0) = pack8(o1); *(v4u*)(HM + (size_t)g * 1024 + c0 + 8) = pack8(o2);
        }
        if (PART == 1) {
            float sm_ = 0.f;
#pragma unroll
            for (int i = 0; i < 16; ++i) sm_ += y[i];
            const float mean = red4(sm_) * (1.0f / RN); float vs = 0.f;
#pragma unroll
            for (int i = 0; i < 16; ++i) { const float dl = y[i] - mean; vs += dl * dl; }
            const float rs = 1.0f / sqrtf(red4(vs) * (1.0f / RN) + GN_EPS);
            const int hh = lane >> 2; const float bon = BON[(size_t)g * RH + hh] + BON[((size_t)R + g) * RH + hh];
            float vm[16], gg[16];
#pragma unroll
            for (int half = 0; half < 2; ++half) { const int rw = 2048 + c0 + 8 * half, nb = nbrow(g, rw); unpack8(*(const v4u*)(RKV + (size_t)g * 3072 + rw), a);
                if (nb >= 0) unpack8(*(const v4u*)(RKV + (size_t)nb * 3072 + rw), bq); else {
#pragma unroll
                    for (int i = 0; i < 8; ++i) bq[i] = 0.f; }
#pragma unroll
                for (int i = 0; i < 8; ++i) vm[8 * half + i] = a[i] + (bq[i] - a[i]) * k3[8 * half + i];
                unpack8(*(const v4u*)(Gb + (size_t)g * RD + c0 + 8 * half), a);
#pragma unroll
                for (int i = 0; i < 8; ++i) gg[8 * half + i] = a[i]; }
            float o1[8], o2[8];
#pragma unroll
            for (int i = 0; i < 8; ++i) { o1[i] = ((y[i] - mean) * rs * k1[i] + k2[i] + bon * vm[i]) * gg[i]; o2[i] = ((y[8 + i] - mean) * rs * k1[8 + i] + k2[8 + i] + bon * vm[8 + i]) * gg[8 + i]; }
            *(v4u*)(YR + (size_t)g * RD + c0) = pack8(o1); *(v4u*)(YR + (size_t)g * RD + c0 + 8) = pack8(o2);
        }
    }
}
struct MoeMeta { int off[NE + 1]; };
__device__ __forceinline__ MoeMeta moe_meta(Frame& F) {
    MoeMeta m; int o = 0;
#pragma unroll
    for (int e = 0; e < NE; ++e) { m.off[e] = o; const unsigned c = __hip_atomic_load((unsigned*)(F.ctl + CW_ECNT + 64 * e), RLX_AGENT); o += (int)((c + 255u) & ~255u); }
    m.off[NE] = o; return m;
}
__device__ __forceinline__ void gather_phase(Frame& F) {
    const MoeMeta m = moe_meta(F);
    if (F.bid == 0 && F.tid < MAXSLOT / 256) { int e = 0;
#pragma unroll
        for (int q = 1; q <= NE - 1; ++q) e += ((int)F.tid * 256 >= m.off[q]) ? 1 : 0;
        ((int*)(F.ws + WS_META + 768 * 1024))[F.tid] = e; }
    const bf16* H = (const bf16*)(F.ws + WS_H); unsigned char* HG = (unsigned char*)(F.ws + WS_HG);
    for (int w = F.bid * NWAVES + F.wave; w < RL * 2; w += F.G * NWAVES) { const int g = w >> 1, k = w & 1; int* tk = (int*)(F.ws + WS_META) + (size_t)g * 8; const int e = tk[k], pos = tk[2 + k];
        int base = 0;
#pragma unroll
        for (int q = 0; q < NE; ++q) base = (e == q) ? m.off[q] : base;
        const int slot = base + pos; if (F.lane == 0) tk[6 + k] = slot;
        const v4u* src = (const v4u*)(H + (size_t)g * D); float a[8], c8[8];
        unpack8(src[2 * F.lane], a); unpack8(src[2 * F.lane + 1], c8);
#pragma unroll
        for (int i = 0; i < 8; ++i) { a[i] = __builtin_amdgcn_fmed3f(a[i], -448.0f, 448.0f); c8[i] = __builtin_amdgcn_fmed3f(c8[i], -448.0f, 448.0f); }
        v4u o; o.x = pk4_fp8(a[0], a[1], a[2], a[3]); o.y = pk4_fp8(a[4], a[5], a[6], a[7]); o.z = pk4_fp8(c8[0], c8[1], c8[2], c8[3]); o.w = pk4_fp8(c8[4], c8[5], c8[6], c8[7]);
        *(v4u*)(HG + (size_t)slot * D + 16 * F.lane) = o; }
}
__device__ __forceinline__ void final_phase(Frame& F, const float* MODl) {
    const bf16* Y2 = (const bf16*)(F.ws + WS_Y2); const float* gfp = INP(I_GF);
    f32x4 gf[4];
#pragma unroll
    for (int j = 0; j < 4; ++j) gf[j] = *(const f32x4*)(gfp + 256 * j + 4 * F.lane);
    int g = F.bid * NWAVES + F.wave; const int gstep = F.G * NWAVES;
    int s0n = 0, s1n = 0; float p0n = 0.f, p1n = 0.f;
    if (g < RL) { const int* tk = (const int*)(F.ws + WS_META) + (size_t)g * 8; s0n = tk[6]; s1n = tk[7]; p0n = ((const float*)tk)[4]; p1n = ((const float*)tk)[5]; }
    for (; g < RL; g += gstep) {
        const int s0 = s0n, s1 = s1n; const float p0 = p0n, p1 = p1n;
        float* xr = (float*)F.out + (size_t)g * D; const float* gt = MODl + (g / T) * 6 * D + 5 * D; f32x4 x[4], gq[4]; v2u ya[4], yb[4];
#pragma unroll
        for (int j = 0; j < 4; ++j) { const int c = 256 * j + 4 * F.lane; x[j] = *(const f32x4*)(xr + c); gq[j] = *(const f32x4*)(gt + c); ya[j] = *(const v2u*)(Y2 + (size_t)s0 * D + c); yb[j] = *(const v2u*)(Y2 + (size_t)s1 * D + c); }
        { const int gn = g + gstep; if (gn < RL) { const int* tk = (const int*)(F.ws + WS_META) + (size_t)gn * 8; s0n = tk[6]; s1n = tk[7]; p0n = ((const float*)tk)[4]; p1n = ((const float*)tk)[5]; } }
        f32x4 v[4]; float ss = 0.f;
#pragma unroll
        for (int j = 0; j < 4; ++j) { const v2u a = ya[j], bq = yb[j];
            f32x4 y; y.x = p0 * bflo(a.x) + p1 * bflo(bq.x); y.y = p0 * bfhi(a.x) + p1 * bfhi(bq.x); y.z = p0 * bflo(a.y) + p1 * bflo(bq.y); y.w = p0 * bfhi(a.y) + p1 * bfhi(bq.y);
            v[j] = x[j] + gq[j] * y; ss += (v[j].x * v[j].x + v[j].y * v[j].y) + (v[j].z * v[j].z + v[j].w * v[j].w); }
        const float rstd = 1.0f / sqrtf(wave_sum(ss) * (1.0f / D) + NORM_EPS);
#pragma unroll
        for (int j = 0; j < 4; ++j) { const int c = 256 * j + 4 * F.lane; *(f32x4*)(xr + c) = v[j] * rstd * gf[j]; }
    }
}

#ifndef MK_SPLIT
#define MK_SPLIT 0
#endif
constexpr int PPL = 12, NPHASE = 1 + NL * PPL + 1;
__device__ __forceinline__ GAS unsigned char* launder_ws(GAS unsigned char* p) { asm volatile("" : "+s"(p)); return p; }
__device__ __forceinline__ const CAS Args* launder_args(const CAS Args* p) { asm volatile("" : "+s"(p)); return p; }
__device__ __forceinline__ void grid_barrier(unsigned* barw, unsigned x, volatile LAS unsigned* st) { XcdBarrier b; b.bar = barw; b.x = x; b.st = st; xcd_barrier(b); }
#define IN(k) (lo <= (k) && (k) < hi)
#define SEAM(k) do { if (IN(k) && IN((k) + 1)) grid_barrier(bar.bar, bar.x, bar.st); } while (0)
#define PH_BEGIN { int t_ = threadIdx.x; asm volatile("" : "+v"(t_)); F.tid = t_; F.lane = t_ & 63; F.wave = __builtin_amdgcn_readfirstlane(t_ >> 6); int b_ = blockIdx.x; asm volatile("" : "+s"(b_)); F.bid = b_; F.cb = b_; F.cg = F.G; } \
        GAS unsigned char* ws = launder_ws(args.ws); F.ws = ws; F.A = launder_args((const CAS Args*)__builtin_amdgcn_kernarg_segment_ptr()); float* MOD = (float*)(ws + WS_MOD); float* XC = (float*)(ws + WS_XC); bf16* Hb = (bf16*)(ws + WS_H); \
        const float* MODl = MOD + (size_t)l * 5 * 6 * D; const float* xl = l == 0 ? INP(I_X) : (const float*)F.out; const float* xc = l == 0 ? INP(I_CTX) : XC; (void)MODl; (void)xl; (void)xc; (void)Hb;
template <int l> __device__ __forceinline__ void layer_body(Frame& F, const Args& args, const int lo, const int hi, const XcdBarrier& bar) {
        const int p0 = 1 + l * PPL; const bool last = (l == NL - 1);
        const int Mrows = last ? RL : R;
        if (IN(p0 + 0)) { PH_BEGIN normmod_phase<false>(F, xl, xc, INP(I_GNM) + l * D, MODl, 0, D, R, nullptr); if (l > 0) conv_rest(F, l); }
        SEAM(p0 + 0);
        if (IN(p0 + 1)) { PH_BEGIN pg8::Gemm g{Hb, (const bf16*)(ws + WS_WIN), R, NPAD, D}; pg8::EpiInproj E{ws};
            if (!last) { pg8::StaticOrder S; S.init(R, NPAD, F.G, F.bid); pg8::gemm_phase<pg8::EpiInproj, pg8::StaticOrder, true, true>(F.lds, g, S, E); }
            else { pg8::InprojLastOrder S; S.G = F.G; S.c = F.bid; pg8::gemm_phase<pg8::EpiInproj, pg8::InprojLastOrder, true, true>(F.lds, g, S, E); } }
        if (IN(p0 + 1) && IN(p0 + 3)) grid_barrier(bar.bar, bar.x, bar.st);
        if (IN(p0 + 3)) { PH_BEGIN const int nR = F.G / 2;
            if (F.bid < nR) rwkv_phase(F, l, F.bid, nR);
            else { F.cb = F.bid - nR; F.cg = F.G - nR; gu32* sub = F.ctl + CW_SUB + 64 * l;
                   sg_phase(F, l); subgrid_arrive(F, sub);
                   mlstm_phase(F, l, F.cb, F.cg); __syncthreads();
                   if (!last) { conv_ffn0(F); conv_win(F, l + 1); }
                   subgrid_arrive(F, sub + 128);
                   subgrid_wait(F, sub, (unsigned)F.cg); subgrid_wait(F, sub + 128, (unsigned)F.cg);
                   finish_phase<0>(F, l, Mrows, F.cb, F.cg); } }
        if (IN(p0 + 3)) { PH_BEGIN const int nR = F.G / 2;
            if (F.bid >= nR) { int kg = 256; asm volatile("" : "+s"(kg));
                pg8::Gemm g{(const bf16*)(ws + WS_SG), (const bf16*)(ws + WS_WG2), R, RD, kg}; pg8::StaticOrder S; S.init(Mrows, RD, F.G - nR, F.bid - nR);
                pg8::EpiStore E{Hb, RD};
                pg8::gemm_phase<pg8::EpiStore, pg8::StaticOrder, true, true>(F.lds, g, S, E); } }
        SEAM(p0 + 3);
        if (IN(p0 + 4)) { PH_BEGIN finish_phase<1>(F, l, Mrows, F.bid, F.G); }
        SEAM(p0 + 4);
        if (IN(p0 + 5)) { PH_BEGIN pg8::Gemm g{(const bf16*)(ws + WS_HM), (const bf16*)(ws + WS_WPM), Mrows, D, D}; pg8::StaticOrder S; S.init(Mrows, D, F.G, F.bid);
            pg8::EpiMerge<0> E{(const bf16*)(ws + WS_MGT), (bf16*)(ws + WS_T1), nullptr};
            pg8::gemm_phase<pg8::EpiMerge<0>, pg8::StaticOrder, true, true>(F.lds, g, S, E); }
        SEAM(p0 + 5);
        if (IN(p0 + 6)) { PH_BEGIN pg8::Gemm g{(const bf16*)(ws + WS_YR), (const bf16*)(ws + WS_WPR), Mrows, D, D}; pg8::StaticOrder S; S.init(Mrows, D, F.G, F.bid);
            pg8::EpiMerge<1> E{(const bf16*)(ws + WS_MGT), (bf16*)(ws + WS_T1), Hb};
            pg8::gemm_phase<pg8::EpiMerge<1>, pg8::StaticOrder, true, true>(F.lds, g, S, E); }
        SEAM(p0 + 6);
        if (IN(p0 + 7)) { PH_BEGIN pg8::Gemm g{Hb, (const bf16*)(ws + WS_WOUT), Mrows, D, D}; pg8::StaticOrder S; S.init(Mrows, D, F.G, F.bid);
            pg8::EpiResid E{xl, xc, (float*)F.out, XC, MODl + 2 * D};
            pg8::gemm_phase<pg8::EpiResid, pg8::StaticOrder, true, true>(F.lds, g, S, E); }
        SEAM(p0 + 7);
        if (IN(p0 + 8)) { PH_BEGIN if (!last) normmod_phase<false>(F, (const float*)F.out, XC, INP(I_GNF) + l * D, MODl, 3 * D, 4 * D, Mrows, nullptr);
                          else normmod_phase<true>(F, (const float*)F.out, XC, INP(I_GNF) + l * D, MODl, 3 * D, 4 * D, Mrows, INP(I_WR)); }
        SEAM(p0 + 8);
        if (!last) {
            if (IN(p0 + 9)) { PH_BEGIN pg8::Gemm g{Hb, (const bf16*)(ws + WS_WGU), Mrows, 2 * FF, D}; pg8::StaticOrder S; S.init(Mrows, 2 * FF, F.G, F.bid);
                pg8::EpiSwiglu E{(bf16*)(ws + WS_HH0), FF};
                pg8::gemm_phase<pg8::EpiSwiglu, pg8::StaticOrder, true, true>(F.lds, g, S, E); }
            SEAM(p0 + 9);
            if (IN(p0 + 10)) { PH_BEGIN pg8::Gemm g{(const bf16*)(ws + WS_HH0), (const bf16*)(ws + WS_WDN), Mrows, D, FF}; pg8::StaticOrder S; S.init(Mrows, D, F.G, F.bid);
                pg8::EpiResid E{(const float*)F.out, XC, (float*)F.out, XC, MODl + 5 * D};
                pg8::gemm_phase<pg8::EpiResid, pg8::StaticOrder, true, true>(F.lds, g, S, E); }
            if (IN(p0 + 10) && IN(p0 + 12)) grid_barrier(bar.bar, bar.x, bar.st);
        } else {
            if (IN(p0 + 9)) { PH_BEGIN conv_experts(F); gather_phase(F); }
            SEAM(p0 + 9);
            if (IN(p0 + 10)) { PH_BEGIN const MoeMeta mm = moe_meta(F); pg8::MoeOrder S; S.ntiles = mm.off[NE] / 256; S.nN = 2 * FE / 256; S.nwg = S.ntiles * S.nN; S.G = F.G; S.c = F.bid; S.texp = (const int*)(ws + WS_META + 768 * 1024);
                int ke = D / 2; asm volatile("" : "+s"(ke));
                pg8::Gemm g{(const bf16*)(ws + WS_HG), (const bf16*)(ws + WS_WEGU), 0, 2 * FE, ke}; pg8::EpiSwiglu8 E{(unsigned char*)(ws + WS_HHE), FE};
                pg8::gemm_phase<pg8::EpiSwiglu8, pg8::MoeOrder, true, true, true>(F.lds, g, S, E); }
            SEAM(p0 + 10);
            if (IN(p0 + 11)) { PH_BEGIN const MoeMeta mm = moe_meta(F); pg8::MoeOrder S; S.ntiles = mm.off[NE] / 256; S.nN = D / 256; S.nwg = S.ntiles * S.nN; S.G = F.G; S.c = F.bid; S.texp = (const int*)(ws + WS_META + 768 * 1024);
                int ke = FE / 2; asm volatile("" : "+s"(ke));
                pg8::Gemm g{(const bf16*)(ws + WS_HHE), (const bf16*)(ws + WS_WEDN), 0, D, ke}; pg8::EpiStoreScaled E{(bf16*)(ws + WS_Y2), D, 1.0f / W8S};
                pg8::gemm_phase<pg8::EpiStoreScaled, pg8::MoeOrder, true, true, true>(F.lds, g, S, E); }
            SEAM(p0 + 11);
        }
    }
__global__ void __launch_bounds__(NTHREADS, 2) mk_fwd(Args args) {
    extern __shared__ __attribute__((aligned(16))) unsigned char lds[];
    Frame F;
    F.lds = (LAS unsigned char*)lds; F.MISC = (volatile LAS unsigned*)(F.lds + MISC_OFF);
    F.tid = threadIdx.x; F.lane = F.tid & 63; F.wave = __builtin_amdgcn_readfirstlane(F.tid >> 6); F.G = gridDim.x; F.bid = blockIdx.x;
    F.ws = args.ws; F.out = args.out; F.ctl = (gu32*)(args.ws + WS_CTL);
    F.A = (const CAS Args*)__builtin_amdgcn_kernarg_segment_ptr();
    if (F.tid < 64) F.MISC[F.tid] = 0u;
    __syncthreads();
    const int lo = args.ph_lo, hi = args.ph_hi;
    XcdBarrier bar; bar.bar = (unsigned*)(F.ctl + CW_BAR) + args.li * XCD_BAR_WORDS; bar.x = 0; bar.st = nullptr;
    if (hi - lo > 1) bar = xcd_barrier_post((unsigned*)(F.ctl + CW_BAR) + args.li * XCD_BAR_WORDS, F.MISC + 8);

    if (IN(0)) { const int l = 0; PH_BEGIN mod_phase(F); conv_win(F, 0); conv_rest(F, 0); }
    SEAM(0);

    layer_body<0>(F, args, lo, hi, bar);
    layer_body<1>(F, args, lo, hi, bar);
    if (IN(NPHASE - 1)) { const int l = NL - 1; PH_BEGIN final_phase(F, MODl); }
#undef IN
#undef SEAM
}

extern "C" void kernel_launch(void* const* d_in, const int* in_sizes, int n_in, void* d_out, int out_size, void* d_ws, size_t ws_size, hipStream_t stream) {
    static int grid = 0;
    if (grid == 0) {
        if (n_in != 33 || out_size != RL * D || ws_size < WS_NEED) { fprintf(stderr, "kernel_launch: unexpected problem (n_in %d, out %d, ws %zu < %zu)\n", n_in, out_size, ws_size, (size_t)WS_NEED); grid = -1; return; }
        int dev = 0, cus = 0, per_cu = 0;
        if (hipGetDevice(&dev) != hipSuccess || hipDeviceGetAttribute(&cus, hipDeviceAttributeMultiprocessorCount, dev) != hipSuccess) { grid = -1; return; }
        if (hipFuncSetAttribute((const void*)mk_fwd, hipFuncAttributeMaxDynamicSharedMemorySize, LDS_BYTES) != hipSuccess) { fprintf(stderr, "kernel_launch: hipFuncSetAttribute failed\n"); grid = -1; return; }
        if (hipOccupancyMaxActiveBlocksPerMultiprocessor(&per_cu, (const void*)mk_fwd, NTHREADS, LDS_BYTES) != hipSuccess || per_cu < 1) { fprintf(stderr, "kernel_launch: occupancy query says %d\n", per_cu); grid = -1; (void)hipGetLastError(); return; }
        grid = cus;
    }
    if (grid < 0) return;
    (void)hipMemsetAsync((char*)d_ws + WS_CTL, 0, CTL_ZERO_BYTES, stream);
    Args a{};
    for (int i = 0; i < 33; ++i) a.in[i] = (const GAS float*)d_in[i];
    a.out = (GAS float*)d_out; a.ws = (GAS unsigned char*)d_ws;
#if MK_SPLIT
    for (int p = 0; p < NPHASE; ++p) { a.ph_lo = p; a.ph_hi = p + 1; hipLaunchKernelGGL(mk_fwd, dim3(grid), dim3(NTHREADS), LDS_BYTES, stream, a); }
#elif defined(PROBE_PH)
    a.ph_lo = 0; a.ph_hi = PROBE_PH + 1; a.li = 0; hipLaunchKernelGGL(mk_fwd, dim3(grid), dim3(NTHREADS), LDS_BYTES, stream, a);
    for (int r = 0; r < PROBE_N; ++r) { a.ph_lo = PROBE_PH; a.ph_hi = PROBE_PH + 1; hipLaunchKernelGGL(mk_fwd, dim3(grid), dim3(NTHREADS), LDS_BYTES, stream, a); }
    a.ph_lo = PROBE_PH + 1; a.ph_hi = NPHASE; a.li = 1; hipLaunchKernelGGL(mk_fwd, dim3(grid), dim3(NTHREADS), LDS_BYTES, stream, a);
#else
    a.ph_lo = 0; a.ph_hi = NPHASE;
    hipLaunchKernelGGL(mk_fwd, dim3(grid), dim3(NTHREADS), LDS_BYTES, stream, a);
#endif
}
```

```cpp
#include <hip/hip_runtime.h>
#include <cstdio>
#include <cstdint>

#define GAS __attribute__((address_space(1)))
#define LAS __attribute__((address_space(3)))
typedef unsigned short bf16;
typedef unsigned v4u __attribute__((ext_vector_type(4)));
typedef unsigned v2u __attribute__((ext_vector_type(2)));
typedef float f32x4 __attribute__((ext_vector_type(4)));
typedef float f32x2 __attribute__((ext_vector_type(2)));
typedef short bf16x8 __attribute__((ext_vector_type(8)));
typedef GAS unsigned gu32;
#define RLX_AGENT __ATOMIC_RELAXED, __HIP_MEMORY_SCOPE_AGENT
#define LDS_WAIT() asm volatile("s_waitcnt lgkmcnt(0)" ::: "memory")
#define VM_WAIT() asm volatile("s_waitcnt vmcnt(0)" ::: "memory")

constexpr int D = 1024, NB = 4, T = 4096, GW = 64, TC = 256, NL = 2;
constexpr int RL = NB * T, RC = NB * TC, R = RL + RC;
constexpr int MH = 8, DQK = 64, DV = 128, LCH = 64;
constexpr int RH = 16, RN = 64, RD = 1024;
constexpr int RW = 3456, DIN = 8608, NPAD = 8704;
constexpr int FF = 2816, NE = 8, FE = 3584;
constexpr int TB = T + TC, NCH = TB / LCH;
constexpr int SMW = 512;
constexpr float NORM_EPS = 1e-6f, GN_EPS = 64e-5f, CAP = 15.0f;
constexpr int MAXSLOT = 2 * RL + NE * 256;

constexpr size_t MiB = 1u << 20;
constexpr size_t WS_CTL = 0, CTL_ZERO_BYTES = 1 * MiB;
constexpr size_t WS_MOD = 1 * MiB, WS_XC = 2 * MiB, WS_META = 6 * MiB, WS_BON = 7 * MiB, WS_SG = 10 * MiB;
constexpr size_t WS_WIN = 19 * MiB, WS_WPM = 36 * MiB, WS_WPR = 38 * MiB, WS_WOUT = 40 * MiB, WS_WG2 = 42 * MiB, WS_WLORA = 43 * MiB, WS_WGU = 44 * MiB, WS_WDN = 55 * MiB;
constexpr size_t WS_H = 61 * MiB;
constexpr size_t WS_Q = 95 * MiB, WS_K = 112 * MiB, WS_V = 129 * MiB, WS_O = 163 * MiB, WS_RKV = 197 * MiB, WS_MGT = 299 * MiB, WS_SM = 367 * MiB;
constexpr size_t WS_HF = 401 * MiB, WS_YS = 469 * MiB, WS_END = 537 * MiB;
constexpr size_t WS_HM = WS_Q, WS_YR = WS_V, WS_T1 = WS_SM;
constexpr size_t WS_HH0 = WS_Q;
constexpr size_t WS_WEGU = 95 * MiB, WS_WEDN = 152 * MiB, WS_HG = 179 * MiB, WS_Y2 = 213 * MiB, WS_HHE = 281 * MiB;
constexpr size_t WS_WEA = 537 * MiB;
static_assert((WS_WEA - WS_WEGU) % (256 * 1024) == 0 && (WS_WEA + 28 * MiB - WS_WEDN) % (896 * 1024) == 0, "expert weight tiles");
static_assert(WS_HHE + (size_t)MAXSLOT * FE <= 401 * MiB && WS_Y2 + (size_t)MAXSLOT * D * 2 <= WS_HHE && WS_HG + (size_t)MAXSLOT * D <= WS_Y2, "ws map");
constexpr float W8S = 64.0f;
constexpr size_t WS_NEED = 579 * MiB;
constexpr int CW_BAR = 4096;
constexpr int CW_ECNT = 16384;
constexpr int CW_SUB = 20480;
constexpr int LDS_BYTES = 159744;
constexpr int MISC_OFF = LDS_BYTES - 256;

__device__ __forceinline__ unsigned cvt_pk_bf16(float lo, float hi) { unsigned r; asm volatile("v_cvt_pk_bf16_f32 %0, %1, %2" : "=v"(r) : "v"(lo), "v"(hi)); return r; }
__device__ __forceinline__ float bflo(unsigned w) { return __uint_as_float(w << 16); }
__device__ __forceinline__ float bfhi(unsigned w) { return __uint_as_float(w & 0xffff0000u); }
__device__ __forceinline__ void unpack8(const v4u w, float (&f)[8]) { f[0] = bflo(w.x); f[1] = bfhi(w.x); f[2] = bflo(w.y); f[3] = bfhi(w.y); f[4] = bflo(w.z); f[5] = bfhi(w.z); f[6] = bflo(w.w); f[7] = bfhi(w.w); }
__device__ __forceinline__ v4u pack8(const float (&f)[8]) { v4u w; w.x = cvt_pk_bf16(f[0], f[1]); w.y = cvt_pk_bf16(f[2], f[3]); w.z = cvt_pk_bf16(f[4], f[5]); w.w = cvt_pk_bf16(f[6], f[7]); return w; }
__device__ __forceinline__ float sigmoidf_(float x) { return __builtin_amdgcn_rcpf(1.0f + __expf(-x)); }
__device__ __forceinline__ float siluf_(float x) { return x * sigmoidf_(x); }
__device__ __forceinline__ float softplusf_(float x) { return fmaxf(x, 0.f) + log1pf(expf(-fabsf(x))); }
__device__ __forceinline__ float fast_tanh(float x) { const float e = __expf(2.0f * x); return 1.0f - 2.0f * __builtin_amdgcn_rcpf(1.0f + e); }
__device__ __forceinline__ float fast_softplus(float x) { return fmaxf(x, 0.f) + __logf(1.0f + __expf(-fabsf(x))); }
template <int CTRL> __device__ __forceinline__ float dpp_add(float v) { const int t = __builtin_amdgcn_update_dpp(0, __float_as_int(v), CTRL, 0xf, 0xf, false); return v + __int_as_float(t); }
__device__ __forceinline__ float red4(float v) { v = dpp_add<0xB1>(v); return dpp_add<0x4E>(v); }
__device__ __forceinline__ float red8(float v) { return dpp_add<0x141>(red4(v)); }
__device__ __forceinline__ float red16(float v) { return dpp_add<0x140>(red8(v)); }
__device__ __forceinline__ float wave_sum(float v) { v = red16(v); v += __shfl_xor(v, 16); return v + __shfl_xor(v, 32); }
__device__ __forceinline__ int row_of(int b, int lr) { return lr < T ? b * T + lr : RL + b * TC + (lr - T); }
__device__ __forceinline__ int tok(int dir, int u) { if (u < TC) return T + (dir ? TC - 1 - u : u); const int tt = u - TC; return dir ? T - 1 - tt : tt; }
__device__ __forceinline__ int nbrow(int g, int rwidx) {
    if (g < RL) { const int t = g & (T - 1), row = t >> 6, col = t & 63, q = rwidx / (RW / 4);
        if (q == 0) return col > 0 ? g - 1 : -1; if (q == 1) return col < GW - 1 ? g + 1 : -1; if (q == 2) return row > 0 ? g - GW : -1; return row < T / GW - 1 ? g + GW : -1; }
    const int t = (g - RL) & (TC - 1); if (rwidx < RW / 2) return t > 0 ? g - 1 : -1; return t < TC - 1 ? g + 1 : -1;
}

#define XB_TMO      128
#define XB_XCNT(j)  (256  + 64 * (j))
#define XB_XSUB(j)  (1280 + 64 * (j))
#define XB_XGEN(j)  (2304 + 64 * (j))
#define XB_TOP      3328
#define XB_TOPGEN   3392
#define XCD_BAR_WORDS 3456
#define XB_SPIN_CAP (1u << 18)
__device__ __forceinline__ unsigned xb_ld(unsigned* p)              { return __hip_atomic_load(p, __ATOMIC_RELAXED, __HIP_MEMORY_SCOPE_AGENT); }
__device__ __forceinline__ unsigned xb_add(unsigned* p, unsigned v) { return __hip_atomic_fetch_add(p, v, __ATOMIC_RELAXED, __HIP_MEMORY_SCOPE_AGENT); }
__device__ __forceinline__ unsigned xb_xcc_id() { return (unsigned)__builtin_amdgcn_s_getreg((3 << 11) | 20) & 0xFu; }
#define XB_SPIN(cond, bar) do { unsigned _sp = 0; while (cond) { __builtin_amdgcn_s_sleep(1); \
    if ((++_sp & 255u) == 0u) { if (xb_ld(&(bar)[XB_TMO])) break; if (_sp > XB_SPIN_CAP) { atomicAdd(&(bar)[XB_TMO], 1u); break; } } } } while (0)
struct XcdBarrier { unsigned* bar; unsigned x; volatile LAS unsigned* st; };
__device__ __forceinline__ XcdBarrier xcd_barrier_post(unsigned* bar, volatile LAS unsigned* st) {
    XcdBarrier b; b.bar = bar; b.x = xb_xcc_id(); b.st = st;
    if (threadIdx.x == 0) (void)xb_add(&bar[XB_XCNT(b.x)], 1u);
    return b;
}
__device__ __forceinline__ void xcd_barrier_complete(unsigned* bar, unsigned x, unsigned& nloc, unsigned& nx) {
    const unsigned G = gridDim.x * gridDim.y * gridDim.z;
    unsigned sum, cnt, mine, sp = 0u;
    for (;;) {
        sum = 0u; cnt = 0u; mine = 0u;
#pragma unroll
        for (unsigned j = 0; j < 16; ++j) { const unsigned c = xb_ld(&bar[XB_XCNT(j)]); sum += c; cnt += (c > 0u) ? 1u : 0u; mine = (j == x) ? c : mine; }
        if (sum == G) break;
        __builtin_amdgcn_s_sleep(1);
        if ((++sp & 255u) == 0u) { if (xb_ld(&bar[XB_TMO])) break; if (sp > XB_SPIN_CAP) { atomicAdd(&bar[XB_TMO], 1u); break; } }
    }
    nloc = mine > 0u ? mine : 1u; nx = cnt > 0u ? cnt : 1u;
}
__device__ __forceinline__ void xcd_barrier(const XcdBarrier& b) {
    asm volatile("s_waitcnt vmcnt(0)" ::: "memory");
    __syncthreads();
    if (threadIdx.x == 0) {
        unsigned* bar = b.bar;
        __builtin_amdgcn_s_waitcnt(0);
        unsigned nloc = b.st[0], nx = b.st[1];
        if (nloc == 0u) { xcd_barrier_complete(bar, b.x, nloc, nx); b.st[0] = nloc; b.st[1] = nx; }
        const unsigned old = xb_add(&bar[XB_XSUB(b.x)], 1u);
        const unsigned gen = old / nloc;
        if (old + 1u == (gen + 1u) * nloc) {
            __builtin_amdgcn_fence(__ATOMIC_RELEASE, "agent");
            asm volatile("s_waitcnt vmcnt(0)" ::: "memory");
            const unsigned og = xb_add(&bar[XB_TOP], 1u);
            const unsigned tg = og / nx;
            if (og + 1u == (tg + 1u) * nx) xb_add(&bar[XB_TOPGEN], 1u);
            else XB_SPIN(xb_ld(&bar[XB_TOPGEN]) == tg, bar);
            __builtin_amdgcn_fence(__ATOMIC_ACQUIRE, "agent");
            xb_add(&bar[XB_XGEN(b.x)], 1u);
            asm volatile("s_waitcnt vmcnt(0)" ::: "memory");
        } else {
            XB_SPIN(xb_ld(&bar[XB_XGEN(b.x)]) == gen, bar);
            __builtin_amdgcn_fence(__ATOMIC_ACQUIRE, "agent");
            asm volatile("s_waitcnt vmcnt(0)" ::: "memory");
        }
    }
    __syncthreads();
}

namespace pg8 {
#define PG8_LAS __attribute__((address_space(3)))
typedef unsigned short bf16_t;
typedef unsigned u32x4 __attribute__((ext_vector_type(4)));
constexpr int BM = 256, BK = 64, HALF = 128, HTB = HALF * BK * 2, STAGE_BYTES = 8 * HTB, NXCD = 8, WGM = 8;
__host__ __device__ __forceinline__ int lds_byte(int r, int c) { const int st = (r >> 4) * 2 + (c >> 5), rr = r & 15, cc = c & 31, ob = rr * 64 + cc * 2; return st * 1024 + (ob ^ (((ob >> 9) & 1) << 5)); }
__host__ __device__ __forceinline__ void stage_rc(int b, int& R_, int& C) { const int st = b / 1024, sb = b % 1024, swz = sb ^ (((sb >> 9) & 1) << 5); R_ = (st >> 1) * 16 + swz / 64; C = (st & 1) * 32 + (swz % 64) / 2; }
__host__ __device__ __forceinline__ int perm32(int rho) { const int n = rho >> 4, i = rho & 15; return 8 * (i >> 2) + 4 * n + (i & 3); }
typedef int i32x8 __attribute__((ext_vector_type(8))); typedef int i32x4 __attribute__((ext_vector_type(4)));
__device__ __forceinline__ i32x8 cat8(bf16x8 lo, bf16x8 hi) { return __builtin_shufflevector(__builtin_bit_cast(i32x4, lo), __builtin_bit_cast(i32x4, hi), 0, 1, 2, 3, 4, 5, 6, 7); }
__device__ __forceinline__ void mfma8_acc(f32x4& acc, const i32x8 a, const i32x8 b) {
#if defined(__HIP_DEVICE_COMPILE__)
    const int one = 0x7F7F7F7F;
    asm volatile("v_mfma_scale_f32_16x16x128_f8f6f4 %0, %1, %2, %0, %3, %3 op_sel_hi:[0,0,0]" : "+v"(acc) : "v"(a), "v"(b), "v"(one));
#endif
}
struct Unit { int pm, pn, pb; };
struct Gemm { const bf16_t* A; const bf16_t* Bt; int M, N, K; };
struct StaticOrder {
    int nM, nN, nwg, G, c;
    __device__ void init(int M, int N, int G_, int c_) { nM = M / BM; nN = N / BM; nwg = nM * nN; G = G_; c = c_; }
    __device__ bool next(int i, Unit& u) const {
        const long L = (long)i * G + c; if (L >= nwg) return false;
        int wgid = (int)L; { const int q = nwg / NXCD, r = nwg % NXCD, xcd = wgid % NXCD, off = wgid / NXCD; wgid = (xcd < r ? xcd * (q + 1) : r * (q + 1) + (xcd - r) * q) + off; }
        const int nig = WGM * nN, gid = wgid / nig, fm = gid * WGM, gsz = (nM - fm) < WGM ? (nM - fm) : WGM;
        u.pm = fm + ((wgid % nig) % gsz); u.pn = (wgid % nig) / gsz; u.pb = u.pn; return true;
    }
    __device__ __forceinline__ void a_ready(const Unit&) const {}
    __device__ __forceinline__ void done(const Unit&) const {}
};
struct InprojLastOrder {
    int G, c;
    __device__ bool next(int i, Unit& u) const {
        const int L = i * G + c; if (L >= 64 * 34 + 4 * 22) return false;
        if (L < 64 * 34) { const int g8 = L / (8 * 34), r = L % (8 * 34); u.pm = g8 * 8 + (r % 8); u.pn = r / 8; }
        else { const int r = L - 64 * 34; u.pm = 64 + (r & 3); int q = r >> 2; q += (q >= 8) ? 4 : 0; q += (q >= 24) ? 8 : 0; u.pn = q; }
        u.pb = u.pn; return true;
    }
    __device__ __forceinline__ void a_ready(const Unit&) const {}
    __device__ __forceinline__ void done(const Unit&) const {}
};
struct MoeOrder {
    int ntiles, nN, nwg, G, c; const int* texp;
    int lo0, lo1, hi1;
    __device__ bool next(int i, Unit& u) const {
        const long L = (long)i * G + c; if (L >= nwg) return false;
        u.pm = (int)(L / nN); u.pn = (int)(L % nN); const int e = __builtin_amdgcn_readfirstlane(texp[u.pm]);
        u.pb = (e < 4 ? lo0 + e * lo1 : (e - 4) * hi1) + u.pn; return true;
    }
    __device__ __forceinline__ void a_ready(const Unit&) const {}
    __device__ __forceinline__ void done(const Unit&) const {}
};
template <class Epi, class Sched, bool ALIGN_EPI = false, bool SP2 = false, bool FP8 = false>
__device__ __forceinline__ void gemm_phase(PG8_LAS unsigned char* lds, const Gemm g, const Sched& S, const Epi& E) {
    int tid_ = threadIdx.x; asm volatile("" : "+v"(tid_));
    const int tid = tid_, wid = __builtin_amdgcn_readfirstlane(tid >> 6), lane = tid & 63, wr = wid >> 2, wc = wid & 3, fr = lane & 15, fq = lane >> 4;
    const int K = g.K, nt = K / BK;
    unsigned voffA[2], voffB[2];
#pragma unroll
    for (int i = 0; i < 2; ++i) { int R, C; stage_rc(tid * 16 + i * 8192, R, C); const int Rb = Epi::PERM ? ((R & ~31) + perm32(R & 31)) : R;
        voffA[i] = (unsigned)(R * K + C) * 2u; voffB[i] = (unsigned)(Rb * K + C) * 2u; }
    const size_t kstep = (size_t)(BK * 2);
    const size_t hstep = (size_t)HALF * K * 2;
    const size_t tstep = 2 * hstep;
    const unsigned ldsw = (unsigned)wid * 1024u;
    const int aoff = lds_byte(wr * 64 + fr, fq * 8), boff = lds_byte(wc * 32 + fr, fq * 8);
#define PG8_SA(b, h) (((b) * 2 + (h)) * HTB)
#define PG8_SB(b, h) ((4 + (b) * 2 + (h)) * HTB)
#define PG8_STAGE(bufoff, gbase, voff) do { _Pragma("unroll") for (int _i = 0; _i < 2; ++_i) \
        __builtin_amdgcn_global_load_lds((const unsigned*)((const char*)(gbase) + (voff)[_i]), (PG8_LAS unsigned*)(lds + (bufoff) + ldsw + _i * 8192), 16, 0, 0); } while (0)
#define PG8_LDA(dst, b, h) do { _Pragma("unroll") for (int m = 0; m < 4; ++m) { if constexpr (FP8) dst##8[m] = cat8(*(const PG8_LAS bf16x8*)(lds + PG8_SA(b, h) + aoff + m * 2048), *(const PG8_LAS bf16x8*)(lds + PG8_SA(b, h) + aoff + m * 2048 + 1024)); \
        else { _Pragma("unroll") for (int k = 0; k < 2; ++k) dst[m][k] = *(const PG8_LAS bf16x8*)(lds + PG8_SA(b, h) + aoff + m * 2048 + k * 1024); } } } while (0)
#define PG8_LDB(dst, b, h) do { _Pragma("unroll") for (int n = 0; n < 2; ++n) { if constexpr (FP8) dst##8[n] = cat8(*(const PG8_LAS bf16x8*)(lds + PG8_SB(b, h) + boff + n * 2048), *(const PG8_LAS bf16x8*)(lds + PG8_SB(b, h) + boff + n * 2048 + 1024)); \
        else { _Pragma("unroll") for (int k = 0; k < 2; ++k) dst[n][k] = *(const PG8_LAS bf16x8*)(lds + PG8_SB(b, h) + boff + n * 2048 + k * 1024); } } } while (0)
#define PG8_MMA(ai, bj, At, Bt) do { __builtin_amdgcn_s_setprio(1); if constexpr (FP8) { _Pragma("unroll") for (int m = 0; m < 4; ++m) _Pragma("unroll") for (int n = 0; n < 2; ++n) \
        mfma8_acc(acc[ai][bj][m][n], Bt##8[n], At##8[m]); } else { \
        _Pragma("unroll") for (int m = 0; m < 4; ++m) _Pragma("unroll") for (int n = 0; n < 2; ++n) _Pragma("unroll") for (int k = 0; k < 2; ++k) \
        acc[ai][bj][m][n] = __builtin_amdgcn_mfma_f32_16x16x32_bf16(Bt[n][k], At[m][k], acc[ai][bj][m][n], 0, 0, 0); } __builtin_amdgcn_s_setprio(0); } while (0)
#define PG8_WAIT_V(n) asm volatile("s_waitcnt vmcnt(" #n ")" ::: "memory")
#define PG8_WAIT_L(n) asm volatile("s_waitcnt lgkmcnt(" #n ")" ::: "memory")
#define PG8_BAR __builtin_amdgcn_s_barrier()
#define PG8_SCHED __builtin_amdgcn_sched_barrier(0)
    Unit cur, nxt; int ui = 0;
    if (!S.next(0, cur)) return;
    f32x4 acc[2][2][4][2];
#pragma unroll
    for (int a = 0; a < 2; ++a)
#pragma unroll
        for (int b = 0; b < 2; ++b)
#pragma unroll
            for (int m = 0; m < 4; ++m)
#pragma unroll
                for (int n = 0; n < 2; ++n) acc[a][b][m][n] = (f32x4){0.f, 0.f, 0.f, 0.f};
    bf16x8 At[4][2], B0[2][2], B1[2][2]; i32x8 At8[4], B08[2], B18[2];
    const char* cA = (const char*)g.A + (size_t)cur.pm * tstep; const char* cB = (const char*)g.Bt + (size_t)cur.pb * tstep;
    S.a_ready(cur);
    if constexpr (SP2) {
        PG8_STAGE(PG8_SB(0, 0), cB, voffB); PG8_STAGE(PG8_SB(0, 1), cB + hstep, voffB); PG8_STAGE(PG8_SA(0, 0), cA, voffA); PG8_STAGE(PG8_SA(0, 1), cA + hstep, voffA);
        if (wr == 1) PG8_BAR;
        PG8_WAIT_V(2); PG8_BAR;
        PG8_STAGE(PG8_SB(1, 0), cB + kstep, voffB); PG8_STAGE(PG8_SA(1, 0), cA + kstep, voffA); PG8_STAGE(PG8_SB(1, 1), cB + hstep + kstep, voffB);
        PG8_WAIT_V(6); PG8_BAR;
    } else {
        PG8_STAGE(PG8_SB(0, 0), cB, voffB); PG8_STAGE(PG8_SA(0, 0), cA, voffA); PG8_STAGE(PG8_SB(0, 1), cB + hstep, voffB); PG8_STAGE(PG8_SA(0, 1), cA + hstep, voffA);
        if (wr == 1) PG8_BAR;
        PG8_WAIT_V(4); PG8_BAR;
        PG8_STAGE(PG8_SB(1, 0), cB + kstep, voffB); PG8_STAGE(PG8_SA(1, 0), cA + kstep, voffA); PG8_STAGE(PG8_SB(1, 1), cB + hstep + kstep, voffB);
        PG8_WAIT_V(6); PG8_BAR;
    }
    for (;;) {
        const bool has_next = S.next(ui + 1, nxt);
        const char* nA = has_next ? (const char*)g.A + (size_t)nxt.pm * tstep : cA; const char* nB = has_next ? (const char*)g.Bt + (size_t)nxt.pb * tstep : cB;
        for (int t = 0; t < nt; t += 2) {
            const bool last = (t == nt - 2);
            const char* a1 = cA + (size_t)(t + 1) * kstep;
            const char* a2 = last ? nA : cA + (size_t)(t + 2) * kstep; const char* b2 = last ? nB : cB + (size_t)(t + 2) * kstep;
            const char* a3 = a2 + kstep; const char* b3 = b2 + kstep;
            if (last && has_next) S.a_ready(nxt);
            if constexpr (SP2) {
            PG8_LDB(B0, 0, 0); PG8_LDB(B1, 0, 1); PG8_SCHED; PG8_LDA(At, 0, 0); PG8_STAGE(PG8_SA(1, 1), a1 + hstep, voffA);
            PG8_WAIT_V(8); PG8_WAIT_L(0); PG8_BAR; PG8_MMA(0, 0, At, B0); PG8_MMA(0, 1, At, B1); PG8_BAR; PG8_SCHED;
            PG8_LDA(At, 0, 1); PG8_STAGE(PG8_SB(0, 0), b2, voffB); PG8_STAGE(PG8_SB(0, 1), b2 + hstep, voffB); PG8_STAGE(PG8_SA(0, 0), a2, voffA);
            PG8_WAIT_V(8); PG8_WAIT_L(0); PG8_BAR; PG8_MMA(1, 0, At, B0); PG8_MMA(1, 1, At, B1); PG8_BAR; PG8_SCHED;
            PG8_LDB(B0, 1, 0); PG8_LDB(B1, 1, 1); PG8_SCHED; PG8_LDA(At, 1, 0); PG8_STAGE(PG8_SA(0, 1), a2 + hstep, voffA);
            PG8_WAIT_V(8); PG8_WAIT_L(0); PG8_BAR; PG8_MMA(0, 0, At, B0); PG8_MMA(0, 1, At, B1); PG8_BAR; PG8_SCHED;
            PG8_LDA(At, 1, 1); PG8_STAGE(PG8_SB(1, 0), b3, voffB); PG8_STAGE(PG8_SB(1, 1), b3 + hstep, voffB); PG8_STAGE(PG8_SA(1, 0), a3, voffA);
            PG8_WAIT_V(8); PG8_WAIT_L(0); PG8_BAR; PG8_MMA(1, 0, At, B0); PG8_MMA(1, 1, At, B1); PG8_BAR; PG8_SCHED;
            } else {
            PG8_LDB(B0, 0, 0); PG8_SCHED; PG8_LDA(At, 0, 0); PG8_STAGE(PG8_SA(1, 1), a1 + hstep, voffA);
            PG8_WAIT_L(8); PG8_BAR; PG8_WAIT_L(0); PG8_MMA(0, 0, At, B0); PG8_BAR; PG8_SCHED;
            PG8_LDB(B1, 0, 1); PG8_STAGE(PG8_SB(0, 0), b2, voffB);
            PG8_BAR; PG8_WAIT_L(0); PG8_MMA(0, 1, At, B1); PG8_BAR;
            PG8_LDA(At, 0, 1); PG8_STAGE(PG8_SA(0, 0), a2, voffA);
            PG8_BAR; PG8_WAIT_L(0); PG8_MMA(1, 0, At, B0); PG8_BAR; PG8_SCHED;
            PG8_STAGE(PG8_SB(0, 1), b2 + hstep, voffB);
            PG8_WAIT_V(6); PG8_BAR; PG8_MMA(1, 1, At, B1); PG8_BAR;
            PG8_LDB(B0, 1, 0); PG8_SCHED; PG8_LDA(At, 1, 0); PG8_STAGE(PG8_SA(0, 1), a2 + hstep, voffA);
            PG8_WAIT_L(8); PG8_BAR; PG8_WAIT_L(0); PG8_MMA(0, 0, At, B0); PG8_BAR; PG8_SCHED;
            PG8_LDB(B1, 1, 1); PG8_STAGE(PG8_SB(1, 0), b3, voffB);
            PG8_BAR; PG8_WAIT_L(0); PG8_MMA(0, 1, At, B1); PG8_BAR;
            PG8_LDA(At, 1, 1); PG8_STAGE(PG8_SA(1, 0), a3, voffA);
            PG8_BAR; PG8_WAIT_L(0); PG8_MMA(1, 0, At, B0); PG8_BAR; PG8_SCHED;
            PG8_STAGE(PG8_SB(1, 1), b3 + hstep, voffB);
            PG8_WAIT_V(6); PG8_BAR; PG8_MMA(1, 1, At, B1); PG8_BAR;
            }
        }
        if constexpr (ALIGN_EPI) { if (wr == 0) PG8_BAR; }
        if constexpr (FP8) asm volatile("s_nop 15\n\ts_nop 15\n\ts_nop 15\n\ts_nop 15" ::: "memory");
        if constexpr (!Epi::AFTER_DRAIN) { E(acc, cur, wr, wc, fr, fq); S.done(cur); }
        if (!has_next) break;
#pragma unroll
        for (int a = 0; a < 2; ++a)
#pragma unroll
            for (int b = 0; b < 2; ++b)
#pragma unroll
                for (int m = 0; m < 4; ++m)
#pragma unroll
                    for (int n = 0; n < 2; ++n) acc[a][b][m][n] = (f32x4){0.f, 0.f, 0.f, 0.f};
        cur = nxt; cA = nA; cB = nB; ++ui;
        if constexpr (ALIGN_EPI) { if (wr == 1) PG8_BAR; }
    }
    PG8_WAIT_V(0);
    if constexpr (!ALIGN_EPI) { if (wr == 0) PG8_BAR; }
    PG8_BAR;
    if constexpr (Epi::AFTER_DRAIN) { E.fused(acc, cur, wr, wc, fr, fq, lds, wid, lane); S.done(cur); }
#undef PG8_SA
#undef PG8_SB
#undef PG8_STAGE
#undef PG8_LDA
#undef PG8_LDB
#undef PG8_MMA
#undef PG8_WAIT_V
#undef PG8_WAIT_L
#undef PG8_BAR
#undef PG8_SCHED
}

__device__ __forceinline__ u32x4 pack_acc8(const f32x4 v0, const f32x4 v1) { u32x4 w; w.x = cvt_pk_bf16(v0[0], v0[1]); w.y = cvt_pk_bf16(v0[2], v0[3]); w.z = cvt_pk_bf16(v1[0], v1[1]); w.w = cvt_pk_bf16(v1[2], v1[3]); return w; }
#define EPI_LOOP_BEGIN  _Pragma("unroll") for (int ai = 0; ai < 2; ++ai) _Pragma("unroll") for (int m = 0; m < 4; ++m) { const int rloc = ai * HALF + wr * 64 + m * 16 + fr; \
                        _Pragma("unroll") for (int bj = 0; bj < 2; ++bj) { const int cloc = bj * HALF + wc * 32 + 8 * fq; const f32x4 v0 = acc[ai][bj][m][0], v1 = acc[ai][bj][m][1];
#define EPI_LOOP_END    } asm volatile("" ::: "memory"); }

struct EpiInproj {
    static constexpr bool PERM = true, AFTER_DRAIN = false;
    GAS unsigned char* ws;
    __device__ __forceinline__ void operator()(const f32x4 (&acc)[2][2][4][2], const Unit& u, int wr, int wc, int fr, int fq) const {
        const int pn = u.pn; size_t off; int ld, ct;
        if (pn < 2) { off = WS_Q; ld = 512; ct = pn; } else if (pn < 4) { off = WS_K; ld = 512; ct = pn - 2; } else if (pn < 8) { off = WS_V; ld = 1024; ct = pn - 4; }
        else if (pn < 12) { off = WS_O; ld = 1024; ct = pn - 8; } else if (pn < 24) { off = WS_RKV; ld = 3072; ct = pn - 12; } else if (pn < 32) { off = WS_MGT; ld = 2048; ct = pn - 24; } else { off = WS_SM; ld = SMW * 2; ct = pn - 32; }
        const size_t row0 = (size_t)u.pm * BM;
        if (pn < 32) {
            bf16_t* base = (bf16_t*)(ws + off) + row0 * ld + ct * BM;
            EPI_LOOP_BEGIN
                *(u32x4*)(base + (size_t)rloc * ld + cloc) = pack_acc8(v0, v1);
            EPI_LOOP_END
        } else {
            float* sb = (float*)(ws + off) + row0 * SMW + ct * BM;
            EPI_LOOP_BEGIN
                float* p = sb + (size_t)rloc * SMW + cloc; *(f32x4*)p = v0; *(f32x4*)(p + 4) = v1;
            EPI_LOOP_END
        }
    }
};
struct EpiStore {
    static constexpr bool PERM = true, AFTER_DRAIN = false;
    bf16_t* C; int ldc;
    __device__ __forceinline__ void operator()(const f32x4 (&acc)[2][2][4][2], const Unit& u, int wr, int wc, int fr, int fq) const {
        const size_t row0 = (size_t)u.pm * BM; const int col0 = u.pn * BM;
        EPI_LOOP_BEGIN
            *(u32x4*)(C + (row0 + rloc) * ldc + col0 + cloc) = pack_acc8(v0, v1);
        EPI_LOOP_END
    }
};
template <int STEP> struct EpiMerge {
    static constexpr bool PERM = true, AFTER_DRAIN = false;
    const bf16_t* MGT; bf16_t* T1; bf16_t* OUT;
    __device__ __forceinline__ void operator()(const f32x4 (&acc)[2][2][4][2], const Unit& u, int wr, int wc, int fr, int fq) const {
        const size_t row0 = (size_t)u.pm * BM; const int col0 = u.pn * BM;
        EPI_LOOP_BEGIN
            const size_t row = row0 + rloc; const int col = col0 + cloc;
            const u32x4 gw = *(const u32x4*)(MGT + row * 2048 + (STEP ? 1024 : 0) + col); float g[8]; unpack8(gw, g);
            float o[8] = {v0[0], v0[1], v0[2], v0[3], v1[0], v1[1], v1[2], v1[3]};
#pragma unroll
            for (int j = 0; j < 8; ++j) o[j] *= sigmoidf_(g[j]);
            if (STEP) { const u32x4 tw = *(const u32x4*)(T1 + row * 1024 + col); float tt[8]; unpack8(tw, tt);
#pragma unroll
                for (int j = 0; j < 8; ++j) o[j] += tt[j]; }
            *(u32x4*)((STEP ? OUT : T1) + row * 1024 + col) = pack8(o);
        EPI_LOOP_END
    }
};
struct EpiResid {
    static constexpr bool PERM = true, AFTER_DRAIN = false;
    const float* src_lat; const float* src_ctx; float* dst_lat; float* dst_ctx; const float* gate;
    __device__ __forceinline__ void operator()(const f32x4 (&acc)[2][2][4][2], const Unit& u, int wr, int wc, int fr, int fq) const {
        const int row0 = u.pm * BM, col0 = u.pn * BM; const bool lat = row0 < RL;
        const float* sb = lat ? src_lat : src_ctx - (size_t)RL * D; float* db = lat ? dst_lat : dst_ctx - (size_t)RL * D;
        const float* gt = gate + (lat ? row0 / T : 4) * 6 * D;
        EPI_LOOP_BEGIN
            const size_t off = (size_t)(row0 + rloc) * D + col0 + cloc; const int col = col0 + cloc;
            const f32x4 g0 = *(const f32x4*)(gt + col), g1 = *(const f32x4*)(gt + col + 4), s0 = *(const f32x4*)(sb + off), s1 = *(const f32x4*)(sb + off + 4);
            *(f32x4*)(db + off) = s0 + g0 * v0; *(f32x4*)(db + off + 4) = s1 + g1 * v1;
        EPI_LOOP_END
    }
};
struct EpiSwiglu {
    static constexpr bool PERM = true, AFTER_DRAIN = false;
    bf16_t* HH; int ldc;
    __device__ __forceinline__ void operator()(const f32x4 (&acc)[2][2][4][2], const Unit& u, int wr, int wc, int fr, int fq) const {
        const size_t row0 = (size_t)u.pm * BM; const int col0 = u.pn * HALF + wc * 32 + 8 * fq;
#pragma unroll
        for (int ai = 0; ai < 2; ++ai)
#pragma unroll
            for (int m = 0; m < 4; ++m) { const int rloc = ai * HALF + wr * 64 + m * 16 + fr; float o[8];
#pragma unroll
                for (int n = 0; n < 2; ++n)
#pragma unroll
                    for (int j = 0; j < 4; ++j) o[4 * n + j] = siluf_(acc[ai][0][m][n][j]) * acc[ai][1][m][n][j];
                *(u32x4*)(HH + (row0 + rloc) * ldc + col0) = pack8(o); asm volatile("" ::: "memory"); }
    }
};

struct EpiSwiglu8 {
    static constexpr bool PERM = true, AFTER_DRAIN = false;
    unsigned char* HH; int ldc;
    __device__ __forceinline__ void operator()(const f32x4 (&acc)[2][2][4][2], const Unit& u, int wr, int wc, int fr, int fq) const {
        const size_t row0 = (size_t)u.pm * BM; const int col0 = u.pn * HALF + wc * 32 + 8 * fq; const float is = 1.0f / W8S;
#pragma unroll
        for (int ai = 0; ai < 2; ++ai)
#pragma unroll
            for (int m = 0; m < 4; ++m) { const int rloc = ai * HALF + wr * 64 + m * 16 + fr; float o[8];
#pragma unroll
                for (int n = 0; n < 2; ++n)
#pragma unroll
                    for (int j = 0; j < 4; ++j) o[4 * n + j] = __builtin_amdgcn_fmed3f(siluf_(acc[ai][0][m][n][j] * is) * (acc[ai][1][m][n][j] * is), -448.0f, 448.0f);
                v2u w; w.x = (unsigned)__builtin_amdgcn_cvt_pk_fp8_f32(o[0], o[1], 0, false); w.x = (unsigned)__builtin_amdgcn_cvt_pk_fp8_f32(o[2], o[3], (int)w.x, true);
                w.y = (unsigned)__builtin_amdgcn_cvt_pk_fp8_f32(o[4], o[5], 0, false); w.y = (unsigned)__builtin_amdgcn_cvt_pk_fp8_f32(o[6], o[7], (int)w.y, true);
                *(v2u*)(HH + (row0 + rloc) * ldc + col0) = w; asm volatile("" ::: "memory"); }
    }
};
struct EpiStoreScaled {
    static constexpr bool PERM = true, AFTER_DRAIN = false;
    bf16_t* C; int ldc; float s;
    __device__ __forceinline__ void operator()(const f32x4 (&acc)[2][2][4][2], const Unit& u, int wr, int wc, int fr, int fq) const {
        const size_t row0 = (size_t)u.pm * BM; const int col0 = u.pn * BM;
        EPI_LOOP_BEGIN
            *(u32x4*)(C + (row0 + rloc) * ldc + col0 + cloc) = pack_acc8(v0 * s, v1 * s);
        EPI_LOOP_END
    }
};

}

struct Args { const GAS float* in[33]; GAS float* out; GAS unsigned char* ws; int ph_lo, ph_hi, li, pad; };
#define CAS __attribute__((address_space(4)))
#define INP(i) ((const float*)F.A->in[i])
constexpr int NWAVES = 8, NTHREADS = 512;
struct Frame {
    LAS unsigned char* lds; volatile LAS unsigned* MISC; gu32* ctl;
    int tid, lane, wave, G, bid;
    int cb, cg;
    GAS unsigned char* ws; GAS float* out;
    const CAS Args* A;
};
enum { I_X = 0, I_C, I_CTX, I_CCTX, I_WADA, I_BADA, I_GNM, I_GNF, I_WIN, I_BG, I_GMN, I_MU, I_W0, I_W2, I_A0, I_A2, I_G2, I_KK, I_KA, I_RK, I_LNW, I_LNB, I_WPM, I_WPR, I_WOUT,
       I_FFG, I_FFU, I_FFD, I_WR, I_EG, I_EU, I_ED, I_GF };

__device__ __forceinline__ void conv_item(const float* W, int ldw, int c0, int k0, bf16* dst, int ldd, int r0, LAS float* scr, int lane) {
#pragma unroll 8
    for (int i = 0; i < 32; ++i) { const int kk = 2 * i + (lane >> 5); scr[kk * 33 + (lane & 31)] = W[(size_t)(k0 + kk) * ldw + c0 + (lane & 31)]; }
    LDS_WAIT(); asm volatile("" ::: "memory");
    const int c = lane & 7;
#pragma unroll
    for (int j = 0; j < 4; ++j) { const int n = (lane >> 3) + 8 * j; const LAS float* s = scr + (8 * c) * 33 + n;
        v4u o; o.x = cvt_pk_bf16(s[0 * 33], s[1 * 33]); o.y = cvt_pk_bf16(s[2 * 33], s[3 * 33]); o.z = cvt_pk_bf16(s[4 * 33], s[5 * 33]); o.w = cvt_pk_bf16(s[6 * 33], s[7 * 33]);
        *(v4u*)(dst + (size_t)(r0 + n) * ldd + k0 + 8 * c) = o; }
    LDS_WAIT(); asm volatile("" ::: "memory");
}
__device__ __forceinline__ unsigned pk4_fp8(float a, float b, float c, float d) { int w = __builtin_amdgcn_cvt_pk_fp8_f32(a, b, 0, false); w = __builtin_amdgcn_cvt_pk_fp8_f32(c, d, w, true); return (unsigned)w; }
__device__ __forceinline__ void conv_item8(const float* W, int ldw, int c0, int k0, unsigned char* dst, int ldd, int r0, float scale, LAS float* scr, int lane) {
#pragma unroll 8
    for (int i = 0; i < 32; ++i) { const int kk = 2 * i + (lane >> 5); scr[kk * 33 + (lane & 31)] = __builtin_amdgcn_fmed3f(W[(size_t)(k0 + kk) * ldw + c0 + (lane & 31)] * scale, -448.0f, 448.0f); }
    LDS_WAIT(); asm volatile("" ::: "memory");
    const int c = lane & 3;
#pragma unroll
    for (int j = 0; j < 2; ++j) { const int n = (lane >> 2) + 16 * j; const LAS float* s = scr + (16 * c) * 33 + n;
        v4u o; o.x = pk4_fp8(s[0 * 33], s[1 * 33], s[2 * 33], s[3 * 33]); o.y = pk4_fp8(s[4 * 33], s[5 * 33], s[6 * 33], s[7 * 33]);
        o.z = pk4_fp8(s[8 * 33], s[9 * 33], s[10 * 33], s[11 * 33]); o.w = pk4_fp8(s[12 * 33], s[13 * 33], s[14 * 33], s[15 * 33]);
        *(v4u*)(dst + (size_t)(r0 + n) * ldd + k0 + 16 * c) = o; }
    LDS_WAIT(); asm volatile("" ::: "memory");
}
__device__ __forceinline__ void conv_seg8(Frame& F, const float* W, int ldw, int K, int c0, int ncols, unsigned char* dst, int ldd, int r0, float scale, int& rot) {
    LAS float* scr = (LAS float*)(F.lds + F.wave * 16384);
    const int NGW = F.cg * NWAVES, nblk = ncols / 32, nitems = (K / 64) * nblk;
    int gw = (F.cb * NWAVES + F.wave + rot) % NGW;
    for (int it = gw; it < nitems; it += NGW) { const int kb = it / nblk, nb = it % nblk; conv_item8(W, ldw, c0 + 32 * nb, 64 * kb, dst, ldd, r0 + 32 * nb, scale, scr, F.lane); }
    rot = (rot + nitems) % NGW;
}
__device__ __forceinline__ void conv_gu8(Frame& F, const float* Wg, const float* Wu, int ldw, int K, int ngroups, unsigned char* dst, float scale, int& rot) {
    LAS float* scr = (LAS float*)(F.lds + F.wave * 16384);
    const int NGW = F.cg * NWAVES, kblk = K / 64, nitems = ngroups * 2 * 4 * kblk;
    int gw = (F.cb * NWAVES + F.wave + rot) % NGW;
    for (int it = gw; it < nitems; it += NGW) { const int kb = it % kblk, r = it / kblk, nb = r & 3, which = (r >> 2) & 1, p = r >> 3;
        conv_item8(which ? Wu : Wg, ldw, 128 * p + 32 * nb, 64 * kb, dst, K, 256 * p + 128 * which + 32 * nb, scale, scr, F.lane); }
    rot = (rot + nitems) % NGW;
}
__device__ __forceinline__ void conv_seg(Frame& F, const float* W, int ldw, int K, int c0, int ncols, bf16* dst, int ldd, int r0, int& rot) {
    LAS float* scr = (LAS float*)(F.lds + F.wave * 16384);
    const int NGW = F.cg * NWAVES, nblk = ncols / 32, nitems = (K / 64) * nblk;
    int gw = (F.cb * NWAVES + F.wave + rot) % NGW;
    for (int it = gw; it < nitems; it += NGW) { const int kb = it / nblk, nb = it % nblk; conv_item(W, ldw, c0 + 32 * nb, 64 * kb, dst, ldd, r0 + 32 * nb, scr, F.lane); }
    rot = (rot + nitems) % NGW;
}
__device__ __forceinline__ void conv_gu(Frame& F, const float* Wg, const float* Wu, int ldw, int K, int ngroups, bf16* dst, int& rot) {
    LAS float* scr = (LAS float*)(F.lds + F.wave * 16384);
    const int NGW = F.cg * NWAVES, kblk = K / 64, nitems = ngroups * 2 * 4 * kblk;
    int gw = (F.cb * NWAVES + F.wave + rot) % NGW;
    for (int it = gw; it < nitems; it += NGW) { const int kb = it % kblk, r = it / kblk, nb = r & 3, which = (r >> 2) & 1, p = r >> 3;
        conv_item(which ? Wu : Wg, ldw, 128 * p + 32 * nb, 64 * kb, dst, K, 256 * p + 128 * which + 32 * nb, scr, F.lane); }
    rot = (rot + nitems) % NGW;
}
__device__ __forceinline__ void zero_bf16_rows(Frame& F, bf16* dst, size_t n16) {
    const v4u z = {0u, 0u, 0u, 0u};
    for (size_t i = (size_t)F.cb * NTHREADS + F.tid; i < n16; i += (size_t)F.cg * NTHREADS) ((v4u*)dst)[i] = z;
}
__device__ __forceinline__ void conv_win(Frame& F, int l) {
    int rot = 0; GAS unsigned char* ws = F.ws;
    bf16* WIN = (bf16*)(ws + WS_WIN); const float* win = INP(I_WIN) + (size_t)l * D * DIN;
    conv_seg(F, win, DIN, D, 0, 3072, WIN, D, 0, rot);
    conv_seg(F, win, DIN, D, 3104, 3072, WIN, D, 3072, rot);
    conv_seg(F, win, DIN, D, 6560, 2048, WIN, D, 6144, rot);
    conv_seg(F, win, DIN, D, 3072, 32, WIN, D, 8192, rot);
    conv_seg(F, win, DIN, D, 6176, 384, WIN, D, 8192 + 32, rot);
    zero_bf16_rows(F, WIN + (size_t)(8192 + 416) * D, (size_t)96 * D * 2 / 16);
}
__device__ __forceinline__ void conv_rest(Frame& F, int l) {
    int rot = 0; GAS unsigned char* ws = F.ws;
    conv_seg(F, INP(I_WPM) + (size_t)l * D * D, D, D, 0, D, (bf16*)(ws + WS_WPM), D, 0, rot);
    conv_seg(F, INP(I_WPR) + (size_t)l * D * D, D, D, 0, D, (bf16*)(ws + WS_WPR), D, 0, rot);
    conv_seg(F, INP(I_WOUT) + (size_t)l * D * D, D, D, 0, D, (bf16*)(ws + WS_WOUT), D, 0, rot);
    { bf16* WG2 = (bf16*)(ws + WS_WG2);
      conv_seg(F, INP(I_G2) + (size_t)l * 128 * RD, RD, 128, 0, RD, WG2, 256, 0, rot);
      for (int i = F.cb * NTHREADS + F.tid; i < 1024 * 16; i += F.cg * NTHREADS) { const int r = i >> 4, p = i & 15; *(v4u*)(WG2 + (size_t)r * 256 + 128 + 8 * p) = (v4u){0u, 0u, 0u, 0u}; } }
    { bf16* WL = (bf16*)(ws + WS_WLORA);
      for (int d = 0; d < 2; ++d) { conv_seg(F, INP(I_W2) + ((size_t)l * 2 + d) * 64 * RD, RD, 64, 0, RD, WL + (size_t)(0 * 2 + d) * RD * 64, 64, 0, rot);
                                    conv_seg(F, INP(I_A2) + ((size_t)l * 2 + d) * 64 * RD, RD, 64, 0, RD, WL + (size_t)(1 * 2 + d) * RD * 64, 64, 0, rot); } }
}
__device__ __forceinline__ void conv_ffn0(Frame& F) {
    int rot = 0; GAS unsigned char* ws = F.ws;
    conv_gu(F, INP(I_FFG), INP(I_FFU), FF, D, FF / 128, (bf16*)(ws + WS_WGU), rot);
    conv_seg(F, INP(I_FFD), D, FF, 0, D, (bf16*)(ws + WS_WDN), FF, 0, rot);
}
__device__ __forceinline__ void conv_experts(Frame& F, int e0, int e1) {
    int rot = 0;
    for (int e = e0; e < e1; ++e) {
        unsigned char* gu = (unsigned char*)F.ws + (e < 4 ? WS_WEA + (size_t)e * 7 * MiB : WS_WEGU + (size_t)(e - 4) * 7 * MiB);
        unsigned char* dn = (unsigned char*)F.ws + (e < 4 ? WS_WEA + 28 * MiB + (size_t)e * 3584 * 1024 : WS_WEDN + (size_t)(e - 4) * 3584 * 1024);
        conv_gu8(F, INP(I_EG) + (size_t)e * D * FE, INP(I_EU) + (size_t)e * D * FE, FE, D, FE / 128, gu, W8S, rot);
        conv_seg8(F, INP(I_ED) + (size_t)e * FE * D, D, FE, 0, D, dn, FE, 0, W8S, rot);
    }
}
__device__ __forceinline__ void mod_phase(Frame& F) {
    LAS float* sl = (LAS float*)F.lds;
    LAS float* part = sl + 5 * D;
    for (int i = F.tid; i < 5 * D; i += NTHREADS) { const int bb = i / D, k = i % D; const float v = bb < 4 ? INP(I_C)[bb * D + k] : INP(I_CCTX)[k]; sl[i] = siluf_(v); }
    __syncthreads();
    float* MOD = (float*)(F.ws + WS_MOD);
    for (int item = F.bid; item < NL * 6 * D / 64; item += F.G) {
        const int l = item / (6 * D / 64), c0 = (item % (6 * D / 64)) * 64; const float* w = INP(I_WADA) + (size_t)l * D * 6 * D + c0 + F.lane;
        float a[5] = {0.f, 0.f, 0.f, 0.f, 0.f};
        for (int k = F.wave * 128; k < F.wave * 128 + 128; ++k) { const float wv = w[(size_t)k * 6 * D];
#pragma unroll
            for (int bb = 0; bb < 5; ++bb) a[bb] += sl[bb * D + k] * wv; }
#pragma unroll
        for (int bb = 0; bb < 5; ++bb) part[(F.wave * 5 + bb) * 64 + F.lane] = a[bb];
        __syncthreads();
        if (F.tid < 5 * 64) { const int bb = F.tid / 64, c = F.tid % 64; float s = INP(I_BADA)[l * 6 * D + c0 + c];
#pragma unroll
            for (int w8 = 0; w8 < 8; ++w8) s += part[(w8 * 5 + bb) * 64 + c];
            MOD[((size_t)l * 5 + bb) * 6 * D + c0 + c] = s; }
        __syncthreads();
    }
}
__device__ __forceinline__ const float* xrow(const float* lat, const float* ctx, int g) { return g < RL ? lat + (size_t)g * D : ctx + (size_t)(g - RL) * D; }
template <bool ROUTER> __device__ __forceinline__ void normmod_phase(Frame& F, const float* lat, const float* ctx, const float* gain, const float* MODl, int off_sh, int off_sc, int nrows, const float* wrt) {
    bf16* H = (bf16*)(F.ws + WS_H);
    LAS unsigned* lcnt = (LAS unsigned*)F.lds;
    LAS int* rec = (LAS int*)(F.lds + 64);
    LAS float* recp = (LAS float*)(F.lds + 64 + 1024);
    const int ngroups = nrows / 64;
    for (int grp = F.bid; grp < ngroups; grp += F.G) {
        if (ROUTER) { if (F.tid < 16) lcnt[F.tid] = 0u; __syncthreads(); }
        f32x4 vnx[4];
        { const float* x0 = xrow(lat, ctx, grp * 64 + F.wave * 8);
#pragma unroll
          for (int j = 0; j < 4; ++j) vnx[j] = *(const f32x4*)(x0 + 256 * j + 4 * F.lane); }
        for (int rr = 0; rr < 8; ++rr) {
            const int lrow = F.wave * 8 + rr, g = grp * 64 + lrow; const float* md = MODl + (g < RL ? g / T : 4) * 6 * D;
            f32x4 v[4]; float ss = 0.f;
#pragma unroll
            for (int j = 0; j < 4; ++j) v[j] = vnx[j];
            if (rr + 1 < 8) { const float* x1 = xrow(lat, ctx, g + 1);
#pragma unroll
                for (int j = 0; j < 4; ++j) vnx[j] = *(const f32x4*)(x1 + 256 * j + 4 * F.lane); }
#pragma unroll
            for (int j = 0; j < 4; ++j) ss += (v[j].x * v[j].x + v[j].y * v[j].y) + (v[j].z * v[j].z + v[j].w * v[j].w);
            const float rstd = 1.0f / sqrtf(wave_sum(ss) * (1.0f / D) + NORM_EPS);
            float lg[NE];
            if (ROUTER) {
#pragma unroll
                for (int e = 0; e < NE; ++e) lg[e] = 0.f; }
#pragma unroll
            for (int j = 0; j < 4; ++j) { const int c = 256 * j + 4 * F.lane;
                const f32x4 gn = *(const f32x4*)(gain + c), sc = *(const f32x4*)(md + off_sc + c), sh = *(const f32x4*)(md + off_sh + c);
                const f32x4 h = v[j] * rstd * gn * (1.0f + sc) + sh;
                v2u o; o.x = cvt_pk_bf16(h.x, h.y); o.y = cvt_pk_bf16(h.z, h.w); *(v2u*)(H + (size_t)g * D + c) = o;
                if (ROUTER) {
#pragma unroll
                    for (int q = 0; q < 4; ++q) { const f32x4 w0 = *(const f32x4*)(wrt + (size_t)(c + q) * NE), w1 = *(const f32x4*)(wrt + (size_t)(c + q) * NE + 4); const float hv = h[q];
                        lg[0] += hv * w0.x; lg[1] += hv * w0.y; lg[2] += hv * w0.z; lg[3] += hv * w0.w; lg[4] += hv * w1.x; lg[5] += hv * w1.y; lg[6] += hv * w1.z; lg[7] += hv * w1.w; } }
            }
            if (ROUTER) {
#pragma unroll
                for (int e = 0; e < NE; ++e) lg[e] = wave_sum(lg[e]);
                int i0 = 0;
#pragma unroll
                for (int e = 1; e < NE; ++e) if (lg[e] > lg[i0]) i0 = e;
                int i1 = i0 == 0 ? 1 : 0;
#pragma unroll
                for (int e = 0; e < NE; ++e) if (e != i0 && lg[e] > lg[i1]) i1 = e;
                if (F.lane == 0) { const float e1 = __expf(lg[i1] - lg[i0]); const float p0 = 1.0f / (1.0f + e1);
                    rec[lrow * 4 + 0] = i0; rec[lrow * 4 + 1] = i1; rec[lrow * 4 + 2] = (int)atomicAdd((unsigned*)&lcnt[i0], 1u); rec[lrow * 4 + 3] = (int)atomicAdd((unsigned*)&lcnt[i1], 1u);
                    recp[lrow * 2 + 0] = p0; recp[lrow * 2 + 1] = e1 * p0; }
            }
        }
        if (ROUTER) {
            __syncthreads();
            if (F.tid < NE) lcnt[8 + F.tid] = __hip_atomic_fetch_add((unsigned*)(F.ctl + CW_ECNT + 64 * F.tid), lcnt[F.tid], RLX_AGENT);
            __syncthreads();
            if (F.tid < 64) { const int g = grp * 64 + F.tid; int* tk = (int*)(F.ws + WS_META) + (size_t)g * 8; const int e0 = rec[F.tid * 4], e1 = rec[F.tid * 4 + 1];
                tk[0] = e0; tk[1] = e1; tk[2] = (int)lcnt[8 + e0] + rec[F.tid * 4 + 2]; tk[3] = (int)lcnt[8 + e1] + rec[F.tid * 4 + 3];
                ((float*)tk)[4] = recp[F.tid * 2]; ((float*)tk)[5] = recp[F.tid * 2 + 1]; }
            __syncthreads();
        }
    }
}
__device__ __forceinline__ void subgrid_arrive(Frame& F, gu32* cnt) {
    asm volatile("s_waitcnt vmcnt(0)" ::: "memory"); __syncthreads();
    if (F.tid == 0) { __builtin_amdgcn_fence(__ATOMIC_RELEASE, "agent"); asm volatile("s_waitcnt vmcnt(0)" ::: "memory"); __hip_atomic_fetch_add(cnt, 1u, RLX_AGENT); }
}
__device__ __forceinline__ void subgrid_wait(Frame& F, gu32* cnt, unsigned n) {
    if (F.tid == 0) { unsigned sp = 0; while (__hip_atomic_load(cnt, RLX_AGENT) < n) { __builtin_amdgcn_s_sleep(2); if (++sp > (1u << 20)) break; }
        __builtin_amdgcn_fence(__ATOMIC_ACQUIRE, "agent"); asm volatile("s_waitcnt vmcnt(0)" ::: "memory"); }
    __syncthreads();
}
__device__ __forceinline__ void sg_phase(Frame& F, int l) {
    const float* SM = (const float*)(F.ws + WS_SM); bf16* SG = (bf16*)(F.ws + WS_SG); const float* mu = INP(I_MU) + l * RW + 3328;
    for (int i = F.cb * NTHREADS + F.tid; i < R * 32; i += F.cg * NTHREADS) { const int g = i >> 5, p = i & 31; float o[8];
        if (p < 16) { const int nb = nbrow(g, 3328); const float* a = SM + (size_t)g * SMW + 288 + 8 * p;
            const f32x4 a0 = *(const f32x4*)a, a1 = *(const f32x4*)(a + 4); f32x4 b0 = {0.f, 0.f, 0.f, 0.f}, b1 = b0;
            if (nb >= 0) { const float* bq = SM + (size_t)nb * SMW + 288 + 8 * p; b0 = *(const f32x4*)bq; b1 = *(const f32x4*)(bq + 4); }
#pragma unroll
            for (int j = 0; j < 4; ++j) { o[j] = sigmoidf_(a0[j] + (b0[j] - a0[j]) * mu[8 * p + j]); o[4 + j] = sigmoidf_(a1[j] + (b1[j] - a1[j]) * mu[8 * p + 4 + j]); }
        } else {
#pragma unroll
            for (int j = 0; j < 8; ++j) o[j] = 0.f; }
        *(v4u*)(SG + (size_t)g * 256 + 8 * p) = pack8(o); }
}

constexpr int ML_P = 72, ML_QS = 0, ML_KS = 64 * ML_P * 2, ML_KT = 2 * ML_KS, ML_PS = 3 * ML_KS, ML_VT = 4 * ML_KS, ML_CB = ML_VT + 48 * ML_P * 2, ML_GT = ML_CB + 48 * ML_P * 2, ML_END = ML_GT + 2 * 6 * 64 * 4;
template <int CTRL, int RMASK> __device__ __forceinline__ float dpp_get(float v, float old) { return __int_as_float(__builtin_amdgcn_update_dpp(__float_as_int(old), __float_as_int(v), CTRL, RMASK, 0xf, false)); }
__device__ __forceinline__ float wave_scan_add(float x) {
    x += dpp_get<0x111, 0xf>(x, 0.f); x += dpp_get<0x112, 0xf>(x, 0.f); x += dpp_get<0x114, 0xf>(x, 0.f); x += dpp_get<0x118, 0xf>(x, 0.f);
    x += dpp_get<0x142, 0xa>(x, 0.f); x += dpp_get<0x143, 0xc>(x, 0.f); return x;
}
__device__ __forceinline__ float wave_scan_max(float x) {
    const float ninf = -__builtin_inff();
    x = fmaxf(x, dpp_get<0x111, 0xf>(x, ninf)); x = fmaxf(x, dpp_get<0x112, 0xf>(x, ninf)); x = fmaxf(x, dpp_get<0x114, 0xf>(x, ninf)); x = fmaxf(x, dpp_get<0x118, 0xf>(x, ninf));
    x = fmaxf(x, dpp_get<0x142, 0xa>(x, ninf)); x = fmaxf(x, dpp_get<0x143, 0xc>(x, ninf)); return x;
}
__device__ __forceinline__ float lane63(float x) { return __int_as_float(__builtin_amdgcn_readlane(__float_as_int(x), 63)); }
__device__ __forceinline__ void mlstm_phase(Frame& F, int l, int first, int stride) {
    LAS unsigned char* L = F.lds;
    LAS bf16* Qs = (LAS bf16*)(L + ML_QS); LAS bf16* Ks = (LAS bf16*)(L + ML_KS); LAS bf16* Kt = (LAS bf16*)(L + ML_KT); LAS bf16* Ps = (LAS bf16*)(L + ML_PS);
    LAS bf16* Vt = (LAS bf16*)(L + ML_VT); LAS bf16* Cb = (LAS bf16*)(L + ML_CB); LAS float* GT = (LAS float*)(L + ML_GT);
    const bf16* Qg = (const bf16*)(F.ws + WS_Q); const bf16* Kg = (const bf16*)(F.ws + WS_K); const bf16* Vg = (const bf16*)(F.ws + WS_V); const float* SM = (const float*)(F.ws + WS_SM);
    bf16* HF = (bf16*)(F.ws + WS_HF); const float* bgate = INP(I_BG) + l * 4 * MH;
    const int tid = F.tid, lane = F.lane, wave = F.wave, r16 = lane & 15, quad = lane >> 4;
    for (int item = first; item < NB * 2 * MH * 4; item += stride) {
        const int vq = item & 3, h = (item >> 2) & 7, dir = (item >> 5) & 1, b = item >> 6;
        __syncthreads();
        for (int i = tid; i < 48 * ML_P; i += NTHREADS) { Cb[i] = 0; Vt[i] = (i >= 32 * ML_P) ? (bf16)0x3F80 : (bf16)0; }
        const float bgi = bgate[(2 * dir) * MH + h], bgf = bgate[(2 * dir + 1) * MH + h];
        const int ss_ = tid & 63, pc = tid >> 6;
        v4u rq, rk, rv = {0u, 0u, 0u, 0u};
        { const int g = row_of(b, tok(dir, ss_)); rq = *(const v4u*)(Qg + (size_t)g * 512 + h * 64 + pc * 8); rk = *(const v4u*)(Kg + (size_t)g * 512 + h * 64 + pc * 8);
          if (pc < 4) rv = *(const v4u*)(Vg + (size_t)g * 1024 + h * 128 + vq * 32 + pc * 8); }
        float m_run = 0.f, gi = 0.f, gf = 0.f;
        auto gate_tables = [&](int buf) {
            LAS float* G = GT + buf * 384;
            const float iv = CAP * fast_tanh((gi + bgi) * (1.0f / CAP)), lf = -fast_softplus(-CAP * fast_tanh((gf + bgf) * (1.0f / CAP)));
            const float bsum = wave_scan_add(lf), pmx = wave_scan_max(iv - bsum);
            const float inter = bsum + m_run, mt = fmaxf(inter, bsum + pmx);
            G[lane] = bsum - mt; G[64 + lane] = iv - bsum; G[128 + lane] = __expf(inter - mt); G[192 + lane] = __expf(-mt);
            const float blast = lane63(bsum), mnew = fmaxf(blast + m_run, blast + lane63(pmx));
            G[256 + lane] = __expf(blast - bsum + iv - mnew);
            if (lane == 0) G[320] = __expf(blast + m_run - mnew);
            m_run = mnew;
        };
        if (wave == 1) { { const int g = row_of(b, tok(dir, lane)); gi = SM[(size_t)g * SMW + (2 * dir) * MH + h]; gf = SM[(size_t)g * SMW + (2 * dir + 1) * MH + h]; }
            gate_tables(0);
            { const int g = row_of(b, tok(dir, 64 + lane)); gi = SM[(size_t)g * SMW + (2 * dir) * MH + h]; gf = SM[(size_t)g * SMW + (2 * dir + 1) * MH + h]; } }
        f32x4 Cacc = {0.f, 0.f, 0.f, 0.f}, Cacc2 = {0.f, 0.f, 0.f, 0.f};
        __syncthreads();
        for (int j = 0; j < NCH; ++j) {
            const LAS float* G = GT + (j & 1) * 384;
            { *(v4u*)(Qs + ss_ * ML_P + pc * 8) = rq; *(v4u*)(Ks + ss_ * ML_P + pc * 8) = rk;
              const unsigned kw[4] = {rk.x, rk.y, rk.z, rk.w};
#pragma unroll
              for (int i = 0; i < 4; ++i) { Kt[(pc * 8 + 2 * i) * ML_P + ss_] = (bf16)(kw[i] & 0xffffu); Kt[(pc * 8 + 2 * i + 1) * ML_P + ss_] = (bf16)(kw[i] >> 16); }
              if (pc < 4) { const unsigned vw[4] = {rv.x, rv.y, rv.z, rv.w};
#pragma unroll
                  for (int i = 0; i < 4; ++i) { Vt[(pc * 8 + 2 * i) * ML_P + ss_] = (bf16)(vw[i] & 0xffffu); Vt[(pc * 8 + 2 * i + 1) * ML_P + ss_] = (bf16)(vw[i] >> 16); } } }
            if (j + 1 < NCH) { const int g = row_of(b, tok(dir, (j + 1) * 64 + ss_)); rq = *(const v4u*)(Qg + (size_t)g * 512 + h * 64 + pc * 8); rk = *(const v4u*)(Kg + (size_t)g * 512 + h * 64 + pc * 8);
                if (pc < 4) rv = *(const v4u*)(Vg + (size_t)g * 1024 + h * 128 + vq * 32 + pc * 8); }
            __syncthreads();
            const int mt = wave >> 1, vnt = wave & 1;
            if (wave == 1 && j + 1 < NCH) { gate_tables((j + 1) & 1);
                if (j + 2 < NCH) { const int g = row_of(b, tok(dir, (j + 2) * 64 + lane)); gi = SM[(size_t)g * SMW + (2 * dir) * MH + h]; gf = SM[(size_t)g * SMW + (2 * dir + 1) * MH + h]; } }
            const bf16x8 qa0 = *(const LAS bf16x8*)(Qs + (16 * mt + r16) * ML_P + quad * 8), qa1 = *(const LAS bf16x8*)(Qs + (16 * mt + r16) * ML_P + 32 + quad * 8);
            f32x4 accq = {0.f, 0.f, 0.f, 0.f}, accqn = {0.f, 0.f, 0.f, 0.f};
            { const bf16x8 c0 = *(const LAS bf16x8*)(Cb + (16 * vnt + r16) * ML_P + quad * 8), c1 = *(const LAS bf16x8*)(Cb + (16 * vnt + r16) * ML_P + 32 + quad * 8);
              const bf16x8 n0 = *(const LAS bf16x8*)(Cb + (32 + r16) * ML_P + quad * 8), n1 = *(const LAS bf16x8*)(Cb + (32 + r16) * ML_P + 32 + quad * 8);
              accq = __builtin_amdgcn_mfma_f32_16x16x32_bf16(qa0, c0, accq, 0, 0, 0); accq = __builtin_amdgcn_mfma_f32_16x16x32_bf16(qa1, c1, accq, 0, 0, 0);
              accqn = __builtin_amdgcn_mfma_f32_16x16x32_bf16(qa0, n0, accqn, 0, 0, 0); accqn = __builtin_amdgcn_mfma_f32_16x16x32_bf16(qa1, n1, accqn, 0, 0, 0); }
#pragma unroll
            for (int nn = 0; nn < 2; ++nn) { const int nt = 2 * (wave & 1) + nn; f32x4 sacc = {0.f, 0.f, 0.f, 0.f};
                if (nt <= mt) { const bf16x8 k0 = *(const LAS bf16x8*)(Ks + (16 * nt + r16) * ML_P + quad * 8), k1 = *(const LAS bf16x8*)(Ks + (16 * nt + r16) * ML_P + 32 + quad * 8);
                    sacc = __builtin_amdgcn_mfma_f32_16x16x32_bf16(qa0, k0, sacc, 0, 0, 0); sacc = __builtin_amdgcn_mfma_f32_16x16x32_bf16(qa1, k1, sacc, 0, 0, 0); }
                const int s = 16 * nt + r16; const float wc_ = G[64 + s];
#pragma unroll
                for (int i = 0; i < 4; ++i) { const int t = 16 * mt + 4 * quad + i; const float p = (s <= t) ? sacc[i] * 0.125f * __expf(G[t] + wc_) : 0.f;
                    Ps[t * ML_P + s] = (bf16)(cvt_pk_bf16(p, 0.f) & 0xffffu); } }
            __syncthreads();
            { f32x4 acc = {0.f, 0.f, 0.f, 0.f}, accn = {0.f, 0.f, 0.f, 0.f};
#pragma unroll
              for (int ks = 0; ks < 2; ++ks) { if (ks == 1 && mt < 2) break;
                  const bf16x8 pa = *(const LAS bf16x8*)(Ps + (16 * mt + r16) * ML_P + 32 * ks + quad * 8);
                  const bf16x8 vb = *(const LAS bf16x8*)(Vt + (16 * vnt + r16) * ML_P + 32 * ks + quad * 8), ob = *(const LAS bf16x8*)(Vt + (32 + r16) * ML_P + 32 * ks + quad * 8);
                  acc = __builtin_amdgcn_mfma_f32_16x16x32_bf16(pa, vb, acc, 0, 0, 0); accn = __builtin_amdgcn_mfma_f32_16x16x32_bf16(pa, ob, accn, 0, 0, 0); }
#pragma unroll
              for (int i = 0; i < 4; ++i) { const int t = 16 * mt + 4 * quad + i; const float wi = G[128 + t] * 0.125f, dn = accn[i] + wi * accqn[i], inv = 1.0f / fmaxf(fabsf(dn), G[192 + t]);
                  const int g = row_of(b, tok(dir, j * 64 + t));
                  HF[((size_t)dir * R + g) * 1024 + h * 128 + vq * 32 + 16 * vnt + r16] = (bf16)(cvt_pk_bf16((acc[i] + wi * accq[i]) * inv, 0.f) & 0xffffu); } }
            { const float aold = G[320]; const int vmt = wave >> 2, dnt = wave & 3;
              f32x4 d1 = {0.f, 0.f, 0.f, 0.f}, d2 = {0.f, 0.f, 0.f, 0.f};
#pragma unroll
              for (int ks = 0; ks < 2; ++ks) {
                  const v4u kraw = *(const LAS v4u*)(Kt + (16 * dnt + r16) * ML_P + 32 * ks + quad * 8); float kf[8]; unpack8(kraw, kf);
                  const f32x4 a0 = *(const LAS f32x4*)&G[256 + 32 * ks + quad * 8], a1 = *(const LAS f32x4*)&G[256 + 32 * ks + quad * 8 + 4];
                  kf[0] *= a0.x; kf[1] *= a0.y; kf[2] *= a0.z; kf[3] *= a0.w; kf[4] *= a1.x; kf[5] *= a1.y; kf[6] *= a1.z; kf[7] *= a1.w;
                  const v4u kp = pack8(kf); const bf16x8 kb = __builtin_bit_cast(bf16x8, kp);
                  const bf16x8 va = *(const LAS bf16x8*)(Vt + (16 * vmt + r16) * ML_P + 32 * ks + quad * 8);
                  d1 = __builtin_amdgcn_mfma_f32_16x16x32_bf16(va, kb, d1, 0, 0, 0);
                  if (wave < 4) { const bf16x8 oa = *(const LAS bf16x8*)(Vt + (32 + r16) * ML_P + 32 * ks + quad * 8); d2 = __builtin_amdgcn_mfma_f32_16x16x32_bf16(oa, kb, d2, 0, 0, 0); } }
              Cacc = Cacc * aold + d1;
#pragma unroll
              for (int i = 0; i < 4; ++i) Cb[(16 * vmt + 4 * quad + i) * ML_P + 16 * dnt + r16] = (bf16)(cvt_pk_bf16(Cacc[i], 0.f) & 0xffffu);
              if (wave < 4) { Cacc2 = Cacc2 * aold + d2;
#pragma unroll
                  for (int i = 0; i < 4; ++i) Cb[(32 + 4 * quad + i) * ML_P + 16 * dnt + r16] = (bf16)(cvt_pk_bf16(Cacc2[i], 0.f) & 0xffffu); } }
            __syncthreads();
        }
    }
}

constexpr int RP = 72;
constexpr int RC_AB = 0, RC_BB = 9216, RC_KB = 18432, RC_RB = 27648, RC_BHT = 36864, RC_KHT = 46080, RC_ABT = 55296, RC_GAKT = 64512, RC_BONP = 67584;
constexpr int RC_TW = 0, RC_AD = 9216;
constexpr int RC_KK16 = 71680, RC_K16 = 80896, RC_R16 = 99328;
constexpr int RC_GAB = 71680, RC_GAK = 75776, RC_HRB = 78848, RC_HRK = 81920, RC_TT = 84992, RC_SAT = 88064, RC_YO = 93184;
constexpr int RC_GL = 109568, RC_VT = 110592, RC_SB = 119808, RC_CONST = 129024, RC_W2T = 133120, RC_A2T = 142336, RC_END = 151552;
static_assert(RC_END <= MISC_OFF && RC_YO + 16384 <= RC_GL && RC_BONP + 1024 <= RC_KK16 && RC_TT + 3072 <= RC_SAT && RC_SAT + 5120 <= RC_YO, "rwkv LDS map");
struct RwPre { f32x4 lw[2], lwn[2], la[2], lan[2]; v4u r, rn, k, kn, v, vn; };
__device__ __forceinline__ void rw_prefetch(RwPre& P, const float* SM, const bf16* RKV, int b, int dir, int h, int j, int tid) {
    const int s = tid >> 3, p8 = (tid & 7) * 8, g = row_of(b, tok(dir, j * 64 + s));
    { const int nb = nbrow(g, 3072); const float* a = SM + (size_t)g * SMW + 32 + 64 * dir + p8; const float* c = SM + (size_t)g * SMW + 160 + 64 * dir + p8;
      P.lw[0] = *(const f32x4*)a; P.lw[1] = *(const f32x4*)(a + 4); P.la[0] = *(const f32x4*)c; P.la[1] = *(const f32x4*)(c + 4);
      const f32x4 z = {0.f, 0.f, 0.f, 0.f}; P.lwn[0] = z; P.lwn[1] = z; P.lan[0] = z; P.lan[1] = z;
      if (nb >= 0) { const float* an = SM + (size_t)nb * SMW + 32 + 64 * dir + p8; const float* cn = SM + (size_t)nb * SMW + 160 + 64 * dir + p8;
          P.lwn[0] = *(const f32x4*)an; P.lwn[1] = *(const f32x4*)(an + 4); P.lan[0] = *(const f32x4*)cn; P.lan[1] = *(const f32x4*)(cn + 4); } }
    const v4u z4 = {0u, 0u, 0u, 0u};
    { const int rw = h * 64 + p8, nb = nbrow(g, rw); P.r = *(const v4u*)(RKV + (size_t)g * 3072 + rw); P.rn = nb >= 0 ? *(const v4u*)(RKV + (size_t)nb * 3072 + rw) : z4; }
    { const int rw = 1024 + h * 64 + p8, nb = nbrow(g, rw); P.k = *(const v4u*)(RKV + (size_t)g * 3072 + rw); P.kn = nb >= 0 ? *(const v4u*)(RKV + (size_t)nb * 3072 + rw) : z4; }
    { const int rw = 2048 + h * 64 + p8, nb = nbrow(g, rw); P.v = *(const v4u*)(RKV + (size_t)g * 3072 + rw); P.vn = nb >= 0 ? *(const v4u*)(RKV + (size_t)nb * 3072 + rw) : z4; }
}
__device__ __forceinline__ bf16x8 lds_frag(const LAS bf16* p) { return *(const LAS bf16x8*)p; }
__device__ __forceinline__ bf16x8 lds_frag_k16(const LAS bf16* p, int quad) { const bf16x8 v = *(const LAS bf16x8*)p; const bf16x8 z = {0, 0, 0, 0, 0, 0, 0, 0}; return quad < 2 ? v : z; }
__device__ __forceinline__ bf16x8 lds_frag_perm(const LAS bf16* p) { const v2u lo = *(const LAS v2u*)p, hi = *(const LAS v2u*)(p + 16); const v4u w = {lo.x, lo.y, hi.x, hi.y}; return __builtin_bit_cast(bf16x8, w); }
__device__ __forceinline__ bf16x8 lds_frag_lo4(const LAS bf16* p) { const v2u lo = *(const LAS v2u*)p; const v4u w = {lo.x, lo.y, 0u, 0u}; return __builtin_bit_cast(bf16x8, w); }
__device__ __forceinline__ unsigned pk2(float lo, float hi) { typedef __bf16 bf2 __attribute__((ext_vector_type(2))); const bf2 v = {(__bf16)lo, (__bf16)hi}; return __builtin_bit_cast(unsigned, v); }
__device__ __forceinline__ bf16 f2b(float x) { return __builtin_bit_cast(unsigned short, (__bf16)x); }
__device__ __forceinline__ float b2f(bf16 x) { return __uint_as_float((unsigned)x << 16); }
#define MFMA16(a, b, c) __builtin_amdgcn_mfma_f32_16x16x32_bf16(a, b, c, 0, 0, 0)
__device__ __forceinline__ void rwkv_phase(Frame& F, int l, int first, int stride) {
    LAS unsigned char* L = F.lds;
    LAS bf16* Ab = (LAS bf16*)(L + RC_AB); LAS bf16* Bb = (LAS bf16*)(L + RC_BB); LAS bf16* Kb = (LAS bf16*)(L + RC_KB); LAS bf16* Rb = (LAS bf16*)(L + RC_RB);
    LAS bf16* BhT = (LAS bf16*)(L + RC_BHT); LAS bf16* KhT = (LAS bf16*)(L + RC_KHT); LAS bf16* AbT = (LAS bf16*)(L + RC_ABT); LAS bf16* GAKT = (LAS bf16*)(L + RC_GAKT); LAS float* BONP = (LAS float*)(L + RC_BONP);
    LAS bf16* TW = (LAS bf16*)(L + RC_TW); LAS bf16* AD = (LAS bf16*)(L + RC_AD);
    LAS bf16* KK16 = (LAS bf16*)(L + RC_KK16); LAS bf16* K16 = (LAS bf16*)(L + RC_K16); LAS bf16* R16 = (LAS bf16*)(L + RC_R16);
    LAS float* GAB = (LAS float*)(L + RC_GAB); LAS bf16* GAK = (LAS bf16*)(L + RC_GAK); LAS bf16* HRB = (LAS bf16*)(L + RC_HRB); LAS bf16* HRK = (LAS bf16*)(L + RC_HRK); LAS bf16* TT = (LAS bf16*)(L + RC_TT);
    LAS bf16* SAt = (LAS bf16*)(L + RC_SAT); LAS float* YO = (LAS float*)(L + RC_YO); LAS float* GL = (LAS float*)(L + RC_GL);
    LAS bf16* Vt = (LAS bf16*)(L + RC_VT); LAS bf16* Sb = (LAS bf16*)(L + RC_SB); LAS float* CN = (LAS float*)(L + RC_CONST); LAS bf16* W2T = (LAS bf16*)(L + RC_W2T); LAS bf16* A2T = (LAS bf16*)(L + RC_A2T);
    const float* SM = (const float*)(F.ws + WS_SM); const bf16* RKV = (const bf16*)(F.ws + WS_RKV); bf16* YS = (bf16*)(F.ws + WS_YS); float* BON = (float*)(F.ws + WS_BON);
    const bf16* WL = (const bf16*)(F.ws + WS_WLORA);
    const int tid = F.tid, lane = F.lane, wave = F.wave;
    for (int item = first; item < NB * 2 * RH; item += stride) {
        const int h = item & 15, dir = (item >> 4) & 1, b = item >> 5;
        __syncthreads();
        if (tid < 64) { const float* mu = INP(I_MU) + l * RW; CN[tid] = mu[h * 64 + tid]; CN[64 + tid] = mu[1024 + h * 64 + tid]; CN[128 + tid] = mu[2048 + h * 64 + tid];
            CN[192 + tid] = mu[3072 + 64 * dir + tid]; CN[256 + tid] = mu[3200 + 64 * dir + tid];
            CN[320 + tid] = INP(I_KK)[l * RD + h * 64 + tid]; CN[384 + tid] = INP(I_KA)[l * RD + h * 64 + tid]; CN[448 + tid] = INP(I_RK)[l * RD + h * 64 + tid];
            CN[512 + tid] = INP(I_W0)[(l * 2 + dir) * RD + h * 64 + tid]; CN[576 + tid] = INP(I_A0)[(l * 2 + dir) * RD + h * 64 + tid]; }
        { const int n = tid >> 3, p8 = (tid & 7) * 8;
          *(v4u*)(W2T + n * 72 + p8) = *(const v4u*)(WL + ((size_t)(0 * 2 + dir) * RD + h * 64 + n) * 64 + p8);
          *(v4u*)(A2T + n * 72 + p8) = *(const v4u*)(WL + ((size_t)(1 * 2 + dir) * RD + h * 64 + n) * 64 + p8); }
        for (int i = tid; i < (RC_CONST - RC_GL) / 4; i += NTHREADS) ((LAS unsigned*)(L + RC_GL))[i] = 0u;
        f32x4 ST[4]; for (int kt = 0; kt < 4; ++kt) ST[kt] = (f32x4){0.f, 0.f, 0.f, 0.f};
        RwPre P; rw_prefetch(P, SM, RKV, b, dir, h, 0, tid);
        __syncthreads();
        for (int j = 0; j < NCH; ++j) {
            { int tl = tid; asm volatile("" : "+v"(tl)); const int s = tl >> 3, p8 = (tl & 7) * 8;
              { float tw[8], ad[8]; const f32x4 muw[2] = {*(const f32x4*)&CN[192 + p8], *(const f32x4*)&CN[196 + p8]}, mua[2] = {*(const f32x4*)&CN[256 + p8], *(const f32x4*)&CN[260 + p8]};
#pragma unroll
                for (int i = 0; i < 8; ++i) { const float pw = P.lw[i >> 2][i & 3], pwn = P.lwn[i >> 2][i & 3], pa = P.la[i >> 2][i & 3], pan = P.lan[i >> 2][i & 3];
                    tw[i] = fast_tanh(pw + (pwn - pw) * muw[i >> 2][i & 3]); ad[i] = pa + (pan - pa) * mua[i >> 2][i & 3]; }
                *(v4u*)(TW + s * 72 + p8) = pack8(tw); *(v4u*)(AD + s * 72 + p8) = pack8(ad); }
              { float a[8], bq[8], o[8]; const f32x4 mur[2] = {*(const f32x4*)&CN[p8], *(const f32x4*)&CN[4 + p8]}, muk[2] = {*(const f32x4*)&CN[64 + p8], *(const f32x4*)&CN[68 + p8]};
                unpack8(P.r, a); unpack8(P.rn, bq);
#pragma unroll
                for (int i = 0; i < 8; ++i) o[i] = a[i] + (bq[i] - a[i]) * mur[i >> 2][i & 3];
                *(v4u*)(R16 + s * RP + p8) = pack8(o);
                unpack8(P.k, a); unpack8(P.kn, bq); float ssq = 0.f; const f32x4 kkc[2] = {*(const f32x4*)&CN[320 + p8], *(const f32x4*)&CN[324 + p8]};
#pragma unroll
                for (int i = 0; i < 8; ++i) { o[i] = a[i] + (bq[i] - a[i]) * muk[i >> 2][i & 3]; a[i] = o[i] * kkc[i >> 2][i & 3]; ssq += a[i] * a[i]; }
                *(v4u*)(K16 + s * RP + p8) = pack8(o);
                const float inv = 1.0f / fmaxf(sqrtf(red8(ssq)), 1e-12f);
#pragma unroll
                for (int i = 0; i < 8; ++i) a[i] *= inv;
                *(v4u*)(KK16 + s * RP + p8) = pack8(a);
                { unpack8(P.v, a); unpack8(P.vn, bq); const f32x4 muv[2] = {*(const f32x4*)&CN[128 + p8], *(const f32x4*)&CN[132 + p8]};
#pragma unroll
                  for (int i = 0; i < 8; ++i) Vt[(p8 + i) * RP + s] = f2b(a[i] + (bq[i] - a[i]) * muv[i >> 2][i & 3]); } } }
            __syncthreads();
            if (j + 1 < NCH) rw_prefetch(P, SM, RKV, b, dir, h, j + 1, tid);
            { int lb = lane; asm volatile("" : "+v"(lb)); const int r16 = lb & 15, quad = lb >> 4; const int c = wave >> 1;
              const bf16x8 a0 = lds_frag(TW + (16 * c + r16) * 72 + quad * 8), a1 = lds_frag(TW + (16 * c + r16) * 72 + 32 + quad * 8);
              const bf16x8 d0 = lds_frag(AD + (16 * c + r16) * 72 + quad * 8), d1 = lds_frag(AD + (16 * c + r16) * 72 + 32 + quad * 8);
              f32x4 cw[2], ca[2];
#pragma unroll
              for (int nn = 0; nn < 2; ++nn) { const int nt = 2 * (wave & 1) + nn; const f32x4 z = {0.f, 0.f, 0.f, 0.f};
                  cw[nn] = MFMA16(a0, lds_frag(W2T + (16 * nt + r16) * 72 + quad * 8), z); cw[nn] = MFMA16(a1, lds_frag(W2T + (16 * nt + r16) * 72 + 32 + quad * 8), cw[nn]);
                  ca[nn] = MFMA16(d0, lds_frag(A2T + (16 * nt + r16) * 72 + quad * 8), z); ca[nn] = MFMA16(d1, lds_frag(A2T + (16 * nt + r16) * 72 + 32 + quad * 8), ca[nn]); }
              __syncthreads();
              float bsum[4] = {0.f, 0.f, 0.f, 0.f};
#pragma unroll
              for (int nn = 0; nn < 2; ++nn) { const int nt = 2 * (wave & 1) + nn, n = 16 * nt + r16; const float w0c = CN[512 + n], a0c = CN[576 + n], kac = CN[384 + n], rkc = CN[448 + n];
                  float wv[4], av[4], pin[4], pex[4];
#pragma unroll
                  for (int i = 0; i < 4; ++i) { wv[i] = __expf(-0.60653066f * sigmoidf_(w0c + cw[nn][i])); av[i] = sigmoidf_(a0c + ca[nn][i]); }
                  pin[0] = wv[0]; pin[1] = pin[0] * wv[1]; pin[2] = pin[1] * wv[2]; pin[3] = pin[2] * wv[3];
                  float x = pin[3], y = __shfl_up(x, 16); if (quad >= 1) x *= y; y = __shfl_up(x, 32); if (quad >= 2) x *= y;
                  float ex = __shfl_up(x, 16); if (quad == 0) ex = 1.0f; const float gl = __shfl(x, 48 + r16);
                  pex[0] = ex; pex[1] = ex * pin[0]; pex[2] = ex * pin[1]; pex[3] = ex * pin[2];
#pragma unroll
                  for (int i = 0; i < 4; ++i) pin[i] *= ex;
                  float abv[4], bhv[4], khv[4];
#pragma unroll
                  for (int i = 0; i < 4; ++i) { const int t = 16 * c + 4 * quad + i; const float kk = b2f(KK16[t * RP + n]), kx = b2f(K16[t * RP + n]), rr = b2f(R16[t * RP + n]);
                      const float kka = kk * av[i], kd = kx * (1.0f + (av[i] - 1.0f) * kac), gi_ = __builtin_amdgcn_rcpf(pin[i]), bb = kka * gi_, kb = kd * gi_;
                      abv[i] = kk * pex[i]; bhv[i] = bb * gl; khv[i] = kb * gl; bsum[i] += rr * kd * rkc;
                      Ab[t * RP + n] = f2b(abv[i]); Rb[t * RP + n] = f2b(rr * pin[i]); Bb[t * RP + n] = f2b(bb); Kb[t * RP + n] = f2b(kb); }
                  { v2u o; o.x = cvt_pk_bf16(abv[0], abv[1]); o.y = cvt_pk_bf16(abv[2], abv[3]); *(v2u*)(AbT + n * RP + 16 * c + 4 * quad) = o;
                    o.x = cvt_pk_bf16(bhv[0], bhv[1]); o.y = cvt_pk_bf16(bhv[2], bhv[3]); *(v2u*)(BhT + n * RP + 16 * c + 4 * quad) = o;
                    o.x = cvt_pk_bf16(khv[0], khv[1]); o.y = cvt_pk_bf16(khv[2], khv[3]); *(v2u*)(KhT + n * RP + 16 * c + 4 * quad) = o; }
                  if (quad == 3) GL[c * 64 + n] = gl;
              }
#pragma unroll
              for (int i = 0; i < 4; ++i) { const float tot = red16(bsum[i]); if (r16 == 0) BONP[(16 * c + 4 * quad + i) * 2 + (wave & 1)] = tot; } }
            __syncthreads();
            { int lf_ = lane; asm volatile("" : "+v"(lf_)); const int r16 = lf_ & 15, quad = lf_ >> 4; const int c = wave & 3, odd = wave >> 2; const LAS bf16* Asrc = odd ? Rb : Ab;     const f32x4 z = {0.f, 0.f, 0.f, 0.f};
              const bf16x8 a0 = lds_frag(Asrc + (16 * c + r16) * RP + quad * 8), a1 = lds_frag(Asrc + (16 * c + r16) * RP + 32 + quad * 8);
              f32x4 g1 = MFMA16(a0, lds_frag(Bb + (16 * c + r16) * RP + quad * 8), z); g1 = MFMA16(a1, lds_frag(Bb + (16 * c + r16) * RP + 32 + quad * 8), g1);
              f32x4 g2 = MFMA16(a0, lds_frag(Kb + (16 * c + r16) * RP + quad * 8), z); g2 = MFMA16(a1, lds_frag(Kb + (16 * c + r16) * RP + 32 + quad * 8), g2);
              if (wave == 7) { const float bs = BONP[lf_ * 2] + BONP[lf_ * 2 + 1]; BON[((size_t)dir * R + row_of(b, tok(dir, j * 64 + lf_))) * RH + h] = bs; }
              float v2m[4];
#pragma unroll
              for (int i = 0; i < 4; ++i) { const int t = 4 * quad + i; const bool keep = odd ? (r16 <= t) : (r16 < t); const float v1 = keep ? g1[i] : 0.f; v2m[i] = keep ? g2[i] : 0.f;
                  if (odd) { HRB[c * 384 + t * 24 + r16] = f2b(v1); HRK[c * 384 + t * 24 + r16] = f2b(v2m[i]); } else { GAB[c * 256 + t * 16 + r16] = v1; GAK[c * 384 + t * 24 + r16] = f2b(v2m[i]); } }
              if (!odd) { { v2u o; o.x = cvt_pk_bf16(v2m[0], v2m[1]); o.y = cvt_pk_bf16(v2m[2], v2m[3]); *(v2u*)(GAKT + c * 384 + r16 * 24 + 4 * quad) = o; }
                  LDS_WAIT(); __builtin_amdgcn_wave_barrier();
                  float tj[16];
                  tj[0] = (r16 == 0) ? 1.0f : 0.f;
#pragma unroll
                  for (int i = 1; i < 16; ++i) { const LAS f32x4* gr = (const LAS f32x4*)(GAB + c * 256 + i * 16); float acc0 = (r16 == i) ? 1.0f : 0.f, acc1 = 0.f;
#pragma unroll
                      for (int q = 0; q < (i + 3) / 4; ++q) { const f32x4 g4 = gr[q];
#pragma unroll
                          for (int e = 0; e < 4; ++e) { const int jj = 4 * q + e; if (jj < i) { if (jj & 1) acc1 -= g4[e] * tj[jj]; else acc0 -= g4[e] * tj[jj]; } } }
                      tj[i] = acc0 + acc1; }
                  if (quad == 0) {
#pragma unroll
                      for (int i = 0; i < 16; ++i) TT[c * 384 + i * 24 + r16] = f2b(tj[i]); } } }
            __syncthreads();
            { int lg = lane; asm volatile("" : "+v"(lg)); const int r16 = lg & 15, quad = lg >> 4; const int c = wave & 3, half = wave >> 2; const f32x4 z = {0.f, 0.f, 0.f, 0.f};
              const bf16x8 ta = lds_frag_k16(TT + c * 384 + r16 * 24 + quad * 8, quad);
              f32x4 o0 = MFMA16(ta, lds_frag(AbT + (16 * (2 * half) + r16) * RP + 16 * c + (quad & 1) * 8), z), o1 = MFMA16(ta, lds_frag(AbT + (16 * (2 * half + 1) + r16) * RP + 16 * c + (quad & 1) * 8), z);
              f32x4 og = z; if (!half) og = MFMA16(ta, lds_frag(GAKT + c * 384 + r16 * 24 + (quad & 1) * 8), z);
#pragma unroll
              for (int i = 0; i < 4; ++i) { const int t = 4 * quad + i; Ab[(16 * c + t) * RP + 16 * (2 * half) + r16] = f2b(o0[i]); Ab[(16 * c + t) * RP + 16 * (2 * half + 1) + r16] = f2b(o1[i]); if (!half) GAK[c * 384 + t * 24 + r16] = f2b(og[i]); } }
            __syncthreads();
            if (wave < 4) {
                int lc = lane; asm volatile("" : "+v"(lc)); const int r16 = lc & 15, quad = lc >> 4, vnt = wave;
#pragma unroll 1
                for (int c = 0; c < 4; ++c) {
                    bf16x8 sb[2];
#pragma unroll
                    for (int ks = 0; ks < 2; ++ks) { v4u w; w.x = pk2(ST[2 * ks][0], ST[2 * ks][1]); w.y = pk2(ST[2 * ks][2], ST[2 * ks][3]); w.z = pk2(ST[2 * ks + 1][0], ST[2 * ks + 1][1]); w.w = pk2(ST[2 * ks + 1][2], ST[2 * ks + 1][3]); sb[ks] = __builtin_bit_cast(bf16x8, w); }
                    const v2u vmw = *(const LAS v2u*)(Vt + (16 * vnt + r16) * RP + 16 * c + 4 * quad); const v4u vm4 = {vmw.x, vmw.y, 0u, 0u}; const bf16x8 vmb = __builtin_bit_cast(bf16x8, vm4);
                    f32x4 sa = {0.f, 0.f, 0.f, 0.f}, yy = {0.f, 0.f, 0.f, 0.f};
#pragma unroll
                    for (int ks = 0; ks < 2; ++ks) { sa = MFMA16(lds_frag_perm(Ab + (16 * c + r16) * RP + 32 * ks + 4 * quad), sb[ks], sa); yy = MFMA16(lds_frag_perm(Rb + (16 * c + r16) * RP + 32 * ks + 4 * quad), sb[ks], yy); }
                    sa = MFMA16(lds_frag_lo4(GAK + c * 384 + r16 * 24 + 4 * quad), vmb, sa); yy = MFMA16(lds_frag_lo4(HRK + c * 384 + r16 * 24 + 4 * quad), vmb, yy);
                    const v4u sa4 = {pk2(sa[0], sa[1]), pk2(sa[2], sa[3]), 0u, 0u}; const bf16x8 sab = __builtin_bit_cast(bf16x8, sa4);
                    const f32x4 z = {0.f, 0.f, 0.f, 0.f};
                    const f32x4 dy = MFMA16(lds_frag_lo4(HRB + c * 384 + r16 * 24 + 4 * quad), sab, z);
#pragma unroll
                    for (int i = 0; i < 4; ++i) YO[(16 * c + 4 * quad + i) * 64 + 16 * vnt + r16] = yy[i] - dy[i];
#pragma unroll
                    for (int kt = 0; kt < 4; ++kt) { const f32x4 e_ = MFMA16(lds_frag_lo4(BhT + (16 * kt + r16) * RP + 16 * c + 4 * quad), sab, z), d_ = MFMA16(lds_frag_lo4(KhT + (16 * kt + r16) * RP + 16 * c + 4 * quad), vmb, z);
                        const f32x4 gl4 = *(const LAS f32x4*)&GL[c * 64 + 16 * kt + 4 * quad]; ST[kt] = ST[kt] * gl4 + d_ - e_; }
                }
            }
            __syncthreads();
            { int to = tid; asm volatile("" : "+v"(to)); const int s4 = to >> 3, q8 = (to & 7) * 8; const f32x4 y0 = *(const f32x4*)&YO[s4 * 64 + q8], y1 = *(const f32x4*)&YO[s4 * 64 + q8 + 4];
              v4u o; o.x = cvt_pk_bf16(y0.x, y0.y); o.y = cvt_pk_bf16(y0.z, y0.w); o.z = cvt_pk_bf16(y1.x, y1.y); o.w = cvt_pk_bf16(y1.z, y1.w);
              *(v4u*)(YS + ((size_t)dir * R + row_of(b, tok(dir, j * 64 + s4))) * RD + h * 64 + q8) = o; }
            __syncthreads();
        }
    }
}
template <int PART> __device__ __forceinline__ void finish_phase(Frame& F, int l, int nrows, int first, int stride) {
    const bf16* HF = (const bf16*)(F.ws + WS_HF); const bf16* O = (const bf16*)(F.ws + WS_O); bf16* HM = (bf16*)(F.ws + WS_HM);
    const bf16* YS = (const bf16*)(F.ws + WS_YS); const bf16* RKV = (const bf16*)(F.ws + WS_RKV); const bf16* Gb = (const bf16*)(F.ws + WS_H); const float* BON = (const float*)(F.ws + WS_BON); bf16* YR = (bf16*)(F.ws + WS_YR);
    const int lane = F.lane, c0 = lane * 16;
    float k1[16], k2[16], k3[16];
    { const float* p1 = PART == 0 ? INP(I_GMN) + l * 1024 + c0 : INP(I_LNW) + l * RD + c0; const float* p2 = INP(I_LNB) + l * RD + c0; const float* p3 = INP(I_MU) + l * RW + 2048 + c0;
#pragma unroll
      for (int q = 0; q < 4; ++q) { const f32x4 t1 = *(const f32x4*)(p1 + 4 * q); k1[4 * q] = t1.x; k1[4 * q + 1] = t1.y; k1[4 * q + 2] = t1.z; k1[4 * q + 3] = t1.w;
          if (PART == 1) { const f32x4 t2 = *(const f32x4*)(p2 + 4 * q), t3 = *(const f32x4*)(p3 + 4 * q); k2[4 * q] = t2.x; k2[4 * q + 1] = t2.y; k2[4 * q + 2] = t2.z; k2[4 * q + 3] = t2.w; k3[4 * q] = t3.x; k3[4 * q + 1] = t3.y; k3[4 * q + 2] = t3.z; k3[4 * q + 3] = t3.w; } } }
    const bf16* S0 = PART == 0 ? HF : YS;
    int g = first * NWAVES + F.wave; const int gstep = stride * NWAVES;
    v4u n0 = {0u, 0u, 0u, 0u}, n1 = n0, n2 = n0, n3 = n0;
    if (g < nrows) { n0 = *(const v4u*)(S0 + (size_t)g * 1024 + c0); n1 = *(const v4u*)(S0 + ((size_t)R + g) * 1024 + c0); n2 = *(const v4u*)(S0 + (size_t)g * 1024 + c0 + 8); n3 = *(const v4u*)(S0 + ((size_t)R + g) * 1024 + c0 + 8); }
    for (; g < nrows; g += gstep) {
        const v4u c_0 = n0, c_1 = n1, c_2 = n2, c_3 = n3;
        { const int gn = g + gstep; if (gn < nrows) { n0 = *(const v4u*)(S0 + (size_t)gn * 1024 + c0); n1 = *(const v4u*)(S0 + ((size_t)R + gn) * 1024 + c0); n2 = *(const v4u*)(S0 + (size_t)gn * 1024 + c0 + 8); n3 = *(const v4u*)(S0 + ((size_t)R + gn) * 1024 + c0 + 8); } }
        float y[16], a[8], bq[8];
        unpack8(c_0, a); unpack8(c_1, bq);
#pragma unroll
        for (int i = 0; i < 8; ++i) y[i] = a[i] + bq[i];
        unpack8(c_2, a); unpack8(c_3, bq);
#pragma unroll
        for (int i = 0; i < 8; ++i) y[8 + i] = a[i] + bq[i];
        if (PART == 0) {
            float ss = 0.f;
#pragma unroll
            for (int i = 0; i < 16; ++i) ss += y[i] * y[i];
            const float rs = 1.0f / sqrtf(red8(ss) * (1.0f / DV) + NORM_EPS);
            float og[16]; unpack8(*(const v4u*)(O + (size_t)g * 1024 + c0), a); unpack8(*(const v4u*)(O + (size_t)g * 1024 + c0 + 8), bq);
#pragma unroll
            for (int i = 0; i < 8; ++i) { og[i] = a[i]; og[8 + i] = bq[i]; }
            float o1[8], o2[8];
#pragma unroll
            for (int i = 0; i < 8; ++i) { o1[i] = y[i] * rs * k1[i] * sigmoidf_(og[i]); o2[i] = y[8 + i] * rs * k1[8 + i] * sigmoidf_(og[8 + i]); }
            *(v4u*)(HM + (size_t)g * 1024 + c0) = pack8(o1); *(v4u*)(HM + (size_t)g * 1024 + c0 + 8) = pack8(o2);
        }
        if (PART == 1) {
            float sm_ = 0.f;
#pragma unroll
            for (int i = 0; i < 16; ++i) sm_ += y[i];
            const float mean = red4(sm_) * (1.0f / RN); float vs = 0.f;
#pragma unroll
            for (int i = 0; i < 16; ++i) { const float dl = y[i] - mean; vs += dl * dl; }
            const float rs = 1.0f / sqrtf(red4(vs) * (1.0f / RN) + GN_EPS);
            const int hh = lane >> 2; const float bon = BON[(size_t)g * RH + hh] + BON[((size_t)R + g) * RH + hh];
            float vm[16], gg[16];
#pragma unroll
            for (int half = 0; half < 2; ++half) { const int rw = 2048 + c0 + 8 * half, nb = nbrow(g, rw); unpack8(*(const v4u*)(RKV + (size_t)g * 3072 + rw), a);
                if (nb >= 0) unpack8(*(const v4u*)(RKV + (size_t)nb * 3072 + rw), bq); else {
#pragma unroll
                    for (int i = 0; i < 8; ++i) bq[i] = 0.f; }
#pragma unroll
                for (int i = 0; i < 8; ++i) vm[8 * half + i] = a[i] + (bq[i] - a[i]) * k3[8 * half + i];
                unpack8(*(const v4u*)(Gb + (size_t)g * RD + c0 + 8 * half), a);
#pragma unroll
                for (int i = 0; i < 8; ++i) gg[8 * half + i] = a[i]; }
            float o1[8], o2[8];
#pragma unroll
            for (int i = 0; i < 8; ++i) { o1[i] = ((y[i] - mean) * rs * k1[i] + k2[i] + bon * vm[i]) * gg[i]; o2[i] = ((y[8 + i] - mean) * rs * k1[8 + i] + k2[8 + i] + bon * vm[8 + i]) * gg[8 + i]; }
            *(v4u*)(YR + (size_t)g * RD + c0) = pack8(o1); *(v4u*)(YR + (size_t)g * RD + c0 + 8) = pack8(o2);
        }
    }
}
struct MoeMeta { int off[NE + 1]; };
__device__ __forceinline__ MoeMeta moe_meta(Frame& F) {
    MoeMeta m; int o = 0;
#pragma unroll
    for (int e = 0; e < NE; ++e) { m.off[e] = o; const unsigned c = __hip_atomic_load((unsigned*)(F.ctl + CW_ECNT + 64 * e), RLX_AGENT); o += (int)((c + 255u) & ~255u); }
    m.off[NE] = o; return m;
}
__device__ __forceinline__ void gather_phase(Frame& F) {
    const MoeMeta m = moe_meta(F);
    if (F.bid == 0 && F.tid < MAXSLOT / 256) { int e = 0;
#pragma unroll
        for (int q = 1; q <= NE - 1; ++q) e += ((int)F.tid * 256 >= m.off[q]) ? 1 : 0;
        ((int*)(F.ws + WS_META + 768 * 1024))[F.tid] = e; }
    const bf16* H = (const bf16*)(F.ws + WS_H); unsigned char* HG = (unsigned char*)(F.ws + WS_HG);
    for (int w = F.bid * NWAVES + F.wave; w < RL * 2; w += F.G * NWAVES) { const int g = w >> 1, k = w & 1; int* tk = (int*)(F.ws + WS_META) + (size_t)g * 8; const int e = tk[k], pos = tk[2 + k];
        int base = 0;
#pragma unroll
        for (int q = 0; q < NE; ++q) base = (e == q) ? m.off[q] : base;
        const int slot = base + pos; if (F.lane == 0) tk[6 + k] = slot;
        const v4u* src = (const v4u*)(H + (size_t)g * D); float a[8], c8[8];
        unpack8(src[2 * F.lane], a); unpack8(src[2 * F.lane + 1], c8);
#pragma unroll
        for (int i = 0; i < 8; ++i) { a[i] = __builtin_amdgcn_fmed3f(a[i], -448.0f, 448.0f); c8[i] = __builtin_amdgcn_fmed3f(c8[i], -448.0f, 448.0f); }
        v4u o; o.x = pk4_fp8(a[0], a[1], a[2], a[3]); o.y = pk4_fp8(a[4], a[5], a[6], a[7]); o.z = pk4_fp8(c8[0], c8[1], c8[2], c8[3]); o.w = pk4_fp8(c8[4], c8[5], c8[6], c8[7]);
        *(v4u*)(HG + (size_t)slot * D + 16 * F.lane) = o; }
}
__device__ __forceinline__ void final_phase(Frame& F, const float* MODl) {
    const bf16* Y2 = (const bf16*)(F.ws + WS_Y2); const float* gfp = INP(I_GF);
    f32x4 gf[4];
#pragma unroll
    for (int j = 0; j < 4; ++j) gf[j] = *(const f32x4*)(gfp + 256 * j + 4 * F.lane);
    int g = F.bid * NWAVES + F.wave; const int gstep = F.G * NWAVES;
    int s0n = 0, s1n = 0; float p0n = 0.f, p1n = 0.f;
    if (g < RL) { const int* tk = (const int*)(F.ws + WS_META) + (size_t)g * 8; s0n = tk[6]; s1n = tk[7]; p0n = ((const float*)tk)[4]; p1n = ((const float*)tk)[5]; }
    for (; g < RL; g += gstep) {
        const int s0 = s0n, s1 = s1n; const float p0 = p0n, p1 = p1n;
        float* xr = (float*)F.out + (size_t)g * D; const float* gt = MODl + (g / T) * 6 * D + 5 * D; f32x4 x[4], gq[4]; v2u ya[4], yb[4];
#pragma unroll
        for (int j = 0; j < 4; ++j) { const int c = 256 * j + 4 * F.lane; x[j] = *(const f32x4*)(xr + c); gq[j] = *(const f32x4*)(gt + c); ya[j] = *(const v2u*)(Y2 + (size_t)s0 * D + c); yb[j] = *(const v2u*)(Y2 + (size_t)s1 * D + c); }
        { const int gn = g + gstep; if (gn < RL) { const int* tk = (const int*)(F.ws + WS_META) + (size_t)gn * 8; s0n = tk[6]; s1n = tk[7]; p0n = ((const float*)tk)[4]; p1n = ((const float*)tk)[5]; } }
        f32x4 v[4]; float ss = 0.f;
#pragma unroll
        for (int j = 0; j < 4; ++j) { const v2u a = ya[j], bq = yb[j];
            f32x4 y; y.x = p0 * bflo(a.x) + p1 * bflo(bq.x); y.y = p0 * bfhi(a.x) + p1 * bfhi(bq.x); y.z = p0 * bflo(a.y) + p1 * bflo(bq.y); y.w = p0 * bfhi(a.y) + p1 * bfhi(bq.y);
            v[j] = x[j] + gq[j] * y; ss += (v[j].x * v[j].x + v[j].y * v[j].y) + (v[j].z * v[j].z + v[j].w * v[j].w); }
        const float rstd = 1.0f / sqrtf(wave_sum(ss) * (1.0f / D) + NORM_EPS);
#pragma unroll
        for (int j = 0; j < 4; ++j) { const int c = 256 * j + 4 * F.lane; *(f32x4*)(xr + c) = v[j] * rstd * gf[j]; }
    }
}

#ifndef MK_SPLIT
#define MK_SPLIT 0
#endif
constexpr int PPL = 12, NPHASE = 1 + NL * PPL + 1;
__device__ __forceinline__ GAS unsigned char* launder_ws(GAS unsigned char* p) { asm volatile("" : "+s"(p)); return p; }
__device__ __forceinline__ const CAS Args* launder_args(const CAS Args* p) { asm volatile("" : "+s"(p)); return p; }
__device__ __forceinline__ void grid_barrier(unsigned* barw, unsigned x, volatile LAS unsigned* st) { XcdBarrier b; b.bar = barw; b.x = x; b.st = st; xcd_barrier(b); }
#define IN(k) (lo <= (k) && (k) < hi)
#define SEAM(k) do { if (IN(k) && IN((k) + 1)) grid_barrier(bar.bar, bar.x, bar.st); } while (0)
#define PH_BEGIN { int t_ = threadIdx.x; asm volatile("" : "+v"(t_)); F.tid = t_; F.lane = t_ & 63; F.wave = __builtin_amdgcn_readfirstlane(t_ >> 6); int b_ = blockIdx.x; asm volatile("" : "+s"(b_)); F.bid = b_; F.cb = b_; F.cg = F.G; } \
        GAS unsigned char* ws = launder_ws(args.ws); F.ws = ws; F.A = launder_args((const CAS Args*)__builtin_amdgcn_kernarg_segment_ptr()); float* MOD = (float*)(ws + WS_MOD); float* XC = (float*)(ws + WS_XC); bf16* Hb = (bf16*)(ws + WS_H); \
        const float* MODl = MOD + (size_t)l * 5 * 6 * D; const float* xl = l == 0 ? INP(I_X) : (const float*)F.out; const float* xc = l == 0 ? INP(I_CTX) : XC; (void)MODl; (void)xl; (void)xc; (void)Hb;
template <int l> __device__ __forceinline__ void layer_body(Frame& F, const Args& args, const int lo, const int hi, const XcdBarrier& bar) {
        const int p0 = 1 + l * PPL; const bool last = (l == NL - 1);
        const int Mrows = last ? RL : R;
        if (IN(p0 + 0)) { PH_BEGIN normmod_phase<false>(F, xl, xc, INP(I_GNM) + l * D, MODl, 0, D, R, nullptr); if (l > 0) conv_rest(F, l); }
        SEAM(p0 + 0);
        if (IN(p0 + 1)) { PH_BEGIN pg8::Gemm g{Hb, (const bf16*)(ws + WS_WIN), R, NPAD, D}; pg8::EpiInproj E{ws};
            if (!last) { pg8::StaticOrder S; S.init(R, NPAD, F.G, F.bid); pg8::gemm_phase<pg8::EpiInproj, pg8::StaticOrder, true, true>(F.lds, g, S, E); }
            else { pg8::InprojLastOrder S; S.G = F.G; S.c = F.bid; pg8::gemm_phase<pg8::EpiInproj, pg8::InprojLastOrder, true, true>(F.lds, g, S, E); } }
        if (IN(p0 + 1) && IN(p0 + 3)) grid_barrier(bar.bar, bar.x, bar.st);
        if (IN(p0 + 3)) { PH_BEGIN const int nR = F.G / 2;
            if (F.bid < nR) rwkv_phase(F, l, F.bid, nR);
            else { F.cb = F.bid - nR; F.cg = F.G - nR; gu32* sub = F.ctl + CW_SUB + 64 * l;
                   sg_phase(F, l); subgrid_arrive(F, sub);
                   mlstm_phase(F, l, F.cb, F.cg); __syncthreads();
                   if (!last) { conv_ffn0(F); conv_win(F, l + 1); }
                   subgrid_arrive(F, sub + 128);
                   subgrid_wait(F, sub, (unsigned)F.cg); subgrid_wait(F, sub + 128, (unsigned)F.cg);
                   finish_phase<0>(F, l, Mrows, F.cb, F.cg); } }
        if (IN(p0 + 3)) { PH_BEGIN const int nR = F.G / 2;
            if (F.bid >= nR) { int kg = 256; asm volatile("" : "+s"(kg));
                pg8::Gemm g{(const bf16*)(ws + WS_SG), (const bf16*)(ws + WS_WG2), R, RD, kg}; pg8::StaticOrder S; S.init(Mrows, RD, F.G - nR, F.bid - nR);
                pg8::EpiStore E{Hb, RD};
                pg8::gemm_phase<pg8::EpiStore, pg8::StaticOrder, true, true>(F.lds, g, S, E); } }
        SEAM(p0 + 3);
        if (IN(p0 + 4)) { PH_BEGIN finish_phase<1>(F, l, Mrows, F.bid, F.G); }
        SEAM(p0 + 4);
        if (IN(p0 + 5)) { PH_BEGIN pg8::Gemm g{(const bf16*)(ws + WS_HM), (const bf16*)(ws + WS_WPM), Mrows, D, D}; pg8::StaticOrder S; S.init(Mrows, D, F.G, F.bid);
            pg8::EpiMerge<0> E{(const bf16*)(ws + WS_MGT), (bf16*)(ws + WS_T1), nullptr};
            pg8::gemm_phase<pg8::EpiMerge<0>, pg8::StaticOrder, true, true>(F.lds, g, S, E); }
        SEAM(p0 + 5);
        if (IN(p0 + 6)) { PH_BEGIN pg8::Gemm g{(const bf16*)(ws + WS_YR), (const bf16*)(ws + WS_WPR), Mrows, D, D}; pg8::StaticOrder S; S.init(Mrows, D, F.G, F.bid);
            pg8::EpiMerge<1> E{(const bf16*)(ws + WS_MGT), (bf16*)(ws + WS_T1), Hb};
            pg8::gemm_phase<pg8::EpiMerge<1>, pg8::StaticOrder, true, true>(F.lds, g, S, E); }
        SEAM(p0 + 6);
        if (IN(p0 + 7)) { PH_BEGIN pg8::Gemm g{Hb, (const bf16*)(ws + WS_WOUT), Mrows, D, D}; pg8::StaticOrder S; S.init(Mrows, D, F.G, F.bid);
            pg8::EpiResid E{xl, xc, (float*)F.out, XC, MODl + 2 * D};
            pg8::gemm_phase<pg8::EpiResid, pg8::StaticOrder, true, true>(F.lds, g, S, E); }
        SEAM(p0 + 7);
        if (IN(p0 + 8)) { PH_BEGIN if (!last) normmod_phase<false>(F, (const float*)F.out, XC, INP(I_GNF) + l * D, MODl, 3 * D, 4 * D, Mrows, nullptr);
                          else normmod_phase<true>(F, (const float*)F.out, XC, INP(I_GNF) + l * D, MODl, 3 * D, 4 * D, Mrows, INP(I_WR)); }
        SEAM(p0 + 8);
        if (!last) {
            if (IN(p0 + 9)) { PH_BEGIN pg8::Gemm g{Hb, (const bf16*)(ws + WS_WGU), Mrows, 2 * FF, D}; pg8::StaticOrder S; S.init(Mrows, 2 * FF, F.G, F.bid);
                pg8::EpiSwiglu E{(bf16*)(ws + WS_HH0), FF};
                pg8::gemm_phase<pg8::EpiSwiglu, pg8::StaticOrder, true, true>(F.lds, g, S, E); }
            SEAM(p0 + 9);
            if (IN(p0 + 10)) { PH_BEGIN pg8::Gemm g{(const bf16*)(ws + WS_HH0), (const bf16*)(ws + WS_WDN), Mrows, D, FF}; pg8::StaticOrder S; S.init(Mrows, D, F.G, F.bid);
                pg8::EpiResid E{(const float*)F.out, XC, (float*)F.out, XC, MODl + 5 * D};
                pg8::gemm_phase<pg8::EpiResid, pg8::StaticOrder, true, true>(F.lds, g, S, E);
                const int nbusy = (Mrows / 256) * (D / 256) - F.G;
                if (nbusy > 0 && nbusy < F.G && F.bid >= nbusy) { __syncthreads(); F.cb = F.bid - nbusy; F.cg = F.G - nbusy; conv_experts(F, 0, 4); } }
            if (IN(p0 + 10) && IN(p0 + 12)) grid_barrier(bar.bar, bar.x, bar.st);
        } else {
            if (IN(p0 + 9)) { PH_BEGIN conv_experts(F, 4, NE); gather_phase(F); }
            SEAM(p0 + 9);
            if (IN(p0 + 10)) { PH_BEGIN const MoeMeta mm = moe_meta(F); pg8::MoeOrder S; S.ntiles = mm.off[NE] / 256; S.nN = 2 * FE / 256; S.nwg = S.ntiles * S.nN; S.G = F.G; S.c = F.bid; S.texp = (const int*)(ws + WS_META + 768 * 1024);
                S.lo0 = (int)((WS_WEA - WS_WEGU) / (256 * 1024)); S.lo1 = 28; S.hi1 = 28;
                int ke = D / 2; asm volatile("" : "+s"(ke));
                pg8::Gemm g{(const bf16*)(ws + WS_HG), (const bf16*)(ws + WS_WEGU), 0, 2 * FE, ke}; pg8::EpiSwiglu8 E{(unsigned char*)(ws + WS_HHE), FE};
                pg8::gemm_phase<pg8::EpiSwiglu8, pg8::MoeOrder, true, true, true>(F.lds, g, S, E); }
            SEAM(p0 + 10);
            if (IN(p0 + 11)) { PH_BEGIN const MoeMeta mm = moe_meta(F); pg8::MoeOrder S; S.ntiles = mm.off[NE] / 256; S.nN = D / 256; S.nwg = S.ntiles * S.nN; S.G = F.G; S.c = F.bid; S.texp = (const int*)(ws + WS_META + 768 * 1024);
                S.lo0 = (int)((WS_WEA + 28 * MiB - WS_WEDN) / (896 * 1024)); S.lo1 = 4; S.hi1 = 4;
                int ke = FE / 2; asm volatile("" : "+s"(ke));
                pg8::Gemm g{(const bf16*)(ws + WS_HHE), (const bf16*)(ws + WS_WEDN), 0, D, ke}; pg8::EpiStoreScaled E{(bf16*)(ws + WS_Y2), D, 1.0f / W8S};
                pg8::gemm_phase<pg8::EpiStoreScaled, pg8::MoeOrder, true, true, true>(F.lds, g, S, E); }
            SEAM(p0 + 11);
        }
    }
__global__ void __launch_bounds__(NTHREADS, 2) mk_fwd(Args args) {
    extern __shared__ __attribute__((aligned(16))) unsigned char lds[];
    Frame F;
    F.lds = (LAS unsigned char*)lds; F.MISC = (volatile LAS unsigned*)(F.lds + MISC_OFF);
    F.tid = threadIdx.x; F.lane = F.tid & 63; F.wave = __builtin_amdgcn_readfirstlane(F.tid >> 6); F.G = gridDim.x; F.bid = blockIdx.x;
    F.ws = args.ws; F.out = args.out; F.ctl = (gu32*)(args.ws + WS_CTL);
    F.A = (const CAS Args*)__builtin_amdgcn_kernarg_segment_ptr();
    if (F.tid < 64) F.MISC[F.tid] = 0u;
    __syncthreads();
    const int lo = args.ph_lo, hi = args.ph_hi;
    XcdBarrier bar; bar.bar = (unsigned*)(F.ctl + CW_BAR) + args.li * XCD_BAR_WORDS; bar.x = 0; bar.st = nullptr;
    if (hi - lo > 1) bar = xcd_barrier_post((unsigned*)(F.ctl + CW_BAR) + args.li * XCD_BAR_WORDS, F.MISC + 8);

    if (IN(0)) { const int l = 0; PH_BEGIN mod_phase(F); conv_win(F, 0); conv_rest(F, 0); }
    SEAM(0);

    layer_body<0>(F, args, lo, hi, bar);
    layer_body<1>(F, args, lo, hi, bar);
    if (IN(NPHASE - 1)) { const int l = NL - 1; PH_BEGIN final_phase(F, MODl); }
#undef IN
#undef SEAM
}

extern "C" void kernel_launch(void* const* d_in, const int* in_sizes, int n_in, void* d_out, int out_size, void* d_ws, size_t ws_size, hipStream_t stream) {
    static int grid = 0;
    if (grid == 0) {
        if (n_in != 33 || out_size != RL * D || ws_size < WS_NEED) { fprintf(stderr, "kernel_launch: unexpected problem (n_in %d, out %d, ws %zu < %zu)\n", n_in, out_size, ws_size, (size_t)WS_NEED); grid = -1; return; }
        int dev = 0, cus = 0, per_cu = 0;
        if (hipGetDevice(&dev) != hipSuccess || hipDeviceGetAttribute(&cus, hipDeviceAttributeMultiprocessorCount, dev) != hipSuccess) { grid = -1; return; }
        if (hipFuncSetAttribute((const void*)mk_fwd, hipFuncAttributeMaxDynamicSharedMemorySize, LDS_BYTES) != hipSuccess) { fprintf(stderr, "kernel_launch: hipFuncSetAttribute failed\n"); grid = -1; return; }
        if (hipOccupancyMaxActiveBlocksPerMultiprocessor(&per_cu, (const void*)mk_fwd, NTHREADS, LDS_BYTES) != hipSuccess || per_cu < 1) { fprintf(stderr, "kernel_launch: occupancy query says %d\n", per_cu); grid = -1; (void)hipGetLastError(); return; }
        grid = cus;
    }
    if (grid < 0) return;
    (void)hipMemsetAsync((char*)d_ws + WS_CTL, 0, CTL_ZERO_BYTES, stream);
    Args a{};
    for (int i = 0; i < 33; ++i) a.in[i] = (const GAS float*)d_in[i];
    a.out = (GAS float*)d_out; a.ws = (GAS unsigned char*)d_ws;
#if MK_SPLIT
    for (int p = 0; p < NPHASE; ++p) { a.ph_lo = p; a.ph_hi = p + 1; hipLaunchKernelGGL(mk_fwd, dim3(grid), dim3(NTHREADS), LDS_BYTES, stream, a); }
#elif defined(PROBE_PH)
    a.ph_lo = 0; a.ph_hi = PROBE_PH + 1; a.li = 0; hipLaunchKernelGGL(mk_fwd, dim3(grid), dim3(NTHREADS), LDS_BYTES, stream, a);
    for (int r = 0; r < PROBE_N; ++r) { a.ph_lo = PROBE_PH; a.ph_hi = PROBE_PH + 1; hipLaunchKernelGGL(mk_fwd, dim3(grid), dim3(NTHREADS), LDS_BYTES, stream, a); }
    a.ph_lo = PROBE_PH + 1; a.ph_hi = NPHASE; a.li = 1; hipLaunchKernelGGL(mk_fwd, dim3(grid), dim3(NTHREADS), LDS_BYTES, stream, a);
#else
    a.ph_lo = 0; a.ph_hi = NPHASE;
    hipLaunchKernelGGL(mk_fwd, dim3(grid), dim3(NTHREADS), LDS_BYTES, stream, a);
#endif
}
```

```cpp
#include <hip/hip_runtime.h>
#include <cstdio>
#include <cstdint>

#define GAS __attribute__((address_space(1)))
#define LAS __attribute__((address_space(3)))
typedef unsigned short bf16;
typedef unsigned v4u __attribute__((ext_vector_type(4)));
typedef unsigned v2u __attribute__((ext_vector_type(2)));
typedef float f32x4 __attribute__((ext_vector_type(4)));
typedef float f32x2 __attribute__((ext_vector_type(2)));
typedef short bf16x8 __attribute__((ext_vector_type(8)));
typedef GAS unsigned gu32;
#define RLX_AGENT __ATOMIC_RELAXED, __HIP_MEMORY_SCOPE_AGENT
#define LDS_WAIT() asm volatile("s_waitcnt lgkmcnt(0)" ::: "memory")
#define VM_WAIT() asm volatile("s_waitcnt vmcnt(0)" ::: "memory")

constexpr int D = 1024, NB = 4, T = 4096, GW = 64, TC = 256, NL = 2;
constexpr int RL = NB * T, RC = NB * TC, R = RL + RC;
constexpr int MH = 8, DQK = 64, DV = 128, LCH = 64;
constexpr int RH = 16, RN = 64, RD = 1024;
constexpr int RW = 3456, DIN = 8608, NPAD = 8704;
constexpr int FF = 2816, NE = 8, FE = 3584;
constexpr int TB = T + TC, NCH = TB / LCH;
constexpr int SMW = 512;
constexpr float NORM_EPS = 1e-6f, GN_EPS = 64e-5f, CAP = 15.0f;
constexpr int MAXSLOT = 2 * RL + NE * 256;

constexpr size_t MiB = 1u << 20;
constexpr size_t WS_CTL = 0, CTL_ZERO_BYTES = 1 * MiB;
constexpr size_t WS_MOD = 1 * MiB, WS_XC = 2 * MiB, WS_META = 6 * MiB, WS_BON = 7 * MiB, WS_SG = 10 * MiB;
constexpr size_t WS_WIN = 19 * MiB, WS_WPM = 36 * MiB, WS_WPR = 38 * MiB, WS_WOUT = 40 * MiB, WS_WG2 = 42 * MiB, WS_WLORA = 43 * MiB, WS_WGU = 44 * MiB, WS_WDN = 55 * MiB;
constexpr size_t WS_H = 61 * MiB;
constexpr size_t WS_Q = 95 * MiB, WS_K = 112 * MiB, WS_V = 129 * MiB, WS_O = 163 * MiB, WS_RKV = 197 * MiB, WS_MGT = 299 * MiB, WS_SM = 367 * MiB;
constexpr size_t WS_HF = 401 * MiB, WS_YS = 469 * MiB, WS_END = 537 * MiB;
constexpr size_t WS_HM = WS_Q, WS_YR = WS_V, WS_T1 = WS_SM;
constexpr size_t WS_HH0 = WS_Q;
constexpr size_t WS_WEGU = 95 * MiB, WS_WEDN = 151 * MiB, WS_HG = 179 * MiB, WS_Y2 = 213 * MiB, WS_HHE = 281 * MiB;
static_assert(WS_HHE + (size_t)MAXSLOT * FE <= 401 * MiB && WS_Y2 + (size_t)MAXSLOT * D * 2 <= WS_HHE && WS_HG + (size_t)MAXSLOT * D <= WS_Y2, "ws map");
constexpr float W8S = 64.0f;
constexpr size_t WS_WDNS = 538 * MiB, WS_S2 = 200 * MiB;
constexpr int NSL = FF / 256;
constexpr size_t WS_NEED = 545 * MiB;
constexpr int CW_BAR = 4096;
constexpr int CW_ECNT = 16384;
constexpr int CW_SUB = 20480;
constexpr int LDS_BYTES = 159744;
constexpr int MISC_OFF = LDS_BYTES - 256;

__device__ __forceinline__ unsigned cvt_pk_bf16(float lo, float hi) { unsigned r; asm volatile("v_cvt_pk_bf16_f32 %0, %1, %2" : "=v"(r) : "v"(lo), "v"(hi)); return r; }
__device__ __forceinline__ float bflo(unsigned w) { return __uint_as_float(w << 16); }
__device__ __forceinline__ float bfhi(unsigned w) { return __uint_as_float(w & 0xffff0000u); }
__device__ __forceinline__ void unpack8(const v4u w, float (&f)[8]) { f[0] = bflo(w.x); f[1] = bfhi(w.x); f[2] = bflo(w.y); f[3] = bfhi(w.y); f[4] = bflo(w.z); f[5] = bfhi(w.z); f[6] = bflo(w.w); f[7] = bfhi(w.w); }
__device__ __forceinline__ v4u pack8(const float (&f)[8]) { v4u w; w.x = cvt_pk_bf16(f[0], f[1]); w.y = cvt_pk_bf16(f[2], f[3]); w.z = cvt_pk_bf16(f[4], f[5]); w.w = cvt_pk_bf16(f[6], f[7]); return w; }
__device__ __forceinline__ float sigmoidf_(float x) { return __builtin_amdgcn_rcpf(1.0f + __expf(-x)); }
__device__ __forceinline__ float siluf_(float x) { return x * sigmoidf_(x); }
__device__ __forceinline__ float softplusf_(float x) { return fmaxf(x, 0.f) + log1pf(expf(-fabsf(x))); }
__device__ __forceinline__ float fast_tanh(float x) { const float e = __expf(2.0f * x); return 1.0f - 2.0f * __builtin_amdgcn_rcpf(1.0f + e); }
__device__ __forceinline__ float fast_softplus(float x) { return fmaxf(x, 0.f) + __logf(1.0f + __expf(-fabsf(x))); }
template <int CTRL> __device__ __forceinline__ float dpp_add(float v) { const int t = __builtin_amdgcn_update_dpp(0, __float_as_int(v), CTRL, 0xf, 0xf, false); return v + __int_as_float(t); }
__device__ __forceinline__ float red4(float v) { v = dpp_add<0xB1>(v); return dpp_add<0x4E>(v); }
__device__ __forceinline__ float red8(float v) { return dpp_add<0x141>(red4(v)); }
__device__ __forceinline__ float red16(float v) { return dpp_add<0x140>(red8(v)); }
__device__ __forceinline__ float wave_sum(float v) { v = red16(v); v += __shfl_xor(v, 16); return v + __shfl_xor(v, 32); }
__device__ __forceinline__ int row_of(int b, int lr) { return lr < T ? b * T + lr : RL + b * TC + (lr - T); }
__device__ __forceinline__ int tok(int dir, int u) { if (u < TC) return T + (dir ? TC - 1 - u : u); const int tt = u - TC; return dir ? T - 1 - tt : tt; }
__device__ __forceinline__ int nbrow(int g, int rwidx) {
    if (g < RL) { const int t = g & (T - 1), row = t >> 6, col = t & 63, q = rwidx / (RW / 4);
        if (q == 0) return col > 0 ? g - 1 : -1; if (q == 1) return col < GW - 1 ? g + 1 : -1; if (q == 2) return row > 0 ? g - GW : -1; return row < T / GW - 1 ? g + GW : -1; }
    const int t = (g - RL) & (TC - 1); if (rwidx < RW / 2) return t > 0 ? g - 1 : -1; return t < TC - 1 ? g + 1 : -1;
}

#define XB_TMO      128
#define XB_XCNT(j)  (256  + 64 * (j))
#define XB_XSUB(j)  (1280 + 64 * (j))
#define XB_XGEN(j)  (2304 + 64 * (j))
#define XB_TOP      3328
#define XB_TOPGEN   3392
#define XCD_BAR_WORDS 3456
#define XB_SPIN_CAP (1u << 18)
__device__ __forceinline__ unsigned xb_ld(unsigned* p)              { return __hip_atomic_load(p, __ATOMIC_RELAXED, __HIP_MEMORY_SCOPE_AGENT); }
__device__ __forceinline__ unsigned xb_add(unsigned* p, unsigned v) { return __hip_atomic_fetch_add(p, v, __ATOMIC_RELAXED, __HIP_MEMORY_SCOPE_AGENT); }
__device__ __forceinline__ unsigned xb_xcc_id() { return (unsigned)__builtin_amdgcn_s_getreg((3 << 11) | 20) & 0xFu; }
#define XB_SPIN(cond, bar) do { unsigned _sp = 0; while (cond) { __builtin_amdgcn_s_sleep(1); \
    if ((++_sp & 255u) == 0u) { if (xb_ld(&(bar)[XB_TMO])) break; if (_sp > XB_SPIN_CAP) { atomicAdd(&(bar)[XB_TMO], 1u); break; } } } } while (0)
struct XcdBarrier { unsigned* bar; unsigned x; volatile LAS unsigned* st; };
__device__ __forceinline__ XcdBarrier xcd_barrier_post(unsigned* bar, volatile LAS unsigned* st) {
    XcdBarrier b; b.bar = bar; b.x = xb_xcc_id(); b.st = st;
    if (threadIdx.x == 0) (void)xb_add(&bar[XB_XCNT(b.x)], 1u);
    return b;
}
__device__ __forceinline__ void xcd_barrier_complete(unsigned* bar, unsigned x, unsigned& nloc, unsigned& nx) {
    const unsigned G = gridDim.x * gridDim.y * gridDim.z;
    unsigned sum, cnt, mine, sp = 0u;
    for (;;) {
        sum = 0u; cnt = 0u; mine = 0u;
#pragma unroll
        for (unsigned j = 0; j < 16; ++j) { const unsigned c = xb_ld(&bar[XB_XCNT(j)]); sum += c; cnt += (c > 0u) ? 1u : 0u; mine = (j == x) ? c : mine; }
        if (sum == G) break;
        __builtin_amdgcn_s_sleep(1);
        if ((++sp & 255u) == 0u) { if (xb_ld(&bar[XB_TMO])) break; if (sp > XB_SPIN_CAP) { atomicAdd(&bar[XB_TMO], 1u); break; } }
    }
    nloc = mine > 0u ? mine : 1u; nx = cnt > 0u ? cnt : 1u;
}
__device__ __forceinline__ void xcd_barrier(const XcdBarrier& b) {
    asm volatile("s_waitcnt vmcnt(0)" ::: "memory");
    __syncthreads();
    if (threadIdx.x == 0) {
        unsigned* bar = b.bar;
        __builtin_amdgcn_s_waitcnt(0);
        unsigned nloc = b.st[0], nx = b.st[1];
        if (nloc == 0u) { xcd_barrier_complete(bar, b.x, nloc, nx); b.st[0] = nloc; b.st[1] = nx; }
        const unsigned old = xb_add(&bar[XB_XSUB(b.x)], 1u);
        const unsigned gen = old / nloc;
        if (old + 1u == (gen + 1u) * nloc) {
            __builtin_amdgcn_fence(__ATOMIC_RELEASE, "agent");
            asm volatile("s_waitcnt vmcnt(0)" ::: "memory");
            const unsigned og = xb_add(&bar[XB_TOP], 1u);
            const unsigned tg = og / nx;
            if (og + 1u == (tg + 1u) * nx) xb_add(&bar[XB_TOPGEN], 1u);
            else XB_SPIN(xb_ld(&bar[XB_TOPGEN]) == tg, bar);
            __builtin_amdgcn_fence(__ATOMIC_ACQUIRE, "agent");
            xb_add(&bar[XB_XGEN(b.x)], 1u);
            asm volatile("s_waitcnt vmcnt(0)" ::: "memory");
        } else {
            XB_SPIN(xb_ld(&bar[XB_XGEN(b.x)]) == gen, bar);
            __builtin_amdgcn_fence(__ATOMIC_ACQUIRE, "agent");
            asm volatile("s_waitcnt vmcnt(0)" ::: "memory");
        }
    }
    __syncthreads();
}

namespace pg8 {
#define PG8_LAS __attribute__((address_space(3)))
typedef unsigned short bf16_t;
typedef unsigned u32x4 __attribute__((ext_vector_type(4)));
constexpr int BM = 256, BK = 64, HALF = 128, HTB = HALF * BK * 2, STAGE_BYTES = 8 * HTB, NXCD = 8, WGM = 8;
__host__ __device__ __forceinline__ int lds_byte(int r, int c) { const int st = (r >> 4) * 2 + (c >> 5), rr = r & 15, cc = c & 31, ob = rr * 64 + cc * 2; return st * 1024 + (ob ^ (((ob >> 9) & 1) << 5)); }
__host__ __device__ __forceinline__ void stage_rc(int b, int& R_, int& C) { const int st = b / 1024, sb = b % 1024, swz = sb ^ (((sb >> 9) & 1) << 5); R_ = (st >> 1) * 16 + swz / 64; C = (st & 1) * 32 + (swz % 64) / 2; }
__host__ __device__ __forceinline__ int perm32(int rho) { const int n = rho >> 4, i = rho & 15; return 8 * (i >> 2) + 4 * n + (i & 3); }
typedef int i32x8 __attribute__((ext_vector_type(8))); typedef int i32x4 __attribute__((ext_vector_type(4)));
__device__ __forceinline__ i32x8 cat8(bf16x8 lo, bf16x8 hi) { return __builtin_shufflevector(__builtin_bit_cast(i32x4, lo), __builtin_bit_cast(i32x4, hi), 0, 1, 2, 3, 4, 5, 6, 7); }
__device__ __forceinline__ void mfma8_acc(f32x4& acc, const i32x8 a, const i32x8 b) {
#if defined(__HIP_DEVICE_COMPILE__)
    const int one = 0x7F7F7F7F;
    asm volatile("v_mfma_scale_f32_16x16x128_f8f6f4 %0, %1, %2, %0, %3, %3 op_sel_hi:[0,0,0]" : "+v"(acc) : "v"(a), "v"(b), "v"(one));
#endif
}
struct Unit { int pm, pn, pb; };
struct Gemm { const bf16_t* A; const bf16_t* Bt; int M, N, K; };
struct StaticOrder {
    int nM, nN, nwg, G, c;
    __device__ void init(int M, int N, int G_, int c_) { nM = M / BM; nN = N / BM; nwg = nM * nN; G = G_; c = c_; }
    __device__ bool next(int i, Unit& u) const {
        const long L = (long)i * G + c; if (L >= nwg) return false;
        int wgid = (int)L; { const int q = nwg / NXCD, r = nwg % NXCD, xcd = wgid % NXCD, off = wgid / NXCD; wgid = (xcd < r ? xcd * (q + 1) : r * (q + 1) + (xcd - r) * q) + off; }
        const int nig = WGM * nN, gid = wgid / nig, fm = gid * WGM, gsz = (nM - fm) < WGM ? (nM - fm) : WGM;
        u.pm = fm + ((wgid % nig) % gsz); u.pn = (wgid % nig) / gsz; u.pb = u.pn; return true;
    }
    __device__ __forceinline__ void a_ready(const Unit&) const {}
    __device__ __forceinline__ void done(const Unit&) const {}
};
struct InprojLastOrder {
    int G, c;
    __device__ bool next(int i, Unit& u) const {
        const int L = i * G + c; if (L >= 64 * 34 + 4 * 22) return false;
        if (L < 64 * 34) { const int g8 = L / (8 * 34), r = L % (8 * 34); u.pm = g8 * 8 + (r % 8); u.pn = r / 8; }
        else { const int r = L - 64 * 34; u.pm = 64 + (r & 3); int q = r >> 2; q += (q >= 8) ? 4 : 0; q += (q >= 24) ? 8 : 0; u.pn = q; }
        u.pb = u.pn; return true;
    }
    __device__ __forceinline__ void a_ready(const Unit&) const {}
    __device__ __forceinline__ void done(const Unit&) const {}
};
struct CtxSliceOrder {
    int nS, G, c;
    __device__ bool next(int i, Unit& u) const { const int L = i * G + c; if (L >= 16 * nS) return false; const int s = L >> 4, r = L & 15; u.pm = 4 * s + (r >> 2); u.pn = r & 3; u.pb = 4 * s + (r & 3); return true; }
    __device__ __forceinline__ void a_ready(const Unit&) const {}
    __device__ __forceinline__ void done(const Unit&) const {}
};
struct MoeOrder {
    int ntiles, nN, nwg, G, c; const int* texp;
    __device__ bool next(int i, Unit& u) const {
        const long L = (long)i * G + c; if (L >= nwg) return false;
        u.pm = (int)(L / nN); u.pn = (int)(L % nN); u.pb = __builtin_amdgcn_readfirstlane(texp[u.pm]) * nN + u.pn; return true;
    }
    __device__ __forceinline__ void a_ready(const Unit&) const {}
    __device__ __forceinline__ void done(const Unit&) const {}
};
template <class Epi, class Sched, bool ALIGN_EPI = false, bool SP2 = false, bool FP8 = false>
__device__ __forceinline__ void gemm_phase(PG8_LAS unsigned char* lds, const Gemm g, const Sched& S, const Epi& E) {
    int tid_ = threadIdx.x; asm volatile("" : "+v"(tid_));
    const int tid = tid_, wid = __builtin_amdgcn_readfirstlane(tid >> 6), lane = tid & 63, wr = wid >> 2, wc = wid & 3, fr = lane & 15, fq = lane >> 4;
    const int K = g.K, nt = K / BK;
    unsigned voffA[2], voffB[2];
#pragma unroll
    for (int i = 0; i < 2; ++i) { int R, C; stage_rc(tid * 16 + i * 8192, R, C); const int Rb = Epi::PERM ? ((R & ~31) + perm32(R & 31)) : R;
        voffA[i] = (unsigned)(R * K + C) * 2u; voffB[i] = (unsigned)(Rb * K + C) * 2u; }
    const size_t kstep = (size_t)(BK * 2);
    const size_t hstep = (size_t)HALF * K * 2;
    const size_t tstep = 2 * hstep;
    const unsigned ldsw = (unsigned)wid * 1024u;
    const int aoff = lds_byte(wr * 64 + fr, fq * 8), boff = lds_byte(wc * 32 + fr, fq * 8);
#define PG8_SA(b, h) (((b) * 2 + (h)) * HTB)
#define PG8_SB(b, h) ((4 + (b) * 2 + (h)) * HTB)
#define PG8_STAGE(bufoff, gbase, voff) do { _Pragma("unroll") for (int _i = 0; _i < 2; ++_i) \
        __builtin_amdgcn_global_load_lds((const unsigned*)((const char*)(gbase) + (voff)[_i]), (PG8_LAS unsigned*)(lds + (bufoff) + ldsw + _i * 8192), 16, 0, 0); } while (0)
#define PG8_LDA(dst, b, h) do { _Pragma("unroll") for (int m = 0; m < 4; ++m) { if constexpr (FP8) dst##8[m] = cat8(*(const PG8_LAS bf16x8*)(lds + PG8_SA(b, h) + aoff + m * 2048), *(const PG8_LAS bf16x8*)(lds + PG8_SA(b, h) + aoff + m * 2048 + 1024)); \
        else { _Pragma("unroll") for (int k = 0; k < 2; ++k) dst[m][k] = *(const PG8_LAS bf16x8*)(lds + PG8_SA(b, h) + aoff + m * 2048 + k * 1024); } } } while (0)
#define PG8_LDB(dst, b, h) do { _Pragma("unroll") for (int n = 0; n < 2; ++n) { if constexpr (FP8) dst##8[n] = cat8(*(const PG8_LAS bf16x8*)(lds + PG8_SB(b, h) + boff + n * 2048), *(const PG8_LAS bf16x8*)(lds + PG8_SB(b, h) + boff + n * 2048 + 1024)); \
        else { _Pragma("unroll") for (int k = 0; k < 2; ++k) dst[n][k] = *(const PG8_LAS bf16x8*)(lds + PG8_SB(b, h) + boff + n * 2048 + k * 1024); } } } while (0)
#define PG8_MMA(ai, bj, At, Bt) do { __builtin_amdgcn_s_setprio(1); if constexpr (FP8) { _Pragma("unroll") for (int m = 0; m < 4; ++m) _Pragma("unroll") for (int n = 0; n < 2; ++n) \
        mfma8_acc(acc[ai][bj][m][n], Bt##8[n], At##8[m]); } else { \
        _Pragma("unroll") for (int m = 0; m < 4; ++m) _Pragma("unroll") for (int n = 0; n < 2; ++n) _Pragma("unroll") for (int k = 0; k < 2; ++k) \
        acc[ai][bj][m][n] = __builtin_amdgcn_mfma_f32_16x16x32_bf16(Bt[n][k], At[m][k], acc[ai][bj][m][n], 0, 0, 0); } __builtin_amdgcn_s_setprio(0); } while (0)
#define PG8_WAIT_V(n) asm volatile("s_waitcnt vmcnt(" #n ")" ::: "memory")
#define PG8_WAIT_L(n) asm volatile("s_waitcnt lgkmcnt(" #n ")" ::: "memory")
#define PG8_BAR __builtin_amdgcn_s_barrier()
#define PG8_SCHED __builtin_amdgcn_sched_barrier(0)
    Unit cur, nxt; int ui = 0;
    if (!S.next(0, cur)) return;
    f32x4 acc[2][2][4][2];
#pragma unroll
    for (int a = 0; a < 2; ++a)
#pragma unroll
        for (int b = 0; b < 2; ++b)
#pragma unroll
            for (int m = 0; m < 4; ++m)
#pragma unroll
                for (int n = 0; n < 2; ++n) acc[a][b][m][n] = (f32x4){0.f, 0.f, 0.f, 0.f};
    bf16x8 At[4][2], B0[2][2], B1[2][2]; i32x8 At8[4], B08[2], B18[2];
    const char* cA = (const char*)g.A + (size_t)cur.pm * tstep; const char* cB = (const char*)g.Bt + (size_t)cur.pb * tstep;
    S.a_ready(cur);
    if constexpr (SP2) {
        PG8_STAGE(PG8_SB(0, 0), cB, voffB); PG8_STAGE(PG8_SB(0, 1), cB + hstep, voffB); PG8_STAGE(PG8_SA(0, 0), cA, voffA); PG8_STAGE(PG8_SA(0, 1), cA + hstep, voffA);
        if (wr == 1) PG8_BAR;
        PG8_WAIT_V(2); PG8_BAR;
        PG8_STAGE(PG8_SB(1, 0), cB + kstep, voffB); PG8_STAGE(PG8_SA(1, 0), cA + kstep, voffA); PG8_STAGE(PG8_SB(1, 1), cB + hstep + kstep, voffB);
        PG8_WAIT_V(6); PG8_BAR;
    } else {
        PG8_STAGE(PG8_SB(0, 0), cB, voffB); PG8_STAGE(PG8_SA(0, 0), cA, voffA); PG8_STAGE(PG8_SB(0, 1), cB + hstep, voffB); PG8_STAGE(PG8_SA(0, 1), cA + hstep, voffA);
        if (wr == 1) PG8_BAR;
        PG8_WAIT_V(4); PG8_BAR;
        PG8_STAGE(PG8_SB(1, 0), cB + kstep, voffB); PG8_STAGE(PG8_SA(1, 0), cA + kstep, voffA); PG8_STAGE(PG8_SB(1, 1), cB + hstep + kstep, voffB);
        PG8_WAIT_V(6); PG8_BAR;
    }
    for (;;) {
        const bool has_next = S.next(ui + 1, nxt);
        const char* nA = has_next ? (const char*)g.A + (size_t)nxt.pm * tstep : cA; const char* nB = has_next ? (const char*)g.Bt + (size_t)nxt.pb * tstep : cB;
        for (int t = 0; t < nt; t += 2) {
            const bool last = (t == nt - 2);
            const char* a1 = cA + (size_t)(t + 1) * kstep;
            const char* a2 = last ? nA : cA + (size_t)(t + 2) * kstep; const char* b2 = last ? nB : cB + (size_t)(t + 2) * kstep;
            const char* a3 = a2 + kstep; const char* b3 = b2 + kstep;
            if (last && has_next) S.a_ready(nxt);
            if constexpr (SP2) {
            PG8_LDB(B0, 0, 0); PG8_LDB(B1, 0, 1); PG8_SCHED; PG8_LDA(At, 0, 0); PG8_STAGE(PG8_SA(1, 1), a1 + hstep, voffA);
            PG8_WAIT_V(8); PG8_WAIT_L(0); PG8_BAR; PG8_MMA(0, 0, At, B0); PG8_MMA(0, 1, At, B1); PG8_BAR; PG8_SCHED;
            PG8_LDA(At, 0, 1); PG8_STAGE(PG8_SB(0, 0), b2, voffB); PG8_STAGE(PG8_SB(0, 1), b2 + hstep, voffB); PG8_STAGE(PG8_SA(0, 0), a2, voffA);
            PG8_WAIT_V(8); PG8_WAIT_L(0); PG8_BAR; PG8_MMA(1, 0, At, B0); PG8_MMA(1, 1, At, B1); PG8_BAR; PG8_SCHED;
            PG8_LDB(B0, 1, 0); PG8_LDB(B1, 1, 1); PG8_SCHED; PG8_LDA(At, 1, 0); PG8_STAGE(PG8_SA(0, 1), a2 + hstep, voffA);
            PG8_WAIT_V(8); PG8_WAIT_L(0); PG8_BAR; PG8_MMA(0, 0, At, B0); PG8_MMA(0, 1, At, B1); PG8_BAR; PG8_SCHED;
            PG8_LDA(At, 1, 1); PG8_STAGE(PG8_SB(1, 0), b3, voffB); PG8_STAGE(PG8_SB(1, 1), b3 + hstep, voffB); PG8_STAGE(PG8_SA(1, 0), a3, voffA);
            PG8_WAIT_V(8); PG8_WAIT_L(0); PG8_BAR; PG8_MMA(1, 0, At, B0); PG8_MMA(1, 1, At, B1); PG8_BAR; PG8_SCHED;
            } else {
            PG8_LDB(B0, 0, 0); PG8_SCHED; PG8_LDA(At, 0, 0); PG8_STAGE(PG8_SA(1, 1), a1 + hstep, voffA);
            PG8_WAIT_L(8); PG8_BAR; PG8_WAIT_L(0); PG8_MMA(0, 0, At, B0); PG8_BAR; PG8_SCHED;
            PG8_LDB(B1, 0, 1); PG8_STAGE(PG8_SB(0, 0), b2, voffB);
            PG8_BAR; PG8_WAIT_L(0); PG8_MMA(0, 1, At, B1); PG8_BAR;
            PG8_LDA(At, 0, 1); PG8_STAGE(PG8_SA(0, 0), a2, voffA);
            PG8_BAR; PG8_WAIT_L(0); PG8_MMA(1, 0, At, B0); PG8_BAR; PG8_SCHED;
            PG8_STAGE(PG8_SB(0, 1), b2 + hstep, voffB);
            PG8_WAIT_V(6); PG8_BAR; PG8_MMA(1, 1, At, B1); PG8_BAR;
            PG8_LDB(B0, 1, 0); PG8_SCHED; PG8_LDA(At, 1, 0); PG8_STAGE(PG8_SA(0, 1), a2 + hstep, voffA);
            PG8_WAIT_L(8); PG8_BAR; PG8_WAIT_L(0); PG8_MMA(0, 0, At, B0); PG8_BAR; PG8_SCHED;
            PG8_LDB(B1, 1, 1); PG8_STAGE(PG8_SB(1, 0), b3, voffB);
            PG8_BAR; PG8_WAIT_L(0); PG8_MMA(0, 1, At, B1); PG8_BAR;
            PG8_LDA(At, 1, 1); PG8_STAGE(PG8_SA(1, 0), a3, voffA);
            PG8_BAR; PG8_WAIT_L(0); PG8_MMA(1, 0, At, B0); PG8_BAR; PG8_SCHED;
            PG8_STAGE(PG8_SB(1, 1), b3 + hstep, voffB);
            PG8_WAIT_V(6); PG8_BAR; PG8_MMA(1, 1, At, B1); PG8_BAR;
            }
        }
        if constexpr (ALIGN_EPI) { if (wr == 0) PG8_BAR; }
        if constexpr (FP8) asm volatile("s_nop 15\n\ts_nop 15\n\ts_nop 15\n\ts_nop 15" ::: "memory");
        if constexpr (!Epi::AFTER_DRAIN) { E(acc, cur, wr, wc, fr, fq); S.done(cur); }
        if (!has_next) break;
#pragma unroll
        for (int a = 0; a < 2; ++a)
#pragma unroll
            for (int b = 0; b < 2; ++b)
#pragma unroll
                for (int m = 0; m < 4; ++m)
#pragma unroll
                    for (int n = 0; n < 2; ++n) acc[a][b][m][n] = (f32x4){0.f, 0.f, 0.f, 0.f};
        cur = nxt; cA = nA; cB = nB; ++ui;
        if constexpr (ALIGN_EPI) { if (wr == 1) PG8_BAR; }
    }
    PG8_WAIT_V(0);
    if constexpr (!ALIGN_EPI) { if (wr == 0) PG8_BAR; }
    PG8_BAR;
    if constexpr (Epi::AFTER_DRAIN) { E.fused(acc, cur, wr, wc, fr, fq, lds, wid, lane); S.done(cur); }
#undef PG8_SA
#undef PG8_SB
#undef PG8_STAGE
#undef PG8_LDA
#undef PG8_LDB
#undef PG8_MMA
#undef PG8_WAIT_V
#undef PG8_WAIT_L
#undef PG8_BAR
#undef PG8_SCHED
}

__device__ __forceinline__ u32x4 pack_acc8(const f32x4 v0, const f32x4 v1) { u32x4 w; w.x = cvt_pk_bf16(v0[0], v0[1]); w.y = cvt_pk_bf16(v0[2], v0[3]); w.z = cvt_pk_bf16(v1[0], v1[1]); w.w = cvt_pk_bf16(v1[2], v1[3]); return w; }
#define EPI_LOOP_BEGIN  _Pragma("unroll") for (int ai = 0; ai < 2; ++ai) _Pragma("unroll") for (int m = 0; m < 4; ++m) { const int rloc = ai * HALF + wr * 64 + m * 16 + fr; \
                        _Pragma("unroll") for (int bj = 0; bj < 2; ++bj) { const int cloc = bj * HALF + wc * 32 + 8 * fq; const f32x4 v0 = acc[ai][bj][m][0], v1 = acc[ai][bj][m][1];
#define EPI_LOOP_END    } asm volatile("" ::: "memory"); }

struct EpiInproj {
    static constexpr bool PERM = true, AFTER_DRAIN = false;
    GAS unsigned char* ws;
    __device__ __forceinline__ void operator()(const f32x4 (&acc)[2][2][4][2], const Unit& u, int wr, int wc, int fr, int fq) const {
        const int pn = u.pn; size_t off; int ld, ct;
        if (pn < 2) { off = WS_Q; ld = 512; ct = pn; } else if (pn < 4) { off = WS_K; ld = 512; ct = pn - 2; } else if (pn < 8) { off = WS_V; ld = 1024; ct = pn - 4; }
        else if (pn < 12) { off = WS_O; ld = 1024; ct = pn - 8; } else if (pn < 24) { off = WS_RKV; ld = 3072; ct = pn - 12; } else if (pn < 32) { off = WS_MGT; ld = 2048; ct = pn - 24; } else { off = WS_SM; ld = SMW * 2; ct = pn - 32; }
        const size_t row0 = (size_t)u.pm * BM;
        if (pn < 32) {
            bf16_t* base = (bf16_t*)(ws + off) + row0 * ld + ct * BM;
            EPI_LOOP_BEGIN
                *(u32x4*)(base + (size_t)rloc * ld + cloc) = pack_acc8(v0, v1);
            EPI_LOOP_END
        } else {
            float* sb = (float*)(ws + off) + row0 * SMW + ct * BM;
            EPI_LOOP_BEGIN
                float* p = sb + (size_t)rloc * SMW + cloc; *(f32x4*)p = v0; *(f32x4*)(p + 4) = v1;
            EPI_LOOP_END
        }
    }
};
struct EpiStore {
    static constexpr bool PERM = true, AFTER_DRAIN = false;
    bf16_t* C; int ldc;
    __device__ __forceinline__ void operator()(const f32x4 (&acc)[2][2][4][2], const Unit& u, int wr, int wc, int fr, int fq) const {
        const size_t row0 = (size_t)u.pm * BM; const int col0 = u.pn * BM;
        EPI_LOOP_BEGIN
            *(u32x4*)(C + (row0 + rloc) * ldc + col0 + cloc) = pack_acc8(v0, v1);
        EPI_LOOP_END
    }
};
template <int STEP> struct EpiMerge {
    static constexpr bool PERM = true, AFTER_DRAIN = false;
    const bf16_t* MGT; bf16_t* T1; bf16_t* OUT;
    __device__ __forceinline__ void operator()(const f32x4 (&acc)[2][2][4][2], const Unit& u, int wr, int wc, int fr, int fq) const {
        const size_t row0 = (size_t)u.pm * BM; const int col0 = u.pn * BM;
        EPI_LOOP_BEGIN
            const size_t row = row0 + rloc; const int col = col0 + cloc;
            const u32x4 gw = *(const u32x4*)(MGT + row * 2048 + (STEP ? 1024 : 0) + col); float g[8]; unpack8(gw, g);
            float o[8] = {v0[0], v0[1], v0[2], v0[3], v1[0], v1[1], v1[2], v1[3]};
#pragma unroll
            for (int j = 0; j < 8; ++j) o[j] *= sigmoidf_(g[j]);
            if (STEP) { const u32x4 tw = *(const u32x4*)(T1 + row * 1024 + col); float tt[8]; unpack8(tw, tt);
#pragma unroll
                for (int j = 0; j < 8; ++j) o[j] += tt[j]; }
            *(u32x4*)((STEP ? OUT : T1) + row * 1024 + col) = pack8(o);
        EPI_LOOP_END
    }
};
struct EpiResid {
    static constexpr bool PERM = true, AFTER_DRAIN = false;
    const float* src_lat; const float* src_ctx; float* dst_lat; float* dst_ctx; const float* gate;
    __device__ __forceinline__ void operator()(const f32x4 (&acc)[2][2][4][2], const Unit& u, int wr, int wc, int fr, int fq) const {
        const int row0 = u.pm * BM, col0 = u.pn * BM; const bool lat = row0 < RL;
        const float* sb = lat ? src_lat : src_ctx - (size_t)RL * D; float* db = lat ? dst_lat : dst_ctx - (size_t)RL * D;
        const float* gt = gate + (lat ? row0 / T : 4) * 6 * D;
        EPI_LOOP_BEGIN
            const size_t off = (size_t)(row0 + rloc) * D + col0 + cloc; const int col = col0 + cloc;
            const f32x4 g0 = *(const f32x4*)(gt + col), g1 = *(const f32x4*)(gt + col + 4), s0 = *(const f32x4*)(sb + off), s1 = *(const f32x4*)(sb + off + 4);
            *(f32x4*)(db + off) = s0 + g0 * v0; *(f32x4*)(db + off + 4) = s1 + g1 * v1;
        EPI_LOOP_END
    }
};
struct EpiSwiglu {
    static constexpr bool PERM = true, AFTER_DRAIN = false;
    bf16_t* HH; int ldc;
    __device__ __forceinline__ void operator()(const f32x4 (&acc)[2][2][4][2], const Unit& u, int wr, int wc, int fr, int fq) const {
        const size_t row0 = (size_t)u.pm * BM; const int col0 = u.pn * HALF + wc * 32 + 8 * fq;
#pragma unroll
        for (int ai = 0; ai < 2; ++ai)
#pragma unroll
            for (int m = 0; m < 4; ++m) { const int rloc = ai * HALF + wr * 64 + m * 16 + fr; float o[8];
#pragma unroll
                for (int n = 0; n < 2; ++n)
#pragma unroll
                    for (int j = 0; j < 4; ++j) o[4 * n + j] = siluf_(acc[ai][0][m][n][j]) * acc[ai][1][m][n][j];
                *(u32x4*)(HH + (row0 + rloc) * ldc + col0) = pack8(o); asm volatile("" ::: "memory"); }
    }
};

struct EpiSwigluCtx {
    static constexpr bool PERM = true, AFTER_DRAIN = false;
    bf16_t* HH; int ldc; bf16_t* HHc; int ctx_from;
    __device__ __forceinline__ void operator()(const f32x4 (&acc)[2][2][4][2], const Unit& u, int wr, int wc, int fr, int fq) const {
        const bool cx = u.pm >= ctx_from;
        const size_t offc = ((size_t)(u.pn >> 1) * 1024 + (size_t)(u.pm - ctx_from) * BM) * 256 + (u.pn & 1) * HALF + wc * 32 + 8 * fq + (size_t)(HHc - HH), offn = (size_t)u.pm * BM * ldc + u.pn * HALF + wc * 32 + 8 * fq;
        bf16_t* base = HH + (cx ? offc : offn); const int ld = cx ? 256 : ldc;
#pragma unroll
        for (int ai = 0; ai < 2; ++ai)
#pragma unroll
            for (int m = 0; m < 4; ++m) { const int rloc = ai * HALF + wr * 64 + m * 16 + fr; float o[8];
#pragma unroll
                for (int n = 0; n < 2; ++n)
#pragma unroll
                    for (int j = 0; j < 4; ++j) o[4 * n + j] = siluf_(acc[ai][0][m][n][j]) * acc[ai][1][m][n][j];
                *(u32x4*)(base + (size_t)rloc * ld) = pack8(o); asm volatile("" ::: "memory"); }
    }
};
struct EpiSlab {
    static constexpr bool PERM = true, AFTER_DRAIN = false;
    float* slab; const float* gate;
    __device__ __forceinline__ void operator()(const f32x4 (&acc)[2][2][4][2], const Unit& u, int wr, int wc, int fr, int fq) const {
        float* base = slab + ((size_t)(u.pm >> 2) * 1024 + (size_t)(u.pm & 3) * BM) * D + u.pn * BM;
        EPI_LOOP_BEGIN
            const int col = u.pn * BM + cloc; const f32x4 g0 = *(const f32x4*)(gate + col), g1 = *(const f32x4*)(gate + col + 4);
            float* p = base + (size_t)rloc * D + cloc; *(f32x4*)p = g0 * v0; *(f32x4*)(p + 4) = g1 * v1;
        EPI_LOOP_END
    }
};

struct EpiSwiglu8 {
    static constexpr bool PERM = true, AFTER_DRAIN = false;
    unsigned char* HH; int ldc;
    __device__ __forceinline__ void operator()(const f32x4 (&acc)[2][2][4][2], const Unit& u, int wr, int wc, int fr, int fq) const {
        const size_t row0 = (size_t)u.pm * BM; const int col0 = u.pn * HALF + wc * 32 + 8 * fq; const float is = 1.0f / W8S;
#pragma unroll
        for (int ai = 0; ai < 2; ++ai)
#pragma unroll
            for (int m = 0; m < 4; ++m) { const int rloc = ai * HALF + wr * 64 + m * 16 + fr; float o[8];
#pragma unroll
                for (int n = 0; n < 2; ++n)
#pragma unroll
                    for (int j = 0; j < 4; ++j) o[4 * n + j] = __builtin_amdgcn_fmed3f(siluf_(acc[ai][0][m][n][j] * is) * (acc[ai][1][m][n][j] * is), -448.0f, 448.0f);
                v2u w; w.x = (unsigned)__builtin_amdgcn_cvt_pk_fp8_f32(o[0], o[1], 0, false); w.x = (unsigned)__builtin_amdgcn_cvt_pk_fp8_f32(o[2], o[3], (int)w.x, true);
                w.y = (unsigned)__builtin_amdgcn_cvt_pk_fp8_f32(o[4], o[5], 0, false); w.y = (unsigned)__builtin_amdgcn_cvt_pk_fp8_f32(o[6], o[7], (int)w.y, true);
                *(v2u*)(HH + (row0 + rloc) * ldc + col0) = w; asm volatile("" ::: "memory"); }
    }
};
struct EpiStoreScaled {
    static constexpr bool PERM = true, AFTER_DRAIN = false;
    bf16_t* C; int ldc; float s;
    __device__ __forceinline__ void operator()(const f32x4 (&acc)[2][2][4][2], const Unit& u, int wr, int wc, int fr, int fq) const {
        const size_t row0 = (size_t)u.pm * BM; const int col0 = u.pn * BM;
        EPI_LOOP_BEGIN
            *(u32x4*)(C + (row0 + rloc) * ldc + col0 + cloc) = pack_acc8(v0 * s, v1 * s);
        EPI_LOOP_END
    }
};

}

struct Args { const GAS float* in[33]; GAS float* out; GAS unsigned char* ws; int ph_lo, ph_hi, li, pad; };
#define CAS __attribute__((address_space(4)))
#define INP(i) ((const float*)F.A->in[i])
constexpr int NWAVES = 8, NTHREADS = 512;
struct Frame {
    LAS unsigned char* lds; volatile LAS unsigned* MISC; gu32* ctl;
    int tid, lane, wave, G, bid;
    int cb, cg;
    GAS unsigned char* ws; GAS float* out;
    const CAS Args* A;
};
enum { I_X = 0, I_C, I_CTX, I_CCTX, I_WADA, I_BADA, I_GNM, I_GNF, I_WIN, I_BG, I_GMN, I_MU, I_W0, I_W2, I_A0, I_A2, I_G2, I_KK, I_KA, I_RK, I_LNW, I_LNB, I_WPM, I_WPR, I_WOUT,
       I_FFG, I_FFU, I_FFD, I_WR, I_EG, I_EU, I_ED, I_GF };

__device__ __forceinline__ void conv_item(const float* W, int ldw, int c0, int k0, bf16* dst, int ldd, int r0, LAS float* scr, int lane) {
#pragma unroll 8
    for (int i = 0; i < 32; ++i) { const int kk = 2 * i + (lane >> 5); scr[kk * 33 + (lane & 31)] = W[(size_t)(k0 + kk) * ldw + c0 + (lane & 31)]; }
    LDS_WAIT(); asm volatile("" ::: "memory");
    const int c = lane & 7;
#pragma unroll
    for (int j = 0; j < 4; ++j) { const int n = (lane >> 3) + 8 * j; const LAS float* s = scr + (8 * c) * 33 + n;
        v4u o; o.x = cvt_pk_bf16(s[0 * 33], s[1 * 33]); o.y = cvt_pk_bf16(s[2 * 33], s[3 * 33]); o.z = cvt_pk_bf16(s[4 * 33], s[5 * 33]); o.w = cvt_pk_bf16(s[6 * 33], s[7 * 33]);
        *(v4u*)(dst + (size_t)(r0 + n) * ldd + k0 + 8 * c) = o; }
    LDS_WAIT(); asm volatile("" ::: "memory");
}
__device__ __forceinline__ unsigned pk4_fp8(float a, float b, float c, float d) { int w = __builtin_amdgcn_cvt_pk_fp8_f32(a, b, 0, false); w = __builtin_amdgcn_cvt_pk_fp8_f32(c, d, w, true); return (unsigned)w; }
__device__ __forceinline__ void conv_item8(const float* W, int ldw, int c0, int k0, unsigned char* dst, int ldd, int r0, float scale, LAS float* scr, int lane) {
#pragma unroll 8
    for (int i = 0; i < 32; ++i) { const int kk = 2 * i + (lane >> 5); scr[kk * 33 + (lane & 31)] = __builtin_amdgcn_fmed3f(W[(size_t)(k0 + kk) * ldw + c0 + (lane & 31)] * scale, -448.0f, 448.0f); }
    LDS_WAIT(); asm volatile("" ::: "memory");
    const int c = lane & 3;
#pragma unroll
    for (int j = 0; j < 2; ++j) { const int n = (lane >> 2) + 16 * j; const LAS float* s = scr + (16 * c) * 33 + n;
        v4u o; o.x = pk4_fp8(s[0 * 33], s[1 * 33], s[2 * 33], s[3 * 33]); o.y = pk4_fp8(s[4 * 33], s[5 * 33], s[6 * 33], s[7 * 33]);
        o.z = pk4_fp8(s[8 * 33], s[9 * 33], s[10 * 33], s[11 * 33]); o.w = pk4_fp8(s[12 * 33], s[13 * 33], s[14 * 33], s[15 * 33]);
        *(v4u*)(dst + (size_t)(r0 + n) * ldd + k0 + 16 * c) = o; }
    LDS_WAIT(); asm volatile("" ::: "memory");
}
__device__ __forceinline__ void conv_seg8(Frame& F, const float* W, int ldw, int K, int c0, int ncols, unsigned char* dst, int ldd, int r0, float scale, int& rot) {
    LAS float* scr = (LAS float*)(F.lds + F.wave * 16384);
    const int NGW = F.cg * NWAVES, nblk = ncols / 32, nitems = (K / 64) * nblk;
    int gw = (F.cb * NWAVES + F.wave + rot) % NGW;
    for (int it = gw; it < nitems; it += NGW) { const int kb = it / nblk, nb = it % nblk; conv_item8(W, ldw, c0 + 32 * nb, 64 * kb, dst, ldd, r0 + 32 * nb, scale, scr, F.lane); }
    rot = (rot + nitems) % NGW;
}
__device__ __forceinline__ void conv_gu8(Frame& F, const float* Wg, const float* Wu, int ldw, int K, int ngroups, unsigned char* dst, float scale, int& rot) {
    LAS float* scr = (LAS float*)(F.lds + F.wave * 16384);
    const int NGW = F.cg * NWAVES, kblk = K / 64, nitems = ngroups * 2 * 4 * kblk;
    int gw = (F.cb * NWAVES + F.wave + rot) % NGW;
    for (int it = gw; it < nitems; it += NGW) { const int kb = it % kblk, r = it / kblk, nb = r & 3, which = (r >> 2) & 1, p = r >> 3;
        conv_item8(which ? Wu : Wg, ldw, 128 * p + 32 * nb, 64 * kb, dst, K, 256 * p + 128 * which + 32 * nb, scale, scr, F.lane); }
    rot = (rot + nitems) % NGW;
}
__device__ __forceinline__ void conv_ffd_dual(Frame& F, const float* W, bf16* dst, bf16* dsts, int& rot) {
    LAS float* scr = (LAS float*)(F.lds + F.wave * 16384);
    const int NGW = F.cg * NWAVES, nblk = D / 32, nitems = (FF / 64) * nblk; const int lane = F.lane;
    int gw = (F.cb * NWAVES + F.wave + rot) % NGW;
    for (int it = gw; it < nitems; it += NGW) { const int kb = it / nblk, nb = it % nblk, k0 = 64 * kb, c0 = 32 * nb;
#pragma unroll 8
        for (int i = 0; i < 32; ++i) { const int kk = 2 * i + (lane >> 5); scr[kk * 33 + (lane & 31)] = W[(size_t)(k0 + kk) * D + c0 + (lane & 31)]; }
        LDS_WAIT(); asm volatile("" ::: "memory");
        const int c = lane & 7;
#pragma unroll
        for (int j = 0; j < 4; ++j) { const int n = (lane >> 3) + 8 * j; const LAS float* s = scr + (8 * c) * 33 + n;
            v4u o; o.x = cvt_pk_bf16(s[0 * 33], s[1 * 33]); o.y = cvt_pk_bf16(s[2 * 33], s[3 * 33]); o.z = cvt_pk_bf16(s[4 * 33], s[5 * 33]); o.w = cvt_pk_bf16(s[6 * 33], s[7 * 33]);
            *(v4u*)(dst + (size_t)(c0 + n) * FF + k0 + 8 * c) = o;
            *(v4u*)(dsts + ((size_t)(k0 >> 8) * 1024 + c0 + n) * 256 + (k0 & 255) + 8 * c) = o; }
        LDS_WAIT(); asm volatile("" ::: "memory"); }
    rot = (rot + nitems) % NGW;
}
__device__ __forceinline__ void conv_seg(Frame& F, const float* W, int ldw, int K, int c0, int ncols, bf16* dst, int ldd, int r0, int& rot) {
    LAS float* scr = (LAS float*)(F.lds + F.wave * 16384);
    const int NGW = F.cg * NWAVES, nblk = ncols / 32, nitems = (K / 64) * nblk;
    int gw = (F.cb * NWAVES + F.wave + rot) % NGW;
    for (int it = gw; it < nitems; it += NGW) { const int kb = it / nblk, nb = it % nblk; conv_item(W, ldw, c0 + 32 * nb, 64 * kb, dst, ldd, r0 + 32 * nb, scr, F.lane); }
    rot = (rot + nitems) % NGW;
}
__device__ __forceinline__ void conv_gu(Frame& F, const float* Wg, const float* Wu, int ldw, int K, int ngroups, bf16* dst, int& rot) {
    LAS float* scr = (LAS float*)(F.lds + F.wave * 16384);
    const int NGW = F.cg * NWAVES, kblk = K / 64, nitems = ngroups * 2 * 4 * kblk;
    int gw = (F.cb * NWAVES + F.wave + rot) % NGW;
    for (int it = gw; it < nitems; it += NGW) { const int kb = it % kblk, r = it / kblk, nb = r & 3, which = (r >> 2) & 1, p = r >> 3;
        conv_item(which ? Wu : Wg, ldw, 128 * p + 32 * nb, 64 * kb, dst, K, 256 * p + 128 * which + 32 * nb, scr, F.lane); }
    rot = (rot + nitems) % NGW;
}
__device__ __forceinline__ void zero_bf16_rows(Frame& F, bf16* dst, size_t n16) {
    const v4u z = {0u, 0u, 0u, 0u};
    for (size_t i = (size_t)F.cb * NTHREADS + F.tid; i < n16; i += (size_t)F.cg * NTHREADS) ((v4u*)dst)[i] = z;
}
__device__ __forceinline__ void conv_win(Frame& F, int l) {
    int rot = 0; GAS unsigned char* ws = F.ws;
    bf16* WIN = (bf16*)(ws + WS_WIN); const float* win = INP(I_WIN) + (size_t)l * D * DIN;
    conv_seg(F, win, DIN, D, 0, 3072, WIN, D, 0, rot);
    conv_seg(F, win, DIN, D, 3104, 3072, WIN, D, 3072, rot);
    conv_seg(F, win, DIN, D, 6560, 2048, WIN, D, 6144, rot);
    conv_seg(F, win, DIN, D, 3072, 32, WIN, D, 8192, rot);
    conv_seg(F, win, DIN, D, 6176, 384, WIN, D, 8192 + 32, rot);
    zero_bf16_rows(F, WIN + (size_t)(8192 + 416) * D, (size_t)96 * D * 2 / 16);
}
__device__ __forceinline__ void conv_rest(Frame& F, int l) {
    int rot = 0; GAS unsigned char* ws = F.ws;
    conv_seg(F, INP(I_WPM) + (size_t)l * D * D, D, D, 0, D, (bf16*)(ws + WS_WPM), D, 0, rot);
    conv_seg(F, INP(I_WPR) + (size_t)l * D * D, D, D, 0, D, (bf16*)(ws + WS_WPR), D, 0, rot);
    conv_seg(F, INP(I_WOUT) + (size_t)l * D * D, D, D, 0, D, (bf16*)(ws + WS_WOUT), D, 0, rot);
    { bf16* WG2 = (bf16*)(ws + WS_WG2);
      conv_seg(F, INP(I_G2) + (size_t)l * 128 * RD, RD, 128, 0, RD, WG2, 256, 0, rot);
      for (int i = F.cb * NTHREADS + F.tid; i < 1024 * 16; i += F.cg * NTHREADS) { const int r = i >> 4, p = i & 15; *(v4u*)(WG2 + (size_t)r * 256 + 128 + 8 * p) = (v4u){0u, 0u, 0u, 0u}; } }
    { bf16* WL = (bf16*)(ws + WS_WLORA);
      for (int d = 0; d < 2; ++d) { conv_seg(F, INP(I_W2) + ((size_t)l * 2 + d) * 64 * RD, RD, 64, 0, RD, WL + (size_t)(0 * 2 + d) * RD * 64, 64, 0, rot);
                                    conv_seg(F, INP(I_A2) + ((size_t)l * 2 + d) * 64 * RD, RD, 64, 0, RD, WL + (size_t)(1 * 2 + d) * RD * 64, 64, 0, rot); } }
}
__device__ __forceinline__ void conv_ffn0(Frame& F) {
    int rot = 0; GAS unsigned char* ws = F.ws;
    conv_gu(F, INP(I_FFG), INP(I_FFU), FF, D, FF / 128, (bf16*)(ws + WS_WGU), rot);
    conv_ffd_dual(F, INP(I_FFD), (bf16*)(ws + WS_WDN), (bf16*)(ws + WS_WDNS), rot);
}
__device__ __forceinline__ void conv_experts(Frame& F) {
    int rot = 0;
    for (int e = 0; e < NE; ++e) {
        conv_gu8(F, INP(I_EG) + (size_t)e * D * FE, INP(I_EU) + (size_t)e * D * FE, FE, D, FE / 128, (unsigned char*)(F.ws + WS_WEGU) + (size_t)e * 2 * FE * D, W8S, rot);
        conv_seg8(F, INP(I_ED) + (size_t)e * FE * D, D, FE, 0, D, (unsigned char*)(F.ws + WS_WEDN) + (size_t)e * D * FE, FE, 0, W8S, rot);
    }
}
__device__ __forceinline__ void mod_phase(Frame& F) {
    LAS float* sl = (LAS float*)F.lds;
    LAS float* part = sl + 5 * D;
    for (int i = F.tid; i < 5 * D; i += NTHREADS) { const int bb = i / D, k = i % D; const float v = bb < 4 ? INP(I_C)[bb * D + k] : INP(I_CCTX)[k]; sl[i] = siluf_(v); }
    __syncthreads();
    float* MOD = (float*)(F.ws + WS_MOD);
    for (int item = F.bid; item < NL * 6 * D / 64; item += F.G) {
        const int l = item / (6 * D / 64), c0 = (item % (6 * D / 64)) * 64; const float* w = INP(I_WADA) + (size_t)l * D * 6 * D + c0 + F.lane;
        float a[5] = {0.f, 0.f, 0.f, 0.f, 0.f};
        for (int k = F.wave * 128; k < F.wave * 128 + 128; ++k) { const float wv = w[(size_t)k * 6 * D];
#pragma unroll
            for (int bb = 0; bb < 5; ++bb) a[bb] += sl[bb * D + k] * wv; }
#pragma unroll
        for (int bb = 0; bb < 5; ++bb) part[(F.wave * 5 + bb) * 64 + F.lane] = a[bb];
        __syncthreads();
        if (F.tid < 5 * 64) { const int bb = F.tid / 64, c = F.tid % 64; float s = INP(I_BADA)[l * 6 * D + c0 + c];
#pragma unroll
            for (int w8 = 0; w8 < 8; ++w8) s += part[(w8 * 5 + bb) * 64 + c];
            MOD[((size_t)l * 5 + bb) * 6 * D + c0 + c] = s; }
        __syncthreads();
    }
}
__device__ __forceinline__ const float* xrow(const float* lat, const float* ctx, int g) { return g < RL ? lat + (size_t)g * D : ctx + (size_t)(g - RL) * D; }
template <bool ROUTER> __device__ __forceinline__ void normmod_phase(Frame& F, const float* lat, const float* ctx, const float* gain, const float* MODl, int off_sh, int off_sc, int nrows, const float* wrt) {
    bf16* H = (bf16*)(F.ws + WS_H);
    LAS unsigned* lcnt = (LAS unsigned*)F.lds;
    LAS int* rec = (LAS int*)(F.lds + 64);
    LAS float* recp = (LAS float*)(F.lds + 64 + 1024);
    const int ngroups = nrows / 64;
    for (int grp = F.bid; grp < ngroups; grp += F.G) {
        if (ROUTER) { if (F.tid < 16) lcnt[F.tid] = 0u; __syncthreads(); }
        f32x4 vnx[4];
        { const float* x0 = xrow(lat, ctx, grp * 64 + F.wave * 8);
#pragma unroll
          for (int j = 0; j < 4; ++j) vnx[j] = *(const f32x4*)(x0 + 256 * j + 4 * F.lane); }
        for (int rr = 0; rr < 8; ++rr) {
            const int lrow = F.wave * 8 + rr, g = grp * 64 + lrow; const float* md = MODl + (g < RL ? g / T : 4) * 6 * D;
            f32x4 v[4]; float ss = 0.f;
#pragma unroll
            for (int j = 0; j < 4; ++j) v[j] = vnx[j];
            if (rr + 1 < 8) { const float* x1 = xrow(lat, ctx, g + 1);
#pragma unroll
                for (int j = 0; j < 4; ++j) vnx[j] = *(const f32x4*)(x1 + 256 * j + 4 * F.lane); }
#pragma unroll
            for (int j = 0; j < 4; ++j) ss += (v[j].x * v[j].x + v[j].y * v[j].y) + (v[j].z * v[j].z + v[j].w * v[j].w);
            const float rstd = 1.0f / sqrtf(wave_sum(ss) * (1.0f / D) + NORM_EPS);
            float lg[NE];
            if (ROUTER) {
#pragma unroll
                for (int e = 0; e < NE; ++e) lg[e] = 0.f; }
#pragma unroll
            for (int j = 0; j < 4; ++j) { const int c = 256 * j + 4 * F.lane;
                const f32x4 gn = *(const f32x4*)(gain + c), sc = *(const f32x4*)(md + off_sc + c), sh = *(const f32x4*)(md + off_sh + c);
                const f32x4 h = v[j] * rstd * gn * (1.0f + sc) + sh;
                v2u o; o.x = cvt_pk_bf16(h.x, h.y); o.y = cvt_pk_bf16(h.z, h.w); *(v2u*)(H + (size_t)g * D + c) = o;
                if (ROUTER) {
#pragma unroll
                    for (int q = 0; q < 4; ++q) { const f32x4 w0 = *(const f32x4*)(wrt + (size_t)(c + q) * NE), w1 = *(const f32x4*)(wrt + (size_t)(c + q) * NE + 4); const float hv = h[q];
                        lg[0] += hv * w0.x; lg[1] += hv * w0.y; lg[2] += hv * w0.z; lg[3] += hv * w0.w; lg[4] += hv * w1.x; lg[5] += hv * w1.y; lg[6] += hv * w1.z; lg[7] += hv * w1.w; } }
            }
            if (ROUTER) {
#pragma unroll
                for (int e = 0; e < NE; ++e) lg[e] = wave_sum(lg[e]);
                int i0 = 0;
#pragma unroll
                for (int e = 1; e < NE; ++e) if (lg[e] > lg[i0]) i0 = e;
                int i1 = i0 == 0 ? 1 : 0;
#pragma unroll
                for (int e = 0; e < NE; ++e) if (e != i0 && lg[e] > lg[i1]) i1 = e;
                if (F.lane == 0) { const float e1 = __expf(lg[i1] - lg[i0]); const float p0 = 1.0f / (1.0f + e1);
                    rec[lrow * 4 + 0] = i0; rec[lrow * 4 + 1] = i1; rec[lrow * 4 + 2] = (int)atomicAdd((unsigned*)&lcnt[i0], 1u); rec[lrow * 4 + 3] = (int)atomicAdd((unsigned*)&lcnt[i1], 1u);
                    recp[lrow * 2 + 0] = p0; recp[lrow * 2 + 1] = e1 * p0; }
            }
        }
        if (ROUTER) {
            __syncthreads();
            if (F.tid < NE) lcnt[8 + F.tid] = __hip_atomic_fetch_add((unsigned*)(F.ctl + CW_ECNT + 64 * F.tid), lcnt[F.tid], RLX_AGENT);
            __syncthreads();
            if (F.tid < 64) { const int g = grp * 64 + F.tid; int* tk = (int*)(F.ws + WS_META) + (size_t)g * 8; const int e0 = rec[F.tid * 4], e1 = rec[F.tid * 4 + 1];
                tk[0] = e0; tk[1] = e1; tk[2] = (int)lcnt[8 + e0] + rec[F.tid * 4 + 2]; tk[3] = (int)lcnt[8 + e1] + rec[F.tid * 4 + 3];
                ((float*)tk)[4] = recp[F.tid * 2]; ((float*)tk)[5] = recp[F.tid * 2 + 1]; }
            __syncthreads();
        }
    }
}
__device__ __forceinline__ void subgrid_arrive(Frame& F, gu32* cnt) {
    asm volatile("s_waitcnt vmcnt(0)" ::: "memory"); __syncthreads();
    if (F.tid == 0) { __builtin_amdgcn_fence(__ATOMIC_RELEASE, "agent"); asm volatile("s_waitcnt vmcnt(0)" ::: "memory"); __hip_atomic_fetch_add(cnt, 1u, RLX_AGENT); }
}
__device__ __forceinline__ void subgrid_wait(Frame& F, gu32* cnt, unsigned n) {
    if (F.tid == 0) { unsigned sp = 0; while (__hip_atomic_load(cnt, RLX_AGENT) < n) { __builtin_amdgcn_s_sleep(2); if (++sp > (1u << 20)) break; }
        __builtin_amdgcn_fence(__ATOMIC_ACQUIRE, "agent"); asm volatile("s_waitcnt vmcnt(0)" ::: "memory"); }
    __syncthreads();
}
__device__ __forceinline__ void normmod_ctx_slabs(Frame& F, const float* XCp, const float* slab, const float* gain, const float* MODl, int off_sh, int off_sc) {
    bf16* H = (bf16*)(F.ws + WS_H); const float* md = MODl + 4 * 6 * D;
    for (int r = F.bid * NWAVES + F.wave; r < RC; r += F.G * NWAVES) {
        f32x4 v[4], p[NSL][4];
#pragma unroll
        for (int j = 0; j < 4; ++j) v[j] = *(const f32x4*)(XCp + (size_t)r * D + 256 * j + 4 * F.lane);
#pragma unroll
        for (int s_ = 0; s_ < NSL; ++s_)
#pragma unroll
            for (int j = 0; j < 4; ++j) p[s_][j] = *(const f32x4*)(slab + ((size_t)s_ * RC + r) * D + 256 * j + 4 * F.lane);
        float ss = 0.f;
#pragma unroll
        for (int j = 0; j < 4; ++j) {
#pragma unroll
            for (int s_ = 0; s_ < NSL; ++s_) v[j] += p[s_][j];
            ss += (v[j].x * v[j].x + v[j].y * v[j].y) + (v[j].z * v[j].z + v[j].w * v[j].w); }
        const float rstd = 1.0f / sqrtf(wave_sum(ss) * (1.0f / D) + NORM_EPS);
#pragma unroll
        for (int j = 0; j < 4; ++j) { const int c = 256 * j + 4 * F.lane;
            const f32x4 gn = *(const f32x4*)(gain + c), sc = *(const f32x4*)(md + off_sc + c), sh = *(const f32x4*)(md + off_sh + c);
            const f32x4 h = v[j] * rstd * gn * (1.0f + sc) + sh;
            v2u o; o.x = cvt_pk_bf16(h.x, h.y); o.y = cvt_pk_bf16(h.z, h.w); *(v2u*)(H + (size_t)(RL + r) * D + c) = o; }
    }
}
__device__ __forceinline__ void sg_phase(Frame& F, int l) {
    const float* SM = (const float*)(F.ws + WS_SM); bf16* SG = (bf16*)(F.ws + WS_SG); const float* mu = INP(I_MU) + l * RW + 3328;
    for (int i = F.cb * NTHREADS + F.tid; i < R * 32; i += F.cg * NTHREADS) { const int g = i >> 5, p = i & 31; float o[8];
        if (p < 16) { const int nb = nbrow(g, 3328); const float* a = SM + (size_t)g * SMW + 288 + 8 * p;
            const f32x4 a0 = *(const f32x4*)a, a1 = *(const f32x4*)(a + 4); f32x4 b0 = {0.f, 0.f, 0.f, 0.f}, b1 = b0;
            if (nb >= 0) { const float* bq = SM + (size_t)nb * SMW + 288 + 8 * p; b0 = *(const f32x4*)bq; b1 = *(const f32x4*)(bq + 4); }
#pragma unroll
            for (int j = 0; j < 4; ++j) { o[j] = sigmoidf_(a0[j] + (b0[j] - a0[j]) * mu[8 * p + j]); o[4 + j] = sigmoidf_(a1[j] + (b1[j] - a1[j]) * mu[8 * p + 4 + j]); }
        } else {
#pragma unroll
            for (int j = 0; j < 8; ++j) o[j] = 0.f; }
        *(v4u*)(SG + (size_t)g * 256 + 8 * p) = pack8(o); }
}

constexpr int ML_P = 72, ML_QS = 0, ML_KS = 64 * ML_P * 2, ML_KT = 2 * ML_KS, ML_PS = 3 * ML_KS, ML_VT = 4 * ML_KS, ML_CB = ML_VT + 48 * ML_P * 2, ML_GT = ML_CB + 48 * ML_P * 2, ML_END = ML_GT + 2 * 6 * 64 * 4;
template <int CTRL, int RMASK> __device__ __forceinline__ float dpp_get(float v, float old) { return __int_as_float(__builtin_amdgcn_update_dpp(__float_as_int(old), __float_as_int(v), CTRL, RMASK, 0xf, false)); }
__device__ __forceinline__ float wave_scan_add(float x) {
    x += dpp_get<0x111, 0xf>(x, 0.f); x += dpp_get<0x112, 0xf>(x, 0.f); x += dpp_get<0x114, 0xf>(x, 0.f); x += dpp_get<0x118, 0xf>(x, 0.f);
    x += dpp_get<0x142, 0xa>(x, 0.f); x += dpp_get<0x143, 0xc>(x, 0.f); return x;
}
__device__ __forceinline__ float wave_scan_max(float x) {
    const float ninf = -__builtin_inff();
    x = fmaxf(x, dpp_get<0x111, 0xf>(x, ninf)); x = fmaxf(x, dpp_get<0x112, 0xf>(x, ninf)); x = fmaxf(x, dpp_get<0x114, 0xf>(x, ninf)); x = fmaxf(x, dpp_get<0x118, 0xf>(x, ninf));
    x = fmaxf(x, dpp_get<0x142, 0xa>(x, ninf)); x = fmaxf(x, dpp_get<0x143, 0xc>(x, ninf)); return x;
}
__device__ __forceinline__ float lane63(float x) { return __int_as_float(__builtin_amdgcn_readlane(__float_as_int(x), 63)); }
__device__ __forceinline__ void mlstm_phase(Frame& F, int l, int first, int stride) {
    LAS unsigned char* L = F.lds;
    LAS bf16* Qs = (LAS bf16*)(L + ML_QS); LAS bf16* Ks = (LAS bf16*)(L + ML_KS); LAS bf16* Kt = (LAS bf16*)(L + ML_KT); LAS bf16* Ps = (LAS bf16*)(L + ML_PS);
    LAS bf16* Vt = (LAS bf16*)(L + ML_VT); LAS bf16* Cb = (LAS bf16*)(L + ML_CB); LAS float* GT = (LAS float*)(L + ML_GT);
    const bf16* Qg = (const bf16*)(F.ws + WS_Q); const bf16* Kg = (const bf16*)(F.ws + WS_K); const bf16* Vg = (const bf16*)(F.ws + WS_V); const float* SM = (const float*)(F.ws + WS_SM);
    bf16* HF = (bf16*)(F.ws + WS_HF); const float* bgate = INP(I_BG) + l * 4 * MH;
    const int tid = F.tid, lane = F.lane, wave = F.wave, r16 = lane & 15, quad = lane >> 4;
    for (int item = first; item < NB * 2 * MH * 4; item += stride) {
        const int vq = item & 3, h = (item >> 2) & 7, dir = (item >> 5) & 1, b = item >> 6;
        __syncthreads();
        for (int i = tid; i < 48 * ML_P; i += NTHREADS) { Cb[i] = 0; Vt[i] = (i >= 32 * ML_P) ? (bf16)0x3F80 : (bf16)0; }
        const float bgi = bgate[(2 * dir) * MH + h], bgf = bgate[(2 * dir + 1) * MH + h];
        const int ss_ = tid & 63, pc = tid >> 6;
        v4u rq, rk, rv = {0u, 0u, 0u, 0u};
        { const int g = row_of(b, tok(dir, ss_)); rq = *(const v4u*)(Qg + (size_t)g * 512 + h * 64 + pc * 8); rk = *(const v4u*)(Kg + (size_t)g * 512 + h * 64 + pc * 8);
          if (pc < 4) rv = *(const v4u*)(Vg + (size_t)g * 1024 + h * 128 + vq * 32 + pc * 8); }
        float m_run = 0.f, gi = 0.f, gf = 0.f;
        auto gate_tables = [&](int buf) {
            LAS float* G = GT + buf * 384;
            const float iv = CAP * fast_tanh((gi + bgi) * (1.0f / CAP)), lf = -fast_softplus(-CAP * fast_tanh((gf + bgf) * (1.0f / CAP)));
            const float bsum = wave_scan_add(lf), pmx = wave_scan_max(iv - bsum);
            const float inter = bsum + m_run, mt = fmaxf(inter, bsum + pmx);
            G[lane] = bsum - mt; G[64 + lane] = iv - bsum; G[128 + lane] = __expf(inter - mt); G[192 + lane] = __expf(-mt);
            const float blast = lane63(bsum), mnew = fmaxf(blast + m_run, blast + lane63(pmx));
            G[256 + lane] = __expf(blast - bsum + iv - mnew);
            if (lane == 0) G[320] = __expf(blast + m_run - mnew);
            m_run = mnew;
        };
        if (wave == 1) { { const int g = row_of(b, tok(dir, lane)); gi = SM[(size_t)g * SMW + (2 * dir) * MH + h]; gf = SM[(size_t)g * SMW + (2 * dir + 1) * MH + h]; }
            gate_tables(0);
            { const int g = row_of(b, tok(dir, 64 + lane)); gi = SM[(size_t)g * SMW + (2 * dir) * MH + h]; gf = SM[(size_t)g * SMW + (2 * dir + 1) * MH + h]; } }
        f32x4 Cacc = {0.f, 0.f, 0.f, 0.f}, Cacc2 = {0.f, 0.f, 0.f, 0.f};
        __syncthreads();
        for (int j = 0; j < NCH; ++j) {
            const LAS float* G = GT + (j & 1) * 384;
            { *(v4u*)(Qs + ss_ * ML_P + pc * 8) = rq; *(v4u*)(Ks + ss_ * ML_P + pc * 8) = rk;
              const unsigned kw[4] = {rk.x, rk.y, rk.z, rk.w};
#pragma unroll
              for (int i = 0; i < 4; ++i) { Kt[(pc * 8 + 2 * i) * ML_P + ss_] = (bf16)(kw[i] & 0xffffu); Kt[(pc * 8 + 2 * i + 1) * ML_P + ss_] = (bf16)(kw[i] >> 16); }
              if (pc < 4) { const unsigned vw[4] = {rv.x, rv.y, rv.z, rv.w};
#pragma unroll
                  for (int i = 0; i < 4; ++i) { Vt[(pc * 8 + 2 * i) * ML_P + ss_] = (bf16)(vw[i] & 0xffffu); Vt[(pc * 8 + 2 * i + 1) * ML_P + ss_] = (bf16)(vw[i] >> 16); } } }
            if (j + 1 < NCH) { const int g = row_of(b, tok(dir, (j + 1) * 64 + ss_)); rq = *(const v4u*)(Qg + (size_t)g * 512 + h * 64 + pc * 8); rk = *(const v4u*)(Kg + (size_t)g * 512 + h * 64 + pc * 8);
                if (pc < 4) rv = *(const v4u*)(Vg + (size_t)g * 1024 + h * 128 + vq * 32 + pc * 8); }
            __syncthreads();
            const int mt = wave >> 1, vnt = wave & 1;
            if (wave == 1 && j + 1 < NCH) { gate_tables((j + 1) & 1);
                if (j + 2 < NCH) { const int g = row_of(b, tok(dir, (j + 2) * 64 + lane)); gi = SM[(size_t)g * SMW + (2 * dir) * MH + h]; gf = SM[(size_t)g * SMW + (2 * dir + 1) * MH + h]; } }
            const bf16x8 qa0 = *(const LAS bf16x8*)(Qs + (16 * mt + r16) * ML_P + quad * 8), qa1 = *(const LAS bf16x8*)(Qs + (16 * mt + r16) * ML_P + 32 + quad * 8);
            f32x4 accq = {0.f, 0.f, 0.f, 0.f}, accqn = {0.f, 0.f, 0.f, 0.f};
            { const bf16x8 c0 = *(const LAS bf16x8*)(Cb + (16 * vnt + r16) * ML_P + quad * 8), c1 = *(const LAS bf16x8*)(Cb + (16 * vnt + r16) * ML_P + 32 + quad * 8);
              const bf16x8 n0 = *(const LAS bf16x8*)(Cb + (32 + r16) * ML_P + quad * 8), n1 = *(const LAS bf16x8*)(Cb + (32 + r16) * ML_P + 32 + quad * 8);
              accq = __builtin_amdgcn_mfma_f32_16x16x32_bf16(qa0, c0, accq, 0, 0, 0); accq = __builtin_amdgcn_mfma_f32_16x16x32_bf16(qa1, c1, accq, 0, 0, 0);
              accqn = __builtin_amdgcn_mfma_f32_16x16x32_bf16(qa0, n0, accqn, 0, 0, 0); accqn = __builtin_amdgcn_mfma_f32_16x16x32_bf16(qa1, n1, accqn, 0, 0, 0); }
#pragma unroll
            for (int nn = 0; nn < 2; ++nn) { const int nt = 2 * (wave & 1) + nn; f32x4 sacc = {0.f, 0.f, 0.f, 0.f};
                if (nt <= mt) { const bf16x8 k0 = *(const LAS bf16x8*)(Ks + (16 * nt + r16) * ML_P + quad * 8), k1 = *(const LAS bf16x8*)(Ks + (16 * nt + r16) * ML_P + 32 + quad * 8);
                    sacc = __builtin_amdgcn_mfma_f32_16x16x32_bf16(qa0, k0, sacc, 0, 0, 0); sacc = __builtin_amdgcn_mfma_f32_16x16x32_bf16(qa1, k1, sacc, 0, 0, 0); }
                const int s = 16 * nt + r16; const float wc_ = G[64 + s];
#pragma unroll
                for (int i = 0; i < 4; ++i) { const int t = 16 * mt + 4 * quad + i; const float p = (s <= t) ? sacc[i] * 0.125f * __expf(G[t] + wc_) : 0.f;
                    Ps[t * ML_P + s] = (bf16)(cvt_pk_bf16(p, 0.f) & 0xffffu); } }
            __syncthreads();
            { f32x4 acc = {0.f, 0.f, 0.f, 0.f}, accn = {0.f, 0.f, 0.f, 0.f};
#pragma unroll
              for (int ks = 0; ks < 2; ++ks) { if (ks == 1 && mt < 2) break;
                  const bf16x8 pa = *(const LAS bf16x8*)(Ps + (16 * mt + r16) * ML_P + 32 * ks + quad * 8);
                  const bf16x8 vb = *(const LAS bf16x8*)(Vt + (16 * vnt + r16) * ML_P + 32 * ks + quad * 8), ob = *(const LAS bf16x8*)(Vt + (32 + r16) * ML_P + 32 * ks + quad * 8);
                  acc = __builtin_amdgcn_mfma_f32_16x16x32_bf16(pa, vb, acc, 0, 0, 0); accn = __builtin_amdgcn_mfma_f32_16x16x32_bf16(pa, ob, accn, 0, 0, 0); }
#pragma unroll
              for (int i = 0; i < 4; ++i) { const int t = 16 * mt + 4 * quad + i; const float wi = G[128 + t] * 0.125f, dn = accn[i] + wi * accqn[i], inv = 1.0f / fmaxf(fabsf(dn), G[192 + t]);
                  const int g = row_of(b, tok(dir, j * 64 + t));
                  HF[((size_t)dir * R + g) * 1024 + h * 128 + vq * 32 + 16 * vnt + r16] = (bf16)(cvt_pk_bf16((acc[i] + wi * accq[i]) * inv, 0.f) & 0xffffu); } }
            { const float aold = G[320]; const int vmt = wave >> 2, dnt = wave & 3;
              f32x4 d1 = {0.f, 0.f, 0.f, 0.f}, d2 = {0.f, 0.f, 0.f, 0.f};
#pragma unroll
              for (int ks = 0; ks < 2; ++ks) {
                  const v4u kraw = *(const LAS v4u*)(Kt + (16 * dnt + r16) * ML_P + 32 * ks + quad * 8); float kf[8]; unpack8(kraw, kf);
                  const f32x4 a0 = *(const LAS f32x4*)&G[256 + 32 * ks + quad * 8], a1 = *(const LAS f32x4*)&G[256 + 32 * ks + quad * 8 + 4];
                  kf[0] *= a0.x; kf[1] *= a0.y; kf[2] *= a0.z; kf[3] *= a0.w; kf[4] *= a1.x; kf[5] *= a1.y; kf[6] *= a1.z; kf[7] *= a1.w;
                  const v4u kp = pack8(kf); const bf16x8 kb = __builtin_bit_cast(bf16x8, kp);
                  const bf16x8 va = *(const LAS bf16x8*)(Vt + (16 * vmt + r16) * ML_P + 32 * ks + quad * 8);
                  d1 = __builtin_amdgcn_mfma_f32_16x16x32_bf16(va, kb, d1, 0, 0, 0);
                  if (wave < 4) { const bf16x8 oa = *(const LAS bf16x8*)(Vt + (32 + r16) * ML_P + 32 * ks + quad * 8); d2 = __builtin_amdgcn_mfma_f32_16x16x32_bf16(oa, kb, d2, 0, 0, 0); } }
              Cacc = Cacc * aold + d1;
#pragma unroll
              for (int i = 0; i < 4; ++i) Cb[(16 * vmt + 4 * quad + i) * ML_P + 16 * dnt + r16] = (bf16)(cvt_pk_bf16(Cacc[i], 0.f) & 0xffffu);
              if (wave < 4) { Cacc2 = Cacc2 * aold + d2;
#pragma unroll
                  for (int i = 0; i < 4; ++i) Cb[(32 + 4 * quad + i) * ML_P + 16 * dnt + r16] = (bf16)(cvt_pk_bf16(Cacc2[i], 0.f) & 0xffffu); } }
            __syncthreads();
        }
    }
}

constexpr int RP = 72;
constexpr int RC_AB = 0, RC_BB = 9216, RC_KB = 18432, RC_RB = 27648, RC_BHT = 36864, RC_KHT = 46080, RC_ABT = 55296, RC_GAKT = 64512, RC_BONP = 67584;
constexpr int RC_TW = 0, RC_AD = 9216;
constexpr int RC_KK16 = 71680, RC_K16 = 80896, RC_R16 = 99328;
constexpr int RC_GAB = 71680, RC_GAK = 75776, RC_HRB = 78848, RC_HRK = 81920, RC_TT = 84992, RC_SAT = 88064, RC_YO = 93184;
constexpr int RC_GL = 109568, RC_VT = 110592, RC_SB = 119808, RC_CONST = 129024, RC_W2T = 133120, RC_A2T = 142336, RC_END = 151552;
static_assert(RC_END <= MISC_OFF && RC_YO + 16384 <= RC_GL && RC_BONP + 1024 <= RC_KK16 && RC_TT + 3072 <= RC_SAT && RC_SAT + 5120 <= RC_YO, "rwkv LDS map");
struct RwPre { f32x4 lw[2], lwn[2], la[2], lan[2]; v4u r, rn, k, kn, v, vn; };
__device__ __forceinline__ void rw_prefetch(RwPre& P, const float* SM, const bf16* RKV, int b, int dir, int h, int j, int tid) {
    const int s = tid >> 3, p8 = (tid & 7) * 8, g = row_of(b, tok(dir, j * 64 + s));
    { const int nb = nbrow(g, 3072); const float* a = SM + (size_t)g * SMW + 32 + 64 * dir + p8; const float* c = SM + (size_t)g * SMW + 160 + 64 * dir + p8;
      P.lw[0] = *(const f32x4*)a; P.lw[1] = *(const f32x4*)(a + 4); P.la[0] = *(const f32x4*)c; P.la[1] = *(const f32x4*)(c + 4);
      const f32x4 z = {0.f, 0.f, 0.f, 0.f}; P.lwn[0] = z; P.lwn[1] = z; P.lan[0] = z; P.lan[1] = z;
      if (nb >= 0) { const float* an = SM + (size_t)nb * SMW + 32 + 64 * dir + p8; const float* cn = SM + (size_t)nb * SMW + 160 + 64 * dir + p8;
          P.lwn[0] = *(const f32x4*)an; P.lwn[1] = *(const f32x4*)(an + 4); P.lan[0] = *(const f32x4*)cn; P.lan[1] = *(const f32x4*)(cn + 4); } }
    const v4u z4 = {0u, 0u, 0u, 0u};
    { const int rw = h * 64 + p8, nb = nbrow(g, rw); P.r = *(const v4u*)(RKV + (size_t)g * 3072 + rw); P.rn = nb >= 0 ? *(const v4u*)(RKV + (size_t)nb * 3072 + rw) : z4; }
    { const int rw = 1024 + h * 64 + p8, nb = nbrow(g, rw); P.k = *(const v4u*)(RKV + (size_t)g * 3072 + rw); P.kn = nb >= 0 ? *(const v4u*)(RKV + (size_t)nb * 3072 + rw) : z4; }
    { const int rw = 2048 + h * 64 + p8, nb = nbrow(g, rw); P.v = *(const v4u*)(RKV + (size_t)g * 3072 + rw); P.vn = nb >= 0 ? *(const v4u*)(RKV + (size_t)nb * 3072 + rw) : z4; }
}
__device__ __forceinline__ bf16x8 lds_frag(const LAS bf16* p) { return *(const LAS bf16x8*)p; }
__device__ __forceinline__ bf16x8 lds_frag_k16(const LAS bf16* p, int quad) { const bf16x8 v = *(const LAS bf16x8*)p; const bf16x8 z = {0, 0, 0, 0, 0, 0, 0, 0}; return quad < 2 ? v : z; }
__device__ __forceinline__ bf16x8 lds_frag_perm(const LAS bf16* p) { const v2u lo = *(const LAS v2u*)p, hi = *(const LAS v2u*)(p + 16); const v4u w = {lo.x, lo.y, hi.x, hi.y}; return __builtin_bit_cast(bf16x8, w); }
__device__ __forceinline__ bf16x8 lds_frag_lo4(const LAS bf16* p) { const v2u lo = *(const LAS v2u*)p; const v4u w = {lo.x, lo.y, 0u, 0u}; return __builtin_bit_cast(bf16x8, w); }
__device__ __forceinline__ unsigned pk2(float lo, float hi) { typedef __bf16 bf2 __attribute__((ext_vector_type(2))); const bf2 v = {(__bf16)lo, (__bf16)hi}; return __builtin_bit_cast(unsigned, v); }
__device__ __forceinline__ bf16 f2b(float x) { return __builtin_bit_cast(unsigned short, (__bf16)x); }
__device__ __forceinline__ float b2f(bf16 x) { return __uint_as_float((unsigned)x << 16); }
#define MFMA16(a, b, c) __builtin_amdgcn_mfma_f32_16x16x32_bf16(a, b, c, 0, 0, 0)
__device__ __forceinline__ void rwkv_phase(Frame& F, int l, int first, int stride) {
    LAS unsigned char* L = F.lds;
    LAS bf16* Ab = (LAS bf16*)(L + RC_AB); LAS bf16* Bb = (LAS bf16*)(L + RC_BB); LAS bf16* Kb = (LAS bf16*)(L + RC_KB); LAS bf16* Rb = (LAS bf16*)(L + RC_RB);
    LAS bf16* BhT = (LAS bf16*)(L + RC_BHT); LAS bf16* KhT = (LAS bf16*)(L + RC_KHT); LAS bf16* AbT = (LAS bf16*)(L + RC_ABT); LAS bf16* GAKT = (LAS bf16*)(L + RC_GAKT); LAS float* BONP = (LAS float*)(L + RC_BONP);
    LAS bf16* TW = (LAS bf16*)(L + RC_TW); LAS bf16* AD = (LAS bf16*)(L + RC_AD);
    LAS bf16* KK16 = (LAS bf16*)(L + RC_KK16); LAS bf16* K16 = (LAS bf16*)(L + RC_K16); LAS bf16* R16 = (LAS bf16*)(L + RC_R16);
    LAS float* GAB = (LAS float*)(L + RC_GAB); LAS bf16* GAK = (LAS bf16*)(L + RC_GAK); LAS bf16* HRB = (LAS bf16*)(L + RC_HRB); LAS bf16* HRK = (LAS bf16*)(L + RC_HRK); LAS bf16* TT = (LAS bf16*)(L + RC_TT);
    LAS bf16* SAt = (LAS bf16*)(L + RC_SAT); LAS float* YO = (LAS float*)(L + RC_YO); LAS float* GL = (LAS float*)(L + RC_GL);
    LAS bf16* Vt = (LAS bf16*)(L + RC_VT); LAS bf16* Sb = (LAS bf16*)(L + RC_SB); LAS float* CN = (LAS float*)(L + RC_CONST); LAS bf16* W2T = (LAS bf16*)(L + RC_W2T); LAS bf16* A2T = (LAS bf16*)(L + RC_A2T);
    const float* SM = (const float*)(F.ws + WS_SM); const bf16* RKV = (const bf16*)(F.ws + WS_RKV); bf16* YS = (bf16*)(F.ws + WS_YS); float* BON = (float*)(F.ws + WS_BON);
    const bf16* WL = (const bf16*)(F.ws + WS_WLORA);
    const int tid = F.tid, lane = F.lane, wave = F.wave;
    for (int item = first; item < NB * 2 * RH; item += stride) {
        const int h = item & 15, dir = (item >> 4) & 1, b = item >> 5;
        __syncthreads();
        if (tid < 64) { const float* mu = INP(I_MU) + l * RW; CN[tid] = mu[h * 64 + tid]; CN[64 + tid] = mu[1024 + h * 64 + tid]; CN[128 + tid] = mu[2048 + h * 64 + tid];
            CN[192 + tid] = mu[3072 + 64 * dir + tid]; CN[256 + tid] = mu[3200 + 64 * dir + tid];
            CN[320 + tid] = INP(I_KK)[l * RD + h * 64 + tid]; CN[384 + tid] = INP(I_KA)[l * RD + h * 64 + tid]; CN[448 + tid] = INP(I_RK)[l * RD + h * 64 + tid];
            CN[512 + tid] = INP(I_W0)[(l * 2 + dir) * RD + h * 64 + tid]; CN[576 + tid] = INP(I_A0)[(l * 2 + dir) * RD + h * 64 + tid]; }
        { const int n = tid >> 3, p8 = (tid & 7) * 8;
          *(v4u*)(W2T + n * 72 + p8) = *(const v4u*)(WL + ((size_t)(0 * 2 + dir) * RD + h * 64 + n) * 64 + p8);
          *(v4u*)(A2T + n * 72 + p8) = *(const v4u*)(WL + ((size_t)(1 * 2 + dir) * RD + h * 64 + n) * 64 + p8); }
        for (int i = tid; i < (RC_CONST - RC_GL) / 4; i += NTHREADS) ((LAS unsigned*)(L + RC_GL))[i] = 0u;
        f32x4 ST[4]; for (int kt = 0; kt < 4; ++kt) ST[kt] = (f32x4){0.f, 0.f, 0.f, 0.f};
        RwPre P; rw_prefetch(P, SM, RKV, b, dir, h, 0, tid);
        __syncthreads();
        for (int j = 0; j < NCH; ++j) {
            { int tl = tid; asm volatile("" : "+v"(tl)); const int s = tl >> 3, p8 = (tl & 7) * 8;
              { float tw[8], ad[8]; const f32x4 muw[2] = {*(const f32x4*)&CN[192 + p8], *(const f32x4*)&CN[196 + p8]}, mua[2] = {*(const f32x4*)&CN[256 + p8], *(const f32x4*)&CN[260 + p8]};
#pragma unroll
                for (int i = 0; i < 8; ++i) { const float pw = P.lw[i >> 2][i & 3], pwn = P.lwn[i >> 2][i & 3], pa = P.la[i >> 2][i & 3], pan = P.lan[i >> 2][i & 3];
                    tw[i] = fast_tanh(pw + (pwn - pw) * muw[i >> 2][i & 3]); ad[i] = pa + (pan - pa) * mua[i >> 2][i & 3]; }
                *(v4u*)(TW + s * 72 + p8) = pack8(tw); *(v4u*)(AD + s * 72 + p8) = pack8(ad); }
              { float a[8], bq[8], o[8]; const f32x4 mur[2] = {*(const f32x4*)&CN[p8], *(const f32x4*)&CN[4 + p8]}, muk[2] = {*(const f32x4*)&CN[64 + p8], *(const f32x4*)&CN[68 + p8]};
                unpack8(P.r, a); unpack8(P.rn, bq);
#pragma unroll
                for (int i = 0; i < 8; ++i) o[i] = a[i] + (bq[i] - a[i]) * mur[i >> 2][i & 3];
                *(v4u*)(R16 + s * RP + p8) = pack8(o);
                unpack8(P.k, a); unpack8(P.kn, bq); float ssq = 0.f; const f32x4 kkc[2] = {*(const f32x4*)&CN[320 + p8], *(const f32x4*)&CN[324 + p8]};
#pragma unroll
                for (int i = 0; i < 8; ++i) { o[i] = a[i] + (bq[i] - a[i]) * muk[i >> 2][i & 3]; a[i] = o[i] * kkc[i >> 2][i & 3]; ssq += a[i] * a[i]; }
                *(v4u*)(K16 + s * RP + p8) = pack8(o);
                const float inv = 1.0f / fmaxf(sqrtf(red8(ssq)), 1e-12f);
#pragma unroll
                for (int i = 0; i < 8; ++i) a[i] *= inv;
                *(v4u*)(KK16 + s * RP + p8) = pack8(a);
                { unpack8(P.v, a); unpack8(P.vn, bq); const f32x4 muv[2] = {*(const f32x4*)&CN[128 + p8], *(const f32x4*)&CN[132 + p8]};
#pragma unroll
                  for (int i = 0; i < 8; ++i) Vt[(p8 + i) * RP + s] = f2b(a[i] + (bq[i] - a[i]) * muv[i >> 2][i & 3]); } } }
            __syncthreads();
            if (j + 1 < NCH) rw_prefetch(P, SM, RKV, b, dir, h, j + 1, tid);
            { int lb = lane; asm volatile("" : "+v"(lb)); const int r16 = lb & 15, quad = lb >> 4; const int c = wave >> 1;
              const bf16x8 a0 = lds_frag(TW + (16 * c + r16) * 72 + quad * 8), a1 = lds_frag(TW + (16 * c + r16) * 72 + 32 + quad * 8);
              const bf16x8 d0 = lds_frag(AD + (16 * c + r16) * 72 + quad * 8), d1 = lds_frag(AD + (16 * c + r16) * 72 + 32 + quad * 8);
              f32x4 cw[2], ca[2];
#pragma unroll
              for (int nn = 0; nn < 2; ++nn) { const int nt = 2 * (wave & 1) + nn; const f32x4 z = {0.f, 0.f, 0.f, 0.f};
                  cw[nn] = MFMA16(a0, lds_frag(W2T + (16 * nt + r16) * 72 + quad * 8), z); cw[nn] = MFMA16(a1, lds_frag(W2T + (16 * nt + r16) * 72 + 32 + quad * 8), cw[nn]);
                  ca[nn] = MFMA16(d0, lds_frag(A2T + (16 * nt + r16) * 72 + quad * 8), z); ca[nn] = MFMA16(d1, lds_frag(A2T + (16 * nt + r16) * 72 + 32 + quad * 8), ca[nn]); }
              __syncthreads();
              float bsum[4] = {0.f, 0.f, 0.f, 0.f};
#pragma unroll
              for (int nn = 0; nn < 2; ++nn) { const int nt = 2 * (wave & 1) + nn, n = 16 * nt + r16; const float w0c = CN[512 + n], a0c = CN[576 + n], kac = CN[384 + n], rkc = CN[448 + n];
                  float wv[4], av[4], pin[4], pex[4];
#pragma unroll
                  for (int i = 0; i < 4; ++i) { wv[i] = __expf(-0.60653066f * sigmoidf_(w0c + cw[nn][i])); av[i] = sigmoidf_(a0c + ca[nn][i]); }
                  pin[0] = wv[0]; pin[1] = pin[0] * wv[1]; pin[2] = pin[1] * wv[2]; pin[3] = pin[2] * wv[3];
                  float x = pin[3], y = __shfl_up(x, 16); if (quad >= 1) x *= y; y = __shfl_up(x, 32); if (quad >= 2) x *= y;
                  float ex = __shfl_up(x, 16); if (quad == 0) ex = 1.0f; const float gl = __shfl(x, 48 + r16);
                  pex[0] = ex; pex[1] = ex * pin[0]; pex[2] = ex * pin[1]; pex[3] = ex * pin[2];
#pragma unroll
                  for (int i = 0; i < 4; ++i) pin[i] *= ex;
                  float abv[4], bhv[4], khv[4];
#pragma unroll
                  for (int i = 0; i < 4; ++i) { const int t = 16 * c + 4 * quad + i; const float kk = b2f(KK16[t * RP + n]), kx = b2f(K16[t * RP + n]), rr = b2f(R16[t * RP + n]);
                      const float kka = kk * av[i], kd = kx * (1.0f + (av[i] - 1.0f) * kac), gi_ = __builtin_amdgcn_rcpf(pin[i]), bb = kka * gi_, kb = kd * gi_;
                      abv[i] = kk * pex[i]; bhv[i] = bb * gl; khv[i] = kb * gl; bsum[i] += rr * kd * rkc;
                      Ab[t * RP + n] = f2b(abv[i]); Rb[t * RP + n] = f2b(rr * pin[i]); Bb[t * RP + n] = f2b(bb); Kb[t * RP + n] = f2b(kb); }
                  { v2u o; o.x = cvt_pk_bf16(abv[0], abv[1]); o.y = cvt_pk_bf16(abv[2], abv[3]); *(v2u*)(AbT + n * RP + 16 * c + 4 * quad) = o;
                    o.x = cvt_pk_bf16(bhv[0], bhv[1]); o.y = cvt_pk_bf16(bhv[2], bhv[3]); *(v2u*)(BhT + n * RP + 16 * c + 4 * quad) = o;
                    o.x = cvt_pk_bf16(khv[0], khv[1]); o.y = cvt_pk_bf16(khv[2], khv[3]); *(v2u*)(KhT + n * RP + 16 * c + 4 * quad) = o; }
                  if (quad == 3) GL[c * 64 + n] = gl;
              }
#pragma unroll
              for (int i = 0; i < 4; ++i) { const float tot = red16(bsum[i]); if (r16 == 0) BONP[(16 * c + 4 * quad + i) * 2 + (wave & 1)] = tot; } }
            __syncthreads();
            { int lf_ = lane; asm volatile("" : "+v"(lf_)); const int r16 = lf_ & 15, quad = lf_ >> 4; const int c = wave & 3, odd = wave >> 2; const LAS bf16* Asrc = odd ? Rb : Ab;     const f32x4 z = {0.f, 0.f, 0.f, 0.f};
              const bf16x8 a0 = lds_frag(Asrc + (16 * c + r16) * RP + quad * 8), a1 = lds_frag(Asrc + (16 * c + r16) * RP + 32 + quad * 8);
              f32x4 g1 = MFMA16(a0, lds_frag(Bb + (16 * c + r16) * RP + quad * 8), z); g1 = MFMA16(a1, lds_frag(Bb + (16 * c + r16) * RP + 32 + quad * 8), g1);
              f32x4 g2 = MFMA16(a0, lds_frag(Kb + (16 * c + r16) * RP + quad * 8), z); g2 = MFMA16(a1, lds_frag(Kb + (16 * c + r16) * RP + 32 + quad * 8), g2);
              if (wave == 7) { const float bs = BONP[lf_ * 2] + BONP[lf_ * 2 + 1]; BON[((size_t)dir * R + row_of(b, tok(dir, j * 64 + lf_))) * RH + h] = bs; }
              float v2m[4];
#pragma unroll
              for (int i = 0; i < 4; ++i) { const int t = 4 * quad + i; const bool keep = odd ? (r16 <= t) : (r16 < t); const float v1 = keep ? g1[i] : 0.f; v2m[i] = keep ? g2[i] : 0.f;
                  if (odd) { HRB[c * 384 + t * 24 + r16] = f2b(v1); HRK[c * 384 + t * 24 + r16] = f2b(v2m[i]); } else { GAB[c * 256 + t * 16 + r16] = v1; GAK[c * 384 + t * 24 + r16] = f2b(v2m[i]); } }
              if (!odd) { { v2u o; o.x = cvt_pk_bf16(v2m[0], v2m[1]); o.y = cvt_pk_bf16(v2m[2], v2m[3]); *(v2u*)(GAKT + c * 384 + r16 * 24 + 4 * quad) = o; }
                  LDS_WAIT(); __builtin_amdgcn_wave_barrier();
                  float tj[16];
                  tj[0] = (r16 == 0) ? 1.0f : 0.f;
#pragma unroll
                  for (int i = 1; i < 16; ++i) { const LAS f32x4* gr = (const LAS f32x4*)(GAB + c * 256 + i * 16); float acc0 = (r16 == i) ? 1.0f : 0.f, acc1 = 0.f;
#pragma unroll
                      for (int q = 0; q < (i + 3) / 4; ++q) { const f32x4 g4 = gr[q];
#pragma unroll
                          for (int e = 0; e < 4; ++e) { const int jj = 4 * q + e; if (jj < i) { if (jj & 1) acc1 -= g4[e] * tj[jj]; else acc0 -= g4[e] * tj[jj]; } } }
                      tj[i] = acc0 + acc1; }
                  if (quad == 0) {
#pragma unroll
                      for (int i = 0; i < 16; ++i) TT[c * 384 + i * 24 + r16] = f2b(tj[i]); } } }
            __syncthreads();
            { int lg = lane; asm volatile("" : "+v"(lg)); const int r16 = lg & 15, quad = lg >> 4; const int c = wave & 3, half = wave >> 2; const f32x4 z = {0.f, 0.f, 0.f, 0.f};
              const bf16x8 ta = lds_frag_k16(TT + c * 384 + r16 * 24 + quad * 8, quad);
              f32x4 o0 = MFMA16(ta, lds_frag(AbT + (16 * (2 * half) + r16) * RP + 16 * c + (quad & 1) * 8), z), o1 = MFMA16(ta, lds_frag(AbT + (16 * (2 * half + 1) + r16) * RP + 16 * c + (quad & 1) * 8), z);
              f32x4 og = z; if (!half) og = MFMA16(ta, lds_frag(GAKT + c * 384 + r16 * 24 + (quad & 1) * 8), z);
#pragma unroll
              for (int i = 0; i < 4; ++i) { const int t = 4 * quad + i; Ab[(16 * c + t) * RP + 16 * (2 * half) + r16] = f2b(o0[i]); Ab[(16 * c + t) * RP + 16 * (2 * half + 1) + r16] = f2b(o1[i]); if (!half) GAK[c * 384 + t * 24 + r16] = f2b(og[i]); } }
            __syncthreads();
            if (wave < 4) {
                int lc = lane; asm volatile("" : "+v"(lc)); const int r16 = lc & 15, quad = lc >> 4, vnt = wave;
#pragma unroll 1
                for (int c = 0; c < 4; ++c) {
                    bf16x8 sb[2];
#pragma unroll
                    for (int ks = 0; ks < 2; ++ks) { v4u w; w.x = pk2(ST[2 * ks][0], ST[2 * ks][1]); w.y = pk2(ST[2 * ks][2], ST[2 * ks][3]); w.z = pk2(ST[2 * ks + 1][0], ST[2 * ks + 1][1]); w.w = pk2(ST[2 * ks + 1][2], ST[2 * ks + 1][3]); sb[ks] = __builtin_bit_cast(bf16x8, w); }
                    const v2u vmw = *(const LAS v2u*)(Vt + (16 * vnt + r16) * RP + 16 * c + 4 * quad); const v4u vm4 = {vmw.x, vmw.y, 0u, 0u}; const bf16x8 vmb = __builtin_bit_cast(bf16x8, vm4);
                    f32x4 sa = {0.f, 0.f, 0.f, 0.f}, yy = {0.f, 0.f, 0.f, 0.f};
#pragma unroll
                    for (int ks = 0; ks < 2; ++ks) { sa = MFMA16(lds_frag_perm(Ab + (16 * c + r16) * RP + 32 * ks + 4 * quad), sb[ks], sa); yy = MFMA16(lds_frag_perm(Rb + (16 * c + r16) * RP + 32 * ks + 4 * quad), sb[ks], yy); }
                    sa = MFMA16(lds_frag_lo4(GAK + c * 384 + r16 * 24 + 4 * quad), vmb, sa); yy = MFMA16(lds_frag_lo4(HRK + c * 384 + r16 * 24 + 4 * quad), vmb, yy);
                    const v4u sa4 = {pk2(sa[0], sa[1]), pk2(sa[2], sa[3]), 0u, 0u}; const bf16x8 sab = __builtin_bit_cast(bf16x8, sa4);
                    const f32x4 z = {0.f, 0.f, 0.f, 0.f};
                    const f32x4 dy = MFMA16(lds_frag_lo4(HRB + c * 384 + r16 * 24 + 4 * quad), sab, z);
#pragma unroll
                    for (int i = 0; i < 4; ++i) YO[(16 * c + 4 * quad + i) * 64 + 16 * vnt + r16] = yy[i] - dy[i];
#pragma unroll
                    for (int kt = 0; kt < 4; ++kt) { const f32x4 e_ = MFMA16(lds_frag_lo4(BhT + (16 * kt + r16) * RP + 16 * c + 4 * quad), sab, z), d_ = MFMA16(lds_frag_lo4(KhT + (16 * kt + r16) * RP + 16 * c + 4 * quad), vmb, z);
                        const f32x4 gl4 = *(const LAS f32x4*)&GL[c * 64 + 16 * kt + 4 * quad]; ST[kt] = ST[kt] * gl4 + d_ - e_; }
                }
            }
            __syncthreads();
            { int to = tid; asm volatile("" : "+v"(to)); const int s4 = to >> 3, q8 = (to & 7) * 8; const f32x4 y0 = *(const f32x4*)&YO[s4 * 64 + q8], y1 = *(const f32x4*)&YO[s4 * 64 + q8 + 4];
              v4u o; o.x = cvt_pk_bf16(y0.x, y0.y); o.y = cvt_pk_bf16(y0.z, y0.w); o.z = cvt_pk_bf16(y1.x, y1.y); o.w = cvt_pk_bf16(y1.z, y1.w);
              *(v4u*)(YS + ((size_t)dir * R + row_of(b, tok(dir, j * 64 + s4))) * RD + h * 64 + q8) = o; }
            __syncthreads();
        }
    }
}
template <int PART> __device__ __forceinline__ void finish_phase(Frame& F, int l, int nrows, int first, int stride) {
    const bf16* HF = (const bf16*)(F.ws + WS_HF); const bf16* O = (const bf16*)(F.ws + WS_O); bf16* HM = (bf16*)(F.ws + WS_HM);
    const bf16* YS = (const bf16*)(F.ws + WS_YS); const bf16* RKV = (const bf16*)(F.ws + WS_RKV); const bf16* Gb = (const bf16*)(F.ws + WS_H); const float* BON = (const float*)(F.ws + WS_BON); bf16* YR = (bf16*)(F.ws + WS_YR);
    const int lane = F.lane, c0 = lane * 16;
    float k1[16], k2[16], k3[16];
    { const float* p1 = PART == 0 ? INP(I_GMN) + l * 1024 + c0 : INP(I_LNW) + l * RD + c0; const float* p2 = INP(I_LNB) + l * RD + c0; const float* p3 = INP(I_MU) + l * RW + 2048 + c0;
#pragma unroll
      for (int q = 0; q < 4; ++q) { const f32x4 t1 = *(const f32x4*)(p1 + 4 * q); k1[4 * q] = t1.x; k1[4 * q + 1] = t1.y; k1[4 * q + 2] = t1.z; k1[4 * q + 3] = t1.w;
          if (PART == 1) { const f32x4 t2 = *(const f32x4*)(p2 + 4 * q), t3 = *(const f32x4*)(p3 + 4 * q); k2[4 * q] = t2.x; k2[4 * q + 1] = t2.y; k2[4 * q + 2] = t2.z; k2[4 * q + 3] = t2.w; k3[4 * q] = t3.x; k3[4 * q + 1] = t3.y; k3[4 * q + 2] = t3.z; k3[4 * q + 3] = t3.w; } } }
    const bf16* S0 = PART == 0 ? HF : YS;
    int g = first * NWAVES + F.wave; const int gstep = stride * NWAVES;
    v4u n0 = {0u, 0u, 0u, 0u}, n1 = n0, n2 = n0, n3 = n0;
    if (g < nrows) { n0 = *(const v4u*)(S0 + (size_t)g * 1024 + c0); n1 = *(const v4u*)(S0 + ((size_t)R + g) * 1024 + c0); n2 = *(const v4u*)(S0 + (size_t)g * 1024 + c0 + 8); n3 = *(const v4u*)(S0 + ((size_t)R + g) * 1024 + c0 + 8); }
    for (; g < nrows; g += gstep) {
        const v4u c_0 = n0, c_1 = n1, c_2 = n2, c_3 = n3;
        { const int gn = g + gstep; if (gn < nrows) { n0 = *(const v4u*)(S0 + (size_t)gn * 1024 + c0); n1 = *(const v4u*)(S0 + ((size_t)R + gn) * 1024 + c0); n2 = *(const v4u*)(S0 + (size_t)gn * 1024 + c0 + 8); n3 = *(const v4u*)(S0 + ((size_t)R + gn) * 1024 + c0 + 8); } }
        float y[16], a[8], bq[8];
        unpack8(c_0, a); unpack8(c_1, bq);
#pragma unroll
        for (int i = 0; i < 8; ++i) y[i] = a[i] + bq[i];
        unpack8(c_2, a); unpack8(c_3, bq);
#pragma unroll
        for (int i = 0; i < 8; ++i) y[8 + i] = a[i] + bq[i];
        if (PART == 0) {
            float ss = 0.f;
#pragma unroll
            for (int i = 0; i < 16; ++i) ss += y[i] * y[i];
            const float rs = 1.0f / sqrtf(red8(ss) * (1.0f / DV) + NORM_EPS);
            float og[16]; unpack8(*(const v4u*)(O + (size_t)g * 1024 + c0), a); unpack8(*(const v4u*)(O + (size_t)g * 1024 + c0 + 8), bq);
#pragma unroll
            for (int i = 0; i < 8; ++i) { og[i] = a[i]; og[8 + i] = bq[i]; }
            float o1[8], o2[8];
#pragma unroll
            for (int i = 0; i < 8; ++i) { o1[i] = y[i] * rs * k1[i] * sigmoidf_(og[i]); o2[i] = y[8 + i] * rs * k1[8 + i] * sigmoidf_(og[8 + i]); }
            *(v4u*)(HM + (size_t)g * 1024 + c0) = pack8(o1); *(v4u*)(HM + (size_t)g * 1024 + c0 + 8) = pack8(o2);
        }
        if (PART == 1) {
            float sm_ = 0.f;
#pragma unroll
            for (int i = 0; i < 16; ++i) sm_ += y[i];
            const float mean = red4(sm_) * (1.0f / RN); float vs = 0.f;
#pragma unroll
            for (int i = 0; i < 16; ++i) { const float dl = y[i] - mean; vs += dl * dl; }
            const float rs = 1.0f / sqrtf(red4(vs) * (1.0f / RN) + GN_EPS);
            const int hh = lane >> 2; const float bon = BON[(size_t)g * RH + hh] + BON[((size_t)R + g) * RH + hh];
            float vm[16], gg[16];
#pragma unroll
            for (int half = 0; half < 2; ++half) { const int rw = 2048 + c0 + 8 * half, nb = nbrow(g, rw); unpack8(*(const v4u*)(RKV + (size_t)g * 3072 + rw), a);
                if (nb >= 0) unpack8(*(const v4u*)(RKV + (size_t)nb * 3072 + rw), bq); else {
#pragma unroll
                    for (int i = 0; i < 8; ++i) bq[i] = 0.f; }
#pragma unroll
                for (int i = 0; i < 8; ++i) vm[8 * half + i] = a[i] + (bq[i] - a[i]) * k3[8 * half + i];
                unpack8(*(const v4u*)(Gb + (size_t)g * RD + c0 + 8 * half), a);
#pragma unroll
                for (int i = 0; i < 8; ++i) gg[8 * half + i] = a[i]; }
            float o1[8], o2[8];
#pragma unroll
            for (int i = 0; i < 8; ++i) { o1[i] = ((y[i] - mean) * rs * k1[i] + k2[i] + bon * vm[i]) * gg[i]; o2[i] = ((y[8 + i] - mean) * rs * k1[8 + i] + k2[8 + i] + bon * vm[8 + i]) * gg[8 + i]; }
            *(v4u*)(YR + (size_t)g * RD + c0) = pack8(o1); *(v4u*)(YR + (size_t)g * RD + c0 + 8) = pack8(o2);
        }
    }
}
struct MoeMeta { int off[NE + 1]; };
__device__ __forceinline__ MoeMeta moe_meta(Frame& F) {
    MoeMeta m; int o = 0;
#pragma unroll
    for (int e = 0; e < NE; ++e) { m.off[e] = o; const unsigned c = __hip_atomic_load((unsigned*)(F.ctl + CW_ECNT + 64 * e), RLX_AGENT); o += (int)((c + 255u) & ~255u); }
    m.off[NE] = o; return m;
}
__device__ __forceinline__ void gather_phase(Frame& F) {
    const MoeMeta m = moe_meta(F);
    if (F.bid == 0 && F.tid < MAXSLOT / 256) { int e = 0;
#pragma unroll
        for (int q = 1; q <= NE - 1; ++q) e += ((int)F.tid * 256 >= m.off[q]) ? 1 : 0;
        ((int*)(F.ws + WS_META + 768 * 1024))[F.tid] = e; }
    const bf16* H = (const bf16*)(F.ws + WS_H); unsigned char* HG = (unsigned char*)(F.ws + WS_HG);
    for (int w = F.bid * NWAVES + F.wave; w < RL * 2; w += F.G * NWAVES) { const int g = w >> 1, k = w & 1; int* tk = (int*)(F.ws + WS_META) + (size_t)g * 8; const int e = tk[k], pos = tk[2 + k];
        int base = 0;
#pragma unroll
        for (int q = 0; q < NE; ++q) base = (e == q) ? m.off[q] : base;
        const int slot = base + pos; if (F.lane == 0) tk[6 + k] = slot;
        const v4u* src = (const v4u*)(H + (size_t)g * D); float a[8], c8[8];
        unpack8(src[2 * F.lane], a); unpack8(src[2 * F.lane + 1], c8);
#pragma unroll
        for (int i = 0; i < 8; ++i) { a[i] = __builtin_amdgcn_fmed3f(a[i], -448.0f, 448.0f); c8[i] = __builtin_amdgcn_fmed3f(c8[i], -448.0f, 448.0f); }
        v4u o; o.x = pk4_fp8(a[0], a[1], a[2], a[3]); o.y = pk4_fp8(a[4], a[5], a[6], a[7]); o.z = pk4_fp8(c8[0], c8[1], c8[2], c8[3]); o.w = pk4_fp8(c8[4], c8[5], c8[6], c8[7]);
        *(v4u*)(HG + (size_t)slot * D + 16 * F.lane) = o; }
}
__device__ __forceinline__ void final_phase(Frame& F, const float* MODl) {
    const bf16* Y2 = (const bf16*)(F.ws + WS_Y2); const float* gfp = INP(I_GF);
    f32x4 gf[4];
#pragma unroll
    for (int j = 0; j < 4; ++j) gf[j] = *(const f32x4*)(gfp + 256 * j + 4 * F.lane);
    int g = F.bid * NWAVES + F.wave; const int gstep = F.G * NWAVES;
    int s0n = 0, s1n = 0; float p0n = 0.f, p1n = 0.f;
    if (g < RL) { const int* tk = (const int*)(F.ws + WS_META) + (size_t)g * 8; s0n = tk[6]; s1n = tk[7]; p0n = ((const float*)tk)[4]; p1n = ((const float*)tk)[5]; }
    for (; g < RL; g += gstep) {
        const int s0 = s0n, s1 = s1n; const float p0 = p0n, p1 = p1n;
        float* xr = (float*)F.out + (size_t)g * D; const float* gt = MODl + (g / T) * 6 * D + 5 * D; f32x4 x[4], gq[4]; v2u ya[4], yb[4];
#pragma unroll
        for (int j = 0; j < 4; ++j) { const int c = 256 * j + 4 * F.lane; x[j] = *(const f32x4*)(xr + c); gq[j] = *(const f32x4*)(gt + c); ya[j] = *(const v2u*)(Y2 + (size_t)s0 * D + c); yb[j] = *(const v2u*)(Y2 + (size_t)s1 * D + c); }
        { const int gn = g + gstep; if (gn < RL) { const int* tk = (const int*)(F.ws + WS_META) + (size_t)gn * 8; s0n = tk[6]; s1n = tk[7]; p0n = ((const float*)tk)[4]; p1n = ((const float*)tk)[5]; } }
        f32x4 v[4]; float ss = 0.f;
#pragma unroll
        for (int j = 0; j < 4; ++j) { const v2u a = ya[j], bq = yb[j];
            f32x4 y; y.x = p0 * bflo(a.x) + p1 * bflo(bq.x); y.y = p0 * bfhi(a.x) + p1 * bfhi(bq.x); y.z = p0 * bflo(a.y) + p1 * bflo(bq.y); y.w = p0 * bfhi(a.y) + p1 * bfhi(bq.y);
            v[j] = x[j] + gq[j] * y; ss += (v[j].x * v[j].x + v[j].y * v[j].y) + (v[j].z * v[j].z + v[j].w * v[j].w); }
        const float rstd = 1.0f / sqrtf(wave_sum(ss) * (1.0f / D) + NORM_EPS);
#pragma unroll
        for (int j = 0; j < 4; ++j) { const int c = 256 * j + 4 * F.lane; *(f32x4*)(xr + c) = v[j] * rstd * gf[j]; }
    }
}

#ifndef MK_SPLIT
#define MK_SPLIT 0
#endif
constexpr int PPL = 12, NPHASE = 1 + NL * PPL + 1;
__device__ __forceinline__ GAS unsigned char* launder_ws(GAS unsigned char* p) { asm volatile("" : "+s"(p)); return p; }
__device__ __forceinline__ const CAS Args* launder_args(const CAS Args* p) { asm volatile("" : "+s"(p)); return p; }
__device__ __forceinline__ void grid_barrier(unsigned* barw, unsigned x, volatile LAS unsigned* st) { XcdBarrier b; b.bar = barw; b.x = x; b.st = st; xcd_barrier(b); }
#define IN(k) (lo <= (k) && (k) < hi)
#define SEAM(k) do { if (IN(k) && IN((k) + 1)) grid_barrier(bar.bar, bar.x, bar.st); } while (0)
#define PH_BEGIN { int t_ = threadIdx.x; asm volatile("" : "+v"(t_)); F.tid = t_; F.lane = t_ & 63; F.wave = __builtin_amdgcn_readfirstlane(t_ >> 6); int b_ = blockIdx.x; asm volatile("" : "+s"(b_)); F.bid = b_; F.cb = b_; F.cg = F.G; } \
        GAS unsigned char* ws = launder_ws(args.ws); F.ws = ws; F.A = launder_args((const CAS Args*)__builtin_amdgcn_kernarg_segment_ptr()); float* MOD = (float*)(ws + WS_MOD); float* XC = (float*)(ws + WS_XC); bf16* Hb = (bf16*)(ws + WS_H); \
        const float* MODl = MOD + (size_t)l * 5 * 6 * D; const float* xl = l == 0 ? INP(I_X) : (const float*)F.out; const float* xc = l == 0 ? INP(I_CTX) : XC; (void)MODl; (void)xl; (void)xc; (void)Hb;
template <int l> __device__ __forceinline__ void layer_body(Frame& F, const Args& args, const int lo, const int hi, const XcdBarrier& bar) {
        const int p0 = 1 + l * PPL; const bool last = (l == NL - 1);
        const int Mrows = last ? RL : R;
        if (IN(p0 + 0)) { PH_BEGIN if (l == 0) normmod_phase<false>(F, xl, xc, INP(I_GNM) + l * D, MODl, 0, D, R, nullptr);
            else { normmod_ctx_slabs(F, xc, (const float*)(ws + WS_S2), INP(I_GNM) + l * D, MODl, 0, D); normmod_phase<false>(F, xl, xc, INP(I_GNM) + l * D, MODl, 0, D, RL, nullptr); conv_rest(F, l); } }
        SEAM(p0 + 0);
        if (IN(p0 + 1)) { PH_BEGIN pg8::Gemm g{Hb, (const bf16*)(ws + WS_WIN), R, NPAD, D}; pg8::EpiInproj E{ws};
            if (!last) { pg8::StaticOrder S; S.init(R, NPAD, F.G, F.bid); pg8::gemm_phase<pg8::EpiInproj, pg8::StaticOrder, true, true>(F.lds, g, S, E); }
            else { pg8::InprojLastOrder S; S.G = F.G; S.c = F.bid; pg8::gemm_phase<pg8::EpiInproj, pg8::InprojLastOrder, true, true>(F.lds, g, S, E); } }
        if (IN(p0 + 1) && IN(p0 + 3)) grid_barrier(bar.bar, bar.x, bar.st);
        if (IN(p0 + 3)) { PH_BEGIN const int nR = F.G / 2;
            if (F.bid < nR) rwkv_phase(F, l, F.bid, nR);
            else { F.cb = F.bid - nR; F.cg = F.G - nR; gu32* sub = F.ctl + CW_SUB + 64 * l;
                   sg_phase(F, l); subgrid_arrive(F, sub);
                   mlstm_phase(F, l, F.cb, F.cg); __syncthreads();
                   if (!last) { conv_ffn0(F); conv_win(F, l + 1); }
                   subgrid_arrive(F, sub + 128);
                   subgrid_wait(F, sub, (unsigned)F.cg); subgrid_wait(F, sub + 128, (unsigned)F.cg);
                   finish_phase<0>(F, l, Mrows, F.cb, F.cg); } }
        if (IN(p0 + 3)) { PH_BEGIN const int nR = F.G / 2;
            if (F.bid >= nR) { int kg = 256; asm volatile("" : "+s"(kg));
                pg8::Gemm g{(const bf16*)(ws + WS_SG), (const bf16*)(ws + WS_WG2), R, RD, kg}; pg8::StaticOrder S; S.init(Mrows, RD, F.G - nR, F.bid - nR);
                pg8::EpiStore E{Hb, RD};
                pg8::gemm_phase<pg8::EpiStore, pg8::StaticOrder, true, true>(F.lds, g, S, E); } }
        SEAM(p0 + 3);
        if (IN(p0 + 4)) { PH_BEGIN finish_phase<1>(F, l, Mrows, F.bid, F.G); }
        SEAM(p0 + 4);
        if (IN(p0 + 5)) { PH_BEGIN pg8::Gemm g{(const bf16*)(ws + WS_HM), (const bf16*)(ws + WS_WPM), Mrows, D, D}; pg8::StaticOrder S; S.init(Mrows, D, F.G, F.bid);
            pg8::EpiMerge<0> E{(const bf16*)(ws + WS_MGT), (bf16*)(ws + WS_T1), nullptr};
            pg8::gemm_phase<pg8::EpiMerge<0>, pg8::StaticOrder, true, true>(F.lds, g, S, E); }
        SEAM(p0 + 5);
        if (IN(p0 + 6)) { PH_BEGIN pg8::Gemm g{(const bf16*)(ws + WS_YR), (const bf16*)(ws + WS_WPR), Mrows, D, D}; pg8::StaticOrder S; S.init(Mrows, D, F.G, F.bid);
            pg8::EpiMerge<1> E{(const bf16*)(ws + WS_MGT), (bf16*)(ws + WS_T1), Hb};
            pg8::gemm_phase<pg8::EpiMerge<1>, pg8::StaticOrder, true, true>(F.lds, g, S, E); }
        SEAM(p0 + 6);
        if (IN(p0 + 7)) { PH_BEGIN pg8::Gemm g{Hb, (const bf16*)(ws + WS_WOUT), Mrows, D, D}; pg8::StaticOrder S; S.init(Mrows, D, F.G, F.bid);
            pg8::EpiResid E{xl, xc, (float*)F.out, XC, MODl + 2 * D};
            pg8::gemm_phase<pg8::EpiResid, pg8::StaticOrder, true, true>(F.lds, g, S, E); }
        SEAM(p0 + 7);
        if (IN(p0 + 8)) { PH_BEGIN if (!last) normmod_phase<false>(F, (const float*)F.out, XC, INP(I_GNF) + l * D, MODl, 3 * D, 4 * D, Mrows, nullptr);
                          else normmod_phase<true>(F, (const float*)F.out, XC, INP(I_GNF) + l * D, MODl, 3 * D, 4 * D, Mrows, INP(I_WR)); }
        SEAM(p0 + 8);
        if (!last) {
            if (IN(p0 + 9)) { PH_BEGIN pg8::Gemm g{Hb, (const bf16*)(ws + WS_WGU), Mrows, 2 * FF, D}; pg8::StaticOrder S; S.init(Mrows, 2 * FF, F.G, F.bid);
                pg8::EpiSwigluCtx E{(bf16*)(ws + WS_HH0), FF, (bf16*)(ws + WS_HH0) + (size_t)RL * FF, RL / 256};
                pg8::gemm_phase<pg8::EpiSwigluCtx, pg8::StaticOrder, true, true>(F.lds, g, S, E); }
            SEAM(p0 + 9);
            if (IN(p0 + 10)) { PH_BEGIN pg8::Gemm g{(const bf16*)(ws + WS_HH0), (const bf16*)(ws + WS_WDN), RL, D, FF}; pg8::StaticOrder S; S.init(RL, D, F.G, F.bid);
                pg8::EpiResid E{(const float*)F.out, XC, (float*)F.out, XC, MODl + 5 * D};
                pg8::gemm_phase<pg8::EpiResid, pg8::StaticOrder, true, true>(F.lds, g, S, E); }
            if (IN(p0 + 10)) { PH_BEGIN int kg = 256; asm volatile("" : "+s"(kg));
                pg8::Gemm g{(const bf16*)(ws + WS_HH0) + (size_t)RL * FF, (const bf16*)(ws + WS_WDNS), RC, D, kg}; pg8::CtxSliceOrder S; S.nS = NSL; S.G = F.G; S.c = (F.bid + 128) % F.G;
                pg8::EpiSlab E{(float*)(ws + WS_S2), MODl + 4 * 6 * D + 5 * D};
                pg8::gemm_phase<pg8::EpiSlab, pg8::CtxSliceOrder, true, true>(F.lds, g, S, E); }
            if (IN(p0 + 10) && IN(p0 + 12)) grid_barrier(bar.bar, bar.x, bar.st);
        } else {
            if (IN(p0 + 9)) { PH_BEGIN conv_experts(F); gather_phase(F); }
            SEAM(p0 + 9);
            if (IN(p0 + 10)) { PH_BEGIN const MoeMeta mm = moe_meta(F); pg8::MoeOrder S; S.ntiles = mm.off[NE] / 256; S.nN = 2 * FE / 256; S.nwg = S.ntiles * S.nN; S.G = F.G; S.c = F.bid; S.texp = (const int*)(ws + WS_META + 768 * 1024);
                int ke = D / 2; asm volatile("" : "+s"(ke));
                pg8::Gemm g{(const bf16*)(ws + WS_HG), (const bf16*)(ws + WS_WEGU), 0, 2 * FE, ke}; pg8::EpiSwiglu8 E{(unsigned char*)(ws + WS_HHE), FE};
                pg8::gemm_phase<pg8::EpiSwiglu8, pg8::MoeOrder, true, true, true>(F.lds, g, S, E); }
            SEAM(p0 + 10);
            if (IN(p0 + 11)) { PH_BEGIN const MoeMeta mm = moe_meta(F); pg8::MoeOrder S; S.ntiles = mm.off[NE] / 256; S.nN = D / 256; S.nwg = S.ntiles * S.nN; S.G = F.G; S.c = F.bid; S.texp = (const int*)(ws + WS_META + 768 * 1024);
                int ke = FE / 2; asm volatile("" : "+s"(ke));
                pg8::Gemm g{(const bf16*)(ws + WS_HHE), (const bf16*)(ws + WS_WEDN), 0, D, ke}; pg8::EpiStoreScaled E{(bf16*)(ws + WS_Y2), D, 1.0f / W8S};
                pg8::gemm_phase<pg8::EpiStoreScaled, pg8::MoeOrder, true, true, true>(F.lds, g, S, E); }
            SEAM(p0 + 11);
        }
    }
__global__ void __launch_bounds__(NTHREADS, 2) mk_fwd(Args args) {
    extern __shared__ __attribute__((aligned(16))) unsigned char lds[];
    Frame F;
    F.lds = (LAS unsigned char*)lds; F.MISC = (volatile LAS unsigned*)(F.lds + MISC_OFF);
    F.tid = threadIdx.x; F.lane = F.tid & 63; F.wave = __builtin_amdgcn_readfirstlane(F.tid >> 6); F.G = gridDim.x; F.bid = blockIdx.x;
    F.ws = args.ws; F.out = args.out; F.ctl = (gu32*)(args.ws + WS_CTL);
    F.A = (const CAS Args*)__builtin_amdgcn_kernarg_segment_ptr();
    if (F.tid < 64) F.MISC[F.tid] = 0u;
    __syncthreads();
    const int lo = args.ph_lo, hi = args.ph_hi;
    XcdBarrier bar; bar.bar = (unsigned*)(F.ctl + CW_BAR) + args.li * XCD_BAR_WORDS; bar.x = 0; bar.st = nullptr;
    if (hi - lo > 1) bar = xcd_barrier_post((unsigned*)(F.ctl + CW_BAR) + args.li * XCD_BAR_WORDS, F.MISC + 8);

    if (IN(0)) { const int l = 0; PH_BEGIN mod_phase(F); conv_win(F, 0); conv_rest(F, 0); }
    SEAM(0);

    layer_body<0>(F, args, lo, hi, bar);
    layer_body<1>(F, args, lo, hi, bar);
    if (IN(NPHASE - 1)) { const int l = NL - 1; PH_BEGIN final_phase(F, MODl); }
#undef IN
#undef SEAM
}

extern "C" void kernel_launch(void* const* d_in, const int* in_sizes, int n_in, void* d_out, int out_size, void* d_ws, size_t ws_size, hipStream_t stream) {
    static int grid = 0;
    if (grid == 0) {
        if (n_in != 33 || out_size != RL * D || ws_size < WS_NEED) { fprintf(stderr, "kernel_launch: unexpected problem (n_in %d, out %d, ws %zu < %zu)\n", n_in, out_size, ws_size, (size_t)WS_NEED); grid = -1; return; }
        int dev = 0, cus = 0, per_cu = 0;
        if (hipGetDevice(&dev) != hipSuccess || hipDeviceGetAttribute(&cus, hipDeviceAttributeMultiprocessorCount, dev) != hipSuccess) { grid = -1; return; }
        if (hipFuncSetAttribute((const void*)mk_fwd, hipFuncAttributeMaxDynamicSharedMemorySize, LDS_BYTES) != hipSuccess) { fprintf(stderr, "kernel_launch: hipFuncSetAttribute failed\n"); grid = -1; return; }
        if (hipOccupancyMaxActiveBlocksPerMultiprocessor(&per_cu, (const void*)mk_fwd, NTHREADS, LDS_BYTES) != hipSuccess || per_cu < 1) { fprintf(stderr, "kernel_launch: occupancy query says %d\n", per_cu); grid = -1; (void)hipGetLastError(); return; }
        grid = cus;
    }
    if (grid < 0) return;
    (void)hipMemsetAsync((char*)d_ws + WS_CTL, 0, CTL_ZERO_BYTES, stream);
    Args a{};
    for (int i = 0; i < 33; ++i) a.in[i] = (const GAS float*)d_in[i];
    a.out = (GAS float*)d_out; a.ws = (GAS unsigned char*)d_ws;
#if MK_SPLIT
    for (int p = 0; p < NPHASE; ++p) { a.ph_lo = p; a.ph_hi = p + 1; hipLaunchKernelGGL(mk_fwd, dim3(grid), dim3(NTHREADS), LDS_BYTES, stream, a); }
#elif defined(PROBE_PH)
    a.ph_lo = 0; a.ph_hi = PROBE_PH + 1; a.li = 0; hipLaunchKernelGGL(mk_fwd, dim3(grid), dim3(NTHREADS), LDS_BYTES, stream, a);
    for (int r = 0; r < PROBE_N; ++r) { a.ph_lo = PROBE_PH; a.ph_hi = PROBE_PH + 1; hipLaunchKernelGGL(mk_fwd, dim3(grid), dim3(NTHREADS), LDS_BYTES, stream, a); }
    a.ph_lo = PROBE_PH + 1; a.ph_hi = NPHASE; a.li = 1; hipLaunchKernelGGL(mk_fwd, dim3(grid), dim3(NTHREADS), LDS_BYTES, stream, a);
#else
    a.ph_lo = 0; a.ph_hi = NPHASE;
    hipLaunchKernelGGL(mk_fwd, dim3(grid), dim3(NTHREADS), LDS_BYTES, stream, a);
#endif
}
```

```cpp
#include <hip/hip_runtime.h>
#include <cstdio>
#include <cstdint>

#define GAS __attribute__((address_space(1)))
#define LAS __attribute__((address_space(3)))
typedef unsigned short bf16;
typedef unsigned v4u __attribute__((ext_vector_type(4)));
typedef unsigned v2u __attribute__((ext_vector_type(2)));
typedef float f32x4 __attribute__((ext_vector_type(4)));
typedef float f32x2 __attribute__((ext_vector_type(2)));
typedef short bf16x8 __attribute__((ext_vector_type(8)));
typedef GAS unsigned gu32;
#define RLX_AGENT __ATOMIC_RELAXED, __HIP_MEMORY_SCOPE_AGENT
#define LDS_WAIT() asm volatile("s_waitcnt lgkmcnt(0)" ::: "memory")
#define VM_WAIT() asm volatile("s_waitcnt vmcnt(0)" ::: "memory")

constexpr int D = 1024, NB = 4, T = 4096, GW = 64, TC = 256, NL = 2;
constexpr int RL = NB * T, RC = NB * TC, R = RL + RC;
constexpr int MH = 8, DQK = 64, DV = 128, LCH = 64;
constexpr int RH = 16, RN = 64, RD = 1024;
constexpr int RW = 3456, DIN = 8608, NPAD = 8704;
constexpr int FF = 2816, NE = 8, FE = 3584;
constexpr int TB = T + TC, NCH = TB / LCH;
constexpr int SMW = 512;
constexpr float NORM_EPS = 1e-6f, GN_EPS = 64e-5f, CAP = 15.0f;
constexpr int MAXSLOT = 2 * RL + NE * 256;

constexpr size_t MiB = 1u << 20;
constexpr size_t WS_CTL = 0, CTL_ZERO_BYTES = 1 * MiB;
constexpr size_t WS_MOD = 1 * MiB, WS_XC = 2 * MiB, WS_META = 6 * MiB, WS_BON = 7 * MiB, WS_SG = 10 * MiB;
constexpr size_t WS_WIN = 19 * MiB, WS_WPM = 36 * MiB, WS_WPR = 38 * MiB, WS_WOUT = 40 * MiB, WS_WG2 = 42 * MiB, WS_WLORA = 43 * MiB, WS_WGU = 44 * MiB, WS_WDN = 55 * MiB;
constexpr size_t WS_H = 61 * MiB;
constexpr size_t WS_Q = 95 * MiB, WS_K = 112 * MiB, WS_V = 129 * MiB, WS_O = 163 * MiB, WS_RKV = 197 * MiB, WS_MGT = 299 * MiB, WS_SM = 367 * MiB;
constexpr size_t WS_HF = 401 * MiB, WS_YS = 469 * MiB, WS_END = 537 * MiB;
constexpr size_t WS_HM = WS_Q, WS_YR = WS_V, WS_T1 = WS_SM;
constexpr size_t WS_HH0 = WS_Q;
constexpr size_t WS_WEGU = 95 * MiB, WS_WEDN = 152 * MiB, WS_HG = 179 * MiB, WS_Y2 = 213 * MiB, WS_HHE = 281 * MiB;
constexpr size_t WS_WEA = 537 * MiB;
static_assert((WS_WEA - WS_WEGU) % (256 * 1024) == 0 && (WS_WEA + 28 * MiB - WS_WEDN) % (896 * 1024) == 0, "expert weight tiles");
static_assert(WS_HHE + (size_t)MAXSLOT * FE <= 401 * MiB && WS_Y2 + (size_t)MAXSLOT * D * 2 <= WS_HHE && WS_HG + (size_t)MAXSLOT * D <= WS_Y2, "ws map");
constexpr float W8S = 64.0f;
constexpr size_t WS_WDNS = 538 * MiB, WS_S2 = 200 * MiB;
constexpr int NSL = FF / 256;
constexpr size_t WS_NEED = 579 * MiB;
constexpr int CW_BAR = 4096;
constexpr int CW_ECNT = 16384;
constexpr int CW_SUB = 20480;
constexpr int LDS_BYTES = 159744;
constexpr int MISC_OFF = LDS_BYTES - 256;

__device__ __forceinline__ unsigned cvt_pk_bf16(float lo, float hi) { unsigned r; asm volatile("v_cvt_pk_bf16_f32 %0, %1, %2" : "=v"(r) : "v"(lo), "v"(hi)); return r; }
__device__ __forceinline__ float bflo(unsigned w) { return __uint_as_float(w << 16); }
__device__ __forceinline__ float bfhi(unsigned w) { return __uint_as_float(w & 0xffff0000u); }
__device__ __forceinline__ void unpack8(const v4u w, float (&f)[8]) { f[0] = bflo(w.x); f[1] = bfhi(w.x); f[2] = bflo(w.y); f[3] = bfhi(w.y); f[4] = bflo(w.z); f[5] = bfhi(w.z); f[6] = bflo(w.w); f[7] = bfhi(w.w); }
__device__ __forceinline__ v4u pack8(const float (&f)[8]) { v4u w; w.x = cvt_pk_bf16(f[0], f[1]); w.y = cvt_pk_bf16(f[2], f[3]); w.z = cvt_pk_bf16(f[4], f[5]); w.w = cvt_pk_bf16(f[6], f[7]); return w; }
__device__ __forceinline__ float sigmoidf_(float x) { return __builtin_amdgcn_rcpf(1.0f + __expf(-x)); }
__device__ __forceinline__ float siluf_(float x) { return x * sigmoidf_(x); }
__device__ __forceinline__ float softplusf_(float x) { return fmaxf(x, 0.f) + log1pf(expf(-fabsf(x))); }
__device__ __forceinline__ float fast_tanh(float x) { const float e = __expf(2.0f * x); return 1.0f - 2.0f * __builtin_amdgcn_rcpf(1.0f + e); }
__device__ __forceinline__ float fast_softplus(float x) { return fmaxf(x, 0.f) + __logf(1.0f + __expf(-fabsf(x))); }
template <int CTRL> __device__ __forceinline__ float dpp_add(float v) { const int t = __builtin_amdgcn_update_dpp(0, __float_as_int(v), CTRL, 0xf, 0xf, false); return v + __int_as_float(t); }
__device__ __forceinline__ float red4(float v) { v = dpp_add<0xB1>(v); return dpp_add<0x4E>(v); }
__device__ __forceinline__ float red8(float v) { return dpp_add<0x141>(red4(v)); }
__device__ __forceinline__ float red16(float v) { return dpp_add<0x140>(red8(v)); }
__device__ __forceinline__ float wave_sum(float v) { v = red16(v); v += __shfl_xor(v, 16); return v + __shfl_xor(v, 32); }
__device__ __forceinline__ int row_of(int b, int lr) { return lr < T ? b * T + lr : RL + b * TC + (lr - T); }
__device__ __forceinline__ int tok(int dir, int u) { if (u < TC) return T + (dir ? TC - 1 - u : u); const int tt = u - TC; return dir ? T - 1 - tt : tt; }
__device__ __forceinline__ int nbrow(int g, int rwidx) {
    if (g < RL) { const int t = g & (T - 1), row = t >> 6, col = t & 63, q = rwidx / (RW / 4);
        if (q == 0) return col > 0 ? g - 1 : -1; if (q == 1) return col < GW - 1 ? g + 1 : -1; if (q == 2) return row > 0 ? g - GW : -1; return row < T / GW - 1 ? g + GW : -1; }
    const int t = (g - RL) & (TC - 1); if (rwidx < RW / 2) return t > 0 ? g - 1 : -1; return t < TC - 1 ? g + 1 : -1;
}

#define XB_TMO      128
#define XB_XCNT(j)  (256  + 64 * (j))
#define XB_XSUB(j)  (1280 + 64 * (j))
#define XB_XGEN(j)  (2304 + 64 * (j))
#define XB_TOP      3328
#define XB_TOPGEN   3392
#define XCD_BAR_WORDS 3456
#define XB_SPIN_CAP (1u << 18)
__device__ __forceinline__ unsigned xb_ld(unsigned* p)              { return __hip_atomic_load(p, __ATOMIC_RELAXED, __HIP_MEMORY_SCOPE_AGENT); }
__device__ __forceinline__ unsigned xb_add(unsigned* p, unsigned v) { return __hip_atomic_fetch_add(p, v, __ATOMIC_RELAXED, __HIP_MEMORY_SCOPE_AGENT); }
__device__ __forceinline__ unsigned xb_xcc_id() { return (unsigned)__builtin_amdgcn_s_getreg((3 << 11) | 20) & 0xFu; }
#define XB_SPIN(cond, bar) do { unsigned _sp = 0; while (cond) { __builtin_amdgcn_s_sleep(1); \
    if ((++_sp & 255u) == 0u) { if (xb_ld(&(bar)[XB_TMO])) break; if (_sp > XB_SPIN_CAP) { atomicAdd(&(bar)[XB_TMO], 1u); break; } } } } while (0)
struct XcdBarrier { unsigned* bar; unsigned x; volatile LAS unsigned* st; };
__device__ __forceinline__ XcdBarrier xcd_barrier_post(unsigned* bar, volatile LAS unsigned* st) {
    XcdBarrier b; b.bar = bar; b.x = xb_xcc_id(); b.st = st;
    if (threadIdx.x == 0) (void)xb_add(&bar[XB_XCNT(b.x)], 1u);
    return b;
}
__device__ __forceinline__ void xcd_barrier_complete(unsigned* bar, unsigned x, unsigned& nloc, unsigned& nx) {
    const unsigned G = gridDim.x * gridDim.y * gridDim.z;
    unsigned sum, cnt, mine, sp = 0u;
    for (;;) {
        sum = 0u; cnt = 0u; mine = 0u;
#pragma unroll
        for (unsigned j = 0; j < 16; ++j) { const unsigned c = xb_ld(&bar[XB_XCNT(j)]); sum += c; cnt += (c > 0u) ? 1u : 0u; mine = (j == x) ? c : mine; }
        if (sum == G) break;
        __builtin_amdgcn_s_sleep(1);
        if ((++sp & 255u) == 0u) { if (xb_ld(&bar[XB_TMO])) break; if (sp > XB_SPIN_CAP) { atomicAdd(&bar[XB_TMO], 1u); break; } }
    }
    nloc = mine > 0u ? mine : 1u; nx = cnt > 0u ? cnt : 1u;
}
__device__ __forceinline__ void xcd_barrier(const XcdBarrier& b) {
    asm volatile("s_waitcnt vmcnt(0)" ::: "memory");
    __syncthreads();
    if (threadIdx.x == 0) {
        unsigned* bar = b.bar;
        __builtin_amdgcn_s_waitcnt(0);
        unsigned nloc = b.st[0], nx = b.st[1];
        if (nloc == 0u) { xcd_barrier_complete(bar, b.x, nloc, nx); b.st[0] = nloc; b.st[1] = nx; }
        const unsigned old = xb_add(&bar[XB_XSUB(b.x)], 1u);
        const unsigned gen = old / nloc;
        if (old + 1u == (gen + 1u) * nloc) {
            __builtin_amdgcn_fence(__ATOMIC_RELEASE, "agent");
            asm volatile("s_waitcnt vmcnt(0)" ::: "memory");
            const unsigned og = xb_add(&bar[XB_TOP], 1u);
            const unsigned tg = og / nx;
            if (og + 1u == (tg + 1u) * nx) xb_add(&bar[XB_TOPGEN], 1u);
            else XB_SPIN(xb_ld(&bar[XB_TOPGEN]) == tg, bar);
            __builtin_amdgcn_fence(__ATOMIC_ACQUIRE, "agent");
            xb_add(&bar[XB_XGEN(b.x)], 1u);
            asm volatile("s_waitcnt vmcnt(0)" ::: "memory");
        } else {
            XB_SPIN(xb_ld(&bar[XB_XGEN(b.x)]) == gen, bar);
            __builtin_amdgcn_fence(__ATOMIC_ACQUIRE, "agent");
            asm volatile("s_waitcnt vmcnt(0)" ::: "memory");
        }
    }
    __syncthreads();
}

namespace pg8 {
#define PG8_LAS __attribute__((address_space(3)))
typedef unsigned short bf16_t;
typedef unsigned u32x4 __attribute__((ext_vector_type(4)));
constexpr int BM = 256, BK = 64, HALF = 128, HTB = HALF * BK * 2, STAGE_BYTES = 8 * HTB, NXCD = 8, WGM = 8;
__host__ __device__ __forceinline__ int lds_byte(int r, int c) { const int st = (r >> 4) * 2 + (c >> 5), rr = r & 15, cc = c & 31, ob = rr * 64 + cc * 2; return st * 1024 + (ob ^ (((ob >> 9) & 1) << 5)); }
__host__ __device__ __forceinline__ void stage_rc(int b, int& R_, int& C) { const int st = b / 1024, sb = b % 1024, swz = sb ^ (((sb >> 9) & 1) << 5); R_ = (st >> 1) * 16 + swz / 64; C = (st & 1) * 32 + (swz % 64) / 2; }
__host__ __device__ __forceinline__ int perm32(int rho) { const int n = rho >> 4, i = rho & 15; return 8 * (i >> 2) + 4 * n + (i & 3); }
typedef int i32x8 __attribute__((ext_vector_type(8))); typedef int i32x4 __attribute__((ext_vector_type(4)));
__device__ __forceinline__ i32x8 cat8(bf16x8 lo, bf16x8 hi) { return __builtin_shufflevector(__builtin_bit_cast(i32x4, lo), __builtin_bit_cast(i32x4, hi), 0, 1, 2, 3, 4, 5, 6, 7); }
__device__ __forceinline__ void mfma8_acc(f32x4& acc, const i32x8 a, const i32x8 b) {
#if defined(__HIP_DEVICE_COMPILE__)
    const int one = 0x7F7F7F7F;
    asm volatile("v_mfma_scale_f32_16x16x128_f8f6f4 %0, %1, %2, %0, %3, %3 op_sel_hi:[0,0,0]" : "+v"(acc) : "v"(a), "v"(b), "v"(one));
#endif
}
struct Unit { int pm, pn, pb; };
struct Gemm { const bf16_t* A; const bf16_t* Bt; int M, N, K; };
struct StaticOrder {
    int nM, nN, nwg, G, c;
    __device__ void init(int M, int N, int G_, int c_) { nM = M / BM; nN = N / BM; nwg = nM * nN; G = G_; c = c_; }
    __device__ bool next(int i, Unit& u) const {
        const long L = (long)i * G + c; if (L >= nwg) return false;
        int wgid = (int)L; { const int q = nwg / NXCD, r = nwg % NXCD, xcd = wgid % NXCD, off = wgid / NXCD; wgid = (xcd < r ? xcd * (q + 1) : r * (q + 1) + (xcd - r) * q) + off; }
        const int nig = WGM * nN, gid = wgid / nig, fm = gid * WGM, gsz = (nM - fm) < WGM ? (nM - fm) : WGM;
        u.pm = fm + ((wgid % nig) % gsz); u.pn = (wgid % nig) / gsz; u.pb = u.pn; return true;
    }
    __device__ __forceinline__ void a_ready(const Unit&) const {}
    __device__ __forceinline__ void done(const Unit&) const {}
};
struct InprojLastOrder {
    int G, c;
    __device__ bool next(int i, Unit& u) const {
        const int L = i * G + c; if (L >= 64 * 34 + 4 * 22) return false;
        if (L < 64 * 34) { const int g8 = L / (8 * 34), r = L % (8 * 34); u.pm = g8 * 8 + (r % 8); u.pn = r / 8; }
        else { const int r = L - 64 * 34; u.pm = 64 + (r & 3); int q = r >> 2; q += (q >= 8) ? 4 : 0; q += (q >= 24) ? 8 : 0; u.pn = q; }
        u.pb = u.pn; return true;
    }
    __device__ __forceinline__ void a_ready(const Unit&) const {}
    __device__ __forceinline__ void done(const Unit&) const {}
};
struct CtxSliceOrder {
    int nS, G, c;
    __device__ bool next(int i, Unit& u) const { const int L = i * G + c; if (L >= 16 * nS) return false; const int s = L >> 4, r = L & 15; u.pm = 4 * s + (r >> 2); u.pn = r & 3; u.pb = 4 * s + (r & 3); return true; }
    __device__ __forceinline__ void a_ready(const Unit&) const {}
    __device__ __forceinline__ void done(const Unit&) const {}
};
struct MoeOrder {
    int ntiles, nN, nwg, G, c; const int* texp;
    int lo0, lo1, hi1;
    __device__ bool next(int i, Unit& u) const {
        const long L = (long)i * G + c; if (L >= nwg) return false;
        u.pm = (int)(L / nN); u.pn = (int)(L % nN); const int e = __builtin_amdgcn_readfirstlane(texp[u.pm]);
        u.pb = (e < 4 ? lo0 + e * lo1 : (e - 4) * hi1) + u.pn; return true;
    }
    __device__ __forceinline__ void a_ready(const Unit&) const {}
    __device__ __forceinline__ void done(const Unit&) const {}
};
template <class Epi, class Sched, bool ALIGN_EPI = false, bool SP2 = false, bool FP8 = false>
__device__ __forceinline__ void gemm_phase(PG8_LAS unsigned char* lds, const Gemm g, const Sched& S, const Epi& E) {
    int tid_ = threadIdx.x; asm volatile("" : "+v"(tid_));
    const int tid = tid_, wid = __builtin_amdgcn_readfirstlane(tid >> 6), lane = tid & 63, wr = wid >> 2, wc = wid & 3, fr = lane & 15, fq = lane >> 4;
    const int K = g.K, nt = K / BK;
    unsigned voffA[2], voffB[2];
#pragma unroll
    for (int i = 0; i < 2; ++i) { int R, C; stage_rc(tid * 16 + i * 8192, R, C); const int Rb = Epi::PERM ? ((R & ~31) + perm32(R & 31)) : R;
        voffA[i] = (unsigned)(R * K + C) * 2u; voffB[i] = (unsigned)(Rb * K + C) * 2u; }
    const size_t kstep = (size_t)(BK * 2);
    const size_t hstep = (size_t)HALF * K * 2;
    const size_t tstep = 2 * hstep;
    const unsigned ldsw = (unsigned)wid * 1024u;
    const int aoff = lds_byte(wr * 64 + fr, fq * 8), boff = lds_byte(wc * 32 + fr, fq * 8);
#define PG8_SA(b, h) (((b) * 2 + (h)) * HTB)
#define PG8_SB(b, h) ((4 + (b) * 2 + (h)) * HTB)
#define PG8_STAGE(bufoff, gbase, voff) do { _Pragma("unroll") for (int _i = 0; _i < 2; ++_i) \
        __builtin_amdgcn_global_load_lds((const unsigned*)((const char*)(gbase) + (voff)[_i]), (PG8_LAS unsigned*)(lds + (bufoff) + ldsw + _i * 8192), 16, 0, 0); } while (0)
#define PG8_LDA(dst, b, h) do { _Pragma("unroll") for (int m = 0; m < 4; ++m) { if constexpr (FP8) dst##8[m] = cat8(*(const PG8_LAS bf16x8*)(lds + PG8_SA(b, h) + aoff + m * 2048), *(const PG8_LAS bf16x8*)(lds + PG8_SA(b, h) + aoff + m * 2048 + 1024)); \
        else { _Pragma("unroll") for (int k = 0; k < 2; ++k) dst[m][k] = *(const PG8_LAS bf16x8*)(lds + PG8_SA(b, h) + aoff + m * 2048 + k * 1024); } } } while (0)
#define PG8_LDB(dst, b, h) do { _Pragma("unroll") for (int n = 0; n < 2; ++n) { if constexpr (FP8) dst##8[n] = cat8(*(const PG8_LAS bf16x8*)(lds + PG8_SB(b, h) + boff + n * 2048), *(const PG8_LAS bf16x8*)(lds + PG8_SB(b, h) + boff + n * 2048 + 1024)); \
        else { _Pragma("unroll") for (int k = 0; k < 2; ++k) dst[n][k] = *(const PG8_LAS bf16x8*)(lds + PG8_SB(b, h) + boff + n * 2048 + k * 1024); } } } while (0)
#define PG8_MMA(ai, bj, At, Bt) do { __builtin_amdgcn_s_setprio(1); if constexpr (FP8) { _Pragma("unroll") for (int m = 0; m < 4; ++m) _Pragma("unroll") for (int n = 0; n < 2; ++n) \
        mfma8_acc(acc[ai][bj][m][n], Bt##8[n], At##8[m]); } else { \
        _Pragma("unroll") for (int m = 0; m < 4; ++m) _Pragma("unroll") for (int n = 0; n < 2; ++n) _Pragma("unroll") for (int k = 0; k < 2; ++k) \
        acc[ai][bj][m][n] = __builtin_amdgcn_mfma_f32_16x16x32_bf16(Bt[n][k], At[m][k], acc[ai][bj][m][n], 0, 0, 0); } __builtin_amdgcn_s_setprio(0); } while (0)
#define PG8_WAIT_V(n) asm volatile("s_waitcnt vmcnt(" #n ")" ::: "memory")
#define PG8_WAIT_L(n) asm volatile("s_waitcnt lgkmcnt(" #n ")" ::: "memory")
#define PG8_BAR __builtin_amdgcn_s_barrier()
#define PG8_SCHED __builtin_amdgcn_sched_barrier(0)
    Unit cur, nxt; int ui = 0;
    if (!S.next(0, cur)) return;
    f32x4 acc[2][2][4][2];
#pragma unroll
    for (int a = 0; a < 2; ++a)
#pragma unroll
        for (int b = 0; b < 2; ++b)
#pragma unroll
            for (int m = 0; m < 4; ++m)
#pragma unroll
                for (int n = 0; n < 2; ++n) acc[a][b][m][n] = (f32x4){0.f, 0.f, 0.f, 0.f};
    bf16x8 At[4][2], B0[2][2], B1[2][2]; i32x8 At8[4], B08[2], B18[2];
    const char* cA = (const char*)g.A + (size_t)cur.pm * tstep; const char* cB = (const char*)g.Bt + (size_t)cur.pb * tstep;
    S.a_ready(cur);
    if constexpr (SP2) {
        PG8_STAGE(PG8_SB(0, 0), cB, voffB); PG8_STAGE(PG8_SB(0, 1), cB + hstep, voffB); PG8_STAGE(PG8_SA(0, 0), cA, voffA); PG8_STAGE(PG8_SA(0, 1), cA + hstep, voffA);
        if (wr == 1) PG8_BAR;
        PG8_WAIT_V(2); PG8_BAR;
        PG8_STAGE(PG8_SB(1, 0), cB + kstep, voffB); PG8_STAGE(PG8_SA(1, 0), cA + kstep, voffA); PG8_STAGE(PG8_SB(1, 1), cB + hstep + kstep, voffB);
        PG8_WAIT_V(6); PG8_BAR;
    } else {
        PG8_STAGE(PG8_SB(0, 0), cB, voffB); PG8_STAGE(PG8_SA(0, 0), cA, voffA); PG8_STAGE(PG8_SB(0, 1), cB + hstep, voffB); PG8_STAGE(PG8_SA(0, 1), cA + hstep, voffA);
        if (wr == 1) PG8_BAR;
        PG8_WAIT_V(4); PG8_BAR;
        PG8_STAGE(PG8_SB(1, 0), cB + kstep, voffB); PG8_STAGE(PG8_SA(1, 0), cA + kstep, voffA); PG8_STAGE(PG8_SB(1, 1), cB + hstep + kstep, voffB);
        PG8_WAIT_V(6); PG8_BAR;
    }
    for (;;) {
        const bool has_next = S.next(ui + 1, nxt);
        const char* nA = has_next ? (const char*)g.A + (size_t)nxt.pm * tstep : cA; const char* nB = has_next ? (const char*)g.Bt + (size_t)nxt.pb * tstep : cB;
        for (int t = 0; t < nt; t += 2) {
            const bool last = (t == nt - 2);
            const char* a1 = cA + (size_t)(t + 1) * kstep;
            const char* a2 = last ? nA : cA + (size_t)(t + 2) * kstep; const char* b2 = last ? nB : cB + (size_t)(t + 2) * kstep;
            const char* a3 = a2 + kstep; const char* b3 = b2 + kstep;
            if (last && has_next) S.a_ready(nxt);
            if constexpr (SP2) {
            PG8_LDB(B0, 0, 0); PG8_LDB(B1, 0, 1); PG8_SCHED; PG8_LDA(At, 0, 0); PG8_STAGE(PG8_SA(1, 1), a1 + hstep, voffA);
            PG8_WAIT_V(8); PG8_WAIT_L(0); PG8_BAR; PG8_MMA(0, 0, At, B0); PG8_MMA(0, 1, At, B1); PG8_BAR; PG8_SCHED;
            PG8_LDA(At, 0, 1); PG8_STAGE(PG8_SB(0, 0), b2, voffB); PG8_STAGE(PG8_SB(0, 1), b2 + hstep, voffB); PG8_STAGE(PG8_SA(0, 0), a2, voffA);
            PG8_WAIT_V(8); PG8_WAIT_L(0); PG8_BAR; PG8_MMA(1, 0, At, B0); PG8_MMA(1, 1, At, B1); PG8_BAR; PG8_SCHED;
            PG8_LDB(B0, 1, 0); PG8_LDB(B1, 1, 1); PG8_SCHED; PG8_LDA(At, 1, 0); PG8_STAGE(PG8_SA(0, 1), a2 + hstep, voffA);
            PG8_WAIT_V(8); PG8_WAIT_L(0); PG8_BAR; PG8_MMA(0, 0, At, B0); PG8_MMA(0, 1, At, B1); PG8_BAR; PG8_SCHED;
            PG8_LDA(At, 1, 1); PG8_STAGE(PG8_SB(1, 0), b3, voffB); PG8_STAGE(PG8_SB(1, 1), b3 + hstep, voffB); PG8_STAGE(PG8_SA(1, 0), a3, voffA);
            PG8_WAIT_V(8); PG8_WAIT_L(0); PG8_BAR; PG8_MMA(1, 0, At, B0); PG8_MMA(1, 1, At, B1); PG8_BAR; PG8_SCHED;
            } else {
            PG8_LDB(B0, 0, 0); PG8_SCHED; PG8_LDA(At, 0, 0); PG8_STAGE(PG8_SA(1, 1), a1 + hstep, voffA);
            PG8_WAIT_L(8); PG8_BAR; PG8_WAIT_L(0); PG8_MMA(0, 0, At, B0); PG8_BAR; PG8_SCHED;
            PG8_LDB(B1, 0, 1); PG8_STAGE(PG8_SB(0, 0), b2, voffB);
            PG8_BAR; PG8_WAIT_L(0); PG8_MMA(0, 1, At, B1); PG8_BAR;
            PG8_LDA(At, 0, 1); PG8_STAGE(PG8_SA(0, 0), a2, voffA);
            PG8_BAR; PG8_WAIT_L(0); PG8_MMA(1, 0, At, B0); PG8_BAR; PG8_SCHED;
            PG8_STAGE(PG8_SB(0, 1), b2 + hstep, voffB);
            PG8_WAIT_V(6); PG8_BAR; PG8_MMA(1, 1, At, B1); PG8_BAR;
            PG8_LDB(B0, 1, 0); PG8_SCHED; PG8_LDA(At, 1, 0); PG8_STAGE(PG8_SA(0, 1), a2 + hstep, voffA);
            PG8_WAIT_L(8); PG8_BAR; PG8_WAIT_L(0); PG8_MMA(0, 0, At, B0); PG8_BAR; PG8_SCHED;
            PG8_LDB(B1, 1, 1); PG8_STAGE(PG8_SB(1, 0), b3, voffB);
            PG8_BAR; PG8_WAIT_L(0); PG8_MMA(0, 1, At, B1); PG8_BAR;
            PG8_LDA(At, 1, 1); PG8_STAGE(PG8_SA(1, 0), a3, voffA);
            PG8_BAR; PG8_WAIT_L(0); PG8_MMA(1, 0, At, B0); PG8_BAR; PG8_SCHED;
            PG8_STAGE(PG8_SB(1, 1), b3 + hstep, voffB);
            PG8_WAIT_V(6); PG8_BAR; PG8_MMA(1, 1, At, B1); PG8_BAR;
            }
        }
        if constexpr (ALIGN_EPI) { if (wr == 0) PG8_BAR; }
        if constexpr (FP8) asm volatile("s_nop 15\n\ts_nop 15\n\ts_nop 15\n\ts_nop 15" ::: "memory");
        if constexpr (!Epi::AFTER_DRAIN) { E(acc, cur, wr, wc, fr, fq); S.done(cur); }
        if (!has_next) break;
#pragma unroll
        for (int a = 0; a < 2; ++a)
#pragma unroll
            for (int b = 0; b < 2; ++b)
#pragma unroll
                for (int m = 0; m < 4; ++m)
#pragma unroll
                    for (int n = 0; n < 2; ++n) acc[a][b][m][n] = (f32x4){0.f, 0.f, 0.f, 0.f};
        cur = nxt; cA = nA; cB = nB; ++ui;
        if constexpr (ALIGN_EPI) { if (wr == 1) PG8_BAR; }
    }
    PG8_WAIT_V(0);
    if constexpr (!ALIGN_EPI) { if (wr == 0) PG8_BAR; }
    PG8_BAR;
    if constexpr (Epi::AFTER_DRAIN) { E.fused(acc, cur, wr, wc, fr, fq, lds, wid, lane); S.done(cur); }
#undef PG8_SA
#undef PG8_SB
#undef PG8_STAGE
#undef PG8_LDA
#undef PG8_LDB
#undef PG8_MMA
#undef PG8_WAIT_V
#undef PG8_WAIT_L
#undef PG8_BAR
#undef PG8_SCHED
}

__device__ __forceinline__ u32x4 pack_acc8(const f32x4 v0, const f32x4 v1) { u32x4 w; w.x = cvt_pk_bf16(v0[0], v0[1]); w.y = cvt_pk_bf16(v0[2], v0[3]); w.z = cvt_pk_bf16(v1[0], v1[1]); w.w = cvt_pk_bf16(v1[2], v1[3]); return w; }
#define EPI_LOOP_BEGIN  _Pragma("unroll") for (int ai = 0; ai < 2; ++ai) _Pragma("unroll") for (int m = 0; m < 4; ++m) { const int rloc = ai * HALF + wr * 64 + m * 16 + fr; \
                        _Pragma("unroll") for (int bj = 0; bj < 2; ++bj) { const int cloc = bj * HALF + wc * 32 + 8 * fq; const f32x4 v0 = acc[ai][bj][m][0], v1 = acc[ai][bj][m][1];
#define EPI_LOOP_END    } asm volatile("" ::: "memory"); }

struct EpiInproj {
    static constexpr bool PERM = true, AFTER_DRAIN = false;
    GAS unsigned char* ws;
    __device__ __forceinline__ void operator()(const f32x4 (&acc)[2][2][4][2], const Unit& u, int wr, int wc, int fr, int fq) const {
        const int pn = u.pn; size_t off; int ld, ct;
        if (pn < 2) { off = WS_Q; ld = 512; ct = pn; } else if (pn < 4) { off = WS_K; ld = 512; ct = pn - 2; } else if (pn < 8) { off = WS_V; ld = 1024; ct = pn - 4; }
        else if (pn < 12) { off = WS_O; ld = 1024; ct = pn - 8; } else if (pn < 24) { off = WS_RKV; ld = 3072; ct = pn - 12; } else if (pn < 32) { off = WS_MGT; ld = 2048; ct = pn - 24; } else { off = WS_SM; ld = SMW * 2; ct = pn - 32; }
        const size_t row0 = (size_t)u.pm * BM;
        if (pn < 32) {
            bf16_t* base = (bf16_t*)(ws + off) + row0 * ld + ct * BM;
            EPI_LOOP_BEGIN
                *(u32x4*)(base + (size_t)rloc * ld + cloc) = pack_acc8(v0, v1);
            EPI_LOOP_END
        } else {
            float* sb = (float*)(ws + off) + row0 * SMW + ct * BM;
            EPI_LOOP_BEGIN
                float* p = sb + (size_t)rloc * SMW + cloc; *(f32x4*)p = v0; *(f32x4*)(p + 4) = v1;
            EPI_LOOP_END
        }
    }
};
struct EpiStore {
    static constexpr bool PERM = true, AFTER_DRAIN = false;
    bf16_t* C; int ldc;
    __device__ __forceinline__ void operator()(const f32x4 (&acc)[2][2][4][2], const Unit& u, int wr, int wc, int fr, int fq) const {
        const size_t row0 = (size_t)u.pm * BM; const int col0 = u.pn * BM;
        EPI_LOOP_BEGIN
            *(u32x4*)(C + (row0 + rloc) * ldc + col0 + cloc) = pack_acc8(v0, v1);
        EPI_LOOP_END
    }
};
template <int STEP> struct EpiMerge {
    static constexpr bool PERM = true, AFTER_DRAIN = false;
    const bf16_t* MGT; bf16_t* T1; bf16_t* OUT;
    __device__ __forceinline__ void operator()(const f32x4 (&acc)[2][2][4][2], const Unit& u, int wr, int wc, int fr, int fq) const {
        const size_t row0 = (size_t)u.pm * BM; const int col0 = u.pn * BM;
        EPI_LOOP_BEGIN
            const size_t row = row0 + rloc; const int col = col0 + cloc;
            const u32x4 gw = *(const u32x4*)(MGT + row * 2048 + (STEP ? 1024 : 0) + col); float g[8]; unpack8(gw, g);
            float o[8] = {v0[0], v0[1], v0[2], v0[3], v1[0], v1[1], v1[2], v1[3]};
#pragma unroll
            for (int j = 0; j < 8; ++j) o[j] *= sigmoidf_(g[j]);
            if (STEP) { const u32x4 tw = *(const u32x4*)(T1 + row * 1024 + col); float tt[8]; unpack8(tw, tt);
#pragma unroll
                for (int j = 0; j < 8; ++j) o[j] += tt[j]; }
            *(u32x4*)((STEP ? OUT : T1) + row * 1024 + col) = pack8(o);
        EPI_LOOP_END
    }
};
struct EpiResid {
    static constexpr bool PERM = true, AFTER_DRAIN = false;
    const float* src_lat; const float* src_ctx; float* dst_lat; float* dst_ctx; const float* gate;
    __device__ __forceinline__ void operator()(const f32x4 (&acc)[2][2][4][2], const Unit& u, int wr, int wc, int fr, int fq) const {
        const int row0 = u.pm * BM, col0 = u.pn * BM; const bool lat = row0 < RL;
        const float* sb = lat ? src_lat : src_ctx - (size_t)RL * D; float* db = lat ? dst_lat : dst_ctx - (size_t)RL * D;
        const float* gt = gate + (lat ? row0 / T : 4) * 6 * D;
        EPI_LOOP_BEGIN
            const size_t off = (size_t)(row0 + rloc) * D + col0 + cloc; const int col = col0 + cloc;
            const f32x4 g0 = *(const f32x4*)(gt + col), g1 = *(const f32x4*)(gt + col + 4), s0 = *(const f32x4*)(sb + off), s1 = *(const f32x4*)(sb + off + 4);
            *(f32x4*)(db + off) = s0 + g0 * v0; *(f32x4*)(db + off + 4) = s1 + g1 * v1;
        EPI_LOOP_END
    }
};
struct EpiSwiglu {
    static constexpr bool PERM = true, AFTER_DRAIN = false;
    bf16_t* HH; int ldc;
    __device__ __forceinline__ void operator()(const f32x4 (&acc)[2][2][4][2], const Unit& u, int wr, int wc, int fr, int fq) const {
        const size_t row0 = (size_t)u.pm * BM; const int col0 = u.pn * HALF + wc * 32 + 8 * fq;
#pragma unroll
        for (int ai = 0; ai < 2; ++ai)
#pragma unroll
            for (int m = 0; m < 4; ++m) { const int rloc = ai * HALF + wr * 64 + m * 16 + fr; float o[8];
#pragma unroll
                for (int n = 0; n < 2; ++n)
#pragma unroll
                    for (int j = 0; j < 4; ++j) o[4 * n + j] = siluf_(acc[ai][0][m][n][j]) * acc[ai][1][m][n][j];
                *(u32x4*)(HH + (row0 + rloc) * ldc + col0) = pack8(o); asm volatile("" ::: "memory"); }
    }
};

struct EpiSwigluCtx {
    static constexpr bool PERM = true, AFTER_DRAIN = false;
    bf16_t* HH; int ldc; bf16_t* HHc; int ctx_from;
    __device__ __forceinline__ void operator()(const f32x4 (&acc)[2][2][4][2], const Unit& u, int wr, int wc, int fr, int fq) const {
        const bool cx = u.pm >= ctx_from;
        const size_t offc = ((size_t)(u.pn >> 1) * 1024 + (size_t)(u.pm - ctx_from) * BM) * 256 + (u.pn & 1) * HALF + wc * 32 + 8 * fq + (size_t)(HHc - HH), offn = (size_t)u.pm * BM * ldc + u.pn * HALF + wc * 32 + 8 * fq;
        bf16_t* base = HH + (cx ? offc : offn); const int ld = cx ? 256 : ldc;
#pragma unroll
        for (int ai = 0; ai < 2; ++ai)
#pragma unroll
            for (int m = 0; m < 4; ++m) { const int rloc = ai * HALF + wr * 64 + m * 16 + fr; float o[8];
#pragma unroll
                for (int n = 0; n < 2; ++n)
#pragma unroll
                    for (int j = 0; j < 4; ++j) o[4 * n + j] = siluf_(acc[ai][0][m][n][j]) * acc[ai][1][m][n][j];
                *(u32x4*)(base + (size_t)rloc * ld) = pack8(o); asm volatile("" ::: "memory"); }
    }
};
struct EpiSlab {
    static constexpr bool PERM = true, AFTER_DRAIN = false;
    float* slab; const float* gate;
    __device__ __forceinline__ void operator()(const f32x4 (&acc)[2][2][4][2], const Unit& u, int wr, int wc, int fr, int fq) const {
        float* base = slab + ((size_t)(u.pm >> 2) * 1024 + (size_t)(u.pm & 3) * BM) * D + u.pn * BM;
        EPI_LOOP_BEGIN
            const int col = u.pn * BM + cloc; const f32x4 g0 = *(const f32x4*)(gate + col), g1 = *(const f32x4*)(gate + col + 4);
            float* p = base + (size_t)rloc * D + cloc; *(f32x4*)p = g0 * v0; *(f32x4*)(p + 4) = g1 * v1;
        EPI_LOOP_END
    }
};

struct EpiSwiglu8 {
    static constexpr bool PERM = true, AFTER_DRAIN = false;
    unsigned char* HH; int ldc;
    __device__ __forceinline__ void operator()(const f32x4 (&acc)[2][2][4][2], const Unit& u, int wr, int wc, int fr, int fq) const {
        const size_t row0 = (size_t)u.pm * BM; const int col0 = u.pn * HALF + wc * 32 + 8 * fq; const float is = 1.0f / W8S;
#pragma unroll
        for (int ai = 0; ai < 2; ++ai)
#pragma unroll
            for (int m = 0; m < 4; ++m) { const int rloc = ai * HALF + wr * 64 + m * 16 + fr; float o[8];
#pragma unroll
                for (int n = 0; n < 2; ++n)
#pragma unroll
                    for (int j = 0; j < 4; ++j) o[4 * n + j] = __builtin_amdgcn_fmed3f(siluf_(acc[ai][0][m][n][j] * is) * (acc[ai][1][m][n][j] * is), -448.0f, 448.0f);
                v2u w; w.x = (unsigned)__builtin_amdgcn_cvt_pk_fp8_f32(o[0], o[1], 0, false); w.x = (unsigned)__builtin_amdgcn_cvt_pk_fp8_f32(o[2], o[3], (int)w.x, true);
                w.y = (unsigned)__builtin_amdgcn_cvt_pk_fp8_f32(o[4], o[5], 0, false); w.y = (unsigned)__builtin_amdgcn_cvt_pk_fp8_f32(o[6], o[7], (int)w.y, true);
                *(v2u*)(HH + (row0 + rloc) * ldc + col0) = w; asm volatile("" ::: "memory"); }
    }
};
struct EpiStoreScaled {
    static constexpr bool PERM = true, AFTER_DRAIN = false;
    bf16_t* C; int ldc; float s;
    __device__ __forceinline__ void operator()(const f32x4 (&acc)[2][2][4][2], const Unit& u, int wr, int wc, int fr, int fq) const {
        const size_t row0 = (size_t)u.pm * BM; const int col0 = u.pn * BM;
        EPI_LOOP_BEGIN
            *(u32x4*)(C + (row0 + rloc) * ldc + col0 + cloc) = pack_acc8(v0 * s, v1 * s);
        EPI_LOOP_END
    }
};

}

struct Args { const GAS float* in[33]; GAS float* out; GAS unsigned char* ws; int ph_lo, ph_hi, li, pad; };
#define CAS __attribute__((address_space(4)))
#define INP(i) ((const float*)F.A->in[i])
constexpr int NWAVES = 8, NTHREADS = 512;
struct Frame {
    LAS unsigned char* lds; volatile LAS unsigned* MISC; gu32* ctl;
    int tid, lane, wave, G, bid;
    int cb, cg;
    GAS unsigned char* ws; GAS float* out;
    const CAS Args* A;
};
enum { I_X = 0, I_C, I_CTX, I_CCTX, I_WADA, I_BADA, I_GNM, I_GNF, I_WIN, I_BG, I_GMN, I_MU, I_W0, I_W2, I_A0, I_A2, I_G2, I_KK, I_KA, I_RK, I_LNW, I_LNB, I_WPM, I_WPR, I_WOUT,
       I_FFG, I_FFU, I_FFD, I_WR, I_EG, I_EU, I_ED, I_GF };

__device__ __forceinline__ void conv_item(const float* W, int ldw, int c0, int k0, bf16* dst, int ldd, int r0, LAS float* scr, int lane) {
#pragma unroll 8
    for (int i = 0; i < 32; ++i) { const int kk = 2 * i + (lane >> 5); scr[kk * 33 + (lane & 31)] = W[(size_t)(k0 + kk) * ldw + c0 + (lane & 31)]; }
    LDS_WAIT(); asm volatile("" ::: "memory");
    const int c = lane & 7;
#pragma unroll
    for (int j = 0; j < 4; ++j) { const int n = (lane >> 3) + 8 * j; const LAS float* s = scr + (8 * c) * 33 + n;
        v4u o; o.x = cvt_pk_bf16(s[0 * 33], s[1 * 33]); o.y = cvt_pk_bf16(s[2 * 33], s[3 * 33]); o.z = cvt_pk_bf16(s[4 * 33], s[5 * 33]); o.w = cvt_pk_bf16(s[6 * 33], s[7 * 33]);
        *(v4u*)(dst + (size_t)(r0 + n) * ldd + k0 + 8 * c) = o; }
    LDS_WAIT(); asm volatile("" ::: "memory");
}
__device__ __forceinline__ unsigned pk4_fp8(float a, float b, float c, float d) { int w = __builtin_amdgcn_cvt_pk_fp8_f32(a, b, 0, false); w = __builtin_amdgcn_cvt_pk_fp8_f32(c, d, w, true); return (unsigned)w; }
__device__ __forceinline__ void conv_item8(const float* W, int ldw, int c0, int k0, unsigned char* dst, int ldd, int r0, float scale, LAS float* scr, int lane) {
#pragma unroll 8
    for (int i = 0; i < 32; ++i) { const int kk = 2 * i + (lane >> 5); scr[kk * 33 + (lane & 31)] = __builtin_amdgcn_fmed3f(W[(size_t)(k0 + kk) * ldw + c0 + (lane & 31)] * scale, -448.0f, 448.0f); }
    LDS_WAIT(); asm volatile("" ::: "memory");
    const int c = lane & 3;
#pragma unroll
    for (int j = 0; j < 2; ++j) { const int n = (lane >> 2) + 16 * j; const LAS float* s = scr + (16 * c) * 33 + n;
        v4u o; o.x = pk4_fp8(s[0 * 33], s[1 * 33], s[2 * 33], s[3 * 33]); o.y = pk4_fp8(s[4 * 33], s[5 * 33], s[6 * 33], s[7 * 33]);
        o.z = pk4_fp8(s[8 * 33], s[9 * 33], s[10 * 33], s[11 * 33]); o.w = pk4_fp8(s[12 * 33], s[13 * 33], s[14 * 33], s[15 * 33]);
        *(v4u*)(dst + (size_t)(r0 + n) * ldd + k0 + 16 * c) = o; }
    LDS_WAIT(); asm volatile("" ::: "memory");
}
__device__ __forceinline__ void conv_seg8(Frame& F, const float* W, int ldw, int K, int c0, int ncols, unsigned char* dst, int ldd, int r0, float scale, int& rot) {
    LAS float* scr = (LAS float*)(F.lds + F.wave * 16384);
    const int NGW = F.cg * NWAVES, nblk = ncols / 32, nitems = (K / 64) * nblk;
    int gw = (F.cb * NWAVES + F.wave + rot) % NGW;
    for (int it = gw; it < nitems; it += NGW) { const int kb = it / nblk, nb = it % nblk; conv_item8(W, ldw, c0 + 32 * nb, 64 * kb, dst, ldd, r0 + 32 * nb, scale, scr, F.lane); }
    rot = (rot + nitems) % NGW;
}
__device__ __forceinline__ void conv_gu8(Frame& F, const float* Wg, const float* Wu, int ldw, int K, int ngroups, unsigned char* dst, float scale, int& rot) {
    LAS float* scr = (LAS float*)(F.lds + F.wave * 16384);
    const int NGW = F.cg * NWAVES, kblk = K / 64, nitems = ngroups * 2 * 4 * kblk;
    int gw = (F.cb * NWAVES + F.wave + rot) % NGW;
    for (int it = gw; it < nitems; it += NGW) { const int kb = it % kblk, r = it / kblk, nb = r & 3, which = (r >> 2) & 1, p = r >> 3;
        conv_item8(which ? Wu : Wg, ldw, 128 * p + 32 * nb, 64 * kb, dst, K, 256 * p + 128 * which + 32 * nb, scale, scr, F.lane); }
    rot = (rot + nitems) % NGW;
}
__device__ __forceinline__ void conv_ffd_dual(Frame& F, const float* W, bf16* dst, bf16* dsts, int& rot) {
    LAS float* scr = (LAS float*)(F.lds + F.wave * 16384);
    const int NGW = F.cg * NWAVES, nblk = D / 32, nitems = (FF / 64) * nblk; const int lane = F.lane;
    int gw = (F.cb * NWAVES + F.wave + rot) % NGW;
    for (int it = gw; it < nitems; it += NGW) { const int kb = it / nblk, nb = it % nblk, k0 = 64 * kb, c0 = 32 * nb;
#pragma unroll 8
        for (int i = 0; i < 32; ++i) { const int kk = 2 * i + (lane >> 5); scr[kk * 33 + (lane & 31)] = W[(size_t)(k0 + kk) * D + c0 + (lane & 31)]; }
        LDS_WAIT(); asm volatile("" ::: "memory");
        const int c = lane & 7;
#pragma unroll
        for (int j = 0; j < 4; ++j) { const int n = (lane >> 3) + 8 * j; const LAS float* s = scr + (8 * c) * 33 + n;
            v4u o; o.x = cvt_pk_bf16(s[0 * 33], s[1 * 33]); o.y = cvt_pk_bf16(s[2 * 33], s[3 * 33]); o.z = cvt_pk_bf16(s[4 * 33], s[5 * 33]); o.w = cvt_pk_bf16(s[6 * 33], s[7 * 33]);
            *(v4u*)(dst + (size_t)(c0 + n) * FF + k0 + 8 * c) = o;
            *(v4u*)(dsts + ((size_t)(k0 >> 8) * 1024 + c0 + n) * 256 + (k0 & 255) + 8 * c) = o; }
        LDS_WAIT(); asm volatile("" ::: "memory"); }
    rot = (rot + nitems) % NGW;
}
__device__ __forceinline__ void conv_seg(Frame& F, const float* W, int ldw, int K, int c0, int ncols, bf16* dst, int ldd, int r0, int& rot) {
    LAS float* scr = (LAS float*)(F.lds + F.wave * 16384);
    const int NGW = F.cg * NWAVES, nblk = ncols / 32, nitems = (K / 64) * nblk;
    int gw = (F.cb * NWAVES + F.wave + rot) % NGW;
    for (int it = gw; it < nitems; it += NGW) { const int kb = it / nblk, nb = it % nblk; conv_item(W, ldw, c0 + 32 * nb, 64 * kb, dst, ldd, r0 + 32 * nb, scr, F.lane); }
    rot = (rot + nitems) % NGW;
}
__device__ __forceinline__ void conv_gu(Frame& F, const float* Wg, const float* Wu, int ldw, int K, int ngroups, bf16* dst, int& rot) {
    LAS float* scr = (LAS float*)(F.lds + F.wave * 16384);
    const int NGW = F.cg * NWAVES, kblk = K / 64, nitems = ngroups * 2 * 4 * kblk;
    int gw = (F.cb * NWAVES + F.wave + rot) % NGW;
    for (int it = gw; it < nitems; it += NGW) { const int kb = it % kblk, r = it / kblk, nb = r & 3, which = (r >> 2) & 1, p = r >> 3;
        conv_item(which ? Wu : Wg, ldw, 128 * p + 32 * nb, 64 * kb, dst, K, 256 * p + 128 * which + 32 * nb, scr, F.lane); }
    rot = (rot + nitems) % NGW;
}
__device__ __forceinline__ void zero_bf16_rows(Frame& F, bf16* dst, size_t n16) {
    const v4u z = {0u, 0u, 0u, 0u};
    for (size_t i = (size_t)F.cb * NTHREADS + F.tid; i < n16; i += (size_t)F.cg * NTHREADS) ((v4u*)dst)[i] = z;
}
__device__ __forceinline__ void conv_win(Frame& F, int l) {
    int rot = 0; GAS unsigned char* ws = F.ws;
    bf16* WIN = (bf16*)(ws + WS_WIN); const float* win = INP(I_WIN) + (size_t)l * D * DIN;
    conv_seg(F, win, DIN, D, 0, 3072, WIN, D, 0, rot);
    conv_seg(F, win, DIN, D, 3104, 3072, WIN, D, 3072, rot);
    conv_seg(F, win, DIN, D, 6560, 2048, WIN, D, 6144, rot);
    conv_seg(F, win, DIN, D, 3072, 32, WIN, D, 8192, rot);
    conv_seg(F, win, DIN, D, 6176, 384, WIN, D, 8192 + 32, rot);
    zero_bf16_rows(F, WIN + (size_t)(8192 + 416) * D, (size_t)96 * D * 2 / 16);
}
__device__ __forceinline__ void conv_rest(Frame& F, int l) {
    int rot = 0; GAS unsigned char* ws = F.ws;
    conv_seg(F, INP(I_WPM) + (size_t)l * D * D, D, D, 0, D, (bf16*)(ws + WS_WPM), D, 0, rot);
    conv_seg(F, INP(I_WPR) + (size_t)l * D * D, D, D, 0, D, (bf16*)(ws + WS_WPR), D, 0, rot);
    conv_seg(F, INP(I_WOUT) + (size_t)l * D * D, D, D, 0, D, (bf16*)(ws + WS_WOUT), D, 0, rot);
    { bf16* WG2 = (bf16*)(ws + WS_WG2);
      conv_seg(F, INP(I_G2) + (size_t)l * 128 * RD, RD, 128, 0, RD, WG2, 256, 0, rot);
      for (int i = F.cb * NTHREADS + F.tid; i < 1024 * 16; i += F.cg * NTHREADS) { const int r = i >> 4, p = i & 15; *(v4u*)(WG2 + (size_t)r * 256 + 128 + 8 * p) = (v4u){0u, 0u, 0u, 0u}; } }
    { bf16* WL = (bf16*)(ws + WS_WLORA);
      for (int d = 0; d < 2; ++d) { conv_seg(F, INP(I_W2) + ((size_t)l * 2 + d) * 64 * RD, RD, 64, 0, RD, WL + (size_t)(0 * 2 + d) * RD * 64, 64, 0, rot);
                                    conv_seg(F, INP(I_A2) + ((size_t)l * 2 + d) * 64 * RD, RD, 64, 0, RD, WL + (size_t)(1 * 2 + d) * RD * 64, 64, 0, rot); } }
}
__device__ __forceinline__ void conv_ffn0(Frame& F) {
    int rot = 0; GAS unsigned char* ws = F.ws;
    conv_gu(F, INP(I_FFG), INP(I_FFU), FF, D, FF / 128, (bf16*)(ws + WS_WGU), rot);
    conv_ffd_dual(F, INP(I_FFD), (bf16*)(ws + WS_WDN), (bf16*)(ws + WS_WDNS), rot);
}
__device__ __forceinline__ void conv_experts(Frame& F, int e0, int e1) {
    int rot = 0;
    for (int e = e0; e < e1; ++e) {
        unsigned char* gu = (unsigned char*)F.ws + (e < 4 ? WS_WEA + (size_t)e * 7 * MiB : WS_WEGU + (size_t)(e - 4) * 7 * MiB);
        unsigned char* dn = (unsigned char*)F.ws + (e < 4 ? WS_WEA + 28 * MiB + (size_t)e * 3584 * 1024 : WS_WEDN + (size_t)(e - 4) * 3584 * 1024);
        conv_gu8(F, INP(I_EG) + (size_t)e * D * FE, INP(I_EU) + (size_t)e * D * FE, FE, D, FE / 128, gu, W8S, rot);
        conv_seg8(F, INP(I_ED) + (size_t)e * FE * D, D, FE, 0, D, dn, FE, 0, W8S, rot);
    }
}
__device__ __forceinline__ void mod_phase(Frame& F) {
    LAS float* sl = (LAS float*)F.lds;
    LAS float* part = sl + 5 * D;
    for (int i = F.tid; i < 5 * D; i += NTHREADS) { const int bb = i / D, k = i % D; const float v = bb < 4 ? INP(I_C)[bb * D + k] : INP(I_CCTX)[k]; sl[i] = siluf_(v); }
    __syncthreads();
    float* MOD = (float*)(F.ws + WS_MOD);
    for (int item = F.bid; item < NL * 6 * D / 64; item += F.G) {
        const int l = item / (6 * D / 64), c0 = (item % (6 * D / 64)) * 64; const float* w = INP(I_WADA) + (size_t)l * D * 6 * D + c0 + F.lane;
        float a[5] = {0.f, 0.f, 0.f, 0.f, 0.f};
        for (int k = F.wave * 128; k < F.wave * 128 + 128; ++k) { const float wv = w[(size_t)k * 6 * D];
#pragma unroll
            for (int bb = 0; bb < 5; ++bb) a[bb] += sl[bb * D + k] * wv; }
#pragma unroll
        for (int bb = 0; bb < 5; ++bb) part[(F.wave * 5 + bb) * 64 + F.lane] = a[bb];
        __syncthreads();
        if (F.tid < 5 * 64) { const int bb = F.tid / 64, c = F.tid % 64; float s = INP(I_BADA)[l * 6 * D + c0 + c];
#pragma unroll
            for (int w8 = 0; w8 < 8; ++w8) s += part[(w8 * 5 + bb) * 64 + c];
            MOD[((size_t)l * 5 + bb) * 6 * D + c0 + c] = s; }
        __syncthreads();
    }
}
__device__ __forceinline__ const float* xrow(const float* lat, const float* ctx, int g) { return g < RL ? lat + (size_t)g * D : ctx + (size_t)(g - RL) * D; }
template <bool ROUTER> __device__ __forceinline__ void normmod_phase(Frame& F, const float* lat, const float* ctx, const float* gain, const float* MODl, int off_sh, int off_sc, int nrows, const float* wrt) {
    bf16* H = (bf16*)(F.ws + WS_H);
    LAS unsigned* lcnt = (LAS unsigned*)F.lds;
    LAS int* rec = (LAS int*)(F.lds + 64);
    LAS float* recp = (LAS float*)(F.lds + 64 + 1024);
    const int ngroups = nrows / 64;
    for (int grp = F.bid; grp < ngroups; grp += F.G) {
        if (ROUTER) { if (F.tid < 16) lcnt[F.tid] = 0u; __syncthreads(); }
        f32x4 vnx[4];
        { const float* x0 = xrow(lat, ctx, grp * 64 + F.wave * 8);
#pragma unroll
          for (int j = 0; j < 4; ++j) vnx[j] = *(const f32x4*)(x0 + 256 * j + 4 * F.lane); }
        for (int rr = 0; rr < 8; ++rr) {
            const int lrow = F.wave * 8 + rr, g = grp * 64 + lrow; const float* md = MODl + (g < RL ? g / T : 4) * 6 * D;
            f32x4 v[4]; float ss = 0.f;
#pragma unroll
            for (int j = 0; j < 4; ++j) v[j] = vnx[j];
            if (rr + 1 < 8) { const float* x1 = xrow(lat, ctx, g + 1);
#pragma unroll
                for (int j = 0; j < 4; ++j) vnx[j] = *(const f32x4*)(x1 + 256 * j + 4 * F.lane); }
#pragma unroll
            for (int j = 0; j < 4; ++j) ss += (v[j].x * v[j].x + v[j].y * v[j].y) + (v[j].z * v[j].z + v[j].w * v[j].w);
            const float rstd = 1.0f / sqrtf(wave_sum(ss) * (1.0f / D) + NORM_EPS);
            float lg[NE];
            if (ROUTER) {
#pragma unroll
                for (int e = 0; e < NE; ++e) lg[e] = 0.f; }
#pragma unroll
            for (int j = 0; j < 4; ++j) { const int c = 256 * j + 4 * F.lane;
                const f32x4 gn = *(const f32x4*)(gain + c), sc = *(const f32x4*)(md + off_sc + c), sh = *(const f32x4*)(md + off_sh + c);
                const f32x4 h = v[j] * rstd * gn * (1.0f + sc) + sh;
                v2u o; o.x = cvt_pk_bf16(h.x, h.y); o.y = cvt_pk_bf16(h.z, h.w); *(v2u*)(H + (size_t)g * D + c) = o;
                if (ROUTER) {
#pragma unroll
                    for (int q = 0; q < 4; ++q) { const f32x4 w0 = *(const f32x4*)(wrt + (size_t)(c + q) * NE), w1 = *(const f32x4*)(wrt + (size_t)(c + q) * NE + 4); const float hv = h[q];
                        lg[0] += hv * w0.x; lg[1] += hv * w0.y; lg[2] += hv * w0.z; lg[3] += hv * w0.w; lg[4] += hv * w1.x; lg[5] += hv * w1.y; lg[6] += hv * w1.z; lg[7] += hv * w1.w; } }
            }
            if (ROUTER) {
#pragma unroll
                for (int e = 0; e < NE; ++e) lg[e] = wave_sum(lg[e]);
                int i0 = 0;
#pragma unroll
                for (int e = 1; e < NE; ++e) if (lg[e] > lg[i0]) i0 = e;
                int i1 = i0 == 0 ? 1 : 0;
#pragma unroll
                for (int e = 0; e < NE; ++e) if (e != i0 && lg[e] > lg[i1]) i1 = e;
                if (F.lane == 0) { const float e1 = __expf(lg[i1] - lg[i0]); const float p0 = 1.0f / (1.0f + e1);
                    rec[lrow * 4 + 0] = i0; rec[lrow * 4 + 1] = i1; rec[lrow * 4 + 2] = (int)atomicAdd((unsigned*)&lcnt[i0], 1u); rec[lrow * 4 + 3] = (int)atomicAdd((unsigned*)&lcnt[i1], 1u);
                    recp[lrow * 2 + 0] = p0; recp[lrow * 2 + 1] = e1 * p0; }
            }
        }
        if (ROUTER) {
            __syncthreads();
            if (F.tid < NE) lcnt[8 + F.tid] = __hip_atomic_fetch_add((unsigned*)(F.ctl + CW_ECNT + 64 * F.tid), lcnt[F.tid], RLX_AGENT);
            __syncthreads();
            if (F.tid < 64) { const int g = grp * 64 + F.tid; int* tk = (int*)(F.ws + WS_META) + (size_t)g * 8; const int e0 = rec[F.tid * 4], e1 = rec[F.tid * 4 + 1];
                tk[0] = e0; tk[1] = e1; tk[2] = (int)lcnt[8 + e0] + rec[F.tid * 4 + 2]; tk[3] = (int)lcnt[8 + e1] + rec[F.tid * 4 + 3];
                ((float*)tk)[4] = recp[F.tid * 2]; ((float*)tk)[5] = recp[F.tid * 2 + 1]; }
            __syncthreads();
        }
    }
}
__device__ __forceinline__ void subgrid_arrive(Frame& F, gu32* cnt) {
    asm volatile("s_waitcnt vmcnt(0)" ::: "memory"); __syncthreads();
    if (F.tid == 0) { __builtin_amdgcn_fence(__ATOMIC_RELEASE, "agent"); asm volatile("s_waitcnt vmcnt(0)" ::: "memory"); __hip_atomic_fetch_add(cnt, 1u, RLX_AGENT); }
}
__device__ __forceinline__ void subgrid_wait(Frame& F, gu32* cnt, unsigned n) {
    if (F.tid == 0) { unsigned sp = 0; while (__hip_atomic_load(cnt, RLX_AGENT) < n) { __builtin_amdgcn_s_sleep(2); if (++sp > (1u << 20)) break; }
        __builtin_amdgcn_fence(__ATOMIC_ACQUIRE, "agent"); asm volatile("s_waitcnt vmcnt(0)" ::: "memory"); }
    __syncthreads();
}
__device__ __forceinline__ void normmod_ctx_slabs(Frame& F, const float* XCp, const float* slab, const float* gain, const float* MODl, int off_sh, int off_sc) {
    bf16* H = (bf16*)(F.ws + WS_H); const float* md = MODl + 4 * 6 * D;
    for (int r = F.bid * NWAVES + F.wave; r < RC; r += F.G * NWAVES) {
        f32x4 v[4], p[NSL][4];
#pragma unroll
        for (int j = 0; j < 4; ++j) v[j] = *(const f32x4*)(XCp + (size_t)r * D + 256 * j + 4 * F.lane);
#pragma unroll
        for (int s_ = 0; s_ < NSL; ++s_)
#pragma unroll
            for (int j = 0; j < 4; ++j) p[s_][j] = *(const f32x4*)(slab + ((size_t)s_ * RC + r) * D + 256 * j + 4 * F.lane);
        float ss = 0.f;
#pragma unroll
        for (int j = 0; j < 4; ++j) {
#pragma unroll
            for (int s_ = 0; s_ < NSL; ++s_) v[j] += p[s_][j];
            ss += (v[j].x * v[j].x + v[j].y * v[j].y) + (v[j].z * v[j].z + v[j].w * v[j].w); }
        const float rstd = 1.0f / sqrtf(wave_sum(ss) * (1.0f / D) + NORM_EPS);
#pragma unroll
        for (int j = 0; j < 4; ++j) { const int c = 256 * j + 4 * F.lane;
            const f32x4 gn = *(const f32x4*)(gain + c), sc = *(const f32x4*)(md + off_sc + c), sh = *(const f32x4*)(md + off_sh + c);
            const f32x4 h = v[j] * rstd * gn * (1.0f + sc) + sh;
            v2u o; o.x = cvt_pk_bf16(h.x, h.y); o.y = cvt_pk_bf16(h.z, h.w); *(v2u*)(H + (size_t)(RL + r) * D + c) = o; }
    }
}
__device__ __forceinline__ void sg_phase(Frame& F, int l) {
    const float* SM = (const float*)(F.ws + WS_SM); bf16* SG = (bf16*)(F.ws + WS_SG); const float* mu = INP(I_MU) + l * RW + 3328;
    for (int i = F.cb * NTHREADS + F.tid; i < R * 32; i += F.cg * NTHREADS) { const int g = i >> 5, p = i & 31; float o[8];
        if (p < 16) { const int nb = nbrow(g, 3328); const float* a = SM + (size_t)g * SMW + 288 + 8 * p;
            const f32x4 a0 = *(const f32x4*)a, a1 = *(const f32x4*)(a + 4); f32x4 b0 = {0.f, 0.f, 0.f, 0.f}, b1 = b0;
            if (nb >= 0) { const float* bq = SM + (size_t)nb * SMW + 288 + 8 * p; b0 = *(const f32x4*)bq; b1 = *(const f32x4*)(bq + 4); }
#pragma unroll
            for (int j = 0; j < 4; ++j) { o[j] = sigmoidf_(a0[j] + (b0[j] - a0[j]) * mu[8 * p + j]); o[4 + j] = sigmoidf_(a1[j] + (b1[j] - a1[j]) * mu[8 * p + 4 + j]); }
        } else {
#pragma unroll
            for (int j = 0; j < 8; ++j) o[j] = 0.f; }
        *(v4u*)(SG + (size_t)g * 256 + 8 * p) = pack8(o); }
}

constexpr int ML_P = 72, ML_QS = 0, ML_KS = 64 * ML_P * 2, ML_KT = 2 * ML_KS, ML_PS = 3 * ML_KS, ML_VT = 4 * ML_KS, ML_CB = ML_VT + 48 * ML_P * 2, ML_GT = ML_CB + 48 * ML_P * 2, ML_END = ML_GT + 2 * 6 * 64 * 4;
template <int CTRL, int RMASK> __device__ __forceinline__ float dpp_get(float v, float old) { return __int_as_float(__builtin_amdgcn_update_dpp(__float_as_int(old), __float_as_int(v), CTRL, RMASK, 0xf, false)); }
__device__ __forceinline__ float wave_scan_add(float x) {
    x += dpp_get<0x111, 0xf>(x, 0.f); x += dpp_get<0x112, 0xf>(x, 0.f); x += dpp_get<0x114, 0xf>(x, 0.f); x += dpp_get<0x118, 0xf>(x, 0.f);
    x += dpp_get<0x142, 0xa>(x, 0.f); x += dpp_get<0x143, 0xc>(x, 0.f); return x;
}
__device__ __forceinline__ float wave_scan_max(float x) {
    const float ninf = -__builtin_inff();
    x = fmaxf(x, dpp_get<0x111, 0xf>(x, ninf)); x = fmaxf(x, dpp_get<0x112, 0xf>(x, ninf)); x = fmaxf(x, dpp_get<0x114, 0xf>(x, ninf)); x = fmaxf(x, dpp_get<0x118, 0xf>(x, ninf));
    x = fmaxf(x, dpp_get<0x142, 0xa>(x, ninf)); x = fmaxf(x, dpp_get<0x143, 0xc>(x, ninf)); return x;
}
__device__ __forceinline__ float lane63(float x) { return __int_as_float(__builtin_amdgcn_readlane(__float_as_int(x), 63)); }
__device__ __forceinline__ void mlstm_phase(Frame& F, int l, int first, int stride) {
    LAS unsigned char* L = F.lds;
    LAS bf16* Qs = (LAS bf16*)(L + ML_QS); LAS bf16* Ks = (LAS bf16*)(L + ML_KS); LAS bf16* Kt = (LAS bf16*)(L + ML_KT); LAS bf16* Ps = (LAS bf16*)(L + ML_PS);
    LAS bf16* Vt = (LAS bf16*)(L + ML_VT); LAS bf16* Cb = (LAS bf16*)(L + ML_CB); LAS float* GT = (LAS float*)(L + ML_GT);
    const bf16* Qg = (const bf16*)(F.ws + WS_Q); const bf16* Kg = (const bf16*)(F.ws + WS_K); const bf16* Vg = (const bf16*)(F.ws + WS_V); const float* SM = (const float*)(F.ws + WS_SM);
    bf16* HF = (bf16*)(F.ws + WS_HF); const float* bgate = INP(I_BG) + l * 4 * MH;
    const int tid = F.tid, lane = F.lane, wave = F.wave, r16 = lane & 15, quad = lane >> 4;
    for (int item = first; item < NB * 2 * MH * 4; item += stride) {
        const int vq = item & 3, h = (item >> 2) & 7, dir = (item >> 5) & 1, b = item >> 6;
        __syncthreads();
        for (int i = tid; i < 48 * ML_P; i += NTHREADS) { Cb[i] = 0; Vt[i] = (i >= 32 * ML_P) ? (bf16)0x3F80 : (bf16)0; }
        const float bgi = bgate[(2 * dir) * MH + h], bgf = bgate[(2 * dir + 1) * MH + h];
        const int ss_ = tid & 63, pc = tid >> 6;
        v4u rq, rk, rv = {0u, 0u, 0u, 0u};
        { const int g = row_of(b, tok(dir, ss_)); rq = *(const v4u*)(Qg + (size_t)g * 512 + h * 64 + pc * 8); rk = *(const v4u*)(Kg + (size_t)g * 512 + h * 64 + pc * 8);
          if (pc < 4) rv = *(const v4u*)(Vg + (size_t)g * 1024 + h * 128 + vq * 32 + pc * 8); }
        float m_run = 0.f, gi = 0.f, gf = 0.f;
        auto gate_tables = [&](int buf) {
            LAS float* G = GT + buf * 384;
            const float iv = CAP * fast_tanh((gi + bgi) * (1.0f / CAP)), lf = -fast_softplus(-CAP * fast_tanh((gf + bgf) * (1.0f / CAP)));
            const float bsum = wave_scan_add(lf), pmx = wave_scan_max(iv - bsum);
            const float inter = bsum + m_run, mt = fmaxf(inter, bsum + pmx);
            G[lane] = bsum - mt; G[64 + lane] = iv - bsum; G[128 + lane] = __expf(inter - mt); G[192 + lane] = __expf(-mt);
            const float blast = lane63(bsum), mnew = fmaxf(blast + m_run, blast + lane63(pmx));
            G[256 + lane] = __expf(blast - bsum + iv - mnew);
            if (lane == 0) G[320] = __expf(blast + m_run - mnew);
            m_run = mnew;
        };
        if (wave == 1) { { const int g = row_of(b, tok(dir, lane)); gi = SM[(size_t)g * SMW + (2 * dir) * MH + h]; gf = SM[(size_t)g * SMW + (2 * dir + 1) * MH + h]; }
            gate_tables(0);
            { const int g = row_of(b, tok(dir, 64 + lane)); gi = SM[(size_t)g * SMW + (2 * dir) * MH + h]; gf = SM[(size_t)g * SMW + (2 * dir + 1) * MH + h]; } }
        f32x4 Cacc = {0.f, 0.f, 0.f, 0.f}, Cacc2 = {0.f, 0.f, 0.f, 0.f};
        __syncthreads();
        for (int j = 0; j < NCH; ++j) {
            const LAS float* G = GT + (j & 1) * 384;
            { *(v4u*)(Qs + ss_ * ML_P + pc * 8) = rq; *(v4u*)(Ks + ss_ * ML_P + pc * 8) = rk;
              const unsigned kw[4] = {rk.x, rk.y, rk.z, rk.w};
#pragma unroll
              for (int i = 0; i < 4; ++i) { Kt[(pc * 8 + 2 * i) * ML_P + ss_] = (bf16)(kw[i] & 0xffffu); Kt[(pc * 8 + 2 * i + 1) * ML_P + ss_] = (bf16)(kw[i] >> 16); }
              if (pc < 4) { const unsigned vw[4] = {rv.x, rv.y, rv.z, rv.w};
#pragma unroll
                  for (int i = 0; i < 4; ++i) { Vt[(pc * 8 + 2 * i) * ML_P + ss_] = (bf16)(vw[i] & 0xffffu); Vt[(pc * 8 + 2 * i + 1) * ML_P + ss_] = (bf16)(vw[i] >> 16); } } }
            if (j + 1 < NCH) { const int g = row_of(b, tok(dir, (j + 1) * 64 + ss_)); rq = *(const v4u*)(Qg + (size_t)g * 512 + h * 64 + pc * 8); rk = *(const v4u*)(Kg + (size_t)g * 512 + h * 64 + pc * 8);
                if (pc < 4) rv = *(const v4u*)(Vg + (size_t)g * 1024 + h * 128 + vq * 32 + pc * 8); }
            __syncthreads();
            const int mt = wave >> 1, vnt = wave & 1;
            if (wave == 1 && j + 1 < NCH) { gate_tables((j + 1) & 1);
                if (j + 2 < NCH) { const int g = row_of(b, tok(dir, (j + 2) * 64 + lane)); gi = SM[(size_t)g * SMW + (2 * dir) * MH + h]; gf = SM[(size_t)g * SMW + (2 * dir + 1) * MH + h]; } }
            const bf16x8 qa0 = *(const LAS bf16x8*)(Qs + (16 * mt + r16) * ML_P + quad * 8), qa1 = *(const LAS bf16x8*)(Qs + (16 * mt + r16) * ML_P + 32 + quad * 8);
            f32x4 accq = {0.f, 0.f, 0.f, 0.f}, accqn = {0.f, 0.f, 0.f, 0.f};
            { const bf16x8 c0 = *(const LAS bf16x8*)(Cb + (16 * vnt + r16) * ML_P + quad * 8), c1 = *(const LAS bf16x8*)(Cb + (16 * vnt + r16) * ML_P + 32 + quad * 8);
              const bf16x8 n0 = *(const LAS bf16x8*)(Cb + (32 + r16) * ML_P + quad * 8), n1 = *(const LAS bf16x8*)(Cb + (32 + r16) * ML_P + 32 + quad * 8);
              accq = __builtin_amdgcn_mfma_f32_16x16x32_bf16(qa0, c0, accq, 0, 0, 0); accq = __builtin_amdgcn_mfma_f32_16x16x32_bf16(qa1, c1, accq, 0, 0, 0);
              accqn = __builtin_amdgcn_mfma_f32_16x16x32_bf16(qa0, n0, accqn, 0, 0, 0); accqn = __builtin_amdgcn_mfma_f32_16x16x32_bf16(qa1, n1, accqn, 0, 0, 0); }
#pragma unroll
            for (int nn = 0; nn < 2; ++nn) { const int nt = 2 * (wave & 1) + nn; f32x4 sacc = {0.f, 0.f, 0.f, 0.f};
                if (nt <= mt) { const bf16x8 k0 = *(const LAS bf16x8*)(Ks + (16 * nt + r16) * ML_P + quad * 8), k1 = *(const LAS bf16x8*)(Ks + (16 * nt + r16) * ML_P + 32 + quad * 8);
                    sacc = __builtin_amdgcn_mfma_f32_16x16x32_bf16(qa0, k0, sacc, 0, 0, 0); sacc = __builtin_amdgcn_mfma_f32_16x16x32_bf16(qa1, k1, sacc, 0, 0, 0); }
                const int s = 16 * nt + r16; const float wc_ = G[64 + s];
#pragma unroll
                for (int i = 0; i < 4; ++i) { const int t = 16 * mt + 4 * quad + i; const float p = (s <= t) ? sacc[i] * 0.125f * __expf(G[t] + wc_) : 0.f;
                    Ps[t * ML_P + s] = (bf16)(cvt_pk_bf16(p, 0.f) & 0xffffu); } }
            __syncthreads();
            { f32x4 acc = {0.f, 0.f, 0.f, 0.f}, accn = {0.f, 0.f, 0.f, 0.f};
#pragma unroll
              for (int ks = 0; ks < 2; ++ks) { if (ks == 1 && mt < 2) break;
                  const bf16x8 pa = *(const LAS bf16x8*)(Ps + (16 * mt + r16) * ML_P + 32 * ks + quad * 8);
                  const bf16x8 vb = *(const LAS bf16x8*)(Vt + (16 * vnt + r16) * ML_P + 32 * ks + quad * 8), ob = *(const LAS bf16x8*)(Vt + (32 + r16) * ML_P + 32 * ks + quad * 8);
                  acc = __builtin_amdgcn_mfma_f32_16x16x32_bf16(pa, vb, acc, 0, 0, 0); accn = __builtin_amdgcn_mfma_f32_16x16x32_bf16(pa, ob, accn, 0, 0, 0); }
#pragma unroll
              for (int i = 0; i < 4; ++i) { const int t = 16 * mt + 4 * quad + i; const float wi = G[128 + t] * 0.125f, dn = accn[i] + wi * accqn[i], inv = 1.0f / fmaxf(fabsf(dn), G[192 + t]);
                  const int g = row_of(b, tok(dir, j * 64 + t));
                  HF[((size_t)dir * R + g) * 1024 + h * 128 + vq * 32 + 16 * vnt + r16] = (bf16)(cvt_pk_bf16((acc[i] + wi * accq[i]) * inv, 0.f) & 0xffffu); } }
            { const float aold = G[320]; const int vmt = wave >> 2, dnt = wave & 3;
              f32x4 d1 = {0.f, 0.f, 0.f, 0.f}, d2 = {0.f, 0.f, 0.f, 0.f};
#pragma unroll
              for (int ks = 0; ks < 2; ++ks) {
                  const v4u kraw = *(const LAS v4u*)(Kt + (16 * dnt + r16) * ML_P + 32 * ks + quad * 8); float kf[8]; unpack8(kraw, kf);
                  const f32x4 a0 = *(const LAS f32x4*)&G[256 + 32 * ks + quad * 8], a1 = *(const LAS f32x4*)&G[256 + 32 * ks + quad * 8 + 4];
                  kf[0] *= a0.x; kf[1] *= a0.y; kf[2] *= a0.z; kf[3] *= a0.w; kf[4] *= a1.x; kf[5] *= a1.y; kf[6] *= a1.z; kf[7] *= a1.w;
                  const v4u kp = pack8(kf); const bf16x8 kb = __builtin_bit_cast(bf16x8, kp);
                  const bf16x8 va = *(const LAS bf16x8*)(Vt + (16 * vmt + r16) * ML_P + 32 * ks + quad * 8);
                  d1 = __builtin_amdgcn_mfma_f32_16x16x32_bf16(va, kb, d1, 0, 0, 0);
                  if (wave < 4) { const bf16x8 oa = *(const LAS bf16x8*)(Vt + (32 + r16) * ML_P + 32 * ks + quad * 8); d2 = __builtin_amdgcn_mfma_f32_16x16x32_bf16(oa, kb, d2, 0, 0, 0); } }
              Cacc = Cacc * aold + d1;
#pragma unroll
              for (int i = 0; i < 4; ++i) Cb[(16 * vmt + 4 * quad + i) * ML_P + 16 * dnt + r16] = (bf16)(cvt_pk_bf16(Cacc[i], 0.f) & 0xffffu);
              if (wave < 4) { Cacc2 = Cacc2 * aold + d2;
#pragma unroll
                  for (int i = 0; i < 4; ++i) Cb[(32 + 4 * quad + i) * ML_P + 16 * dnt + r16] = (bf16)(cvt_pk_bf16(Cacc2[i], 0.f) & 0xffffu); } }
            __syncthreads();
        }
    }
}

constexpr int RP = 72;
constexpr int RC_AB = 0, RC_BB = 9216, RC_KB = 18432, RC_RB = 27648, RC_BHT = 36864, RC_KHT = 46080, RC_ABT = 55296, RC_GAKT = 64512, RC_BONP = 67584;
constexpr int RC_TW = 0, RC_AD = 9216;
constexpr int RC_KK16 = 71680, RC_K16 = 80896, RC_R16 = 99328;
constexpr int RC_GAB = 71680, RC_GAK = 75776, RC_HRB = 78848, RC_HRK = 81920, RC_TT = 84992, RC_SAT = 88064, RC_YO = 93184;
constexpr int RC_GL = 109568, RC_VT = 110592, RC_SB = 119808, RC_CONST = 129024, RC_W2T = 133120, RC_A2T = 142336, RC_END = 151552;
static_assert(RC_END <= MISC_OFF && RC_YO + 16384 <= RC_GL && RC_BONP + 1024 <= RC_KK16 && RC_TT + 3072 <= RC_SAT && RC_SAT + 5120 <= RC_YO, "rwkv LDS map");
struct RwPre { f32x4 lw[2], lwn[2], la[2], lan[2]; v4u r, rn, k, kn, v, vn; };
__device__ __forceinline__ void rw_prefetch(RwPre& P, const float* SM, const bf16* RKV, int b, int dir, int h, int j, int tid) {
    const int s = tid >> 3, p8 = (tid & 7) * 8, g = row_of(b, tok(dir, j * 64 + s));
    { const int nb = nbrow(g, 3072); const float* a = SM + (size_t)g * SMW + 32 + 64 * dir + p8; const float* c = SM + (size_t)g * SMW + 160 + 64 * dir + p8;
      P.lw[0] = *(const f32x4*)a; P.lw[1] = *(const f32x4*)(a + 4); P.la[0] = *(const f32x4*)c; P.la[1] = *(const f32x4*)(c + 4);
      const f32x4 z = {0.f, 0.f, 0.f, 0.f}; P.lwn[0] = z; P.lwn[1] = z; P.lan[0] = z; P.lan[1] = z;
      if (nb >= 0) { const float* an = SM + (size_t)nb * SMW + 32 + 64 * dir + p8; const float* cn = SM + (size_t)nb * SMW + 160 + 64 * dir + p8;
          P.lwn[0] = *(const f32x4*)an; P.lwn[1] = *(const f32x4*)(an + 4); P.lan[0] = *(const f32x4*)cn; P.lan[1] = *(const f32x4*)(cn + 4); } }
    const v4u z4 = {0u, 0u, 0u, 0u};
    { const int rw = h * 64 + p8, nb = nbrow(g, rw); P.r = *(const v4u*)(RKV + (size_t)g * 3072 + rw); P.rn = nb >= 0 ? *(const v4u*)(RKV + (size_t)nb * 3072 + rw) : z4; }
    { const int rw = 1024 + h * 64 + p8, nb = nbrow(g, rw); P.k = *(const v4u*)(RKV + (size_t)g * 3072 + rw); P.kn = nb >= 0 ? *(const v4u*)(RKV + (size_t)nb * 3072 + rw) : z4; }
    { const int rw = 2048 + h * 64 + p8, nb = nbrow(g, rw); P.v = *(const v4u*)(RKV + (size_t)g * 3072 + rw); P.vn = nb >= 0 ? *(const v4u*)(RKV + (size_t)nb * 3072 + rw) : z4; }
}
__device__ __forceinline__ bf16x8 lds_frag(const LAS bf16* p) { return *(const LAS bf16x8*)p; }
__device__ __forceinline__ bf16x8 lds_frag_k16(const LAS bf16* p, int quad) { const bf16x8 v = *(const LAS bf16x8*)p; const bf16x8 z = {0, 0, 0, 0, 0, 0, 0, 0}; return quad < 2 ? v : z; }
__device__ __forceinline__ bf16x8 lds_frag_perm(const LAS bf16* p) { const v2u lo = *(const LAS v2u*)p, hi = *(const LAS v2u*)(p + 16); const v4u w = {lo.x, lo.y, hi.x, hi.y}; return __builtin_bit_cast(bf16x8, w); }
__device__ __forceinline__ bf16x8 lds_frag_lo4(const LAS bf16* p) { const v2u lo = *(const LAS v2u*)p; const v4u w = {lo.x, lo.y, 0u, 0u}; return __builtin_bit_cast(bf16x8, w); }
__device__ __forceinline__ unsigned pk2(float lo, float hi) { typedef __bf16 bf2 __attribute__((ext_vector_type(2))); const bf2 v = {(__bf16)lo, (__bf16)hi}; return __builtin_bit_cast(unsigned, v); }
__device__ __forceinline__ bf16 f2b(float x) { return __builtin_bit_cast(unsigned short, (__bf16)x); }
__device__ __forceinline__ float b2f(bf16 x) { return __uint_as_float((unsigned)x << 16); }
#define MFMA16(a, b, c) __builtin_amdgcn_mfma_f32_16x16x32_bf16(a, b, c, 0, 0, 0)
__device__ __forceinline__ void rwkv_phase(Frame& F, int l, int first, int stride) {
    LAS unsigned char* L = F.lds;
    LAS bf16* Ab = (LAS bf16*)(L + RC_AB); LAS bf16* Bb = (LAS bf16*)(L + RC_BB); LAS bf16* Kb = (LAS bf16*)(L + RC_KB); LAS bf16* Rb = (LAS bf16*)(L + RC_RB);
    LAS bf16* BhT = (LAS bf16*)(L + RC_BHT); LAS bf16* KhT = (LAS bf16*)(L + RC_KHT); LAS bf16* AbT = (LAS bf16*)(L + RC_ABT); LAS bf16* GAKT = (LAS bf16*)(L + RC_GAKT); LAS float* BONP = (LAS float*)(L + RC_BONP);
    LAS bf16* TW = (LAS bf16*)(L + RC_TW); LAS bf16* AD = (LAS bf16*)(L + RC_AD);
    LAS bf16* KK16 = (LAS bf16*)(L + RC_KK16); LAS bf16* K16 = (LAS bf16*)(L + RC_K16); LAS bf16* R16 = (LAS bf16*)(L + RC_R16);
    LAS float* GAB = (LAS float*)(L + RC_GAB); LAS bf16* GAK = (LAS bf16*)(L + RC_GAK); LAS bf16* HRB = (LAS bf16*)(L + RC_HRB); LAS bf16* HRK = (LAS bf16*)(L + RC_HRK); LAS bf16* TT = (LAS bf16*)(L + RC_TT);
    LAS bf16* SAt = (LAS bf16*)(L + RC_SAT); LAS float* YO = (LAS float*)(L + RC_YO); LAS float* GL = (LAS float*)(L + RC_GL);
    LAS bf16* Vt = (LAS bf16*)(L + RC_VT); LAS bf16* Sb = (LAS bf16*)(L + RC_SB); LAS float* CN = (LAS float*)(L + RC_CONST); LAS bf16* W2T = (LAS bf16*)(L + RC_W2T); LAS bf16* A2T = (LAS bf16*)(L + RC_A2T);
    const float* SM = (const float*)(F.ws + WS_SM); const bf16* RKV = (const bf16*)(F.ws + WS_RKV); bf16* YS = (bf16*)(F.ws + WS_YS); float* BON = (float*)(F.ws + WS_BON);
    const bf16* WL = (const bf16*)(F.ws + WS_WLORA);
    const int tid = F.tid, lane = F.lane, wave = F.wave;
    for (int item = first; item < NB * 2 * RH; item += stride) {
        const int h = item & 15, dir = (item >> 4) & 1, b = item >> 5;
        __syncthreads();
        if (tid < 64) { const float* mu = INP(I_MU) + l * RW; CN[tid] = mu[h * 64 + tid]; CN[64 + tid] = mu[1024 + h * 64 + tid]; CN[128 + tid] = mu[2048 + h * 64 + tid];
            CN[192 + tid] = mu[3072 + 64 * dir + tid]; CN[256 + tid] = mu[3200 + 64 * dir + tid];
            CN[320 + tid] = INP(I_KK)[l * RD + h * 64 + tid]; CN[384 + tid] = INP(I_KA)[l * RD + h * 64 + tid]; CN[448 + tid] = INP(I_RK)[l * RD + h * 64 + tid];
            CN[512 + tid] = INP(I_W0)[(l * 2 + dir) * RD + h * 64 + tid]; CN[576 + tid] = INP(I_A0)[(l * 2 + dir) * RD + h * 64 + tid]; }
        { const int n = tid >> 3, p8 = (tid & 7) * 8;
          *(v4u*)(W2T + n * 72 + p8) = *(const v4u*)(WL + ((size_t)(0 * 2 + dir) * RD + h * 64 + n) * 64 + p8);
          *(v4u*)(A2T + n * 72 + p8) = *(const v4u*)(WL + ((size_t)(1 * 2 + dir) * RD + h * 64 + n) * 64 + p8); }
        for (int i = tid; i < (RC_CONST - RC_GL) / 4; i += NTHREADS) ((LAS unsigned*)(L + RC_GL))[i] = 0u;
        f32x4 ST[4]; for (int kt = 0; kt < 4; ++kt) ST[kt] = (f32x4){0.f, 0.f, 0.f, 0.f};
        RwPre P; rw_prefetch(P, SM, RKV, b, dir, h, 0, tid);
        __syncthreads();
        for (int j = 0; j < NCH; ++j) {
            { int tl = tid; asm volatile("" : "+v"(tl)); const int s = tl >> 3, p8 = (tl & 7) * 8;
              { float tw[8], ad[8]; const f32x4 muw[2] = {*(const f32x4*)&CN[192 + p8], *(const f32x4*)&CN[196 + p8]}, mua[2] = {*(const f32x4*)&CN[256 + p8], *(const f32x4*)&CN[260 + p8]};
#pragma unroll
                for (int i = 0; i < 8; ++i) { const float pw = P.lw[i >> 2][i & 3], pwn = P.lwn[i >> 2][i & 3], pa = P.la[i >> 2][i & 3], pan = P.lan[i >> 2][i & 3];
                    tw[i] = fast_tanh(pw + (pwn - pw) * muw[i >> 2][i & 3]); ad[i] = pa + (pan - pa) * mua[i >> 2][i & 3]; }
                *(v4u*)(TW + s * 72 + p8) = pack8(tw); *(v4u*)(AD + s * 72 + p8) = pack8(ad); }
              { float a[8], bq[8], o[8]; const f32x4 mur[2] = {*(const f32x4*)&CN[p8], *(const f32x4*)&CN[4 + p8]}, muk[2] = {*(const f32x4*)&CN[64 + p8], *(const f32x4*)&CN[68 + p8]};
                unpack8(P.r, a); unpack8(P.rn, bq);
#pragma unroll
                for (int i = 0; i < 8; ++i) o[i] = a[i] + (bq[i] - a[i]) * mur[i >> 2][i & 3];
                *(v4u*)(R16 + s * RP + p8) = pack8(o);
                unpack8(P.k, a); unpack8(P.kn, bq); float ssq = 0.f; const f32x4 kkc[2] = {*(const f32x4*)&CN[320 + p8], *(const f32x4*)&CN[324 + p8]};
#pragma unroll
                for (int i = 0; i < 8; ++i) { o[i] = a[i] + (bq[i] - a[i]) * muk[i >> 2][i & 3]; a[i] = o[i] * kkc[i >> 2][i & 3]; ssq += a[i] * a[i]; }
                *(v4u*)(K16 + s * RP + p8) = pack8(o);
                const float inv = 1.0f / fmaxf(sqrtf(red8(ssq)), 1e-12f);
#pragma unroll
                for (int i = 0; i < 8; ++i) a[i] *= inv;
                *(v4u*)(KK16 + s * RP + p8) = pack8(a);
                { unpack8(P.v, a); unpack8(P.vn, bq); const f32x4 muv[2] = {*(const f32x4*)&CN[128 + p8], *(const f32x4*)&CN[132 + p8]};
#pragma unroll
                  for (int i = 0; i < 8; ++i) Vt[(p8 + i) * RP + s] = f2b(a[i] + (bq[i] - a[i]) * muv[i >> 2][i & 3]); } } }
            __syncthreads();
            if (j + 1 < NCH) rw_prefetch(P, SM, RKV, b, dir, h, j + 1, tid);
            { int lb = lane; asm volatile("" : "+v"(lb)); const int r16 = lb & 15, quad = lb >> 4; const int c = wave >> 1;
              const bf16x8 a0 = lds_frag(TW + (16 * c + r16) * 72 + quad * 8), a1 = lds_frag(TW + (16 * c + r16) * 72 + 32 + quad * 8);
              const bf16x8 d0 = lds_frag(AD + (16 * c + r16) * 72 + quad * 8), d1 = lds_frag(AD + (16 * c + r16) * 72 + 32 + quad * 8);
              f32x4 cw[2], ca[2];
#pragma unroll
              for (int nn = 0; nn < 2; ++nn) { const int nt = 2 * (wave & 1) + nn; const f32x4 z = {0.f, 0.f, 0.f, 0.f};
                  cw[nn] = MFMA16(a0, lds_frag(W2T + (16 * nt + r16) * 72 + quad * 8), z); cw[nn] = MFMA16(a1, lds_frag(W2T + (16 * nt + r16) * 72 + 32 + quad * 8), cw[nn]);
                  ca[nn] = MFMA16(d0, lds_frag(A2T + (16 * nt + r16) * 72 + quad * 8), z); ca[nn] = MFMA16(d1, lds_frag(A2T + (16 * nt + r16) * 72 + 32 + quad * 8), ca[nn]); }
              __syncthreads();
              float bsum[4] = {0.f, 0.f, 0.f, 0.f};
#pragma unroll
              for (int nn = 0; nn < 2; ++nn) { const int nt = 2 * (wave & 1) + nn, n = 16 * nt + r16; const float w0c = CN[512 + n], a0c = CN[576 + n], kac = CN[384 + n], rkc = CN[448 + n];
                  float wv[4], av[4], pin[4], pex[4];
#pragma unroll
                  for (int i = 0; i < 4; ++i) { wv[i] = __expf(-0.60653066f * sigmoidf_(w0c + cw[nn][i])); av[i] = sigmoidf_(a0c + ca[nn][i]); }
                  pin[0] = wv[0]; pin[1] = pin[0] * wv[1]; pin[2] = pin[1] * wv[2]; pin[3] = pin[2] * wv[3];
                  float x = pin[3], y = __shfl_up(x, 16); if (quad >= 1) x *= y; y = __shfl_up(x, 32); if (quad >= 2) x *= y;
                  float ex = __shfl_up(x, 16); if (quad == 0) ex = 1.0f; const float gl = __shfl(x, 48 + r16);
                  pex[0] = ex; pex[1] = ex * pin[0]; pex[2] = ex * pin[1]; pex[3] = ex * pin[2];
#pragma unroll
                  for (int i = 0; i < 4; ++i) pin[i] *= ex;
                  float abv[4], bhv[4], khv[4];
#pragma unroll
                  for (int i = 0; i < 4; ++i) { const int t = 16 * c + 4 * quad + i; const float kk = b2f(KK16[t * RP + n]), kx = b2f(K16[t * RP + n]), rr = b2f(R16[t * RP + n]);
                      const float kka = kk * av[i], kd = kx * (1.0f + (av[i] - 1.0f) * kac), gi_ = __builtin_amdgcn_rcpf(pin[i]), bb = kka * gi_, kb = kd * gi_;
                      abv[i] = kk * pex[i]; bhv[i] = bb * gl; khv[i] = kb * gl; bsum[i] += rr * kd * rkc;
                      Ab[t * RP + n] = f2b(abv[i]); Rb[t * RP + n] = f2b(rr * pin[i]); Bb[t * RP + n] = f2b(bb); Kb[t * RP + n] = f2b(kb); }
                  { v2u o; o.x = cvt_pk_bf16(abv[0], abv[1]); o.y = cvt_pk_bf16(abv[2], abv[3]); *(v2u*)(AbT + n * RP + 16 * c + 4 * quad) = o;
                    o.x = cvt_pk_bf16(bhv[0], bhv[1]); o.y = cvt_pk_bf16(bhv[2], bhv[3]); *(v2u*)(BhT + n * RP + 16 * c + 4 * quad) = o;
                    o.x = cvt_pk_bf16(khv[0], khv[1]); o.y = cvt_pk_bf16(khv[2], khv[3]); *(v2u*)(KhT + n * RP + 16 * c + 4 * quad) = o; }
                  if (quad == 3) GL[c * 64 + n] = gl;
              }
#pragma unroll
              for (int i = 0; i < 4; ++i) { const float tot = red16(bsum[i]); if (r16 == 0) BONP[(16 * c + 4 * quad + i) * 2 + (wave & 1)] = tot; } }
            __syncthreads();
            { int lf_ = lane; asm volatile("" : "+v"(lf_)); const int r16 = lf_ & 15, quad = lf_ >> 4; const int c = wave & 3, odd = wave >> 2; const LAS bf16* Asrc = odd ? Rb : Ab;     const f32x4 z = {0.f, 0.f, 0.f, 0.f};
              const bf16x8 a0 = lds_frag(Asrc + (16 * c + r16) * RP + quad * 8), a1 = lds_frag(Asrc + (16 * c + r16) * RP + 32 + quad * 8);
              f32x4 g1 = MFMA16(a0, lds_frag(Bb + (16 * c + r16) * RP + quad * 8), z); g1 = MFMA16(a1, lds_frag(Bb + (16 * c + r16) * RP + 32 + quad * 8), g1);
              f32x4 g2 = MFMA16(a0, lds_frag(Kb + (16 * c + r16) * RP + quad * 8), z); g2 = MFMA16(a1, lds_frag(Kb + (16 * c + r16) * RP + 32 + quad * 8), g2);
              if (wave == 7) { const float bs = BONP[lf_ * 2] + BONP[lf_ * 2 + 1]; BON[((size_t)dir * R + row_of(b, tok(dir, j * 64 + lf_))) * RH + h] = bs; }
              float v2m[4];
#pragma unroll
              for (int i = 0; i < 4; ++i) { const int t = 4 * quad + i; const bool keep = odd ? (r16 <= t) : (r16 < t); const float v1 = keep ? g1[i] : 0.f; v2m[i] = keep ? g2[i] : 0.f;
                  if (odd) { HRB[c * 384 + t * 24 + r16] = f2b(v1); HRK[c * 384 + t * 24 + r16] = f2b(v2m[i]); } else { GAB[c * 256 + t * 16 + r16] = v1; GAK[c * 384 + t * 24 + r16] = f2b(v2m[i]); } }
              if (!odd) { { v2u o; o.x = cvt_pk_bf16(v2m[0], v2m[1]); o.y = cvt_pk_bf16(v2m[2], v2m[3]); *(v2u*)(GAKT + c * 384 + r16 * 24 + 4 * quad) = o; }
                  LDS_WAIT(); __builtin_amdgcn_wave_barrier();
                  float tj[16];
                  tj[0] = (r16 == 0) ? 1.0f : 0.f;
#pragma unroll
                  for (int i = 1; i < 16; ++i) { const LAS f32x4* gr = (const LAS f32x4*)(GAB + c * 256 + i * 16); float acc0 = (r16 == i) ? 1.0f : 0.f, acc1 = 0.f;
#pragma unroll
                      for (int q = 0; q < (i + 3) / 4; ++q) { const f32x4 g4 = gr[q];
#pragma unroll
                          for (int e = 0; e < 4; ++e) { const int jj = 4 * q + e; if (jj < i) { if (jj & 1) acc1 -= g4[e] * tj[jj]; else acc0 -= g4[e] * tj[jj]; } } }
                      tj[i] = acc0 + acc1; }
                  if (quad == 0) {
#pragma unroll
                      for (int i = 0; i < 16; ++i) TT[c * 384 + i * 24 + r16] = f2b(tj[i]); } } }
            __syncthreads();
            { int lg = lane; asm volatile("" : "+v"(lg)); const int r16 = lg & 15, quad = lg >> 4; const int c = wave & 3, half = wave >> 2; const f32x4 z = {0.f, 0.f, 0.f, 0.f};
              const bf16x8 ta = lds_frag_k16(TT + c * 384 + r16 * 24 + quad * 8, quad);
              f32x4 o0 = MFMA16(ta, lds_frag(AbT + (16 * (2 * half) + r16) * RP + 16 * c + (quad & 1) * 8), z), o1 = MFMA16(ta, lds_frag(AbT + (16 * (2 * half + 1) + r16) * RP + 16 * c + (quad & 1) * 8), z);
              f32x4 og = z; if (!half) og = MFMA16(ta, lds_frag(GAKT + c * 384 + r16 * 24 + (quad & 1) * 8), z);
#pragma unroll
              for (int i = 0; i < 4; ++i) { const int t = 4 * quad + i; Ab[(16 * c + t) * RP + 16 * (2 * half) + r16] = f2b(o0[i]); Ab[(16 * c + t) * RP + 16 * (2 * half + 1) + r16] = f2b(o1[i]); if (!half) GAK[c * 384 + t * 24 + r16] = f2b(og[i]); } }
            __syncthreads();
            if (wave < 4) {
                int lc = lane; asm volatile("" : "+v"(lc)); const int r16 = lc & 15, quad = lc >> 4, vnt = wave;
#pragma unroll 1
                for (int c = 0; c < 4; ++c) {
                    bf16x8 sb[2];
#pragma unroll
                    for (int ks = 0; ks < 2; ++ks) { v4u w; w.x = pk2(ST[2 * ks][0], ST[2 * ks][1]); w.y = pk2(ST[2 * ks][2], ST[2 * ks][3]); w.z = pk2(ST[2 * ks + 1][0], ST[2 * ks + 1][1]); w.w = pk2(ST[2 * ks + 1][2], ST[2 * ks + 1][3]); sb[ks] = __builtin_bit_cast(bf16x8, w); }
                    const v2u vmw = *(const LAS v2u*)(Vt + (16 * vnt + r16) * RP + 16 * c + 4 * quad); const v4u vm4 = {vmw.x, vmw.y, 0u, 0u}; const bf16x8 vmb = __builtin_bit_cast(bf16x8, vm4);
                    f32x4 sa = {0.f, 0.f, 0.f, 0.f}, yy = {0.f, 0.f, 0.f, 0.f};
#pragma unroll
                    for (int ks = 0; ks < 2; ++ks) { sa = MFMA16(lds_frag_perm(Ab + (16 * c + r16) * RP + 32 * ks + 4 * quad), sb[ks], sa); yy = MFMA16(lds_frag_perm(Rb + (16 * c + r16) * RP + 32 * ks + 4 * quad), sb[ks], yy); }
                    sa = MFMA16(lds_frag_lo4(GAK + c * 384 + r16 * 24 + 4 * quad), vmb, sa); yy = MFMA16(lds_frag_lo4(HRK + c * 384 + r16 * 24 + 4 * quad), vmb, yy);
                    const v4u sa4 = {pk2(sa[0], sa[1]), pk2(sa[2], sa[3]), 0u, 0u}; const bf16x8 sab = __builtin_bit_cast(bf16x8, sa4);
                    const f32x4 z = {0.f, 0.f, 0.f, 0.f};
                    const f32x4 dy = MFMA16(lds_frag_lo4(HRB + c * 384 + r16 * 24 + 4 * quad), sab, z);
#pragma unroll
                    for (int i = 0; i < 4; ++i) YO[(16 * c + 4 * quad + i) * 64 + 16 * vnt + r16] = yy[i] - dy[i];
#pragma unroll
                    for (int kt = 0; kt < 4; ++kt) { const f32x4 e_ = MFMA16(lds_frag_lo4(BhT + (16 * kt + r16) * RP + 16 * c + 4 * quad), sab, z), d_ = MFMA16(lds_frag_lo4(KhT + (16 * kt + r16) * RP + 16 * c + 4 * quad), vmb, z);
                        const f32x4 gl4 = *(const LAS f32x4*)&GL[c * 64 + 16 * kt + 4 * quad]; ST[kt] = ST[kt] * gl4 + d_ - e_; }
                }
            }
            __syncthreads();
            { int to = tid; asm volatile("" : "+v"(to)); const int s4 = to >> 3, q8 = (to & 7) * 8; const f32x4 y0 = *(const f32x4*)&YO[s4 * 64 + q8], y1 = *(const f32x4*)&YO[s4 * 64 + q8 + 4];
              v4u o; o.x = cvt_pk_bf16(y0.x, y0.y); o.y = cvt_pk_bf16(y0.z, y0.w); o.z = cvt_pk_bf16(y1.x, y1.y); o.w = cvt_pk_bf16(y1.z, y1.w);
              *(v4u*)(YS + ((size_t)dir * R + row_of(b, tok(dir, j * 64 + s4))) * RD + h * 64 + q8) = o; }
            __syncthreads();
        }
    }
}
template <int PART> __device__ __forceinline__ void finish_phase(Frame& F, int l, int nrows, int first, int stride) {
    const bf16* HF = (const bf16*)(F.ws + WS_HF); const bf16* O = (const bf16*)(F.ws + WS_O); bf16* HM = (bf16*)(F.ws + WS_HM);
    const bf16* YS = (const bf16*)(F.ws + WS_YS); const bf16* RKV = (const bf16*)(F.ws + WS_RKV); const bf16* Gb = (const bf16*)(F.ws + WS_H); const float* BON = (const float*)(F.ws + WS_BON); bf16* YR = (bf16*)(F.ws + WS_YR);
    const int lane = F.lane, c0 = lane * 16;
    float k1[16], k2[16], k3[16];
    { const float* p1 = PART == 0 ? INP(I_GMN) + l * 1024 + c0 : INP(I_LNW) + l * RD + c0; const float* p2 = INP(I_LNB) + l * RD + c0; const float* p3 = INP(I_MU) + l * RW + 2048 + c0;
#pragma unroll
      for (int q = 0; q < 4; ++q) { const f32x4 t1 = *(const f32x4*)(p1 + 4 * q); k1[4 * q] = t1.x; k1[4 * q + 1] = t1.y; k1[4 * q + 2] = t1.z; k1[4 * q + 3] = t1.w;
          if (PART == 1) { const f32x4 t2 = *(const f32x4*)(p2 + 4 * q), t3 = *(const f32x4*)(p3 + 4 * q); k2[4 * q] = t2.x; k2[4 * q + 1] = t2.y; k2[4 * q + 2] = t2.z; k2[4 * q + 3] = t2.w; k3[4 * q] = t3.x; k3[4 * q + 1] = t3.y; k3[4 * q + 2] = t3.z; k3[4 * q + 3] = t3.w; } } }
    const bf16* S0 = PART == 0 ? HF : YS;
    int g = first * NWAVES + F.wave; const int gstep = stride * NWAVES;
    v4u n0 = {0u, 0u, 0u, 0u}, n1 = n0, n2 = n0, n3 = n0;
    if (g < nrows) { n0 = *(const v4u*)(S0 + (size_t)g * 1024 + c0); n1 = *(const v4u*)(S0 + ((size_t)R + g) * 1024 + c0); n2 = *(const v4u*)(S0 + (size_t)g * 1024 + c0 + 8); n3 = *(const v4u*)(S0 + ((size_t)R + g) * 1024 + c0 + 8); }
    for (; g < nrows; g += gstep) {
        const v4u c_0 = n0, c_1 = n1, c_2 = n2, c_3 = n3;
        { const int gn = g + gstep; if (gn < nrows) { n0 = *(const v4u*)(S0 + (size_t)gn * 1024 + c0); n1 = *(const v4u*)(S0 + ((size_t)R + gn) * 1024 + c0); n2 = *(const v4u*)(S0 + (size_t)gn * 1024 + c0 + 8); n3 = *(const v4u*)(S0 + ((size_t)R + gn) * 1024 + c0 + 8); } }
        float y[16], a[8], bq[8];
        unpack8(c_0, a); unpack8(c_1, bq);
#pragma unroll
        for (int i = 0; i < 8; ++i) y[i] = a[i] + bq[i];
        unpack8(c_2, a); unpack8(c_3, bq);
#pragma unroll
        for (int i = 0; i < 8; ++i) y[8 + i] = a[i] + bq[i];
        if (PART == 0) {
            float ss = 0.f;
#pragma unroll
            for (int i = 0; i < 16; ++i) ss += y[i] * y[i];
            const float rs = 1.0f / sqrtf(red8(ss) * (1.0f / DV) + NORM_EPS);
            float og[16]; unpack8(*(const v4u*)(O + (size_t)g * 1024 + c0), a); unpack8(*(const v4u*)(O + (size_t)g * 1024 + c0 + 8), bq);
#pragma unroll
            for (int i = 0; i < 8; ++i) { og[i] = a[i]; og[8 + i] = bq[i]; }
            float o1[8], o2[8];
#pragma unroll
            for (int i = 0; i < 8; ++i) { o1[i] = y[i] * rs * k1[i] * sigmoidf_(og[i]); o2[i] = y[8 + i] * rs * k1[8 + i] * sigmoidf_(og[8 + i]); }
            *(v4u*)(HM + (size_t)g * 1024 + c0) = pack8(o1); *(v4u*)(HM + (size_t)g * 1024 + c0 + 8) = pack8(o2);
        }
        if (PART == 1) {
            float sm_ = 0.f;
#pragma unroll
            for (int i = 0; i < 16; ++i) sm_ += y[i];
            const float mean = red4(sm_) * (1.0f / RN); float vs = 0.f;
#pragma unroll
            for (int i = 0; i < 16; ++i) { const float dl = y[i] - mean; vs += dl * dl; }
            const float rs = 1.0f / sqrtf(red4(vs) * (1.0f / RN) + GN_EPS);
            const int hh = lane >> 2; const float bon = BON[(size_t)g * RH + hh] + BON[((size_t)R + g) * RH + hh];
            float vm[16], gg[16];
#pragma unroll
            for (int half = 0; half < 2; ++half) { const int rw = 2048 + c0 + 8 * half, nb = nbrow(g, rw); unpack8(*(const v4u*)(RKV + (size_t)g * 3072 + rw), a);
                if (nb >= 0) unpack8(*(const v4u*)(RKV + (size_t)nb * 3072 + rw), bq); else {
#pragma unroll
                    for (int i = 0; i < 8; ++i) bq[i] = 0.f; }
#pragma unroll
                for (int i = 0; i < 8; ++i) vm[8 * half + i] = a[i] + (bq[i] - a[i]) * k3[8 * half + i];
                unpack8(*(const v4u*)(Gb + (size_t)g * RD + c0 + 8 * half), a);
#pragma unroll
                for (int i = 0; i < 8; ++i) gg[8 * half + i] = a[i]; }
            float o1[8], o2[8];
#pragma unroll
            for (int i = 0; i < 8; ++i) { o1[i] = ((y[i] - mean) * rs * k1[i] + k2[i] + bon * vm[i]) * gg[i]; o2[i] = ((y[8 + i] - mean) * rs * k1[8 + i] + k2[8 + i] + bon * vm[8 + i]) * gg[8 + i]; }
            *(v4u*)(YR + (size_t)g * RD + c0) = pack8(o1); *(v4u*)(YR + (size_t)g * RD + c0 + 8) = pack8(o2);
        }
    }
}
struct MoeMeta { int off[NE + 1]; };
__device__ __forceinline__ MoeMeta moe_meta(Frame& F) {
    MoeMeta m; int o = 0;
#pragma unroll
    for (int e = 0; e < NE; ++e) { m.off[e] = o; const unsigned c = __hip_atomic_load((unsigned*)(F.ctl + CW_ECNT + 64 * e), RLX_AGENT); o += (int)((c + 255u) & ~255u); }
    m.off[NE] = o; return m;
}
__device__ __forceinline__ void gather_phase(Frame& F) {
    const MoeMeta m = moe_meta(F);
    if (F.bid == 0 && F.tid < MAXSLOT / 256) { int e = 0;
#pragma unroll
        for (int q = 1; q <= NE - 1; ++q) e += ((int)F.tid * 256 >= m.off[q]) ? 1 : 0;
        ((int*)(F.ws + WS_META + 768 * 1024))[F.tid] = e; }
    const bf16* H = (const bf16*)(F.ws + WS_H); unsigned char* HG = (unsigned char*)(F.ws + WS_HG);
    for (int w = F.bid * NWAVES + F.wave; w < RL * 2; w += F.G * NWAVES) { const int g = w >> 1, k = w & 1; int* tk = (int*)(F.ws + WS_META) + (size_t)g * 8; const int e = tk[k], pos = tk[2 + k];
        int base = 0;
#pragma unroll
        for (int q = 0; q < NE; ++q) base = (e == q) ? m.off[q] : base;
        const int slot = base + pos; if (F.lane == 0) tk[6 + k] = slot;
        const v4u* src = (const v4u*)(H + (size_t)g * D); float a[8], c8[8];
        unpack8(src[2 * F.lane], a); unpack8(src[2 * F.lane + 1], c8);
#pragma unroll
        for (int i = 0; i < 8; ++i) { a[i] = __builtin_amdgcn_fmed3f(a[i], -448.0f, 448.0f); c8[i] = __builtin_amdgcn_fmed3f(c8[i], -448.0f, 448.0f); }
        v4u o; o.x = pk4_fp8(a[0], a[1], a[2], a[3]); o.y = pk4_fp8(a[4], a[5], a[6], a[7]); o.z = pk4_fp8(c8[0], c8[1], c8[2], c8[3]); o.w = pk4_fp8(c8[4], c8[5], c8[6], c8[7]);
        *(v4u*)(HG + (size_t)slot * D + 16 * F.lane) = o; }
}
__device__ __forceinline__ void final_phase(Frame& F, const float* MODl) {
    const bf16* Y2 = (const bf16*)(F.ws + WS_Y2); const float* gfp = INP(I_GF);
    f32x4 gf[4];
#pragma unroll
    for (int j = 0; j < 4; ++j) gf[j] = *(const f32x4*)(gfp + 256 * j + 4 * F.lane);
    int g = F.bid * NWAVES + F.wave; const int gstep = F.G * NWAVES;
    int s0n = 0, s1n = 0; float p0n = 0.f, p1n = 0.f;
    if (g < RL) { const int* tk = (const int*)(F.ws + WS_META) + (size_t)g * 8; s0n = tk[6]; s1n = tk[7]; p0n = ((const float*)tk)[4]; p1n = ((const float*)tk)[5]; }
    for (; g < RL; g += gstep) {
        const int s0 = s0n, s1 = s1n; const float p0 = p0n, p1 = p1n;
        float* xr = (float*)F.out + (size_t)g * D; const float* gt = MODl + (g / T) * 6 * D + 5 * D; f32x4 x[4], gq[4]; v2u ya[4], yb[4];
#pragma unroll
        for (int j = 0; j < 4; ++j) { const int c = 256 * j + 4 * F.lane; x[j] = *(const f32x4*)(xr + c); gq[j] = *(const f32x4*)(gt + c); ya[j] = *(const v2u*)(Y2 + (size_t)s0 * D + c); yb[j] = *(const v2u*)(Y2 + (size_t)s1 * D + c); }
        { const int gn = g + gstep; if (gn < RL) { const int* tk = (const int*)(F.ws + WS_META) + (size_t)gn * 8; s0n = tk[6]; s1n = tk[7]; p0n = ((const float*)tk)[4]; p1n = ((const float*)tk)[5]; } }
        f32x4 v[4]; float ss = 0.f;
#pragma unroll
        for (int j = 0; j < 4; ++j) { const v2u a = ya[j], bq = yb[j];
            f32x4 y; y.x = p0 * bflo(a.x) + p1 * bflo(bq.x); y.y = p0 * bfhi(a.x) + p1 * bfhi(bq.x); y.z = p0 * bflo(a.y) + p1 * bflo(bq.y); y.w = p0 * bfhi(a.y) + p1 * bfhi(bq.y);
            v[j] = x[j] + gq[j] * y; ss += (v[j].x * v[j].x + v[j].y * v[j].y) + (v[j].z * v[j].z + v[j].w * v[j].w); }
        const float rstd = 1.0f / sqrtf(wave_sum(ss) * (1.0f / D) + NORM_EPS);
#pragma unroll
        for (int j = 0; j < 4; ++j) { const int c = 256 * j + 4 * F.lane; *(f32x4*)(xr + c) = v[j] * rstd * gf[j]; }
    }
}

#ifndef MK_SPLIT
#define MK_SPLIT 0
#endif
constexpr int PPL = 12, NPHASE = 1 + NL * PPL + 1;
__device__ __forceinline__ GAS unsigned char* launder_ws(GAS unsigned char* p) { asm volatile("" : "+s"(p)); return p; }
__device__ __forceinline__ const CAS Args* launder_args(const CAS Args* p) { asm volatile("" : "+s"(p)); return p; }
__device__ __forceinline__ void grid_barrier(unsigned* barw, unsigned x, volatile LAS unsigned* st) { XcdBarrier b; b.bar = barw; b.x = x; b.st = st; xcd_barrier(b); }
#define IN(k) (lo <= (k) && (k) < hi)
#define SEAM(k) do { if (IN(k) && IN((k) + 1)) grid_barrier(bar.bar, bar.x, bar.st); } while (0)
#define PH_BEGIN { int t_ = threadIdx.x; asm volatile("" : "+v"(t_)); F.tid = t_; F.lane = t_ & 63; F.wave = __builtin_amdgcn_readfirstlane(t_ >> 6); int b_ = blockIdx.x; asm volatile("" : "+s"(b_)); F.bid = b_; F.cb = b_; F.cg = F.G; } \
        GAS unsigned char* ws = launder_ws(args.ws); F.ws = ws; F.A = launder_args((const CAS Args*)__builtin_amdgcn_kernarg_segment_ptr()); float* MOD = (float*)(ws + WS_MOD); float* XC = (float*)(ws + WS_XC); bf16* Hb = (bf16*)(ws + WS_H); \
        const float* MODl = MOD + (size_t)l * 5 * 6 * D; const float* xl = l == 0 ? INP(I_X) : (const float*)F.out; const float* xc = l == 0 ? INP(I_CTX) : XC; (void)MODl; (void)xl; (void)xc; (void)Hb;
template <int l> __device__ __forceinline__ void layer_body(Frame& F, const Args& args, const int lo, const int hi, const XcdBarrier& bar) {
        const int p0 = 1 + l * PPL; const bool last = (l == NL - 1);
        const int Mrows = last ? RL : R;
        if (IN(p0 + 0)) { PH_BEGIN if (l == 0) normmod_phase<false>(F, xl, xc, INP(I_GNM) + l * D, MODl, 0, D, R, nullptr);
            else { normmod_ctx_slabs(F, xc, (const float*)(ws + WS_S2), INP(I_GNM) + l * D, MODl, 0, D); normmod_phase<false>(F, xl, xc, INP(I_GNM) + l * D, MODl, 0, D, RL, nullptr); conv_rest(F, l); } }
        SEAM(p0 + 0);
        if (IN(p0 + 1)) { PH_BEGIN pg8::Gemm g{Hb, (const bf16*)(ws + WS_WIN), R, NPAD, D}; pg8::EpiInproj E{ws};
            if (!last) { pg8::StaticOrder S; S.init(R, NPAD, F.G, F.bid); pg8::gemm_phase<pg8::EpiInproj, pg8::StaticOrder, true, true>(F.lds, g, S, E); }
            else { pg8::InprojLastOrder S; S.G = F.G; S.c = F.bid; pg8::gemm_phase<pg8::EpiInproj, pg8::InprojLastOrder, true, true>(F.lds, g, S, E); } }
        if (IN(p0 + 1) && IN(p0 + 3)) grid_barrier(bar.bar, bar.x, bar.st);
        if (IN(p0 + 3)) { PH_BEGIN const int nR = F.G / 2;
            if (F.bid < nR) rwkv_phase(F, l, F.bid, nR);
            else { F.cb = F.bid - nR; F.cg = F.G - nR; gu32* sub = F.ctl + CW_SUB + 64 * l;
                   sg_phase(F, l); subgrid_arrive(F, sub);
                   mlstm_phase(F, l, F.cb, F.cg); __syncthreads();
                   if (!last) { conv_ffn0(F); conv_win(F, l + 1); } else conv_experts(F, 0, 4);
                   subgrid_arrive(F, sub + 128);
                   subgrid_wait(F, sub, (unsigned)F.cg); subgrid_wait(F, sub + 128, (unsigned)F.cg);
                   finish_phase<0>(F, l, Mrows, F.cb, F.cg); } }
        if (IN(p0 + 3)) { PH_BEGIN const int nR = F.G / 2;
            if (F.bid >= nR) { int kg = 256; asm volatile("" : "+s"(kg));
                pg8::Gemm g{(const bf16*)(ws + WS_SG), (const bf16*)(ws + WS_WG2), R, RD, kg}; pg8::StaticOrder S; S.init(Mrows, RD, F.G - nR, F.bid - nR);
                pg8::EpiStore E{Hb, RD};
                pg8::gemm_phase<pg8::EpiStore, pg8::StaticOrder, true, true>(F.lds, g, S, E); } }
        SEAM(p0 + 3);
        if (IN(p0 + 4)) { PH_BEGIN finish_phase<1>(F, l, Mrows, F.bid, F.G); }
        SEAM(p0 + 4);
        if (IN(p0 + 5)) { PH_BEGIN pg8::Gemm g{(const bf16*)(ws + WS_HM), (const bf16*)(ws + WS_WPM), Mrows, D, D}; pg8::StaticOrder S; S.init(Mrows, D, F.G, F.bid);
            pg8::EpiMerge<0> E{(const bf16*)(ws + WS_MGT), (bf16*)(ws + WS_T1), nullptr};
            pg8::gemm_phase<pg8::EpiMerge<0>, pg8::StaticOrder, true, true>(F.lds, g, S, E); }
        SEAM(p0 + 5);
        if (IN(p0 + 6)) { PH_BEGIN pg8::Gemm g{(const bf16*)(ws + WS_YR), (const bf16*)(ws + WS_WPR), Mrows, D, D}; pg8::StaticOrder S; S.init(Mrows, D, F.G, F.bid);
            pg8::EpiMerge<1> E{(const bf16*)(ws + WS_MGT), (bf16*)(ws + WS_T1), Hb};
            pg8::gemm_phase<pg8::EpiMerge<1>, pg8::StaticOrder, true, true>(F.lds, g, S, E); }
        SEAM(p0 + 6);
        if (IN(p0 + 7)) { PH_BEGIN pg8::Gemm g{Hb, (const bf16*)(ws + WS_WOUT), Mrows, D, D}; pg8::StaticOrder S; S.init(Mrows, D, F.G, F.bid);
            pg8::EpiResid E{xl, xc, (float*)F.out, XC, MODl + 2 * D};
            pg8::gemm_phase<pg8::EpiResid, pg8::StaticOrder, true, true>(F.lds, g, S, E); }
        SEAM(p0 + 7);
        if (IN(p0 + 8)) { PH_BEGIN if (!last) normmod_phase<false>(F, (const float*)F.out, XC, INP(I_GNF) + l * D, MODl, 3 * D, 4 * D, Mrows, nullptr);
                          else normmod_phase<true>(F, (const float*)F.out, XC, INP(I_GNF) + l * D, MODl, 3 * D, 4 * D, Mrows, INP(I_WR)); }
        SEAM(p0 + 8);
        if (!last) {
            if (IN(p0 + 9)) { PH_BEGIN pg8::Gemm g{Hb, (const bf16*)(ws + WS_WGU), Mrows, 2 * FF, D}; pg8::StaticOrder S; S.init(Mrows, 2 * FF, F.G, F.bid);
                pg8::EpiSwigluCtx E{(bf16*)(ws + WS_HH0), FF, (bf16*)(ws + WS_HH0) + (size_t)RL * FF, RL / 256};
                pg8::gemm_phase<pg8::EpiSwigluCtx, pg8::StaticOrder, true, true>(F.lds, g, S, E); }
            SEAM(p0 + 9);
            if (IN(p0 + 10)) { PH_BEGIN pg8::Gemm g{(const bf16*)(ws + WS_HH0), (const bf16*)(ws + WS_WDN), RL, D, FF}; pg8::StaticOrder S; S.init(RL, D, F.G, F.bid);
                pg8::EpiResid E{(const float*)F.out, XC, (float*)F.out, XC, MODl + 5 * D};
                pg8::gemm_phase<pg8::EpiResid, pg8::StaticOrder, true, true>(F.lds, g, S, E); }
            if (IN(p0 + 10)) { PH_BEGIN int kg = 256; asm volatile("" : "+s"(kg));
                pg8::Gemm g{(const bf16*)(ws + WS_HH0) + (size_t)RL * FF, (const bf16*)(ws + WS_WDNS), RC, D, kg}; pg8::CtxSliceOrder S; S.nS = NSL; S.G = F.G; S.c = (F.bid + 128) % F.G;
                pg8::EpiSlab E{(float*)(ws + WS_S2), MODl + 4 * 6 * D + 5 * D};
                pg8::gemm_phase<pg8::EpiSlab, pg8::CtxSliceOrder, true, true>(F.lds, g, S, E); }
            if (IN(p0 + 10) && IN(p0 + 12)) grid_barrier(bar.bar, bar.x, bar.st);
        } else {
            if (IN(p0 + 9)) { PH_BEGIN conv_experts(F, 4, NE); gather_phase(F); }
            SEAM(p0 + 9);
            if (IN(p0 + 10)) { PH_BEGIN const MoeMeta mm = moe_meta(F); pg8::MoeOrder S; S.ntiles = mm.off[NE] / 256; S.nN = 2 * FE / 256; S.nwg = S.ntiles * S.nN; S.G = F.G; S.c = F.bid; S.texp = (const int*)(ws + WS_META + 768 * 1024);
                S.lo0 = (int)((WS_WEA - WS_WEGU) / (256 * 1024)); S.lo1 = 28; S.hi1 = 28;
                int ke = D / 2; asm volatile("" : "+s"(ke));
                pg8::Gemm g{(const bf16*)(ws + WS_HG), (const bf16*)(ws + WS_WEGU), 0, 2 * FE, ke}; pg8::EpiSwiglu8 E{(unsigned char*)(ws + WS_HHE), FE};
                pg8::gemm_phase<pg8::EpiSwiglu8, pg8::MoeOrder, true, true, true>(F.lds, g, S, E); }
            SEAM(p0 + 10);
            if (IN(p0 + 11)) { PH_BEGIN const MoeMeta mm = moe_meta(F); pg8::MoeOrder S; S.ntiles = mm.off[NE] / 256; S.nN = D / 256; S.nwg = S.ntiles * S.nN; S.G = F.G; S.c = F.bid; S.texp = (const int*)(ws + WS_META + 768 * 1024);
                S.lo0 = (int)((WS_WEA + 28 * MiB - WS_WEDN) / (896 * 1024)); S.lo1 = 4; S.hi1 = 4;
                int ke = FE / 2; asm volatile("" : "+s"(ke));
                pg8::Gemm g{(const bf16*)(ws + WS_HHE), (const bf16*)(ws + WS_WEDN), 0, D, ke}; pg8::EpiStoreScaled E{(bf16*)(ws + WS_Y2), D, 1.0f / W8S};
                pg8::gemm_phase<pg8::EpiStoreScaled, pg8::MoeOrder, true, true, true>(F.lds, g, S, E); }
            SEAM(p0 + 11);
        }
    }
__global__ void __launch_bounds__(NTHREADS, 2) mk_fwd(Args args) {
    extern __shared__ __attribute__((aligned(16))) unsigned char lds[];
    Frame F;
    F.lds = (LAS unsigned char*)lds; F.MISC = (volatile LAS unsigned*)(F.lds + MISC_OFF);
    F.tid = threadIdx.x; F.lane = F.tid & 63; F.wave = __builtin_amdgcn_readfirstlane(F.tid >> 6); F.G = gridDim.x; F.bid = blockIdx.x;
    F.ws = args.ws; F.out = args.out; F.ctl = (gu32*)(args.ws + WS_CTL);
    F.A = (const CAS Args*)__builtin_amdgcn_kernarg_segment_ptr();
    if (F.tid < 64) F.MISC[F.tid] = 0u;
    __syncthreads();
    const int lo = args.ph_lo, hi = args.ph_hi;
    XcdBarrier bar; bar.bar = (unsigned*)(F.ctl + CW_BAR) + args.li * XCD_BAR_WORDS; bar.x = 0; bar.st = nullptr;
    if (hi - lo > 1) bar = xcd_barrier_post((unsigned*)(F.ctl + CW_BAR) + args.li * XCD_BAR_WORDS, F.MISC + 8);

    if (IN(0)) { const int l = 0; PH_BEGIN mod_phase(F); conv_win(F, 0); conv_rest(F, 0); }
    SEAM(0);

    layer_body<0>(F, args, lo, hi, bar);
    layer_body<1>(F, args, lo, hi, bar);
    if (IN(NPHASE - 1)) { const int l = NL - 1; PH_BEGIN final_phase(F, MODl); }
#undef IN
#undef SEAM
}

extern "C" void kernel_launch(void* const* d_in, const int* in_sizes, int n_in, void* d_out, int out_size, void* d_ws, size_t ws_size, hipStream_t stream) {
    static int grid = 0;
    if (grid == 0) {
        if (n_in != 33 || out_size != RL * D || ws_size < WS_NEED) { fprintf(stderr, "kernel_launch: unexpected problem (n_in %d, out %d, ws %zu < %zu)\n", n_in, out_size, ws_size, (size_t)WS_NEED); grid = -1; return; }
        int dev = 0, cus = 0, per_cu = 0;
        if (hipGetDevice(&dev) != hipSuccess || hipDeviceGetAttribute(&cus, hipDeviceAttributeMultiprocessorCount, dev) != hipSuccess) { grid = -1; return; }
        if (hipFuncSetAttribute((const void*)mk_fwd, hipFuncAttributeMaxDynamicSharedMemorySize, LDS_BYTES) != hipSuccess) { fprintf(stderr, "kernel_launch: hipFuncSetAttribute failed\n"); grid = -1; return; }
        if (hipOccupancyMaxActiveBlocksPerMultiprocessor(&per_cu, (const void*)mk_fwd, NTHREADS, LDS_BYTES) != hipSuccess || per_cu < 1) { fprintf(stderr, "kernel_launch: occupancy query says %d\n", per_cu); grid = -1; (void)hipGetLastError(); return; }
        grid = cus;
    }
    if (grid < 0) return;
    (void)hipMemsetAsync((char*)d_ws + WS_CTL, 0, CTL_ZERO_BYTES, stream);
    Args a{};
    for (int i = 0; i < 33; ++i) a.in[i] = (const GAS float*)d_in[i];
    a.out = (GAS float*)d_out; a.ws = (GAS unsigned char*)d_ws;
#if MK_SPLIT
    for (int p = 0; p < NPHASE; ++p) { a.ph_lo = p; a.ph_hi = p + 1; hipLaunchKernelGGL(mk_fwd, dim3(grid), dim3(NTHREADS), LDS_BYTES, stream, a); }
#elif defined(PROBE_PH)
    a.ph_lo = 0; a.ph_hi = PROBE_PH + 1; a.li = 0; hipLaunchKernelGGL(mk_fwd, dim3(grid), dim3(NTHREADS), LDS_BYTES, stream, a);
    for (int r = 0; r < PROBE_N; ++r) { a.ph_lo = PROBE_PH; a.ph_hi = PROBE_PH + 1; hipLaunchKernelGGL(mk_fwd, dim3(grid), dim3(NTHREADS), LDS_BYTES, stream, a); }
    a.ph_lo = PROBE_PH + 1; a.ph_hi = NPHASE; a.li = 1; hipLaunchKernelGGL(mk_fwd, dim3(grid), dim3(NTHREADS), LDS_BYTES, stream, a);
#else
    a.ph_lo = 0; a.ph_hi = NPHASE;
    hipLaunchKernelGGL(mk_fwd, dim3(grid), dim3(NTHREADS), LDS_BYTES, stream, a);
#endif
}
```

```cpp
#include <hip/hip_runtime.h>
#include <cstdio>
#include <cstdint>

#define GAS __attribute__((address_space(1)))
#define LAS __attribute__((address_space(3)))
typedef unsigned short bf16;
typedef unsigned v4u __attribute__((ext_vector_type(4)));
typedef unsigned v2u __attribute__((ext_vector_type(2)));
typedef float f32x4 __attribute__((ext_vector_type(4)));
typedef float f32x2 __attribute__((ext_vector_type(2)));
typedef short bf16x8 __attribute__((ext_vector_type(8)));
typedef GAS unsigned gu32;
#define RLX_AGENT __ATOMIC_RELAXED, __HIP_MEMORY_SCOPE_AGENT
#define LDS_WAIT() asm volatile("s_waitcnt lgkmcnt(0)" ::: "memory")
#define VM_WAIT() asm volatile("s_waitcnt vmcnt(0)" ::: "memory")

constexpr int D = 1024, NB = 4, T = 4096, GW = 64, TC = 256, NL = 2;
constexpr int RL = NB * T, RC = NB * TC, R = RL + RC;
constexpr int MH = 8, DQK = 64, DV = 128, LCH = 64;
constexpr int RH = 16, RN = 64, RD = 1024;
constexpr int RW = 3456, DIN = 8608, NPAD = 8704;
constexpr int FF = 2816, NE = 8, FE = 3584;
constexpr int TB = T + TC, NCH = TB / LCH;
constexpr int SMW = 512;
constexpr float NORM_EPS = 1e-6f, GN_EPS = 64e-5f, CAP = 15.0f;
constexpr int MAXSLOT = 2 * RL + NE * 256;

constexpr size_t MiB = 1u << 20;
constexpr size_t WS_CTL = 0, CTL_ZERO_BYTES = 1 * MiB;
constexpr size_t WS_MOD = 1 * MiB, WS_XC = 2 * MiB, WS_META = 6 * MiB, WS_BON = 7 * MiB, WS_SG = 10 * MiB;
constexpr size_t WS_WIN = 19 * MiB, WS_WPM = 36 * MiB, WS_WPR = 38 * MiB, WS_WOUT = 40 * MiB, WS_WG2 = 42 * MiB, WS_WLORA = 43 * MiB, WS_WGU = 44 * MiB, WS_WDN = 55 * MiB;
constexpr size_t WS_H = 61 * MiB;
constexpr size_t WS_Q = 95 * MiB, WS_K = 112 * MiB, WS_V = 129 * MiB, WS_O = 163 * MiB, WS_RKV = 197 * MiB, WS_MGT = 299 * MiB, WS_SM = 367 * MiB;
constexpr size_t WS_HF = 401 * MiB, WS_YS = 469 * MiB, WS_END = 537 * MiB;
constexpr size_t WS_HM = WS_Q, WS_YR = WS_V, WS_T1 = WS_O;
constexpr size_t WS_HH0 = WS_Q;
constexpr size_t WS_WEGU = 95 * MiB, WS_WEDN = 152 * MiB, WS_HG = 179 * MiB, WS_Y2 = 213 * MiB, WS_HHE = 281 * MiB;
constexpr size_t WS_WEA = 537 * MiB;
static_assert((WS_WEA - WS_WEGU) % (256 * 1024) == 0 && (WS_WEA + 28 * MiB - WS_WEDN) % (896 * 1024) == 0, "expert weight tiles");
static_assert(WS_HHE + (size_t)MAXSLOT * FE <= 401 * MiB && WS_Y2 + (size_t)MAXSLOT * D * 2 <= WS_HHE && WS_HG + (size_t)MAXSLOT * D <= WS_Y2, "ws map");
constexpr float W8S = 64.0f;
constexpr size_t WS_WDNS = 538 * MiB, WS_S2 = 200 * MiB;
constexpr int NSL = FF / 256;
constexpr size_t WS_NEED = 579 * MiB;
constexpr int CW_BAR = 4096;
constexpr int CW_ECNT = 16384;
constexpr int CW_SUB = 20480;
constexpr int LDS_BYTES = 159744;
constexpr int MISC_OFF = LDS_BYTES - 256;

__device__ __forceinline__ unsigned cvt_pk_bf16(float lo, float hi) { unsigned r; asm volatile("v_cvt_pk_bf16_f32 %0, %1, %2" : "=v"(r) : "v"(lo), "v"(hi)); return r; }
__device__ __forceinline__ float bflo(unsigned w) { return __uint_as_float(w << 16); }
__device__ __forceinline__ float bfhi(unsigned w) { return __uint_as_float(w & 0xffff0000u); }
__device__ __forceinline__ void unpack8(const v4u w, float (&f)[8]) { f[0] = bflo(w.x); f[1] = bfhi(w.x); f[2] = bflo(w.y); f[3] = bfhi(w.y); f[4] = bflo(w.z); f[5] = bfhi(w.z); f[6] = bflo(w.w); f[7] = bfhi(w.w); }
__device__ __forceinline__ v4u pack8(const float (&f)[8]) { v4u w; w.x = cvt_pk_bf16(f[0], f[1]); w.y = cvt_pk_bf16(f[2], f[3]); w.z = cvt_pk_bf16(f[4], f[5]); w.w = cvt_pk_bf16(f[6], f[7]); return w; }
__device__ __forceinline__ float sigmoidf_(float x) { return __builtin_amdgcn_rcpf(1.0f + __expf(-x)); }
__device__ __forceinline__ float siluf_(float x) { return x * sigmoidf_(x); }
__device__ __forceinline__ float softplusf_(float x) { return fmaxf(x, 0.f) + log1pf(expf(-fabsf(x))); }
__device__ __forceinline__ float fast_tanh(float x) { const float e = __expf(2.0f * x); return 1.0f - 2.0f * __builtin_amdgcn_rcpf(1.0f + e); }
__device__ __forceinline__ float fast_softplus(float x) { return fmaxf(x, 0.f) + __logf(1.0f + __expf(-fabsf(x))); }
template <int CTRL> __device__ __forceinline__ float dpp_add(float v) { const int t = __builtin_amdgcn_update_dpp(0, __float_as_int(v), CTRL, 0xf, 0xf, false); return v + __int_as_float(t); }
template <int CTRL> __device__ __forceinline__ float dpp_one(float v) { return __int_as_float(__builtin_amdgcn_update_dpp(0x3f800000, __float_as_int(v), CTRL, 0xf, 0xf, false)); }
__device__ __forceinline__ float red4(float v) { v = dpp_add<0xB1>(v); return dpp_add<0x4E>(v); }
__device__ __forceinline__ float red8(float v) { return dpp_add<0x141>(red4(v)); }
__device__ __forceinline__ float red16(float v) { return dpp_add<0x140>(red8(v)); }
__device__ __forceinline__ float wave_sum(float v) { v = red16(v); v += __shfl_xor(v, 16); return v + __shfl_xor(v, 32); }
__device__ __forceinline__ int row_of(int b, int lr) { return lr < T ? b * T + lr : RL + b * TC + (lr - T); }
__device__ __forceinline__ int tok(int dir, int u) { if (u < TC) return T + (dir ? TC - 1 - u : u); const int tt = u - TC; return dir ? T - 1 - tt : tt; }
__device__ __forceinline__ int nbrow(int g, int rwidx) {
    if (g < RL) { const int t = g & (T - 1), row = t >> 6, col = t & 63, q = rwidx / (RW / 4);
        if (q == 0) return col > 0 ? g - 1 : -1; if (q == 1) return col < GW - 1 ? g + 1 : -1; if (q == 2) return row > 0 ? g - GW : -1; return row < T / GW - 1 ? g + GW : -1; }
    const int t = (g - RL) & (TC - 1); if (rwidx < RW / 2) return t > 0 ? g - 1 : -1; return t < TC - 1 ? g + 1 : -1;
}

#define XB_TMO      128
#define XB_XCNT(j)  (256  + 64 * (j))
#define XB_XSUB(j)  (1280 + 64 * (j))
#define XB_XGEN(j)  (2304 + 64 * (j))
#define XB_TOP      3328
#define XB_TOPGEN   3392
#define XCD_BAR_WORDS 3456
#define XB_SPIN_CAP (1u << 18)
__device__ __forceinline__ unsigned xb_ld(unsigned* p)              { return __hip_atomic_load(p, __ATOMIC_RELAXED, __HIP_MEMORY_SCOPE_AGENT); }
__device__ __forceinline__ unsigned xb_add(unsigned* p, unsigned v) { return __hip_atomic_fetch_add(p, v, __ATOMIC_RELAXED, __HIP_MEMORY_SCOPE_AGENT); }
__device__ __forceinline__ unsigned xb_xcc_id() { return (unsigned)__builtin_amdgcn_s_getreg((3 << 11) | 20) & 0xFu; }
#define XB_SPIN(cond, bar) do { unsigned _sp = 0; while (cond) { __builtin_amdgcn_s_sleep(1); \
    if ((++_sp & 255u) == 0u) { if (xb_ld(&(bar)[XB_TMO])) break; if (_sp > XB_SPIN_CAP) { atomicAdd(&(bar)[XB_TMO], 1u); break; } } } } while (0)
struct XcdBarrier { unsigned* bar; unsigned x; volatile LAS unsigned* st; };
__device__ __forceinline__ XcdBarrier xcd_barrier_post(unsigned* bar, volatile LAS unsigned* st) {
    XcdBarrier b; b.bar = bar; b.x = xb_xcc_id(); b.st = st;
    if (threadIdx.x == 0) (void)xb_add(&bar[XB_XCNT(b.x)], 1u);
    return b;
}
__device__ __forceinline__ void xcd_barrier_complete(unsigned* bar, unsigned x, unsigned& nloc, unsigned& nx) {
    const unsigned G = gridDim.x * gridDim.y * gridDim.z;
    unsigned sum, cnt, mine, sp = 0u;
    for (;;) {
        sum = 0u; cnt = 0u; mine = 0u;
#pragma unroll
        for (unsigned j = 0; j < 16; ++j) { const unsigned c = xb_ld(&bar[XB_XCNT(j)]); sum += c; cnt += (c > 0u) ? 1u : 0u; mine = (j == x) ? c : mine; }
        if (sum == G) break;
        __builtin_amdgcn_s_sleep(1);
        if ((++sp & 255u) == 0u) { if (xb_ld(&bar[XB_TMO])) break; if (sp > XB_SPIN_CAP) { atomicAdd(&bar[XB_TMO], 1u); break; } }
    }
    nloc = mine > 0u ? mine : 1u; nx = cnt > 0u ? cnt : 1u;
}
__device__ __forceinline__ void xcd_barrier(const XcdBarrier& b) {
    asm volatile("s_waitcnt vmcnt(0)" ::: "memory");
    __syncthreads();
    if (threadIdx.x == 0) {
        unsigned* bar = b.bar;
        __builtin_amdgcn_s_waitcnt(0);
        unsigned nloc = b.st[0], nx = b.st[1];
        if (nloc == 0u) { xcd_barrier_complete(bar, b.x, nloc, nx); b.st[0] = nloc; b.st[1] = nx; }
        const unsigned old = xb_add(&bar[XB_XSUB(b.x)], 1u);
        const unsigned gen = old / nloc;
        if (old + 1u == (gen + 1u) * nloc) {
            __builtin_amdgcn_fence(__ATOMIC_RELEASE, "agent");
            asm volatile("s_waitcnt vmcnt(0)" ::: "memory");
            const unsigned og = xb_add(&bar[XB_TOP], 1u);
            const unsigned tg = og / nx;
            if (og + 1u == (tg + 1u) * nx) xb_add(&bar[XB_TOPGEN], 1u);
            else XB_SPIN(xb_ld(&bar[XB_TOPGEN]) == tg, bar);
            __builtin_amdgcn_fence(__ATOMIC_ACQUIRE, "agent");
            xb_add(&bar[XB_XGEN(b.x)], 1u);
            asm volatile("s_waitcnt vmcnt(0)" ::: "memory");
        } else {
            XB_SPIN(xb_ld(&bar[XB_XGEN(b.x)]) == gen, bar);
            __builtin_amdgcn_fence(__ATOMIC_ACQUIRE, "agent");
            asm volatile("s_waitcnt vmcnt(0)" ::: "memory");
        }
    }
    __syncthreads();
}

namespace pg8 {
#define PG8_LAS __attribute__((address_space(3)))
typedef unsigned short bf16_t;
typedef unsigned u32x4 __attribute__((ext_vector_type(4)));
constexpr int BM = 256, BK = 64, HALF = 128, HTB = HALF * BK * 2, STAGE_BYTES = 8 * HTB, NXCD = 8, WGM = 8;
__host__ __device__ __forceinline__ int lds_byte(int r, int c) { const int st = (r >> 4) * 2 + (c >> 5), rr = r & 15, cc = c & 31, ob = rr * 64 + cc * 2; return st * 1024 + (ob ^ (((ob >> 9) & 1) << 5)); }
__host__ __device__ __forceinline__ void stage_rc(int b, int& R_, int& C) { const int st = b / 1024, sb = b % 1024, swz = sb ^ (((sb >> 9) & 1) << 5); R_ = (st >> 1) * 16 + swz / 64; C = (st & 1) * 32 + (swz % 64) / 2; }
__host__ __device__ __forceinline__ int perm32(int rho) { const int n = rho >> 4, i = rho & 15; return 8 * (i >> 2) + 4 * n + (i & 3); }
typedef int i32x8 __attribute__((ext_vector_type(8))); typedef int i32x4 __attribute__((ext_vector_type(4)));
__device__ __forceinline__ i32x8 cat8(bf16x8 lo, bf16x8 hi) { return __builtin_shufflevector(__builtin_bit_cast(i32x4, lo), __builtin_bit_cast(i32x4, hi), 0, 1, 2, 3, 4, 5, 6, 7); }
__device__ __forceinline__ void mfma8_acc(f32x4& acc, const i32x8 a, const i32x8 b) {
#if defined(__HIP_DEVICE_COMPILE__)
    const int one = 0x7F7F7F7F;
    asm volatile("v_mfma_scale_f32_16x16x128_f8f6f4 %0, %1, %2, %0, %3, %3 op_sel_hi:[0,0,0]" : "+v"(acc) : "v"(a), "v"(b), "v"(one));
#endif
}
struct Unit { int pm, pn, pb; };
struct Gemm { const bf16_t* A; const bf16_t* Bt; int M, N, K; };
struct StaticOrder {
    int nM, nN, nwg, G, c;
    __device__ void init(int M, int N, int G_, int c_) { nM = M / BM; nN = N / BM; nwg = nM * nN; G = G_; c = c_; }
    __device__ bool next(int i, Unit& u) const {
        const long L = (long)i * G + c; if (L >= nwg) return false;
        int wgid = (int)L; { const int q = nwg / NXCD, r = nwg % NXCD, xcd = wgid % NXCD, off = wgid / NXCD; wgid = (xcd < r ? xcd * (q + 1) : r * (q + 1) + (xcd - r) * q) + off; }
        const int nig = WGM * nN, gid = wgid / nig, fm = gid * WGM, gsz = (nM - fm) < WGM ? (nM - fm) : WGM;
        u.pm = fm + ((wgid % nig) % gsz); u.pn = (wgid % nig) / gsz; u.pb = u.pn; return true;
    }
    __device__ __forceinline__ void a_ready(const Unit&) const {}
    __device__ __forceinline__ void done(const Unit&) const {}
};
struct InprojLastOrder {
    int G, c;
    __device__ bool next(int i, Unit& u) const {
        const int L = i * G + c; if (L >= 64 * 34 + 4 * 22) return false;
        if (L < 64 * 34) { const int g8 = L / (8 * 34), r = L % (8 * 34); u.pm = g8 * 8 + (r % 8); u.pn = r / 8; }
        else { const int r = L - 64 * 34; u.pm = 64 + (r & 3); int q = r >> 2; q += (q >= 8) ? 4 : 0; q += (q >= 24) ? 8 : 0; u.pn = q; }
        u.pb = u.pn; return true;
    }
    __device__ __forceinline__ void a_ready(const Unit&) const {}
    __device__ __forceinline__ void done(const Unit&) const {}
};
struct CtxSliceOrder {
    int nS, G, c;
    __device__ bool next(int i, Unit& u) const { const int L = i * G + c; if (L >= 16 * nS) return false; const int s = L >> 4, r = L & 15; u.pm = 4 * s + (r >> 2); u.pn = r & 3; u.pb = 4 * s + (r & 3); return true; }
    __device__ __forceinline__ void a_ready(const Unit&) const {}
    __device__ __forceinline__ void done(const Unit&) const {}
};
struct MoeOrder {
    int ntiles, nN, nwg, G, c; const int* texp;
    int lo0, lo1, hi1;
    __device__ bool next(int i, Unit& u) const {
        const long L = (long)i * G + c; if (L >= nwg) return false;
        u.pm = (int)(L / nN); u.pn = (int)(L % nN); const int e = __builtin_amdgcn_readfirstlane(texp[u.pm]);
        u.pb = (e < 4 ? lo0 + e * lo1 : (e - 4) * hi1) + u.pn; return true;
    }
    __device__ __forceinline__ void a_ready(const Unit&) const {}
    __device__ __forceinline__ void done(const Unit&) const {}
};
template <class Epi, class Sched, bool ALIGN_EPI = false, bool SP2 = false, bool FP8 = false>
__device__ __forceinline__ void gemm_phase(PG8_LAS unsigned char* lds, const Gemm g, const Sched& S, const Epi& E) {
    int tid_ = threadIdx.x; asm volatile("" : "+v"(tid_));
    const int tid = tid_, wid = __builtin_amdgcn_readfirstlane(tid >> 6), lane = tid & 63, wr = wid >> 2, wc = wid & 3, fr = lane & 15, fq = lane >> 4;
    const int K = g.K, nt = K / BK;
    unsigned voffA[2], voffB[2];
#pragma unroll
    for (int i = 0; i < 2; ++i) { int R, C; stage_rc(tid * 16 + i * 8192, R, C); const int Rb = Epi::PERM ? ((R & ~31) + perm32(R & 31)) : R;
        voffA[i] = (unsigned)(R * K + C) * 2u; voffB[i] = (unsigned)(Rb * K + C) * 2u; }
    const size_t kstep = (size_t)(BK * 2);
    const size_t hstep = (size_t)HALF * K * 2;
    const size_t tstep = 2 * hstep;
    const unsigned ldsw = (unsigned)wid * 1024u;
    const int aoff = lds_byte(wr * 64 + fr, fq * 8), boff = lds_byte(wc * 32 + fr, fq * 8);
#define PG8_SA(b, h) (((b) * 2 + (h)) * HTB)
#define PG8_SB(b, h) ((4 + (b) * 2 + (h)) * HTB)
#define PG8_STAGE(bufoff, gbase, voff) do { _Pragma("unroll") for (int _i = 0; _i < 2; ++_i) \
        __builtin_amdgcn_global_load_lds((const unsigned*)((const char*)(gbase) + (voff)[_i]), (PG8_LAS unsigned*)(lds + (bufoff) + ldsw + _i * 8192), 16, 0, 0); } while (0)
#define PG8_LDA(dst, b, h) do { _Pragma("unroll") for (int m = 0; m < 4; ++m) { if constexpr (FP8) dst##8[m] = cat8(*(const PG8_LAS bf16x8*)(lds + PG8_SA(b, h) + aoff + m * 2048), *(const PG8_LAS bf16x8*)(lds + PG8_SA(b, h) + aoff + m * 2048 + 1024)); \
        else { _Pragma("unroll") for (int k = 0; k < 2; ++k) dst[m][k] = *(const PG8_LAS bf16x8*)(lds + PG8_SA(b, h) + aoff + m * 2048 + k * 1024); } } } while (0)
#define PG8_LDB(dst, b, h) do { _Pragma("unroll") for (int n = 0; n < 2; ++n) { if constexpr (FP8) dst##8[n] = cat8(*(const PG8_LAS bf16x8*)(lds + PG8_SB(b, h) + boff + n * 2048), *(const PG8_LAS bf16x8*)(lds + PG8_SB(b, h) + boff + n * 2048 + 1024)); \
        else { _Pragma("unroll") for (int k = 0; k < 2; ++k) dst[n][k] = *(const PG8_LAS bf16x8*)(lds + PG8_SB(b, h) + boff + n * 2048 + k * 1024); } } } while (0)
#define PG8_MMA(ai, bj, At, Bt) do { __builtin_amdgcn_s_setprio(1); if constexpr (FP8) { _Pragma("unroll") for (int m = 0; m < 4; ++m) _Pragma("unroll") for (int n = 0; n < 2; ++n) \
        mfma8_acc(acc[ai][bj][m][n], Bt##8[n], At##8[m]); } else { \
        _Pragma("unroll") for (int m = 0; m < 4; ++m) _Pragma("unroll") for (int n = 0; n < 2; ++n) _Pragma("unroll") for (int k = 0; k < 2; ++k) \
        acc[ai][bj][m][n] = __builtin_amdgcn_mfma_f32_16x16x32_bf16(Bt[n][k], At[m][k], acc[ai][bj][m][n], 0, 0, 0); } __builtin_amdgcn_s_setprio(0); } while (0)
#define PG8_WAIT_V(n) asm volatile("s_waitcnt vmcnt(" #n ")" ::: "memory")
#define PG8_WAIT_L(n) asm volatile("s_waitcnt lgkmcnt(" #n ")" ::: "memory")
#define PG8_BAR __builtin_amdgcn_s_barrier()
#define PG8_SCHED __builtin_amdgcn_sched_barrier(0)
    Unit cur, nxt; int ui = 0;
    if (!S.next(0, cur)) return;
    f32x4 acc[2][2][4][2];
#pragma unroll
    for (int a = 0; a < 2; ++a)
#pragma unroll
        for (int b = 0; b < 2; ++b)
#pragma unroll
            for (int m = 0; m < 4; ++m)
#pragma unroll
                for (int n = 0; n < 2; ++n) acc[a][b][m][n] = (f32x4){0.f, 0.f, 0.f, 0.f};
    bf16x8 At[4][2], B0[2][2], B1[2][2]; i32x8 At8[4], B08[2], B18[2];
    const char* cA = (const char*)g.A + (size_t)cur.pm * tstep; const char* cB = (const char*)g.Bt + (size_t)cur.pb * tstep;
    S.a_ready(cur);
    if constexpr (SP2) {
        PG8_STAGE(PG8_SB(0, 0), cB, voffB); PG8_STAGE(PG8_SB(0, 1), cB + hstep, voffB); PG8_STAGE(PG8_SA(0, 0), cA, voffA); PG8_STAGE(PG8_SA(0, 1), cA + hstep, voffA);
        if (wr == 1) PG8_BAR;
        PG8_WAIT_V(2); PG8_BAR;
        PG8_STAGE(PG8_SB(1, 0), cB + kstep, voffB); PG8_STAGE(PG8_SA(1, 0), cA + kstep, voffA); PG8_STAGE(PG8_SB(1, 1), cB + hstep + kstep, voffB);
        PG8_WAIT_V(6); PG8_BAR;
    } else {
        PG8_STAGE(PG8_SB(0, 0), cB, voffB); PG8_STAGE(PG8_SA(0, 0), cA, voffA); PG8_STAGE(PG8_SB(0, 1), cB + hstep, voffB); PG8_STAGE(PG8_SA(0, 1), cA + hstep, voffA);
        if (wr == 1) PG8_BAR;
        PG8_WAIT_V(4); PG8_BAR;
        PG8_STAGE(PG8_SB(1, 0), cB + kstep, voffB); PG8_STAGE(PG8_SA(1, 0), cA + kstep, voffA); PG8_STAGE(PG8_SB(1, 1), cB + hstep + kstep, voffB);
        PG8_WAIT_V(6); PG8_BAR;
    }
    for (;;) {
        const bool has_next = S.next(ui + 1, nxt);
        const char* nA = has_next ? (const char*)g.A + (size_t)nxt.pm * tstep : cA; const char* nB = has_next ? (const char*)g.Bt + (size_t)nxt.pb * tstep : cB;
        for (int t = 0; t < nt; t += 2) {
            const bool last = (t == nt - 2);
            const char* a1 = cA + (size_t)(t + 1) * kstep;
            const char* a2 = last ? nA : cA + (size_t)(t + 2) * kstep; const char* b2 = last ? nB : cB + (size_t)(t + 2) * kstep;
            const char* a3 = a2 + kstep; const char* b3 = b2 + kstep;
            if (last && has_next) S.a_ready(nxt);
            if constexpr (SP2) {
            PG8_LDB(B0, 0, 0); PG8_LDB(B1, 0, 1); PG8_SCHED; PG8_LDA(At, 0, 0); PG8_STAGE(PG8_SA(1, 1), a1 + hstep, voffA);
            PG8_WAIT_V(8); PG8_WAIT_L(0); PG8_BAR; PG8_MMA(0, 0, At, B0); PG8_MMA(0, 1, At, B1); PG8_BAR; PG8_SCHED;
            PG8_LDA(At, 0, 1); PG8_STAGE(PG8_SB(0, 0), b2, voffB); PG8_STAGE(PG8_SB(0, 1), b2 + hstep, voffB); PG8_STAGE(PG8_SA(0, 0), a2, voffA);
            PG8_WAIT_V(8); PG8_WAIT_L(0); PG8_BAR; PG8_MMA(1, 0, At, B0); PG8_MMA(1, 1, At, B1); PG8_BAR; PG8_SCHED;
            PG8_LDB(B0, 1, 0); PG8_LDB(B1, 1, 1); PG8_SCHED; PG8_LDA(At, 1, 0); PG8_STAGE(PG8_SA(0, 1), a2 + hstep, voffA);
            PG8_WAIT_V(8); PG8_WAIT_L(0); PG8_BAR; PG8_MMA(0, 0, At, B0); PG8_MMA(0, 1, At, B1); PG8_BAR; PG8_SCHED;
            PG8_LDA(At, 1, 1); PG8_STAGE(PG8_SB(1, 0), b3, voffB); PG8_STAGE(PG8_SB(1, 1), b3 + hstep, voffB); PG8_STAGE(PG8_SA(1, 0), a3, voffA);
            PG8_WAIT_V(8); PG8_WAIT_L(0); PG8_BAR; PG8_MMA(1, 0, At, B0); PG8_MMA(1, 1, At, B1); PG8_BAR; PG8_SCHED;
            } else {
            PG8_LDB(B0, 0, 0); PG8_SCHED; PG8_LDA(At, 0, 0); PG8_STAGE(PG8_SA(1, 1), a1 + hstep, voffA);
            PG8_WAIT_L(8); PG8_BAR; PG8_WAIT_L(0); PG8_MMA(0, 0, At, B0); PG8_BAR; PG8_SCHED;
            PG8_LDB(B1, 0, 1); PG8_STAGE(PG8_SB(0, 0), b2, voffB);
            PG8_BAR; PG8_WAIT_L(0); PG8_MMA(0, 1, At, B1); PG8_BAR;
            PG8_LDA(At, 0, 1); PG8_STAGE(PG8_SA(0, 0), a2, voffA);
            PG8_BAR; PG8_WAIT_L(0); PG8_MMA(1, 0, At, B0); PG8_BAR; PG8_SCHED;
            PG8_STAGE(PG8_SB(0, 1), b2 + hstep, voffB);
            PG8_WAIT_V(6); PG8_BAR; PG8_MMA(1, 1, At, B1); PG8_BAR;
            PG8_LDB(B0, 1, 0); PG8_SCHED; PG8_LDA(At, 1, 0); PG8_STAGE(PG8_SA(0, 1), a2 + hstep, voffA);
            PG8_WAIT_L(8); PG8_BAR; PG8_WAIT_L(0); PG8_MMA(0, 0, At, B0); PG8_BAR; PG8_SCHED;
            PG8_LDB(B1, 1, 1); PG8_STAGE(PG8_SB(1, 0), b3, voffB);
            PG8_BAR; PG8_WAIT_L(0); PG8_MMA(0, 1, At, B1); PG8_BAR;
            PG8_LDA(At, 1, 1); PG8_STAGE(PG8_SA(1, 0), a3, voffA);
            PG8_BAR; PG8_WAIT_L(0); PG8_MMA(1, 0, At, B0); PG8_BAR; PG8_SCHED;
            PG8_STAGE(PG8_SB(1, 1), b3 + hstep, voffB);
            PG8_WAIT_V(6); PG8_BAR; PG8_MMA(1, 1, At, B1); PG8_BAR;
            }
        }
        if constexpr (ALIGN_EPI) { if (wr == 0) PG8_BAR; }
        if constexpr (FP8) asm volatile("s_nop 15\n\ts_nop 15\n\ts_nop 15\n\ts_nop 15" ::: "memory");
        if constexpr (!Epi::AFTER_DRAIN) { E(acc, cur, wr, wc, fr, fq); S.done(cur); }
        if (!has_next) break;
#pragma unroll
        for (int a = 0; a < 2; ++a)
#pragma unroll
            for (int b = 0; b < 2; ++b)
#pragma unroll
                for (int m = 0; m < 4; ++m)
#pragma unroll
                    for (int n = 0; n < 2; ++n) acc[a][b][m][n] = (f32x4){0.f, 0.f, 0.f, 0.f};
        cur = nxt; cA = nA; cB = nB; ++ui;
        if constexpr (ALIGN_EPI) { if (wr == 1) PG8_BAR; }
    }
    PG8_WAIT_V(0);
    if constexpr (!ALIGN_EPI) { if (wr == 0) PG8_BAR; }
    PG8_BAR;
    if constexpr (Epi::AFTER_DRAIN) { E.fused(acc, cur, wr, wc, fr, fq, lds, wid, lane); S.done(cur); }
#undef PG8_SA
#undef PG8_SB
#undef PG8_STAGE
#undef PG8_LDA
#undef PG8_LDB
#undef PG8_MMA
#undef PG8_WAIT_V
#undef PG8_WAIT_L
#undef PG8_BAR
#undef PG8_SCHED
}

__device__ __forceinline__ u32x4 pack_acc8(const f32x4 v0, const f32x4 v1) { u32x4 w; w.x = cvt_pk_bf16(v0[0], v0[1]); w.y = cvt_pk_bf16(v0[2], v0[3]); w.z = cvt_pk_bf16(v1[0], v1[1]); w.w = cvt_pk_bf16(v1[2], v1[3]); return w; }
#define EPI_LOOP_BEGIN  _Pragma("unroll") for (int ai = 0; ai < 2; ++ai) _Pragma("unroll") for (int m = 0; m < 4; ++m) { const int rloc = ai * HALF + wr * 64 + m * 16 + fr; \
                        _Pragma("unroll") for (int bj = 0; bj < 2; ++bj) { const int cloc = bj * HALF + wc * 32 + 8 * fq; const f32x4 v0 = acc[ai][bj][m][0], v1 = acc[ai][bj][m][1];
#define EPI_LOOP_END    } asm volatile("" ::: "memory"); }

struct EpiInproj {
    static constexpr bool PERM = true, AFTER_DRAIN = false;
    GAS unsigned char* ws;
    __device__ __forceinline__ void operator()(const f32x4 (&acc)[2][2][4][2], const Unit& u, int wr, int wc, int fr, int fq) const {
        const int pn = u.pn; size_t off; int ld, ct;
        if (pn < 2) { off = WS_Q; ld = 512; ct = pn; } else if (pn < 4) { off = WS_K; ld = 512; ct = pn - 2; } else if (pn < 8) { off = WS_V; ld = 1024; ct = pn - 4; }
        else if (pn < 12) { off = WS_O; ld = 1024; ct = pn - 8; } else if (pn < 24) { off = WS_RKV; ld = 3072; ct = pn - 12; } else if (pn < 32) { off = WS_MGT; ld = 2048; ct = pn - 24; } else { off = WS_SM; ld = SMW * 2; ct = pn - 32; }
        const size_t row0 = (size_t)u.pm * BM;
        if (pn < 32) {
            bf16_t* base = (bf16_t*)(ws + off) + row0 * ld + ct * BM;
            EPI_LOOP_BEGIN
                *(u32x4*)(base + (size_t)rloc * ld + cloc) = pack_acc8(v0, v1);
            EPI_LOOP_END
        } else {
            float* sb = (float*)(ws + off) + row0 * SMW + ct * BM;
            EPI_LOOP_BEGIN
                float* p = sb + (size_t)rloc * SMW + cloc; *(f32x4*)p = v0; *(f32x4*)(p + 4) = v1;
            EPI_LOOP_END
        }
    }
};
struct EpiStore {
    static constexpr bool PERM = true, AFTER_DRAIN = false;
    bf16_t* C; int ldc;
    __device__ __forceinline__ void operator()(const f32x4 (&acc)[2][2][4][2], const Unit& u, int wr, int wc, int fr, int fq) const {
        const size_t row0 = (size_t)u.pm * BM; const int col0 = u.pn * BM;
        EPI_LOOP_BEGIN
            *(u32x4*)(C + (row0 + rloc) * ldc + col0 + cloc) = pack_acc8(v0, v1);
        EPI_LOOP_END
    }
};
template <int STEP> struct EpiMerge {
    static constexpr bool PERM = true, AFTER_DRAIN = false;
    const bf16_t* MGT; bf16_t* T1; bf16_t* OUT;
    __device__ __forceinline__ void operator()(const f32x4 (&acc)[2][2][4][2], const Unit& u, int wr, int wc, int fr, int fq) const {
        const size_t row0 = (size_t)u.pm * BM; const int col0 = u.pn * BM;
        EPI_LOOP_BEGIN
            const size_t row = row0 + rloc; const int col = col0 + cloc;
            const u32x4 gw = *(const u32x4*)(MGT + row * 2048 + (STEP ? 1024 : 0) + col); float g[8]; unpack8(gw, g);
            float o[8] = {v0[0], v0[1], v0[2], v0[3], v1[0], v1[1], v1[2], v1[3]};
#pragma unroll
            for (int j = 0; j < 8; ++j) o[j] *= sigmoidf_(g[j]);
            if (STEP) { const u32x4 tw = *(const u32x4*)(T1 + row * 1024 + col); float tt[8]; unpack8(tw, tt);
#pragma unroll
                for (int j = 0; j < 8; ++j) o[j] += tt[j]; }
            *(u32x4*)((STEP ? OUT : T1) + row * 1024 + col) = pack8(o);
        EPI_LOOP_END
    }
};
struct EpiResid {
    static constexpr bool PERM = true, AFTER_DRAIN = false;
    const float* src_lat; const float* src_ctx; float* dst_lat; float* dst_ctx; const float* gate;
    __device__ __forceinline__ void operator()(const f32x4 (&acc)[2][2][4][2], const Unit& u, int wr, int wc, int fr, int fq) const {
        const int row0 = u.pm * BM, col0 = u.pn * BM; const bool lat = row0 < RL;
        const float* sb = lat ? src_lat : src_ctx - (size_t)RL * D; float* db = lat ? dst_lat : dst_ctx - (size_t)RL * D;
        const float* gt = gate + (lat ? row0 / T : 4) * 6 * D;
        EPI_LOOP_BEGIN
            const size_t off = (size_t)(row0 + rloc) * D + col0 + cloc; const int col = col0 + cloc;
            const f32x4 g0 = *(const f32x4*)(gt + col), g1 = *(const f32x4*)(gt + col + 4), s0 = *(const f32x4*)(sb + off), s1 = *(const f32x4*)(sb + off + 4);
            *(f32x4*)(db + off) = s0 + g0 * v0; *(f32x4*)(db + off + 4) = s1 + g1 * v1;
        EPI_LOOP_END
    }
};
struct EpiSwiglu {
    static constexpr bool PERM = true, AFTER_DRAIN = false;
    bf16_t* HH; int ldc;
    __device__ __forceinline__ void operator()(const f32x4 (&acc)[2][2][4][2], const Unit& u, int wr, int wc, int fr, int fq) const {
        const size_t row0 = (size_t)u.pm * BM; const int col0 = u.pn * HALF + wc * 32 + 8 * fq;
#pragma unroll
        for (int ai = 0; ai < 2; ++ai)
#pragma unroll
            for (int m = 0; m < 4; ++m) { const int rloc = ai * HALF + wr * 64 + m * 16 + fr; float o[8];
#pragma unroll
                for (int n = 0; n < 2; ++n)
#pragma unroll
                    for (int j = 0; j < 4; ++j) o[4 * n + j] = siluf_(acc[ai][0][m][n][j]) * acc[ai][1][m][n][j];
                *(u32x4*)(HH + (row0 + rloc) * ldc + col0) = pack8(o); asm volatile("" ::: "memory"); }
    }
};

struct EpiSwigluCtx {
    static constexpr bool PERM = true, AFTER_DRAIN = false;
    bf16_t* HH; int ldc; bf16_t* HHc; int ctx_from;
    __device__ __forceinline__ void operator()(const f32x4 (&acc)[2][2][4][2], const Unit& u, int wr, int wc, int fr, int fq) const {
        const bool cx = u.pm >= ctx_from;
        const size_t offc = ((size_t)(u.pn >> 1) * 1024 + (size_t)(u.pm - ctx_from) * BM) * 256 + (u.pn & 1) * HALF + wc * 32 + 8 * fq + (size_t)(HHc - HH), offn = (size_t)u.pm * BM * ldc + u.pn * HALF + wc * 32 + 8 * fq;
        bf16_t* base = HH + (cx ? offc : offn); const int ld = cx ? 256 : ldc;
#pragma unroll
        for (int ai = 0; ai < 2; ++ai)
#pragma unroll
            for (int m = 0; m < 4; ++m) { const int rloc = ai * HALF + wr * 64 + m * 16 + fr; float o[8];
#pragma unroll
                for (int n = 0; n < 2; ++n)
#pragma unroll
                    for (int j = 0; j < 4; ++j) o[4 * n + j] = siluf_(acc[ai][0][m][n][j]) * acc[ai][1][m][n][j];
                *(u32x4*)(base + (size_t)rloc * ld) = pack8(o); asm volatile("" ::: "memory"); }
    }
};
struct EpiSlab {
    static constexpr bool PERM = true, AFTER_DRAIN = false;
    float* slab; const float* gate;
    __device__ __forceinline__ void operator()(const f32x4 (&acc)[2][2][4][2], const Unit& u, int wr, int wc, int fr, int fq) const {
        float* base = slab + ((size_t)(u.pm >> 2) * 1024 + (size_t)(u.pm & 3) * BM) * D + u.pn * BM;
        EPI_LOOP_BEGIN
            const int col = u.pn * BM + cloc; const f32x4 g0 = *(const f32x4*)(gate + col), g1 = *(const f32x4*)(gate + col + 4);
            float* p = base + (size_t)rloc * D + cloc; *(f32x4*)p = g0 * v0; *(f32x4*)(p + 4) = g1 * v1;
        EPI_LOOP_END
    }
};

struct EpiSwiglu8 {
    static constexpr bool PERM = true, AFTER_DRAIN = false;
    unsigned char* HH; int ldc;
    __device__ __forceinline__ void operator()(const f32x4 (&acc)[2][2][4][2], const Unit& u, int wr, int wc, int fr, int fq) const {
        const size_t row0 = (size_t)u.pm * BM; const int col0 = u.pn * HALF + wc * 32 + 8 * fq; const float is = 1.0f / W8S;
#pragma unroll
        for (int ai = 0; ai < 2; ++ai)
#pragma unroll
            for (int m = 0; m < 4; ++m) { const int rloc = ai * HALF + wr * 64 + m * 16 + fr; float o[8];
#pragma unroll
                for (int n = 0; n < 2; ++n)
#pragma unroll
                    for (int j = 0; j < 4; ++j) o[4 * n + j] = __builtin_amdgcn_fmed3f(siluf_(acc[ai][0][m][n][j] * is) * (acc[ai][1][m][n][j] * is), -448.0f, 448.0f);
                v2u w; w.x = (unsigned)__builtin_amdgcn_cvt_pk_fp8_f32(o[0], o[1], 0, false); w.x = (unsigned)__builtin_amdgcn_cvt_pk_fp8_f32(o[2], o[3], (int)w.x, true);
                w.y = (unsigned)__builtin_amdgcn_cvt_pk_fp8_f32(o[4], o[5], 0, false); w.y = (unsigned)__builtin_amdgcn_cvt_pk_fp8_f32(o[6], o[7], (int)w.y, true);
                *(v2u*)(HH + (row0 + rloc) * ldc + col0) = w; asm volatile("" ::: "memory"); }
    }
};
struct EpiStoreScaled {
    static constexpr bool PERM = true, AFTER_DRAIN = false;
    bf16_t* C; int ldc; float s;
    __device__ __forceinline__ void operator()(const f32x4 (&acc)[2][2][4][2], const Unit& u, int wr, int wc, int fr, int fq) const {
        const size_t row0 = (size_t)u.pm * BM; const int col0 = u.pn * BM;
        EPI_LOOP_BEGIN
            *(u32x4*)(C + (row0 + rloc) * ldc + col0 + cloc) = pack_acc8(v0 * s, v1 * s);
        EPI_LOOP_END
    }
};

}

struct Args { const GAS float* in[33]; GAS float* out; GAS unsigned char* ws; int ph_lo, ph_hi, li, pad; };
#define CAS __attribute__((address_space(4)))
#define INP(i) ((const float*)F.A->in[i])
constexpr int NWAVES = 8, NTHREADS = 512;
struct Frame {
    LAS unsigned char* lds; volatile LAS unsigned* MISC; gu32* ctl;
    int tid, lane, wave, G, bid;
    int cb, cg;
    GAS unsigned char* ws; GAS float* out;
    const CAS Args* A;
};
enum { I_X = 0, I_C, I_CTX, I_CCTX, I_WADA, I_BADA, I_GNM, I_GNF, I_WIN, I_BG, I_GMN, I_MU, I_W0, I_W2, I_A0, I_A2, I_G2, I_KK, I_KA, I_RK, I_LNW, I_LNB, I_WPM, I_WPR, I_WOUT,
       I_FFG, I_FFU, I_FFD, I_WR, I_EG, I_EU, I_ED, I_GF };

__device__ __forceinline__ void conv_item(const float* W, int ldw, int c0, int k0, bf16* dst, int ldd, int r0, LAS float* scr, int lane) {
#pragma unroll 8
    for (int i = 0; i < 32; ++i) { const int kk = 2 * i + (lane >> 5); scr[kk * 33 + (lane & 31)] = W[(size_t)(k0 + kk) * ldw + c0 + (lane & 31)]; }
    LDS_WAIT(); asm volatile("" ::: "memory");
    const int c = lane & 7;
#pragma unroll
    for (int j = 0; j < 4; ++j) { const int n = (lane >> 3) + 8 * j; const LAS float* s = scr + (8 * c) * 33 + n;
        v4u o; o.x = cvt_pk_bf16(s[0 * 33], s[1 * 33]); o.y = cvt_pk_bf16(s[2 * 33], s[3 * 33]); o.z = cvt_pk_bf16(s[4 * 33], s[5 * 33]); o.w = cvt_pk_bf16(s[6 * 33], s[7 * 33]);
        *(v4u*)(dst + (size_t)(r0 + n) * ldd + k0 + 8 * c) = o; }
    LDS_WAIT(); asm volatile("" ::: "memory");
}
__device__ __forceinline__ unsigned pk4_fp8(float a, float b, float c, float d) { int w = __builtin_amdgcn_cvt_pk_fp8_f32(a, b, 0, false); w = __builtin_amdgcn_cvt_pk_fp8_f32(c, d, w, true); return (unsigned)w; }
__device__ __forceinline__ void conv_item8(const float* W, int ldw, int c0, int k0, unsigned char* dst, int ldd, int r0, float scale, LAS float* scr, int lane) {
#pragma unroll 8
    for (int i = 0; i < 32; ++i) { const int kk = 2 * i + (lane >> 5); scr[kk * 33 + (lane & 31)] = __builtin_amdgcn_fmed3f(W[(size_t)(k0 + kk) * ldw + c0 + (lane & 31)] * scale, -448.0f, 448.0f); }
    LDS_WAIT(); asm volatile("" ::: "memory");
    const int c = lane & 3;
#pragma unroll
    for (int j = 0; j < 2; ++j) { const int n = (lane >> 2) + 16 * j; const LAS float* s = scr + (16 * c) * 33 + n;
        v4u o; o.x = pk4_fp8(s[0 * 33], s[1 * 33], s[2 * 33], s[3 * 33]); o.y = pk4_fp8(s[4 * 33], s[5 * 33], s[6 * 33], s[7 * 33]);
        o.z = pk4_fp8(s[8 * 33], s[9 * 33], s[10 * 33], s[11 * 33]); o.w = pk4_fp8(s[12 * 33], s[13 * 33], s[14 * 33], s[15 * 33]);
        *(v4u*)(dst + (size_t)(r0 + n) * ldd + k0 + 16 * c) = o; }
    LDS_WAIT(); asm volatile("" ::: "memory");
}
__device__ __forceinline__ void conv_seg8(Frame& F, const float* W, int ldw, int K, int c0, int ncols, unsigned char* dst, int ldd, int r0, float scale, int& rot) {
    LAS float* scr = (LAS float*)(F.lds + F.wave * 16384);
    const int NGW = F.cg * NWAVES, nblk = ncols / 32, nitems = (K / 64) * nblk;
    int gw = (F.cb * NWAVES + F.wave + rot) % NGW;
    for (int it = gw; it < nitems; it += NGW) { const int kb = it / nblk, nb = it % nblk; conv_item8(W, ldw, c0 + 32 * nb, 64 * kb, dst, ldd, r0 + 32 * nb, scale, scr, F.lane); }
    rot = (rot + nitems) % NGW;
}
__device__ __forceinline__ void conv_gu8(Frame& F, const float* Wg, const float* Wu, int ldw, int K, int ngroups, unsigned char* dst, float scale, int& rot) {
    LAS float* scr = (LAS float*)(F.lds + F.wave * 16384);
    const int NGW = F.cg * NWAVES, kblk = K / 64, nitems = ngroups * 2 * 4 * kblk;
    int gw = (F.cb * NWAVES + F.wave + rot) % NGW;
    for (int it = gw; it < nitems; it += NGW) { const int kb = it % kblk, r = it / kblk, nb = r & 3, which = (r >> 2) & 1, p = r >> 3;
        conv_item8(which ? Wu : Wg, ldw, 128 * p + 32 * nb, 64 * kb, dst, K, 256 * p + 128 * which + 32 * nb, scale, scr, F.lane); }
    rot = (rot + nitems) % NGW;
}
__device__ __forceinline__ void conv_ffd_dual(Frame& F, const float* W, bf16* dst, bf16* dsts, int& rot) {
    LAS float* scr = (LAS float*)(F.lds + F.wave * 16384);
    const int NGW = F.cg * NWAVES, nblk = D / 32, nitems = (FF / 64) * nblk; const int lane = F.lane;
    int gw = (F.cb * NWAVES + F.wave + rot) % NGW;
    for (int it = gw; it < nitems; it += NGW) { const int kb = it / nblk, nb = it % nblk, k0 = 64 * kb, c0 = 32 * nb;
#pragma unroll 8
        for (int i = 0; i < 32; ++i) { const int kk = 2 * i + (lane >> 5); scr[kk * 33 + (lane & 31)] = W[(size_t)(k0 + kk) * D + c0 + (lane & 31)]; }
        LDS_WAIT(); asm volatile("" ::: "memory");
        const int c = lane & 7;
#pragma unroll
        for (int j = 0; j < 4; ++j) { const int n = (lane >> 3) + 8 * j; const LAS float* s = scr + (8 * c) * 33 + n;
            v4u o; o.x = cvt_pk_bf16(s[0 * 33], s[1 * 33]); o.y = cvt_pk_bf16(s[2 * 33], s[3 * 33]); o.z = cvt_pk_bf16(s[4 * 33], s[5 * 33]); o.w = cvt_pk_bf16(s[6 * 33], s[7 * 33]);
            *(v4u*)(dst + (size_t)(c0 + n) * FF + k0 + 8 * c) = o;
            *(v4u*)(dsts + ((size_t)(k0 >> 8) * 1024 + c0 + n) * 256 + (k0 & 255) + 8 * c) = o; }
        LDS_WAIT(); asm volatile("" ::: "memory"); }
    rot = (rot + nitems) % NGW;
}
__device__ __forceinline__ void conv_seg(Frame& F, const float* W, int ldw, int K, int c0, int ncols, bf16* dst, int ldd, int r0, int& rot) {
    LAS float* scr = (LAS float*)(F.lds + F.wave * 16384);
    const int NGW = F.cg * NWAVES, nblk = ncols / 32, nitems = (K / 64) * nblk;
    int gw = (F.cb * NWAVES + F.wave + rot) % NGW;
    for (int it = gw; it < nitems; it += NGW) { const int kb = it / nblk, nb = it % nblk; conv_item(W, ldw, c0 + 32 * nb, 64 * kb, dst, ldd, r0 + 32 * nb, scr, F.lane); }
    rot = (rot + nitems) % NGW;
}
__device__ __forceinline__ void conv_gu(Frame& F, const float* Wg, const float* Wu, int ldw, int K, int ngroups, bf16* dst, int& rot) {
    LAS float* scr = (LAS float*)(F.lds + F.wave * 16384);
    const int NGW = F.cg * NWAVES, kblk = K / 64, nitems = ngroups * 2 * 4 * kblk;
    int gw = (F.cb * NWAVES + F.wave + rot) % NGW;
    for (int it = gw; it < nitems; it += NGW) { const int kb = it % kblk, r = it / kblk, nb = r & 3, which = (r >> 2) & 1, p = r >> 3;
        conv_item(which ? Wu : Wg, ldw, 128 * p + 32 * nb, 64 * kb, dst, K, 256 * p + 128 * which + 32 * nb, scr, F.lane); }
    rot = (rot + nitems) % NGW;
}
__device__ __forceinline__ void zero_bf16_rows(Frame& F, bf16* dst, size_t n16) {
    const v4u z = {0u, 0u, 0u, 0u};
    for (size_t i = (size_t)F.cb * NTHREADS + F.tid; i < n16; i += (size_t)F.cg * NTHREADS) ((v4u*)dst)[i] = z;
}
__device__ __forceinline__ void conv_win(Frame& F, int l) {
    int rot = 0; GAS unsigned char* ws = F.ws;
    bf16* WIN = (bf16*)(ws + WS_WIN); const float* win = INP(I_WIN) + (size_t)l * D * DIN;
    conv_seg(F, win, DIN, D, 0, 3072, WIN, D, 0, rot);
    conv_seg(F, win, DIN, D, 3104, 3072, WIN, D, 3072, rot);
    conv_seg(F, win, DIN, D, 6560, 2048, WIN, D, 6144, rot);
    conv_seg(F, win, DIN, D, 3072, 32, WIN, D, 8192, rot);
    conv_seg(F, win, DIN, D, 6176, 384, WIN, D, 8192 + 32, rot);
    zero_bf16_rows(F, WIN + (size_t)(8192 + 416) * D, (size_t)96 * D * 2 / 16);
}
__device__ __forceinline__ void conv_rest(Frame& F, int l) {
    int rot = 0; GAS unsigned char* ws = F.ws;
    conv_seg(F, INP(I_WPM) + (size_t)l * D * D, D, D, 0, D, (bf16*)(ws + WS_WPM), D, 0, rot);
    conv_seg(F, INP(I_WPR) + (size_t)l * D * D, D, D, 0, D, (bf16*)(ws + WS_WPR), D, 0, rot);
    conv_seg(F, INP(I_WOUT) + (size_t)l * D * D, D, D, 0, D, (bf16*)(ws + WS_WOUT), D, 0, rot);
    { bf16* WG2 = (bf16*)(ws + WS_WG2);
      conv_seg(F, INP(I_G2) + (size_t)l * 128 * RD, RD, 128, 0, RD, WG2, 256, 0, rot);
      for (int i = F.cb * NTHREADS + F.tid; i < 1024 * 16; i += F.cg * NTHREADS) { const int r = i >> 4, p = i & 15; *(v4u*)(WG2 + (size_t)r * 256 + 128 + 8 * p) = (v4u){0u, 0u, 0u, 0u}; } }
    { bf16* WL = (bf16*)(ws + WS_WLORA);
      for (int d = 0; d < 2; ++d) { conv_seg(F, INP(I_W2) + ((size_t)l * 2 + d) * 64 * RD, RD, 64, 0, RD, WL + (size_t)(0 * 2 + d) * RD * 64, 64, 0, rot);
                                    conv_seg(F, INP(I_A2) + ((size_t)l * 2 + d) * 64 * RD, RD, 64, 0, RD, WL + (size_t)(1 * 2 + d) * RD * 64, 64, 0, rot); } }
}
__device__ __forceinline__ void conv_ffn0(Frame& F) {
    int rot = 0; GAS unsigned char* ws = F.ws;
    conv_gu(F, INP(I_FFG), INP(I_FFU), FF, D, FF / 128, (bf16*)(ws + WS_WGU), rot);
    conv_ffd_dual(F, INP(I_FFD), (bf16*)(ws + WS_WDN), (bf16*)(ws + WS_WDNS), rot);
}
__device__ __forceinline__ void conv_experts(Frame& F, int e0, int e1) {
    int rot = 0;
    for (int e = e0; e < e1; ++e) {
        unsigned char* gu = (unsigned char*)F.ws + (e < 4 ? WS_WEA + (size_t)e * 7 * MiB : WS_WEGU + (size_t)(e - 4) * 7 * MiB);
        unsigned char* dn = (unsigned char*)F.ws + (e < 4 ? WS_WEA + 28 * MiB + (size_t)e * 3584 * 1024 : WS_WEDN + (size_t)(e - 4) * 3584 * 1024);
        conv_gu8(F, INP(I_EG) + (size_t)e * D * FE, INP(I_EU) + (size_t)e * D * FE, FE, D, FE / 128, gu, W8S, rot);
        conv_seg8(F, INP(I_ED) + (size_t)e * FE * D, D, FE, 0, D, dn, FE, 0, W8S, rot);
    }
}
__device__ __forceinline__ void mod_phase(Frame& F) {
    LAS float* sl = (LAS float*)F.lds;
    LAS float* part = sl + 5 * D;
    for (int i = F.tid; i < 5 * D; i += NTHREADS) { const int bb = i / D, k = i % D; const float v = bb < 4 ? INP(I_C)[bb * D + k] : INP(I_CCTX)[k]; sl[i] = siluf_(v); }
    __syncthreads();
    float* MOD = (float*)(F.ws + WS_MOD);
    for (int item = F.bid; item < NL * 6 * D / 64; item += F.G) {
        const int l = item / (6 * D / 64), c0 = (item % (6 * D / 64)) * 64; const float* w = INP(I_WADA) + (size_t)l * D * 6 * D + c0 + F.lane;
        float a[5] = {0.f, 0.f, 0.f, 0.f, 0.f};
        for (int k = F.wave * 128; k < F.wave * 128 + 128; ++k) { const float wv = w[(size_t)k * 6 * D];
#pragma unroll
            for (int bb = 0; bb < 5; ++bb) a[bb] += sl[bb * D + k] * wv; }
#pragma unroll
        for (int bb = 0; bb < 5; ++bb) part[(F.wave * 5 + bb) * 64 + F.lane] = a[bb];
        __syncthreads();
        if (F.tid < 5 * 64) { const int bb = F.tid / 64, c = F.tid % 64; float s = INP(I_BADA)[l * 6 * D + c0 + c];
#pragma unroll
            for (int w8 = 0; w8 < 8; ++w8) s += part[(w8 * 5 + bb) * 64 + c];
            MOD[((size_t)l * 5 + bb) * 6 * D + c0 + c] = s; }
        __syncthreads();
    }
}
__device__ __forceinline__ const float* xrow(const float* lat, const float* ctx, int g) { return g < RL ? lat + (size_t)g * D : ctx + (size_t)(g - RL) * D; }
template <bool ROUTER> __device__ __forceinline__ void normmod_phase(Frame& F, const float* lat, const float* ctx, const float* gain, const float* MODl, int off_sh, int off_sc, int nrows, const float* wrt) {
    bf16* H = (bf16*)(F.ws + WS_H);
    LAS unsigned* lcnt = (LAS unsigned*)F.lds;
    LAS int* rec = (LAS int*)(F.lds + 64);
    LAS float* recp = (LAS float*)(F.lds + 64 + 1024);
    const int ngroups = nrows / 64;
    for (int grp = F.bid; grp < ngroups; grp += F.G) {
        if (ROUTER) { if (F.tid < 16) lcnt[F.tid] = 0u; __syncthreads(); }
        f32x4 vnx[4];
        { const float* x0 = xrow(lat, ctx, grp * 64 + F.wave * 8);
#pragma unroll
          for (int j = 0; j < 4; ++j) vnx[j] = *(const f32x4*)(x0 + 256 * j + 4 * F.lane); }
        for (int rr = 0; rr < 8; ++rr) {
            const int lrow = F.wave * 8 + rr, g = grp * 64 + lrow; const float* md = MODl + (g < RL ? g / T : 4) * 6 * D;
            f32x4 v[4]; float ss = 0.f;
#pragma unroll
            for (int j = 0; j < 4; ++j) v[j] = vnx[j];
            if (rr + 1 < 8) { const float* x1 = xrow(lat, ctx, g + 1);
#pragma unroll
                for (int j = 0; j < 4; ++j) vnx[j] = *(const f32x4*)(x1 + 256 * j + 4 * F.lane); }
#pragma unroll
            for (int j = 0; j < 4; ++j) ss += (v[j].x * v[j].x + v[j].y * v[j].y) + (v[j].z * v[j].z + v[j].w * v[j].w);
            const float rstd = 1.0f / sqrtf(wave_sum(ss) * (1.0f / D) + NORM_EPS);
            float lg[NE];
            if (ROUTER) {
#pragma unroll
                for (int e = 0; e < NE; ++e) lg[e] = 0.f; }
#pragma unroll
            for (int j = 0; j < 4; ++j) { const int c = 256 * j + 4 * F.lane;
                const f32x4 gn = *(const f32x4*)(gain + c), sc = *(const f32x4*)(md + off_sc + c), sh = *(const f32x4*)(md + off_sh + c);
                const f32x4 h = v[j] * rstd * gn * (1.0f + sc) + sh;
                v2u o; o.x = cvt_pk_bf16(h.x, h.y); o.y = cvt_pk_bf16(h.z, h.w); *(v2u*)(H + (size_t)g * D + c) = o;
                if (ROUTER) {
#pragma unroll
                    for (int q = 0; q < 4; ++q) { const f32x4 w0 = *(const f32x4*)(wrt + (size_t)(c + q) * NE), w1 = *(const f32x4*)(wrt + (size_t)(c + q) * NE + 4); const float hv = h[q];
                        lg[0] += hv * w0.x; lg[1] += hv * w0.y; lg[2] += hv * w0.z; lg[3] += hv * w0.w; lg[4] += hv * w1.x; lg[5] += hv * w1.y; lg[6] += hv * w1.z; lg[7] += hv * w1.w; } }
            }
            if (ROUTER) {
#pragma unroll
                for (int e = 0; e < NE; ++e) lg[e] = wave_sum(lg[e]);
                int i0 = 0;
#pragma unroll
                for (int e = 1; e < NE; ++e) if (lg[e] > lg[i0]) i0 = e;
                int i1 = i0 == 0 ? 1 : 0;
#pragma unroll
                for (int e = 0; e < NE; ++e) if (e != i0 && lg[e] > lg[i1]) i1 = e;
                if (F.lane == 0) { const float e1 = __expf(lg[i1] - lg[i0]); const float p0 = 1.0f / (1.0f + e1);
                    rec[lrow * 4 + 0] = i0; rec[lrow * 4 + 1] = i1; rec[lrow * 4 + 2] = (int)atomicAdd((unsigned*)&lcnt[i0], 1u); rec[lrow * 4 + 3] = (int)atomicAdd((unsigned*)&lcnt[i1], 1u);
                    recp[lrow * 2 + 0] = p0; recp[lrow * 2 + 1] = e1 * p0; }
            }
        }
        if (ROUTER) {
            __syncthreads();
            if (F.tid < NE) lcnt[8 + F.tid] = __hip_atomic_fetch_add((unsigned*)(F.ctl + CW_ECNT + 64 * F.tid), lcnt[F.tid], RLX_AGENT);
            __syncthreads();
            if (F.tid < 64) { const int g = grp * 64 + F.tid; int* tk = (int*)(F.ws + WS_META) + (size_t)g * 8; const int e0 = rec[F.tid * 4], e1 = rec[F.tid * 4 + 1];
                tk[0] = e0; tk[1] = e1; tk[2] = (int)lcnt[8 + e0] + rec[F.tid * 4 + 2]; tk[3] = (int)lcnt[8 + e1] + rec[F.tid * 4 + 3];
                ((float*)tk)[4] = recp[F.tid * 2]; ((float*)tk)[5] = recp[F.tid * 2 + 1]; }
            __syncthreads();
        }
    }
}
__device__ __forceinline__ void subgrid_arrive(Frame& F, gu32* cnt) {
    asm volatile("s_waitcnt vmcnt(0)" ::: "memory"); __syncthreads();
    if (F.tid == 0) { __builtin_amdgcn_fence(__ATOMIC_RELEASE, "agent"); asm volatile("s_waitcnt vmcnt(0)" ::: "memory"); __hip_atomic_fetch_add(cnt, 1u, RLX_AGENT); }
}
__device__ __forceinline__ void subgrid_wait(Frame& F, gu32* cnt, unsigned n) {
    if (F.tid == 0) { unsigned sp = 0; while (__hip_atomic_load(cnt, RLX_AGENT) < n) { __builtin_amdgcn_s_sleep(2); if (++sp > (1u << 20)) break; }
        __builtin_amdgcn_fence(__ATOMIC_ACQUIRE, "agent"); asm volatile("s_waitcnt vmcnt(0)" ::: "memory"); }
    __syncthreads();
}
__device__ __forceinline__ void normmod_ctx_slabs(Frame& F, const float* XCp, const float* slab, const float* gain, const float* MODl, int off_sh, int off_sc) {
    bf16* H = (bf16*)(F.ws + WS_H); const float* md = MODl + 4 * 6 * D;
    for (int r = F.bid * NWAVES + F.wave; r < RC; r += F.G * NWAVES) {
        f32x4 v[4], p[NSL][4];
#pragma unroll
        for (int j = 0; j < 4; ++j) v[j] = *(const f32x4*)(XCp + (size_t)r * D + 256 * j + 4 * F.lane);
#pragma unroll
        for (int s_ = 0; s_ < NSL; ++s_)
#pragma unroll
            for (int j = 0; j < 4; ++j) p[s_][j] = *(const f32x4*)(slab + ((size_t)s_ * RC + r) * D + 256 * j + 4 * F.lane);
        float ss = 0.f;
#pragma unroll
        for (int j = 0; j < 4; ++j) {
#pragma unroll
            for (int s_ = 0; s_ < NSL; ++s_) v[j] += p[s_][j];
            ss += (v[j].x * v[j].x + v[j].y * v[j].y) + (v[j].z * v[j].z + v[j].w * v[j].w); }
        const float rstd = 1.0f / sqrtf(wave_sum(ss) * (1.0f / D) + NORM_EPS);
#pragma unroll
        for (int j = 0; j < 4; ++j) { const int c = 256 * j + 4 * F.lane;
            const f32x4 gn = *(const f32x4*)(gain + c), sc = *(const f32x4*)(md + off_sc + c), sh = *(const f32x4*)(md + off_sh + c);
            const f32x4 h = v[j] * rstd * gn * (1.0f + sc) + sh;
            v2u o; o.x = cvt_pk_bf16(h.x, h.y); o.y = cvt_pk_bf16(h.z, h.w); *(v2u*)(H + (size_t)(RL + r) * D + c) = o; }
    }
}
__device__ __forceinline__ void sg_phase(Frame& F, int l) {
    const float* SM = (const float*)(F.ws + WS_SM); bf16* SG = (bf16*)(F.ws + WS_SG); const float* mu = INP(I_MU) + l * RW + 3328;
    for (int i = F.cb * NTHREADS + F.tid; i < R * 32; i += F.cg * NTHREADS) { const int g = i >> 5, p = i & 31; float o[8];
        if (p < 16) { const int nb = nbrow(g, 3328); const float* a = SM + (size_t)g * SMW + 288 + 8 * p;
            const f32x4 a0 = *(const f32x4*)a, a1 = *(const f32x4*)(a + 4); f32x4 b0 = {0.f, 0.f, 0.f, 0.f}, b1 = b0;
            if (nb >= 0) { const float* bq = SM + (size_t)nb * SMW + 288 + 8 * p; b0 = *(const f32x4*)bq; b1 = *(const f32x4*)(bq + 4); }
#pragma unroll
            for (int j = 0; j < 4; ++j) { o[j] = sigmoidf_(a0[j] + (b0[j] - a0[j]) * mu[8 * p + j]); o[4 + j] = sigmoidf_(a1[j] + (b1[j] - a1[j]) * mu[8 * p + 4 + j]); }
        } else {
#pragma unroll
            for (int j = 0; j < 8; ++j) o[j] = 0.f; }
        *(v4u*)(SG + (size_t)g * 256 + 8 * p) = pack8(o); }
}

constexpr int ML_P = 72, ML_QS = 0, ML_KS = 64 * ML_P * 2, ML_KT = 2 * ML_KS, ML_PS = 3 * ML_KS, ML_VT = 4 * ML_KS, ML_CB = ML_VT + 48 * ML_P * 2, ML_GT = ML_CB + 48 * ML_P * 2, ML_END = ML_GT + 2 * 6 * 64 * 4;
template <int CTRL, int RMASK> __device__ __forceinline__ float dpp_get(float v, float old) { return __int_as_float(__builtin_amdgcn_update_dpp(__float_as_int(old), __float_as_int(v), CTRL, RMASK, 0xf, false)); }
__device__ __forceinline__ float wave_scan_add(float x) {
    x += dpp_get<0x111, 0xf>(x, 0.f); x += dpp_get<0x112, 0xf>(x, 0.f); x += dpp_get<0x114, 0xf>(x, 0.f); x += dpp_get<0x118, 0xf>(x, 0.f);
    x += dpp_get<0x142, 0xa>(x, 0.f); x += dpp_get<0x143, 0xc>(x, 0.f); return x;
}
__device__ __forceinline__ float wave_scan_max(float x) {
    const float ninf = -__builtin_inff();
    x = fmaxf(x, dpp_get<0x111, 0xf>(x, ninf)); x = fmaxf(x, dpp_get<0x112, 0xf>(x, ninf)); x = fmaxf(x, dpp_get<0x114, 0xf>(x, ninf)); x = fmaxf(x, dpp_get<0x118, 0xf>(x, ninf));
    x = fmaxf(x, dpp_get<0x142, 0xa>(x, ninf)); x = fmaxf(x, dpp_get<0x143, 0xc>(x, ninf)); return x;
}
__device__ __forceinline__ float lane63(float x) { return __int_as_float(__builtin_amdgcn_readlane(__float_as_int(x), 63)); }
__device__ __forceinline__ void mlstm_phase(Frame& F, int l, int first, int stride) {
    LAS unsigned char* L = F.lds;
    LAS bf16* Qs = (LAS bf16*)(L + ML_QS); LAS bf16* Ks = (LAS bf16*)(L + ML_KS); LAS bf16* Kt = (LAS bf16*)(L + ML_KT); LAS bf16* Ps = (LAS bf16*)(L + ML_PS);
    LAS bf16* Vt = (LAS bf16*)(L + ML_VT); LAS bf16* Cb = (LAS bf16*)(L + ML_CB); LAS float* GT = (LAS float*)(L + ML_GT);
    const bf16* Qg = (const bf16*)(F.ws + WS_Q); const bf16* Kg = (const bf16*)(F.ws + WS_K); const bf16* Vg = (const bf16*)(F.ws + WS_V); const float* SM = (const float*)(F.ws + WS_SM);
    bf16* HF = (bf16*)(F.ws + WS_HF); const float* bgate = INP(I_BG) + l * 4 * MH;
    const int tid = F.tid, lane = F.lane, wave = F.wave, r16 = lane & 15, quad = lane >> 4;
    for (int item = first; item < NB * 2 * MH * 4; item += stride) {
        const int vq = item & 3, h = (item >> 2) & 7, dir = (item >> 5) & 1, b = item >> 6;
        __syncthreads();
        for (int i = tid; i < 48 * ML_P; i += NTHREADS) { Cb[i] = 0; Vt[i] = (i >= 32 * ML_P) ? (bf16)0x3F80 : (bf16)0; }
        const float bgi = bgate[(2 * dir) * MH + h], bgf = bgate[(2 * dir + 1) * MH + h];
        const int ss_ = tid & 63, pc = tid >> 6;
        v4u rq, rk, rv = {0u, 0u, 0u, 0u};
        { const int g = row_of(b, tok(dir, ss_)); rq = *(const v4u*)(Qg + (size_t)g * 512 + h * 64 + pc * 8); rk = *(const v4u*)(Kg + (size_t)g * 512 + h * 64 + pc * 8);
          if (pc < 4) rv = *(const v4u*)(Vg + (size_t)g * 1024 + h * 128 + vq * 32 + pc * 8); }
        float m_run = 0.f, gi = 0.f, gf = 0.f;
        auto gate_tables = [&](int buf) {
            LAS float* G = GT + buf * 384;
            const float iv = CAP * fast_tanh((gi + bgi) * (1.0f / CAP)), lf = -fast_softplus(-CAP * fast_tanh((gf + bgf) * (1.0f / CAP)));
            const float bsum = wave_scan_add(lf), pmx = wave_scan_max(iv - bsum);
            const float inter = bsum + m_run, mt = fmaxf(inter, bsum + pmx);
            G[lane] = bsum - mt; G[64 + lane] = iv - bsum; G[128 + lane] = __expf(inter - mt); G[192 + lane] = __expf(-mt);
            const float blast = lane63(bsum), mnew = fmaxf(blast + m_run, blast + lane63(pmx));
            G[256 + lane] = __expf(blast - bsum + iv - mnew);
            if (lane == 0) G[320] = __expf(blast + m_run - mnew);
            m_run = mnew;
        };
        if (wave == 1) { { const int g = row_of(b, tok(dir, lane)); gi = SM[(size_t)g * SMW + (2 * dir) * MH + h]; gf = SM[(size_t)g * SMW + (2 * dir + 1) * MH + h]; }
            gate_tables(0);
            { const int g = row_of(b, tok(dir, 64 + lane)); gi = SM[(size_t)g * SMW + (2 * dir) * MH + h]; gf = SM[(size_t)g * SMW + (2 * dir + 1) * MH + h]; } }
        f32x4 Cacc = {0.f, 0.f, 0.f, 0.f}, Cacc2 = {0.f, 0.f, 0.f, 0.f};
        __syncthreads();
        for (int j = 0; j < NCH; ++j) {
            const LAS float* G = GT + (j & 1) * 384;
            { *(v4u*)(Qs + ss_ * ML_P + pc * 8) = rq; *(v4u*)(Ks + ss_ * ML_P + pc * 8) = rk;
              const unsigned kw[4] = {rk.x, rk.y, rk.z, rk.w};
#pragma unroll
              for (int i = 0; i < 4; ++i) { Kt[(pc * 8 + 2 * i) * ML_P + ss_] = (bf16)(kw[i] & 0xffffu); Kt[(pc * 8 + 2 * i + 1) * ML_P + ss_] = (bf16)(kw[i] >> 16); }
              if (pc < 4) { const unsigned vw[4] = {rv.x, rv.y, rv.z, rv.w};
#pragma unroll
                  for (int i = 0; i < 4; ++i) { Vt[(pc * 8 + 2 * i) * ML_P + ss_] = (bf16)(vw[i] & 0xffffu); Vt[(pc * 8 + 2 * i + 1) * ML_P + ss_] = (bf16)(vw[i] >> 16); } } }
            if (j + 1 < NCH) { const int g = row_of(b, tok(dir, (j + 1) * 64 + ss_)); rq = *(const v4u*)(Qg + (size_t)g * 512 + h * 64 + pc * 8); rk = *(const v4u*)(Kg + (size_t)g * 512 + h * 64 + pc * 8);
                if (pc < 4) rv = *(const v4u*)(Vg + (size_t)g * 1024 + h * 128 + vq * 32 + pc * 8); }
            __syncthreads();
            const int mt = wave >> 1, vnt = wave & 1;
            if (wave == 1 && j + 1 < NCH) { gate_tables((j + 1) & 1);
                if (j + 2 < NCH) { const int g = row_of(b, tok(dir, (j + 2) * 64 + lane)); gi = SM[(size_t)g * SMW + (2 * dir) * MH + h]; gf = SM[(size_t)g * SMW + (2 * dir + 1) * MH + h]; } }
            const bf16x8 qa0 = *(const LAS bf16x8*)(Qs + (16 * mt + r16) * ML_P + quad * 8), qa1 = *(const LAS bf16x8*)(Qs + (16 * mt + r16) * ML_P + 32 + quad * 8);
            f32x4 accq = {0.f, 0.f, 0.f, 0.f}, accqn = {0.f, 0.f, 0.f, 0.f};
            { const bf16x8 c0 = *(const LAS bf16x8*)(Cb + (16 * vnt + r16) * ML_P + quad * 8), c1 = *(const LAS bf16x8*)(Cb + (16 * vnt + r16) * ML_P + 32 + quad * 8);
              const bf16x8 n0 = *(const LAS bf16x8*)(Cb + (32 + r16) * ML_P + quad * 8), n1 = *(const LAS bf16x8*)(Cb + (32 + r16) * ML_P + 32 + quad * 8);
              accq = __builtin_amdgcn_mfma_f32_16x16x32_bf16(qa0, c0, accq, 0, 0, 0); accq = __builtin_amdgcn_mfma_f32_16x16x32_bf16(qa1, c1, accq, 0, 0, 0);
              accqn = __builtin_amdgcn_mfma_f32_16x16x32_bf16(qa0, n0, accqn, 0, 0, 0); accqn = __builtin_amdgcn_mfma_f32_16x16x32_bf16(qa1, n1, accqn, 0, 0, 0); }
#pragma unroll
            for (int nn = 0; nn < 2; ++nn) { const int nt = 2 * (wave & 1) + nn; f32x4 sacc = {0.f, 0.f, 0.f, 0.f};
                if (nt <= mt) { const bf16x8 k0 = *(const LAS bf16x8*)(Ks + (16 * nt + r16) * ML_P + quad * 8), k1 = *(const LAS bf16x8*)(Ks + (16 * nt + r16) * ML_P + 32 + quad * 8);
                    sacc = __builtin_amdgcn_mfma_f32_16x16x32_bf16(qa0, k0, sacc, 0, 0, 0); sacc = __builtin_amdgcn_mfma_f32_16x16x32_bf16(qa1, k1, sacc, 0, 0, 0); }
                const int s = 16 * nt + r16; const float wc_ = G[64 + s];
#pragma unroll
                for (int i = 0; i < 4; ++i) { const int t = 16 * mt + 4 * quad + i; const float p = (s <= t) ? sacc[i] * 0.125f * __expf(G[t] + wc_) : 0.f;
                    Ps[t * ML_P + s] = (bf16)(cvt_pk_bf16(p, 0.f) & 0xffffu); } }
            __syncthreads();
            { f32x4 acc = {0.f, 0.f, 0.f, 0.f}, accn = {0.f, 0.f, 0.f, 0.f};
#pragma unroll
              for (int ks = 0; ks < 2; ++ks) { if (ks == 1 && mt < 2) break;
                  const bf16x8 pa = *(const LAS bf16x8*)(Ps + (16 * mt + r16) * ML_P + 32 * ks + quad * 8);
                  const bf16x8 vb = *(const LAS bf16x8*)(Vt + (16 * vnt + r16) * ML_P + 32 * ks + quad * 8), ob = *(const LAS bf16x8*)(Vt + (32 + r16) * ML_P + 32 * ks + quad * 8);
                  acc = __builtin_amdgcn_mfma_f32_16x16x32_bf16(pa, vb, acc, 0, 0, 0); accn = __builtin_amdgcn_mfma_f32_16x16x32_bf16(pa, ob, accn, 0, 0, 0); }
#pragma unroll
              for (int i = 0; i < 4; ++i) { const int t = 16 * mt + 4 * quad + i; const float wi = G[128 + t] * 0.125f, dn = accn[i] + wi * accqn[i], inv = 1.0f / fmaxf(fabsf(dn), G[192 + t]);
                  const int g = row_of(b, tok(dir, j * 64 + t));
                  HF[((size_t)dir * R + g) * 1024 + h * 128 + vq * 32 + 16 * vnt + r16] = (bf16)(cvt_pk_bf16((acc[i] + wi * accq[i]) * inv, 0.f) & 0xffffu); } }
            { const float aold = G[320]; const int vmt = wave >> 2, dnt = wave & 3;
              f32x4 d1 = {0.f, 0.f, 0.f, 0.f}, d2 = {0.f, 0.f, 0.f, 0.f};
#pragma unroll
              for (int ks = 0; ks < 2; ++ks) {
                  const v4u kraw = *(const LAS v4u*)(Kt + (16 * dnt + r16) * ML_P + 32 * ks + quad * 8); float kf[8]; unpack8(kraw, kf);
                  const f32x4 a0 = *(const LAS f32x4*)&G[256 + 32 * ks + quad * 8], a1 = *(const LAS f32x4*)&G[256 + 32 * ks + quad * 8 + 4];
                  kf[0] *= a0.x; kf[1] *= a0.y; kf[2] *= a0.z; kf[3] *= a0.w; kf[4] *= a1.x; kf[5] *= a1.y; kf[6] *= a1.z; kf[7] *= a1.w;
                  const v4u kp = pack8(kf); const bf16x8 kb = __builtin_bit_cast(bf16x8, kp);
                  const bf16x8 va = *(const LAS bf16x8*)(Vt + (16 * vmt + r16) * ML_P + 32 * ks + quad * 8);
                  d1 = __builtin_amdgcn_mfma_f32_16x16x32_bf16(va, kb, d1, 0, 0, 0);
                  if (wave < 4) { const bf16x8 oa = *(const LAS bf16x8*)(Vt + (32 + r16) * ML_P + 32 * ks + quad * 8); d2 = __builtin_amdgcn_mfma_f32_16x16x32_bf16(oa, kb, d2, 0, 0, 0); } }
              Cacc = Cacc * aold + d1;
#pragma unroll
              for (int i = 0; i < 4; ++i) Cb[(16 * vmt + 4 * quad + i) * ML_P + 16 * dnt + r16] = (bf16)(cvt_pk_bf16(Cacc[i], 0.f) & 0xffffu);
              if (wave < 4) { Cacc2 = Cacc2 * aold + d2;
#pragma unroll
                  for (int i = 0; i < 4; ++i) Cb[(32 + 4 * quad + i) * ML_P + 16 * dnt + r16] = (bf16)(cvt_pk_bf16(Cacc2[i], 0.f) & 0xffffu); } }
            __syncthreads();
        }
    }
}

constexpr int RP = 72;
constexpr int RC_AB = 0, RC_BB = 9216, RC_KB = 18432, RC_RB = 27648, RC_BHT = 36864, RC_KHT = 46080, RC_ABT = 55296, RC_GAKT = 64512, RC_BONP = 67584;
constexpr int RC_TW = 0, RC_AD = 9216;
constexpr int RC_KK16 = 71680, RC_K16 = 80896, RC_R16 = 99328;
constexpr int RC_GAB = 71680, RC_GAK = 75776, RC_HRB = 78848, RC_HRK = 81920, RC_TT = 84992, RC_SAT = 88064, RC_YO = 93184;
constexpr int RC_GL = 109568, RC_VT = 110592, RC_SB = 119808, RC_CONST = 129024, RC_W2T = 133120, RC_A2T = 142336, RC_END = 151552;
static_assert(RC_END <= MISC_OFF && RC_YO + 16384 <= RC_GL && RC_BONP + 1024 <= RC_KK16 && RC_TT + 3072 <= RC_SAT && RC_SAT + 5120 <= RC_YO, "rwkv LDS map");
struct RwPre { f32x4 lw[2], lwn[2], la[2], lan[2]; v4u r, rn, k, kn, v, vn; };
__device__ __forceinline__ void rw_prefetch(RwPre& P, const float* SM, const bf16* RKV, int b, int dir, int h, int j, int tid) {
    const int s = tid >> 3, p8 = (tid & 7) * 8, g = row_of(b, tok(dir, j * 64 + s));
    { const int nb = nbrow(g, 3072); const float* a = SM + (size_t)g * SMW + 32 + 64 * dir + p8; const float* c = SM + (size_t)g * SMW + 160 + 64 * dir + p8;
      P.lw[0] = *(const f32x4*)a; P.lw[1] = *(const f32x4*)(a + 4); P.la[0] = *(const f32x4*)c; P.la[1] = *(const f32x4*)(c + 4);
      const f32x4 z = {0.f, 0.f, 0.f, 0.f}; P.lwn[0] = z; P.lwn[1] = z; P.lan[0] = z; P.lan[1] = z;
      if (nb >= 0) { const float* an = SM + (size_t)nb * SMW + 32 + 64 * dir + p8; const float* cn = SM + (size_t)nb * SMW + 160 + 64 * dir + p8;
          P.lwn[0] = *(const f32x4*)an; P.lwn[1] = *(const f32x4*)(an + 4); P.lan[0] = *(const f32x4*)cn; P.lan[1] = *(const f32x4*)(cn + 4); } }
    const v4u z4 = {0u, 0u, 0u, 0u};
    { const int rw = h * 64 + p8, nb = nbrow(g, rw); P.r = *(const v4u*)(RKV + (size_t)g * 3072 + rw); P.rn = nb >= 0 ? *(const v4u*)(RKV + (size_t)nb * 3072 + rw) : z4; }
    { const int rw = 1024 + h * 64 + p8, nb = nbrow(g, rw); P.k = *(const v4u*)(RKV + (size_t)g * 3072 + rw); P.kn = nb >= 0 ? *(const v4u*)(RKV + (size_t)nb * 3072 + rw) : z4; }
    { const int rw = 2048 + h * 64 + p8, nb = nbrow(g, rw); P.v = *(const v4u*)(RKV + (size_t)g * 3072 + rw); P.vn = nb >= 0 ? *(const v4u*)(RKV + (size_t)nb * 3072 + rw) : z4; }
}
__device__ __forceinline__ bf16x8 lds_frag(const LAS bf16* p) { return *(const LAS bf16x8*)p; }
__device__ __forceinline__ bf16x8 lds_frag_k16(const LAS bf16* p, int quad) { const bf16x8 v = *(const LAS bf16x8*)p; const bf16x8 z = {0, 0, 0, 0, 0, 0, 0, 0}; return quad < 2 ? v : z; }
__device__ __forceinline__ bf16x8 lds_frag_perm(const LAS bf16* p) { const v2u lo = *(const LAS v2u*)p, hi = *(const LAS v2u*)(p + 16); const v4u w = {lo.x, lo.y, hi.x, hi.y}; return __builtin_bit_cast(bf16x8, w); }
__device__ __forceinline__ bf16x8 lds_frag_lo4(const LAS bf16* p) { const v2u lo = *(const LAS v2u*)p; const v4u w = {lo.x, lo.y, 0u, 0u}; return __builtin_bit_cast(bf16x8, w); }
__device__ __forceinline__ unsigned pk2(float lo, float hi) { typedef __bf16 bf2 __attribute__((ext_vector_type(2))); const bf2 v = {(__bf16)lo, (__bf16)hi}; return __builtin_bit_cast(unsigned, v); }
__device__ __forceinline__ bf16 f2b(float x) { return __builtin_bit_cast(unsigned short, (__bf16)x); }
__device__ __forceinline__ float b2f(bf16 x) { return __uint_as_float((unsigned)x << 16); }
#define MFMA16(a, b, c) __builtin_amdgcn_mfma_f32_16x16x32_bf16(a, b, c, 0, 0, 0)
__device__ __forceinline__ void rwkv_phase(Frame& F, int l, int first, int stride) {
    LAS unsigned char* L = F.lds;
    LAS bf16* Ab = (LAS bf16*)(L + RC_AB); LAS bf16* Bb = (LAS bf16*)(L + RC_BB); LAS bf16* Kb = (LAS bf16*)(L + RC_KB); LAS bf16* Rb = (LAS bf16*)(L + RC_RB);
    LAS bf16* BhT = (LAS bf16*)(L + RC_BHT); LAS bf16* KhT = (LAS bf16*)(L + RC_KHT); LAS bf16* AbT = (LAS bf16*)(L + RC_ABT); LAS bf16* GAKT = (LAS bf16*)(L + RC_GAKT); LAS float* BONP = (LAS float*)(L + RC_BONP);
    LAS bf16* TW = (LAS bf16*)(L + RC_TW); LAS bf16* AD = (LAS bf16*)(L + RC_AD);
    LAS bf16* KK16 = (LAS bf16*)(L + RC_KK16); LAS bf16* K16 = (LAS bf16*)(L + RC_K16); LAS bf16* R16 = (LAS bf16*)(L + RC_R16);
    LAS float* GAB = (LAS float*)(L + RC_GAB); LAS bf16* GAK = (LAS bf16*)(L + RC_GAK); LAS bf16* HRB = (LAS bf16*)(L + RC_HRB); LAS bf16* HRK = (LAS bf16*)(L + RC_HRK); LAS bf16* TT = (LAS bf16*)(L + RC_TT);
    LAS bf16* SAt = (LAS bf16*)(L + RC_SAT); LAS float* YO = (LAS float*)(L + RC_YO); LAS float* GL = (LAS float*)(L + RC_GL);
    LAS bf16* Vt = (LAS bf16*)(L + RC_VT); LAS bf16* Sb = (LAS bf16*)(L + RC_SB); LAS float* CN = (LAS float*)(L + RC_CONST); LAS bf16* W2T = (LAS bf16*)(L + RC_W2T); LAS bf16* A2T = (LAS bf16*)(L + RC_A2T);
    const float* SM = (const float*)(F.ws + WS_SM); const bf16* RKV = (const bf16*)(F.ws + WS_RKV); bf16* YS = (bf16*)(F.ws + WS_YS); float* BON = (float*)(F.ws + WS_BON);
    const bf16* WL = (const bf16*)(F.ws + WS_WLORA);
    const int tid = F.tid, lane = F.lane, wave = F.wave;
    for (int item = first; item < NB * 2 * RH; item += stride) {
        const int h = item & 15, dir = (item >> 4) & 1, b = item >> 5;
        __syncthreads();
        if (tid < 64) { const float* mu = INP(I_MU) + l * RW; CN[tid] = mu[h * 64 + tid]; CN[64 + tid] = mu[1024 + h * 64 + tid]; CN[128 + tid] = mu[2048 + h * 64 + tid];
            CN[192 + tid] = mu[3072 + 64 * dir + tid]; CN[256 + tid] = mu[3200 + 64 * dir + tid];
            CN[320 + tid] = INP(I_KK)[l * RD + h * 64 + tid]; CN[384 + tid] = INP(I_KA)[l * RD + h * 64 + tid]; CN[448 + tid] = INP(I_RK)[l * RD + h * 64 + tid];
            CN[512 + tid] = INP(I_W0)[(l * 2 + dir) * RD + h * 64 + tid]; CN[576 + tid] = INP(I_A0)[(l * 2 + dir) * RD + h * 64 + tid]; }
        { const int n = tid >> 3, p8 = (tid & 7) * 8;
          *(v4u*)(W2T + n * 72 + p8) = *(const v4u*)(WL + ((size_t)(0 * 2 + dir) * RD + h * 64 + n) * 64 + p8);
          *(v4u*)(A2T + n * 72 + p8) = *(const v4u*)(WL + ((size_t)(1 * 2 + dir) * RD + h * 64 + n) * 64 + p8); }
        for (int i = tid; i < (RC_CONST - RC_GL) / 4; i += NTHREADS) ((LAS unsigned*)(L + RC_GL))[i] = 0u;
        f32x4 ST[4]; for (int kt = 0; kt < 4; ++kt) ST[kt] = (f32x4){0.f, 0.f, 0.f, 0.f};
        RwPre P; rw_prefetch(P, SM, RKV, b, dir, h, 0, tid);
        __syncthreads();
        for (int j = 0; j < NCH; ++j) {
            { int tl = tid; asm volatile("" : "+v"(tl)); const int s = tl >> 3, p8 = (tl & 7) * 8;
              { float tw[8], ad[8]; const f32x4 muw[2] = {*(const f32x4*)&CN[192 + p8], *(const f32x4*)&CN[196 + p8]}, mua[2] = {*(const f32x4*)&CN[256 + p8], *(const f32x4*)&CN[260 + p8]};
#pragma unroll
                for (int i = 0; i < 8; ++i) { const float pw = P.lw[i >> 2][i & 3], pwn = P.lwn[i >> 2][i & 3], pa = P.la[i >> 2][i & 3], pan = P.lan[i >> 2][i & 3];
                    tw[i] = fast_tanh(pw + (pwn - pw) * muw[i >> 2][i & 3]); ad[i] = pa + (pan - pa) * mua[i >> 2][i & 3]; }
                *(v4u*)(TW + s * 72 + p8) = pack8(tw); *(v4u*)(AD + s * 72 + p8) = pack8(ad); }
              { float a[8], bq[8], o[8]; const f32x4 mur[2] = {*(const f32x4*)&CN[p8], *(const f32x4*)&CN[4 + p8]}, muk[2] = {*(const f32x4*)&CN[64 + p8], *(const f32x4*)&CN[68 + p8]};
                unpack8(P.r, a); unpack8(P.rn, bq);
#pragma unroll
                for (int i = 0; i < 8; ++i) o[i] = a[i] + (bq[i] - a[i]) * mur[i >> 2][i & 3];
                *(v4u*)(R16 + s * RP + p8) = pack8(o);
                unpack8(P.k, a); unpack8(P.kn, bq); float ssq = 0.f; const f32x4 kkc[2] = {*(const f32x4*)&CN[320 + p8], *(const f32x4*)&CN[324 + p8]};
#pragma unroll
                for (int i = 0; i < 8; ++i) { o[i] = a[i] + (bq[i] - a[i]) * muk[i >> 2][i & 3]; a[i] = o[i] * kkc[i >> 2][i & 3]; ssq += a[i] * a[i]; }
                *(v4u*)(K16 + s * RP + p8) = pack8(o);
                const float inv = 1.0f / fmaxf(sqrtf(red8(ssq)), 1e-12f);
#pragma unroll
                for (int i = 0; i < 8; ++i) a[i] *= inv;
                *(v4u*)(KK16 + s * RP + p8) = pack8(a);
                { unpack8(P.v, a); unpack8(P.vn, bq); const f32x4 muv[2] = {*(const f32x4*)&CN[128 + p8], *(const f32x4*)&CN[132 + p8]};
#pragma unroll
                  for (int i = 0; i < 8; ++i) Vt[(p8 + i) * RP + s] = f2b(a[i] + (bq[i] - a[i]) * muv[i >> 2][i & 3]); } } }
            __syncthreads();
            if (j + 1 < NCH) rw_prefetch(P, SM, RKV, b, dir, h, j + 1, tid);
            { int lb = lane; asm volatile("" : "+v"(lb)); const int r16 = lb & 15, quad = lb >> 4; const int c = wave >> 1, t = 16 * c + r16;
              const bf16x8 a0 = lds_frag(TW + t * 72 + quad * 8), a1 = lds_frag(TW + t * 72 + 32 + quad * 8);
              const bf16x8 d0 = lds_frag(AD + t * 72 + quad * 8), d1 = lds_frag(AD + t * 72 + 32 + quad * 8);
              f32x4 cw[2], ca[2];
#pragma unroll
              for (int nn = 0; nn < 2; ++nn) { const int nt = 2 * (wave & 1) + nn; const f32x4 z = {0.f, 0.f, 0.f, 0.f};
                  cw[nn] = MFMA16(lds_frag(W2T + (16 * nt + r16) * 72 + quad * 8), a0, z); cw[nn] = MFMA16(lds_frag(W2T + (16 * nt + r16) * 72 + 32 + quad * 8), a1, cw[nn]);
                  ca[nn] = MFMA16(lds_frag(A2T + (16 * nt + r16) * 72 + quad * 8), d0, z); ca[nn] = MFMA16(lds_frag(A2T + (16 * nt + r16) * 72 + 32 + quad * 8), d1, ca[nn]); }
              __syncthreads();
              float bsum = 0.f; const int glsrc = ((lb & 48) | 15) << 2;
#pragma unroll
              for (int nn = 0; nn < 2; ++nn) { const int n0 = 16 * (2 * (wave & 1) + nn) + 4 * quad;
                  const f32x4 w0c = *(const LAS f32x4*)&CN[512 + n0], a0c = *(const LAS f32x4*)&CN[576 + n0], kac = *(const LAS f32x4*)&CN[384 + n0], rkc = *(const LAS f32x4*)&CN[448 + n0];
                  const v2u kkw = *(const LAS v2u*)(KK16 + t * RP + n0), kxw = *(const LAS v2u*)(K16 + t * RP + n0), rrw = *(const LAS v2u*)(R16 + t * RP + n0);
                  const float kk[4] = {bflo(kkw.x), bfhi(kkw.x), bflo(kkw.y), bfhi(kkw.y)}, kx[4] = {bflo(kxw.x), bfhi(kxw.x), bflo(kxw.y), bfhi(kxw.y)}, rr[4] = {bflo(rrw.x), bfhi(rrw.x), bflo(rrw.y), bfhi(rrw.y)};
                  float av[4], pin[4], pex[4], gl[4];
#pragma unroll
                  for (int i = 0; i < 4; ++i) { float x = __expf(-0.60653066f * sigmoidf_(w0c[i] + cw[nn][i])); av[i] = sigmoidf_(a0c[i] + ca[nn][i]);
                      x *= dpp_one<0x111>(x); x *= dpp_one<0x112>(x); x *= dpp_one<0x114>(x); x *= dpp_one<0x118>(x);
                      pin[i] = x; pex[i] = dpp_one<0x111>(x); gl[i] = __int_as_float(__builtin_amdgcn_ds_bpermute(glsrc, __float_as_int(x))); }
                  float abv[4], rbv[4], bbv[4], kbv[4], bhv[4], khv[4];
#pragma unroll
                  for (int i = 0; i < 4; ++i) { const float kka = kk[i] * av[i], kd = kx[i] * (1.0f + (av[i] - 1.0f) * kac[i]), gi_ = __builtin_amdgcn_rcpf(pin[i]);
                      bbv[i] = kka * gi_; kbv[i] = kd * gi_; abv[i] = kk[i] * pex[i]; rbv[i] = rr[i] * pin[i]; bhv[i] = bbv[i] * gl[i]; khv[i] = kbv[i] * gl[i]; bsum += rr[i] * kd * rkc[i]; }
                  { v2u o; o.x = cvt_pk_bf16(abv[0], abv[1]); o.y = cvt_pk_bf16(abv[2], abv[3]); *(LAS v2u*)(Ab + t * RP + n0) = o;
#pragma unroll
                    for (int i = 0; i < 4; ++i) AbT[(n0 + i) * RP + t] = (bf16)((i & 1) ? (((i >> 1) ? o.y : o.x) >> 16) : (((i >> 1) ? o.y : o.x) & 0xffffu));
                    o.x = cvt_pk_bf16(rbv[0], rbv[1]); o.y = cvt_pk_bf16(rbv[2], rbv[3]); *(LAS v2u*)(Rb + t * RP + n0) = o;
                    o.x = cvt_pk_bf16(bbv[0], bbv[1]); o.y = cvt_pk_bf16(bbv[2], bbv[3]); *(LAS v2u*)(Bb + t * RP + n0) = o;
                    o.x = cvt_pk_bf16(kbv[0], kbv[1]); o.y = cvt_pk_bf16(kbv[2], kbv[3]); *(LAS v2u*)(Kb + t * RP + n0) = o; }
#pragma unroll
                  for (int i = 0; i < 4; ++i) { BhT[(n0 + i) * RP + t] = f2b(bhv[i]); KhT[(n0 + i) * RP + t] = f2b(khv[i]); }
                  if (r16 == 15) { const f32x4 g4 = {gl[0], gl[1], gl[2], gl[3]}; *(LAS f32x4*)&GL[c * 64 + n0] = g4; }
              }
              bsum += __shfl_xor(bsum, 16); bsum += __shfl_xor(bsum, 32); if (quad == 0) BONP[t * 2 + (wave & 1)] = bsum; }
            __syncthreads();
            { int lf_ = lane; asm volatile("" : "+v"(lf_)); const int r16 = lf_ & 15, quad = lf_ >> 4; const int c = wave & 3, odd = wave >> 2; const LAS bf16* Asrc = odd ? Rb : Ab;     const f32x4 z = {0.f, 0.f, 0.f, 0.f};
              const bf16x8 a0 = lds_frag(Asrc + (16 * c + r16) * RP + quad * 8), a1 = lds_frag(Asrc + (16 * c + r16) * RP + 32 + quad * 8);
              f32x4 g1 = MFMA16(a0, lds_frag(Bb + (16 * c + r16) * RP + quad * 8), z); g1 = MFMA16(a1, lds_frag(Bb + (16 * c + r16) * RP + 32 + quad * 8), g1);
              f32x4 g2 = MFMA16(a0, lds_frag(Kb + (16 * c + r16) * RP + quad * 8), z); g2 = MFMA16(a1, lds_frag(Kb + (16 * c + r16) * RP + 32 + quad * 8), g2);
              if (wave == 7) { const float bs = BONP[lf_ * 2] + BONP[lf_ * 2 + 1]; BON[((size_t)dir * R + row_of(b, tok(dir, j * 64 + lf_))) * RH + h] = bs; }
              float v2m[4];
#pragma unroll
              for (int i = 0; i < 4; ++i) { const int t = 4 * quad + i; const bool keep = odd ? (r16 <= t) : (r16 < t); const float v1 = keep ? g1[i] : 0.f; v2m[i] = keep ? g2[i] : 0.f;
                  if (odd) { HRB[c * 384 + t * 24 + r16] = f2b(v1); HRK[c * 384 + t * 24 + r16] = f2b(v2m[i]); } else { GAB[c * 256 + t * 16 + r16] = v1; GAK[c * 384 + t * 24 + r16] = f2b(v2m[i]); } }
              if (!odd) { { v2u o; o.x = cvt_pk_bf16(v2m[0], v2m[1]); o.y = cvt_pk_bf16(v2m[2], v2m[3]); *(v2u*)(GAKT + c * 384 + r16 * 24 + 4 * quad) = o; }
                  LDS_WAIT(); __builtin_amdgcn_wave_barrier();
                  float tj[16];
                  tj[0] = (r16 == 0) ? 1.0f : 0.f;
#pragma unroll
                  for (int i = 1; i < 16; ++i) { const LAS f32x4* gr = (const LAS f32x4*)(GAB + c * 256 + i * 16); float acc0 = (r16 == i) ? 1.0f : 0.f, acc1 = 0.f;
#pragma unroll
                      for (int q = 0; q < (i + 3) / 4; ++q) { const f32x4 g4 = gr[q];
#pragma unroll
                          for (int e = 0; e < 4; ++e) { const int jj = 4 * q + e; if (jj < i) { if (jj & 1) acc1 -= g4[e] * tj[jj]; else acc0 -= g4[e] * tj[jj]; } } }
                      tj[i] = acc0 + acc1; }
                  if (quad == 0) {
#pragma unroll
                      for (int i = 0; i < 16; ++i) TT[c * 384 + i * 24 + r16] = f2b(tj[i]); } } }
            __syncthreads();
            { int lg = lane; asm volatile("" : "+v"(lg)); const int r16 = lg & 15, quad = lg >> 4; const int c = wave & 3, half = wave >> 2; const f32x4 z = {0.f, 0.f, 0.f, 0.f};
              const bf16x8 ta = lds_frag_k16(TT + c * 384 + r16 * 24 + quad * 8, quad);
              f32x4 o0 = MFMA16(ta, lds_frag(AbT + (16 * (2 * half) + r16) * RP + 16 * c + (quad & 1) * 8), z), o1 = MFMA16(ta, lds_frag(AbT + (16 * (2 * half + 1) + r16) * RP + 16 * c + (quad & 1) * 8), z);
              f32x4 og = z; if (!half) og = MFMA16(ta, lds_frag(GAKT + c * 384 + r16 * 24 + (quad & 1) * 8), z);
#pragma unroll
              for (int i = 0; i < 4; ++i) { const int t = 4 * quad + i; Ab[(16 * c + t) * RP + 16 * (2 * half) + r16] = f2b(o0[i]); Ab[(16 * c + t) * RP + 16 * (2 * half + 1) + r16] = f2b(o1[i]); if (!half) GAK[c * 384 + t * 24 + r16] = f2b(og[i]); } }
            __syncthreads();
            if (wave < 4) {
                int lc = lane; asm volatile("" : "+v"(lc)); const int r16 = lc & 15, quad = lc >> 4, vnt = wave;
#pragma unroll 1
                for (int c = 0; c < 4; ++c) {
                    bf16x8 sb[2];
#pragma unroll
                    for (int ks = 0; ks < 2; ++ks) { v4u w; w.x = pk2(ST[2 * ks][0], ST[2 * ks][1]); w.y = pk2(ST[2 * ks][2], ST[2 * ks][3]); w.z = pk2(ST[2 * ks + 1][0], ST[2 * ks + 1][1]); w.w = pk2(ST[2 * ks + 1][2], ST[2 * ks + 1][3]); sb[ks] = __builtin_bit_cast(bf16x8, w); }
                    const v2u vmw = *(const LAS v2u*)(Vt + (16 * vnt + r16) * RP + 16 * c + 4 * quad); const v4u vm4 = {vmw.x, vmw.y, 0u, 0u}; const bf16x8 vmb = __builtin_bit_cast(bf16x8, vm4);
                    f32x4 sa = {0.f, 0.f, 0.f, 0.f}, yy = {0.f, 0.f, 0.f, 0.f};
#pragma unroll
                    for (int ks = 0; ks < 2; ++ks) { sa = MFMA16(lds_frag_perm(Ab + (16 * c + r16) * RP + 32 * ks + 4 * quad), sb[ks], sa); yy = MFMA16(lds_frag_perm(Rb + (16 * c + r16) * RP + 32 * ks + 4 * quad), sb[ks], yy); }
                    sa = MFMA16(lds_frag_lo4(GAK + c * 384 + r16 * 24 + 4 * quad), vmb, sa); yy = MFMA16(lds_frag_lo4(HRK + c * 384 + r16 * 24 + 4 * quad), vmb, yy);
                    const v4u sa4 = {pk2(sa[0], sa[1]), pk2(sa[2], sa[3]), 0u, 0u}; const bf16x8 sab = __builtin_bit_cast(bf16x8, sa4);
                    const f32x4 z = {0.f, 0.f, 0.f, 0.f};
                    const f32x4 dy = MFMA16(lds_frag_lo4(HRB + c * 384 + r16 * 24 + 4 * quad), sab, z);
#pragma unroll
                    for (int i = 0; i < 4; ++i) YO[(16 * c + 4 * quad + i) * 64 + 16 * vnt + r16] = yy[i] - dy[i];
#pragma unroll
                    for (int kt = 0; kt < 4; ++kt) { const f32x4 e_ = MFMA16(lds_frag_lo4(BhT + (16 * kt + r16) * RP + 16 * c + 4 * quad), sab, z), d_ = MFMA16(lds_frag_lo4(KhT + (16 * kt + r16) * RP + 16 * c + 4 * quad), vmb, z);
                        const f32x4 gl4 = *(const LAS f32x4*)&GL[c * 64 + 16 * kt + 4 * quad]; ST[kt] = ST[kt] * gl4 + d_ - e_; }
                }
            }
            __syncthreads();
            { int to = tid; asm volatile("" : "+v"(to)); const int s4 = to >> 3, q8 = (to & 7) * 8; const f32x4 y0 = *(const f32x4*)&YO[s4 * 64 + q8], y1 = *(const f32x4*)&YO[s4 * 64 + q8 + 4];
              v4u o; o.x = cvt_pk_bf16(y0.x, y0.y); o.y = cvt_pk_bf16(y0.z, y0.w); o.z = cvt_pk_bf16(y1.x, y1.y); o.w = cvt_pk_bf16(y1.z, y1.w);
              *(v4u*)(YS + ((size_t)dir * R + row_of(b, tok(dir, j * 64 + s4))) * RD + h * 64 + q8) = o; }
            __syncthreads();
        }
    }
}
template <int PART> __device__ __forceinline__ void finish_phase(Frame& F, int l, int nrows, int first, int stride) {
    const bf16* HF = (const bf16*)(F.ws + WS_HF); const bf16* O = (const bf16*)(F.ws + WS_O); bf16* HM = (bf16*)(F.ws + WS_HM);
    const bf16* YS = (const bf16*)(F.ws + WS_YS); const bf16* RKV = (const bf16*)(F.ws + WS_RKV); const bf16* Gb = (const bf16*)(F.ws + WS_H); const float* BON = (const float*)(F.ws + WS_BON); bf16* YR = (bf16*)(F.ws + WS_YR);
    const int lane = F.lane, c0 = lane * 16;
    float k1[16], k2[16], k3[16];
    { const float* p1 = PART == 0 ? INP(I_GMN) + l * 1024 + c0 : INP(I_LNW) + l * RD + c0; const float* p2 = INP(I_LNB) + l * RD + c0; const float* p3 = INP(I_MU) + l * RW + 2048 + c0;
#pragma unroll
      for (int q = 0; q < 4; ++q) { const f32x4 t1 = *(const f32x4*)(p1 + 4 * q); k1[4 * q] = t1.x; k1[4 * q + 1] = t1.y; k1[4 * q + 2] = t1.z; k1[4 * q + 3] = t1.w;
          if (PART == 1) { const f32x4 t2 = *(const f32x4*)(p2 + 4 * q), t3 = *(const f32x4*)(p3 + 4 * q); k2[4 * q] = t2.x; k2[4 * q + 1] = t2.y; k2[4 * q + 2] = t2.z; k2[4 * q + 3] = t2.w; k3[4 * q] = t3.x; k3[4 * q + 1] = t3.y; k3[4 * q + 2] = t3.z; k3[4 * q + 3] = t3.w; } } }
    const bf16* S0 = PART == 0 ? HF : YS;
    int g = first * NWAVES + F.wave; const int gstep = stride * NWAVES;
    v4u n0 = {0u, 0u, 0u, 0u}, n1 = n0, n2 = n0, n3 = n0;
    if (g < nrows) { n0 = *(const v4u*)(S0 + (size_t)g * 1024 + c0); n1 = *(const v4u*)(S0 + ((size_t)R + g) * 1024 + c0); n2 = *(const v4u*)(S0 + (size_t)g * 1024 + c0 + 8); n3 = *(const v4u*)(S0 + ((size_t)R + g) * 1024 + c0 + 8); }
    for (; g < nrows; g += gstep) {
        const v4u c_0 = n0, c_1 = n1, c_2 = n2, c_3 = n3;
        { const int gn = g + gstep; if (gn < nrows) { n0 = *(const v4u*)(S0 + (size_t)gn * 1024 + c0); n1 = *(const v4u*)(S0 + ((size_t)R + gn) * 1024 + c0); n2 = *(const v4u*)(S0 + (size_t)gn * 1024 + c0 + 8); n3 = *(const v4u*)(S0 + ((size_t)R + gn) * 1024 + c0 + 8); } }
        float y[16], a[8], bq[8];
        unpack8(c_0, a); unpack8(c_1, bq);
#pragma unroll
        for (int i = 0; i < 8; ++i) y[i] = a[i] + bq[i];
        unpack8(c_2, a); unpack8(c_3, bq);
#pragma unroll
        for (int i = 0; i < 8; ++i) y[8 + i] = a[i] + bq[i];
        if (PART == 0) {
            float ss = 0.f;
#pragma unroll
            for (int i = 0; i < 16; ++i) ss += y[i] * y[i];
            const float rs = 1.0f / sqrtf(red8(ss) * (1.0f / DV) + NORM_EPS);
            float og[16]; unpack8(*(const v4u*)(O + (size_t)g * 1024 + c0), a); unpack8(*(const v4u*)(O + (size_t)g * 1024 + c0 + 8), bq);
#pragma unroll
            for (int i = 0; i < 8; ++i) { og[i] = a[i]; og[8 + i] = bq[i]; }
            float o1[8], o2[8];
#pragma unroll
            for (int i = 0; i < 8; ++i) { o1[i] = y[i] * rs * k1[i] * sigmoidf_(og[i]); o2[i] = y[8 + i] * rs * k1[8 + i] * sigmoidf_(og[8 + i]); }
            *(v4u*)(HM + (size_t)g * 1024 + c0) = pack8(o1); *(v4u*)(HM + (size_t)g * 1024 + c0 + 8) = pack8(o2);
        }
        if (PART == 1) {
            float sm_ = 0.f;
#pragma unroll
            for (int i = 0; i < 16; ++i) sm_ += y[i];
            const float mean = red4(sm_) * (1.0f / RN); float vs = 0.f;
#pragma unroll
            for (int i = 0; i < 16; ++i) { const float dl = y[i] - mean; vs += dl * dl; }
            const float rs = 1.0f / sqrtf(red4(vs) * (1.0f / RN) + GN_EPS);
            const int hh = lane >> 2; const float bon = BON[(size_t)g * RH + hh] + BON[((size_t)R + g) * RH + hh];
            float vm[16], gg[16];
#pragma unroll
            for (int half = 0; half < 2; ++half) { const int rw = 2048 + c0 + 8 * half, nb = nbrow(g, rw); unpack8(*(const v4u*)(RKV + (size_t)g * 3072 + rw), a);
                if (nb >= 0) unpack8(*(const v4u*)(RKV + (size_t)nb * 3072 + rw), bq); else {
#pragma unroll
                    for (int i = 0; i < 8; ++i) bq[i] = 0.f; }
#pragma unroll
                for (int i = 0; i < 8; ++i) vm[8 * half + i] = a[i] + (bq[i] - a[i]) * k3[8 * half + i];
                unpack8(*(const v4u*)(Gb + (size_t)g * RD + c0 + 8 * half), a);
#pragma unroll
                for (int i = 0; i < 8; ++i) gg[8 * half + i] = a[i]; }
            float o1[8], o2[8];
#pragma unroll
            for (int i = 0; i < 8; ++i) { o1[i] = ((y[i] - mean) * rs * k1[i] + k2[i] + bon * vm[i]) * gg[i]; o2[i] = ((y[8 + i] - mean) * rs * k1[8 + i] + k2[8 + i] + bon * vm[8 + i]) * gg[8 + i]; }
            *(v4u*)(YR + (size_t)g * RD + c0) = pack8(o1); *(v4u*)(YR + (size_t)g * RD + c0 + 8) = pack8(o2);
        }
    }
}
struct MoeMeta { int off[NE + 1]; };
__device__ __forceinline__ MoeMeta moe_meta(Frame& F) {
    MoeMeta m; int o = 0;
#pragma unroll
    for (int e = 0; e < NE; ++e) { m.off[e] = o; const unsigned c = __hip_atomic_load((unsigned*)(F.ctl + CW_ECNT + 64 * e), RLX_AGENT); o += (int)((c + 255u) & ~255u); }
    m.off[NE] = o; return m;
}
__device__ __forceinline__ void gather_phase(Frame& F) {
    const MoeMeta m = moe_meta(F);
    if (F.bid == 0 && F.tid < MAXSLOT / 256) { int e = 0;
#pragma unroll
        for (int q = 1; q <= NE - 1; ++q) e += ((int)F.tid * 256 >= m.off[q]) ? 1 : 0;
        ((int*)(F.ws + WS_META + 768 * 1024))[F.tid] = e; }
    const bf16* H = (const bf16*)(F.ws + WS_H); unsigned char* HG = (unsigned char*)(F.ws + WS_HG);
    for (int w = F.bid * NWAVES + F.wave; w < RL * 2; w += F.G * NWAVES) { const int g = w >> 1, k = w & 1; int* tk = (int*)(F.ws + WS_META) + (size_t)g * 8; const int e = tk[k], pos = tk[2 + k];
        int base = 0;
#pragma unroll
        for (int q = 0; q < NE; ++q) base = (e == q) ? m.off[q] : base;
        const int slot = base + pos; if (F.lane == 0) tk[6 + k] = slot;
        const v4u* src = (const v4u*)(H + (size_t)g * D); float a[8], c8[8];
        unpack8(src[2 * F.lane], a); unpack8(src[2 * F.lane + 1], c8);
#pragma unroll
        for (int i = 0; i < 8; ++i) { a[i] = __builtin_amdgcn_fmed3f(a[i], -448.0f, 448.0f); c8[i] = __builtin_amdgcn_fmed3f(c8[i], -448.0f, 448.0f); }
        v4u o; o.x = pk4_fp8(a[0], a[1], a[2], a[3]); o.y = pk4_fp8(a[4], a[5], a[6], a[7]); o.z = pk4_fp8(c8[0], c8[1], c8[2], c8[3]); o.w = pk4_fp8(c8[4], c8[5], c8[6], c8[7]);
        *(v4u*)(HG + (size_t)slot * D + 16 * F.lane) = o; }
}
__device__ __forceinline__ void final_phase(Frame& F, const float* MODl) {
    const bf16* Y2 = (const bf16*)(F.ws + WS_Y2); const float* gfp = INP(I_GF);
    f32x4 gf[4];
#pragma unroll
    for (int j = 0; j < 4; ++j) gf[j] = *(const f32x4*)(gfp + 256 * j + 4 * F.lane);
    int g = F.bid * NWAVES + F.wave; const int gstep = F.G * NWAVES;
    int s0n = 0, s1n = 0; float p0n = 0.f, p1n = 0.f;
    if (g < RL) { const int* tk = (const int*)(F.ws + WS_META) + (size_t)g * 8; s0n = tk[6]; s1n = tk[7]; p0n = ((const float*)tk)[4]; p1n = ((const float*)tk)[5]; }
    for (; g < RL; g += gstep) {
        const int s0 = s0n, s1 = s1n; const float p0 = p0n, p1 = p1n;
        float* xr = (float*)F.out + (size_t)g * D; const float* gt = MODl + (g / T) * 6 * D + 5 * D; f32x4 x[4], gq[4]; v2u ya[4], yb[4];
#pragma unroll
        for (int j = 0; j < 4; ++j) { const int c = 256 * j + 4 * F.lane; x[j] = *(const f32x4*)(xr + c); gq[j] = *(const f32x4*)(gt + c); ya[j] = *(const v2u*)(Y2 + (size_t)s0 * D + c); yb[j] = *(const v2u*)(Y2 + (size_t)s1 * D + c); }
        { const int gn = g + gstep; if (gn < RL) { const int* tk = (const int*)(F.ws + WS_META) + (size_t)gn * 8; s0n = tk[6]; s1n = tk[7]; p0n = ((const float*)tk)[4]; p1n = ((const float*)tk)[5]; } }
        f32x4 v[4]; float ss = 0.f;
#pragma unroll
        for (int j = 0; j < 4; ++j) { const v2u a = ya[j], bq = yb[j];
            f32x4 y; y.x = p0 * bflo(a.x) + p1 * bflo(bq.x); y.y = p0 * bfhi(a.x) + p1 * bfhi(bq.x); y.z = p0 * bflo(a.y) + p1 * bflo(bq.y); y.w = p0 * bfhi(a.y) + p1 * bfhi(bq.y);
            v[j] = x[j] + gq[j] * y; ss += (v[j].x * v[j].x + v[j].y * v[j].y) + (v[j].z * v[j].z + v[j].w * v[j].w); }
        const float rstd = 1.0f / sqrtf(wave_sum(ss) * (1.0f / D) + NORM_EPS);
#pragma unroll
        for (int j = 0; j < 4; ++j) { const int c = 256 * j + 4 * F.lane; *(f32x4*)(xr + c) = v[j] * rstd * gf[j]; }
    }
}

#ifndef MK_SPLIT
#define MK_SPLIT 0
#endif
constexpr int PPL = 12, NPHASE = 1 + NL * PPL + 1;
__device__ __forceinline__ GAS unsigned char* launder_ws(GAS unsigned char* p) { asm volatile("" : "+s"(p)); return p; }
__device__ __forceinline__ const CAS Args* launder_args(const CAS Args* p) { asm volatile("" : "+s"(p)); return p; }
__device__ __forceinline__ void grid_barrier(unsigned* barw, unsigned x, volatile LAS unsigned* st) { XcdBarrier b; b.bar = barw; b.x = x; b.st = st; xcd_barrier(b); }
#define IN(k) (lo <= (k) && (k) < hi)
#define SEAM(k) do { if (IN(k) && IN((k) + 1)) grid_barrier(bar.bar, bar.x, bar.st); } while (0)
#define PH_BEGIN { int t_ = threadIdx.x; asm volatile("" : "+v"(t_)); F.tid = t_; F.lane = t_ & 63; F.wave = __builtin_amdgcn_readfirstlane(t_ >> 6); int b_ = blockIdx.x; asm volatile("" : "+s"(b_)); F.bid = b_; F.cb = b_; F.cg = F.G; } \
        GAS unsigned char* ws = launder_ws(args.ws); F.ws = ws; F.A = launder_args((const CAS Args*)__builtin_amdgcn_kernarg_segment_ptr()); float* MOD = (float*)(ws + WS_MOD); float* XC = (float*)(ws + WS_XC); bf16* Hb = (bf16*)(ws + WS_H); \
        const float* MODl = MOD + (size_t)l * 5 * 6 * D; const float* xl = l == 0 ? INP(I_X) : (const float*)F.out; const float* xc = l == 0 ? INP(I_CTX) : XC; (void)MODl; (void)xl; (void)xc; (void)Hb;
template <int l> __device__ __forceinline__ void layer_body(Frame& F, const Args& args, const int lo, const int hi, const XcdBarrier& bar) {
        const int p0 = 1 + l * PPL; const bool last = (l == NL - 1);
        const int Mrows = last ? RL : R;
        if (IN(p0 + 0)) { PH_BEGIN if (l == 0) normmod_phase<false>(F, xl, xc, INP(I_GNM) + l * D, MODl, 0, D, R, nullptr);
            else { normmod_ctx_slabs(F, xc, (const float*)(ws + WS_S2), INP(I_GNM) + l * D, MODl, 0, D); normmod_phase<false>(F, xl, xc, INP(I_GNM) + l * D, MODl, 0, D, RL, nullptr); conv_rest(F, l); } }
        SEAM(p0 + 0);
        if (IN(p0 + 1)) { PH_BEGIN pg8::Gemm g{Hb, (const bf16*)(ws + WS_WIN), R, NPAD, D}; pg8::EpiInproj E{ws};
            if (!last) { pg8::StaticOrder S; S.init(R, NPAD, F.G, F.bid); pg8::gemm_phase<pg8::EpiInproj, pg8::StaticOrder, true, true>(F.lds, g, S, E); }
            else { pg8::InprojLastOrder S; S.G = F.G; S.c = F.bid; pg8::gemm_phase<pg8::EpiInproj, pg8::InprojLastOrder, true, true>(F.lds, g, S, E); } }
        if (IN(p0 + 1) && IN(p0 + 3)) grid_barrier(bar.bar, bar.x, bar.st);
        if (IN(p0 + 3)) { PH_BEGIN const int nR = F.G / 2;
            if (F.bid < nR) rwkv_phase(F, l, F.bid, nR);
            else { F.cb = F.bid - nR; F.cg = F.G - nR; gu32* sub = F.ctl + CW_SUB + 64 * l;
                   sg_phase(F, l); subgrid_arrive(F, sub);
                   mlstm_phase(F, l, F.cb, F.cg); __syncthreads();
                   if (!last) { conv_ffn0(F); conv_win(F, l + 1); } else conv_experts(F, 0, 4);
                   subgrid_arrive(F, sub + 128);
                   subgrid_wait(F, sub, (unsigned)F.cg); subgrid_wait(F, sub + 128, (unsigned)F.cg);
                   finish_phase<0>(F, l, Mrows, F.cb, F.cg); subgrid_arrive(F, sub + 256); } }
        if (IN(p0 + 3)) { PH_BEGIN const int nR = F.G / 2;
            if (F.bid >= nR) { int kg = 256; asm volatile("" : "+s"(kg));
                pg8::Gemm g{(const bf16*)(ws + WS_SG), (const bf16*)(ws + WS_WG2), R, RD, kg}; pg8::StaticOrder S; S.init(Mrows, RD, F.G - nR, F.bid - nR);
                pg8::EpiStore E{Hb, RD};
                pg8::gemm_phase<pg8::EpiStore, pg8::StaticOrder, true, true>(F.lds, g, S, E); } }
        if (IN(p0 + 3)) { PH_BEGIN const int nR = F.G / 2;
            if (F.bid >= nR) { F.cb = F.bid - nR; F.cg = F.G - nR; subgrid_wait(F, F.ctl + CW_SUB + 64 * l + 256, (unsigned)F.cg);
                pg8::Gemm g{(const bf16*)(ws + WS_HM), (const bf16*)(ws + WS_WPM), Mrows, D, D}; pg8::StaticOrder S; S.init(Mrows, D, F.G - nR, F.bid - nR);
                pg8::EpiMerge<0> E{(const bf16*)(ws + WS_MGT), (bf16*)(ws + WS_T1), nullptr};
                pg8::gemm_phase<pg8::EpiMerge<0>, pg8::StaticOrder, true, true>(F.lds, g, S, E); } }
        SEAM(p0 + 3);
        if (IN(p0 + 4)) { PH_BEGIN finish_phase<1>(F, l, Mrows, F.bid, F.G); }
        if (IN(p0 + 4) && IN(p0 + 6)) grid_barrier(bar.bar, bar.x, bar.st);
        if (IN(p0 + 6)) { PH_BEGIN pg8::Gemm g{(const bf16*)(ws + WS_YR), (const bf16*)(ws + WS_WPR), Mrows, D, D}; pg8::StaticOrder S; S.init(Mrows, D, F.G, F.bid);
            pg8::EpiMerge<1> E{(const bf16*)(ws + WS_MGT), (bf16*)(ws + WS_T1), Hb};
            pg8::gemm_phase<pg8::EpiMerge<1>, pg8::StaticOrder, true, true>(F.lds, g, S, E); }
        SEAM(p0 + 6);
        if (IN(p0 + 7)) { PH_BEGIN pg8::Gemm g{Hb, (const bf16*)(ws + WS_WOUT), Mrows, D, D}; pg8::StaticOrder S; S.init(Mrows, D, F.G, F.bid);
            pg8::EpiResid E{xl, xc, (float*)F.out, XC, MODl + 2 * D};
            pg8::gemm_phase<pg8::EpiResid, pg8::StaticOrder, true, true>(F.lds, g, S, E); }
        SEAM(p0 + 7);
        if (IN(p0 + 8)) { PH_BEGIN if (!last) normmod_phase<false>(F, (const float*)F.out, XC, INP(I_GNF) + l * D, MODl, 3 * D, 4 * D, Mrows, nullptr);
                          else normmod_phase<true>(F, (const float*)F.out, XC, INP(I_GNF) + l * D, MODl, 3 * D, 4 * D, Mrows, INP(I_WR)); }
        SEAM(p0 + 8);
        if (!last) {
            if (IN(p0 + 9)) { PH_BEGIN pg8::Gemm g{Hb, (const bf16*)(ws + WS_WGU), Mrows, 2 * FF, D}; pg8::StaticOrder S; S.init(Mrows, 2 * FF, F.G, F.bid);
                pg8::EpiSwigluCtx E{(bf16*)(ws + WS_HH0), FF, (bf16*)(ws + WS_HH0) + (size_t)RL * FF, RL / 256};
                pg8::gemm_phase<pg8::EpiSwigluCtx, pg8::StaticOrder, true, true>(F.lds, g, S, E); }
            SEAM(p0 + 9);
            if (IN(p0 + 10)) { PH_BEGIN pg8::Gemm g{(const bf16*)(ws + WS_HH0), (const bf16*)(ws + WS_WDN), RL, D, FF}; pg8::StaticOrder S; S.init(RL, D, F.G, F.bid);
                pg8::EpiResid E{(const float*)F.out, XC, (float*)F.out, XC, MODl + 5 * D};
                pg8::gemm_phase<pg8::EpiResid, pg8::StaticOrder, true, true>(F.lds, g, S, E); }
            if (IN(p0 + 10)) { PH_BEGIN int kg = 256; asm volatile("" : "+s"(kg));
                pg8::Gemm g{(const bf16*)(ws + WS_HH0) + (size_t)RL * FF, (const bf16*)(ws + WS_WDNS), RC, D, kg}; pg8::CtxSliceOrder S; S.nS = NSL; S.G = F.G; S.c = (F.bid + 128) % F.G;
                pg8::EpiSlab E{(float*)(ws + WS_S2), MODl + 4 * 6 * D + 5 * D};
                pg8::gemm_phase<pg8::EpiSlab, pg8::CtxSliceOrder, true, true>(F.lds, g, S, E); }
            if (IN(p0 + 10) && IN(p0 + 12)) grid_barrier(bar.bar, bar.x, bar.st);
        } else {
            if (IN(p0 + 9)) { PH_BEGIN conv_experts(F, 4, NE); gather_phase(F); }
            SEAM(p0 + 9);
            if (IN(p0 + 10)) { PH_BEGIN const MoeMeta mm = moe_meta(F); pg8::MoeOrder S; S.ntiles = mm.off[NE] / 256; S.nN = 2 * FE / 256; S.nwg = S.ntiles * S.nN; S.G = F.G; S.c = F.bid; S.texp = (const int*)(ws + WS_META + 768 * 1024);
                S.lo0 = (int)((WS_WEA - WS_WEGU) / (256 * 1024)); S.lo1 = 28; S.hi1 = 28;
                int ke = D / 2; asm volatile("" : "+s"(ke));
                pg8::Gemm g{(const bf16*)(ws + WS_HG), (const bf16*)(ws + WS_WEGU), 0, 2 * FE, ke}; pg8::EpiSwiglu8 E{(unsigned char*)(ws + WS_HHE), FE};
                pg8::gemm_phase<pg8::EpiSwiglu8, pg8::MoeOrder, true, true, true>(F.lds, g, S, E); }
            SEAM(p0 + 10);
            if (IN(p0 + 11)) { PH_BEGIN const MoeMeta mm = moe_meta(F); pg8::MoeOrder S; S.ntiles = mm.off[NE] / 256; S.nN = D / 256; S.nwg = S.ntiles * S.nN; S.G = F.G; S.c = F.bid; S.texp = (const int*)(ws + WS_META + 768 * 1024);
                S.lo0 = (int)((WS_WEA + 28 * MiB - WS_WEDN) / (896 * 1024)); S.lo1 = 4; S.hi1 = 4;
                int ke = FE / 2; asm volatile("" : "+s"(ke));
                pg8::Gemm g{(const bf16*)(ws + WS_HHE), (const bf16*)(ws + WS_WEDN), 0, D, ke}; pg8::EpiStoreScaled E{(bf16*)(ws + WS_Y2), D, 1.0f / W8S};
                pg8::gemm_phase<pg8::EpiStoreScaled, pg8::MoeOrder, true, true, true>(F.lds, g, S, E); }
            SEAM(p0 + 11);
        }
    }
__global__ void __launch_bounds__(NTHREADS, 2) mk_fwd(Args args) {
    extern __shared__ __attribute__((aligned(16))) unsigned char lds[];
    Frame F;
    F.lds = (LAS unsigned char*)lds; F.MISC = (volatile LAS unsigned*)(F.lds + MISC_OFF);
    F.tid = threadIdx.x; F.lane = F.tid & 63; F.wave = __builtin_amdgcn_readfirstlane(F.tid >> 6); F.G = gridDim.x; F.bid = blockIdx.x;
    F.ws = args.ws; F.out = args.out; F.ctl = (gu32*)(args.ws + WS_CTL);
    F.A = (const CAS Args*)__builtin_amdgcn_kernarg_segment_ptr();
    if (F.tid < 64) F.MISC[F.tid] = 0u;
    __syncthreads();
    const int lo = args.ph_lo, hi = args.ph_hi;
    XcdBarrier bar; bar.bar = (unsigned*)(F.ctl + CW_BAR) + args.li * XCD_BAR_WORDS; bar.x = 0; bar.st = nullptr;
    if (hi - lo > 1) bar = xcd_barrier_post((unsigned*)(F.ctl + CW_BAR) + args.li * XCD_BAR_WORDS, F.MISC + 8);

    if (IN(0)) { const int l = 0; PH_BEGIN mod_phase(F); conv_win(F, 0); conv_rest(F, 0); }
    SEAM(0);

    layer_body<0>(F, args, lo, hi, bar);
    layer_body<1>(F, args, lo, hi, bar);
    if (IN(NPHASE - 1)) { const int l = NL - 1; PH_BEGIN final_phase(F, MODl); }
#undef IN
#undef SEAM
}

extern "C" void kernel_launch(void* const* d_in, const int* in_sizes, int n_in, void* d_out, int out_size, void* d_ws, size_t ws_size, hipStream_t stream) {
    static int grid = 0;
    if (grid == 0) {
        if (n_in != 33 || out_size != RL * D || ws_size < WS_NEED) { fprintf(stderr, "kernel_launch: unexpected problem (n_in %d, out %d, ws %zu < %zu)\n", n_in, out_size, ws_size, (size_t)WS_NEED); grid = -1; return; }
        int dev = 0, cus = 0, per_cu = 0;
        if (hipGetDevice(&dev) != hipSuccess || hipDeviceGetAttribute(&cus, hipDeviceAttributeMultiprocessorCount, dev) != hipSuccess) { grid = -1; return; }
        if (hipFuncSetAttribute((const void*)mk_fwd, hipFuncAttributeMaxDynamicSharedMemorySize, LDS_BYTES) != hipSuccess) { fprintf(stderr, "kernel_launch: hipFuncSetAttribute failed\n"); grid = -1; return; }
        if (hipOccupancyMaxActiveBlocksPerMultiprocessor(&per_cu, (const void*)mk_fwd, NTHREADS, LDS_BYTES) != hipSuccess || per_cu < 1) { fprintf(stderr, "kernel_launch: occupancy query says %d\n", per_cu); grid = -1; (void)hipGetLastError(); return; }
        grid = cus;
    }
    if (grid < 0) return;
    (void)hipMemsetAsync((char*)d_ws + WS_CTL, 0, CTL_ZERO_BYTES, stream);
    Args a{};
    for (int i = 0; i < 33; ++i) a.in[i] = (const GAS float*)d_in[i];
    a.out = (GAS float*)d_out; a.ws = (GAS unsigned char*)d_ws;
#if MK_SPLIT
    for (int p = 0; p < NPHASE; ++p) { a.ph_lo = p; a.ph_hi = p + 1; hipLaunchKernelGGL(mk_fwd, dim3(grid), dim3(NTHREADS), LDS_BYTES, stream, a); }
#elif defined(PROBE_PH)
    a.ph_lo = 0; a.ph_hi = PROBE_PH + 1; a.li = 0; hipLaunchKernelGGL(mk_fwd, dim3(grid), dim3(NTHREADS), LDS_BYTES, stream, a);
    for (int r = 0; r < PROBE_N; ++r) { a.ph_lo = PROBE_PH; a.ph_hi = PROBE_PH + 1; hipLaunchKernelGGL(mk_fwd, dim3(grid), dim3(NTHREADS), LDS_BYTES, stream, a); }
    a.ph_lo = PROBE_PH + 1; a.ph_hi = NPHASE; a.li = 1; hipLaunchKernelGGL(mk_fwd, dim3(grid), dim3(NTHREADS), LDS_BYTES, stream, a);
#else
    a.ph_lo = 0; a.ph_hi = NPHASE;
    hipLaunchKernelGGL(mk_fwd, dim3(grid), dim3(NTHREADS), LDS_BYTES, stream, a);
#endif
}
```

```cpp
#include <hip/hip_runtime.h>
#include <cstdio>
#include <cstdint>

#define GAS __attribute__((address_space(1)))
#define LAS __attribute__((address_space(3)))
typedef unsigned short bf16;
typedef unsigned v4u __attribute__((ext_vector_type(4)));
typedef unsigned v2u __attribute__((ext_vector_type(2)));
typedef float f32x4 __attribute__((ext_vector_type(4)));
typedef float f32x2 __attribute__((ext_vector_type(2)));
typedef short bf16x8 __attribute__((ext_vector_type(8)));
typedef GAS unsigned gu32;
#define RLX_AGENT __ATOMIC_RELAXED, __HIP_MEMORY_SCOPE_AGENT
#define LDS_WAIT() asm volatile("s_waitcnt lgkmcnt(0)" ::: "memory")
#define VM_WAIT() asm volatile("s_waitcnt vmcnt(0)" ::: "memory")

constexpr int D = 1024, NB = 4, T = 4096, GW = 64, TC = 256, NL = 2;
constexpr int RL = NB * T, RC = NB * TC, R = RL + RC;
constexpr int MH = 8, DQK = 64, DV = 128, LCH = 64;
constexpr int RH = 16, RN = 64, RD = 1024;
constexpr int RW = 3456, DIN = 8608, NPAD = 8704;
constexpr int FF = 2816, NE = 8, FE = 3584;
constexpr int TB = T + TC, NCH = TB / LCH;
constexpr int SMW = 512;
constexpr float NORM_EPS = 1e-6f, GN_EPS = 64e-5f, CAP = 15.0f;
constexpr int MAXSLOT = 2 * RL + NE * 256;

constexpr size_t MiB = 1u << 20;
constexpr size_t WS_CTL = 0, CTL_ZERO_BYTES = 1 * MiB;
constexpr size_t WS_MOD = 1 * MiB, WS_XC = 2 * MiB, WS_META = 6 * MiB, WS_BON = 7 * MiB, WS_SG = 10 * MiB;
constexpr size_t WS_WIN = 19 * MiB, WS_WPM = 36 * MiB, WS_WPR = 38 * MiB, WS_WOUT = 40 * MiB, WS_WG2 = 42 * MiB, WS_WLORA = 43 * MiB, WS_WGU = 44 * MiB, WS_WDN = 55 * MiB;
constexpr size_t WS_H = 61 * MiB;
constexpr size_t WS_Q = 95 * MiB, WS_K = 112 * MiB, WS_V = 129 * MiB, WS_O = 163 * MiB, WS_RKV = 197 * MiB, WS_MGT = 299 * MiB, WS_SM = 367 * MiB;
constexpr size_t WS_HF = 401 * MiB, WS_YS = 469 * MiB, WS_END = 537 * MiB;
constexpr size_t WS_HM = WS_Q, WS_YR = WS_V, WS_T1 = WS_O;
constexpr size_t WS_HH0 = WS_Q;
constexpr size_t WS_WEGU = 95 * MiB, WS_WEDN = 152 * MiB, WS_HG = 179 * MiB, WS_Y2 = 213 * MiB, WS_HHE = 281 * MiB;
constexpr size_t WS_WEA = 537 * MiB;
constexpr size_t WS_WE4D = 45440 * 1024ull, WS_WE4U = 48 * MiB, WS_WE5D = 19 * MiB, WS_WE5U = 23040 * 1024ull;
static_assert(WS_WE4D >= WS_WGU && WS_WE4D + 3584 * 1024 <= WS_WE4U && WS_WE4U + 7 * MiB <= WS_H && WS_WE5D >= WS_WIN && WS_WE5D + 3584 * 1024 <= WS_WE5U && WS_WE5U + 7 * MiB <= WS_WPM, "early expert buffers");
static_assert((WS_WEGU - WS_WE4U) % (256 * 1024) == 0 && (WS_WEGU - WS_WE5U) % (256 * 1024) == 0 && (WS_WEDN - WS_WE4D) % (896 * 1024) == 0 && (WS_WEDN - WS_WE5D) % (896 * 1024) == 0, "expert weight tiles");
static_assert((WS_WEA - WS_WEGU) % (256 * 1024) == 0 && (WS_WEA + 28 * MiB - WS_WEDN) % (896 * 1024) == 0, "expert weight tiles");
static_assert(WS_HHE + (size_t)MAXSLOT * FE <= 401 * MiB && WS_Y2 + (size_t)MAXSLOT * D * 2 <= WS_HHE && WS_HG + (size_t)MAXSLOT * D <= WS_Y2, "ws map");
constexpr float W8S = 64.0f;
constexpr size_t WS_WDNS = 538 * MiB, WS_S2 = 200 * MiB;
constexpr int NSL = FF / 256;
constexpr size_t WS_NEED = 579 * MiB;
constexpr int CW_BAR = 4096;
constexpr int CW_ECNT = 16384;
constexpr int CW_SUB = 20480;
constexpr int LDS_BYTES = 159744;
constexpr int MISC_OFF = LDS_BYTES - 256;

__device__ __forceinline__ unsigned cvt_pk_bf16(float lo, float hi) { unsigned r; asm volatile("v_cvt_pk_bf16_f32 %0, %1, %2" : "=v"(r) : "v"(lo), "v"(hi)); return r; }
__device__ __forceinline__ float bflo(unsigned w) { return __uint_as_float(w << 16); }
__device__ __forceinline__ float bfhi(unsigned w) { return __uint_as_float(w & 0xffff0000u); }
__device__ __forceinline__ void unpack8(const v4u w, float (&f)[8]) { f[0] = bflo(w.x); f[1] = bfhi(w.x); f[2] = bflo(w.y); f[3] = bfhi(w.y); f[4] = bflo(w.z); f[5] = bfhi(w.z); f[6] = bflo(w.w); f[7] = bfhi(w.w); }
__device__ __forceinline__ v4u pack8(const float (&f)[8]) { v4u w; w.x = cvt_pk_bf16(f[0], f[1]); w.y = cvt_pk_bf16(f[2], f[3]); w.z = cvt_pk_bf16(f[4], f[5]); w.w = cvt_pk_bf16(f[6], f[7]); return w; }
__device__ __forceinline__ float sigmoidf_(float x) { return __builtin_amdgcn_rcpf(1.0f + __expf(-x)); }
__device__ __forceinline__ float siluf_(float x) { return x * sigmoidf_(x); }
__device__ __forceinline__ float softplusf_(float x) { return fmaxf(x, 0.f) + log1pf(expf(-fabsf(x))); }
__device__ __forceinline__ float fast_tanh(float x) { const float e = __expf(2.0f * x); return 1.0f - 2.0f * __builtin_amdgcn_rcpf(1.0f + e); }
__device__ __forceinline__ float fast_softplus(float x) { return fmaxf(x, 0.f) + __logf(1.0f + __expf(-fabsf(x))); }
template <int CTRL> __device__ __forceinline__ float dpp_add(float v) { const int t = __builtin_amdgcn_update_dpp(0, __float_as_int(v), CTRL, 0xf, 0xf, false); return v + __int_as_float(t); }
template <int CTRL> __device__ __forceinline__ float dpp_one(float v) { return __int_as_float(__builtin_amdgcn_update_dpp(0x3f800000, __float_as_int(v), CTRL, 0xf, 0xf, false)); }
__device__ __forceinline__ float red4(float v) { v = dpp_add<0xB1>(v); return dpp_add<0x4E>(v); }
__device__ __forceinline__ float red8(float v) { return dpp_add<0x141>(red4(v)); }
__device__ __forceinline__ float red16(float v) { return dpp_add<0x140>(red8(v)); }
__device__ __forceinline__ float wave_sum(float v) { v = red16(v); v += __shfl_xor(v, 16); return v + __shfl_xor(v, 32); }
__device__ __forceinline__ int row_of(int b, int lr) { return lr < T ? b * T + lr : RL + b * TC + (lr - T); }
__device__ __forceinline__ int tok(int dir, int u) { if (u < TC) return T + (dir ? TC - 1 - u : u); const int tt = u - TC; return dir ? T - 1 - tt : tt; }
__device__ __forceinline__ int nbrow(int g, int rwidx) {
    if (g < RL) { const int t = g & (T - 1), row = t >> 6, col = t & 63, q = rwidx / (RW / 4);
        if (q == 0) return col > 0 ? g - 1 : -1; if (q == 1) return col < GW - 1 ? g + 1 : -1; if (q == 2) return row > 0 ? g - GW : -1; return row < T / GW - 1 ? g + GW : -1; }
    const int t = (g - RL) & (TC - 1); if (rwidx < RW / 2) return t > 0 ? g - 1 : -1; return t < TC - 1 ? g + 1 : -1;
}

#define XB_TMO      128
#define XB_XCNT(j)  (256  + 64 * (j))
#define XB_XSUB(j)  (1280 + 64 * (j))
#define XB_XGEN(j)  (2304 + 64 * (j))
#define XB_TOP      3328
#define XB_TOPGEN   3392
#define XCD_BAR_WORDS 3456
#define XB_SPIN_CAP (1u << 18)
__device__ __forceinline__ unsigned xb_ld(unsigned* p)              { return __hip_atomic_load(p, __ATOMIC_RELAXED, __HIP_MEMORY_SCOPE_AGENT); }
__device__ __forceinline__ unsigned xb_add(unsigned* p, unsigned v) { return __hip_atomic_fetch_add(p, v, __ATOMIC_RELAXED, __HIP_MEMORY_SCOPE_AGENT); }
__device__ __forceinline__ unsigned xb_xcc_id() { return (unsigned)__builtin_amdgcn_s_getreg((3 << 11) | 20) & 0xFu; }
#define XB_SPIN(cond, bar) do { unsigned _sp = 0; while (cond) { __builtin_amdgcn_s_sleep(1); \
    if ((++_sp & 255u) == 0u) { if (xb_ld(&(bar)[XB_TMO])) break; if (_sp > XB_SPIN_CAP) { atomicAdd(&(bar)[XB_TMO], 1u); break; } } } } while (0)
struct XcdBarrier { unsigned* bar; unsigned x; volatile LAS unsigned* st; };
__device__ __forceinline__ XcdBarrier xcd_barrier_post(unsigned* bar, volatile LAS unsigned* st) {
    XcdBarrier b; b.bar = bar; b.x = xb_xcc_id(); b.st = st;
    if (threadIdx.x == 0) (void)xb_add(&bar[XB_XCNT(b.x)], 1u);
    return b;
}
__device__ __forceinline__ void xcd_barrier_complete(unsigned* bar, unsigned x, unsigned& nloc, unsigned& nx) {
    const unsigned G = gridDim.x * gridDim.y * gridDim.z;
    unsigned sum, cnt, mine, sp = 0u;
    for (;;) {
        sum = 0u; cnt = 0u; mine = 0u;
#pragma unroll
        for (unsigned j = 0; j < 16; ++j) { const unsigned c = xb_ld(&bar[XB_XCNT(j)]); sum += c; cnt += (c > 0u) ? 1u : 0u; mine = (j == x) ? c : mine; }
        if (sum == G) break;
        __builtin_amdgcn_s_sleep(1);
        if ((++sp & 255u) == 0u) { if (xb_ld(&bar[XB_TMO])) break; if (sp > XB_SPIN_CAP) { atomicAdd(&bar[XB_TMO], 1u); break; } }
    }
    nloc = mine > 0u ? mine : 1u; nx = cnt > 0u ? cnt : 1u;
}
__device__ __forceinline__ void xcd_barrier(const XcdBarrier& b) {
    asm volatile("s_waitcnt vmcnt(0)" ::: "memory");
    __syncthreads();
    if (threadIdx.x == 0) {
        unsigned* bar = b.bar;
        __builtin_amdgcn_s_waitcnt(0);
        unsigned nloc = b.st[0], nx = b.st[1];
        if (nloc == 0u) { xcd_barrier_complete(bar, b.x, nloc, nx); b.st[0] = nloc; b.st[1] = nx; }
        const unsigned old = xb_add(&bar[XB_XSUB(b.x)], 1u);
        const unsigned gen = old / nloc;
        if (old + 1u == (gen + 1u) * nloc) {
            __builtin_amdgcn_fence(__ATOMIC_RELEASE, "agent");
            asm volatile("s_waitcnt vmcnt(0)" ::: "memory");
            const unsigned og = xb_add(&bar[XB_TOP], 1u);
            const unsigned tg = og / nx;
            if (og + 1u == (tg + 1u) * nx) xb_add(&bar[XB_TOPGEN], 1u);
            else XB_SPIN(xb_ld(&bar[XB_TOPGEN]) == tg, bar);
            __builtin_amdgcn_fence(__ATOMIC_ACQUIRE, "agent");
            xb_add(&bar[XB_XGEN(b.x)], 1u);
            asm volatile("s_waitcnt vmcnt(0)" ::: "memory");
        } else {
            XB_SPIN(xb_ld(&bar[XB_XGEN(b.x)]) == gen, bar);
            __builtin_amdgcn_fence(__ATOMIC_ACQUIRE, "agent");
            asm volatile("s_waitcnt vmcnt(0)" ::: "memory");
        }
    }
    __syncthreads();
}

namespace pg8 {
#define PG8_LAS __attribute__((address_space(3)))
typedef unsigned short bf16_t;
typedef unsigned u32x4 __attribute__((ext_vector_type(4)));
constexpr int BM = 256, BK = 64, HALF = 128, HTB = HALF * BK * 2, STAGE_BYTES = 8 * HTB, NXCD = 8, WGM = 8;
__host__ __device__ __forceinline__ int lds_byte(int r, int c) { const int st = (r >> 4) * 2 + (c >> 5), rr = r & 15, cc = c & 31, ob = rr * 64 + cc * 2; return st * 1024 + (ob ^ (((ob >> 9) & 1) << 5)); }
__host__ __device__ __forceinline__ void stage_rc(int b, int& R_, int& C) { const int st = b / 1024, sb = b % 1024, swz = sb ^ (((sb >> 9) & 1) << 5); R_ = (st >> 1) * 16 + swz / 64; C = (st & 1) * 32 + (swz % 64) / 2; }
__host__ __device__ __forceinline__ int perm32(int rho) { const int n = rho >> 4, i = rho & 15; return 8 * (i >> 2) + 4 * n + (i & 3); }
typedef int i32x8 __attribute__((ext_vector_type(8))); typedef int i32x4 __attribute__((ext_vector_type(4)));
__device__ __forceinline__ i32x8 cat8(bf16x8 lo, bf16x8 hi) { return __builtin_shufflevector(__builtin_bit_cast(i32x4, lo), __builtin_bit_cast(i32x4, hi), 0, 1, 2, 3, 4, 5, 6, 7); }
__device__ __forceinline__ void mfma8_acc(f32x4& acc, const i32x8 a, const i32x8 b) {
#if defined(__HIP_DEVICE_COMPILE__)
    const int one = 0x7F7F7F7F;
    asm volatile("v_mfma_scale_f32_16x16x128_f8f6f4 %0, %1, %2, %0, %3, %3 op_sel_hi:[0,0,0]" : "+v"(acc) : "v"(a), "v"(b), "v"(one));
#endif
}
struct Unit { int pm, pn, pb; };
struct Gemm { const bf16_t* A; const bf16_t* Bt; int M, N, K; };
struct StaticOrder {
    int nM, nN, nwg, G, c;
    __device__ void init(int M, int N, int G_, int c_) { nM = M / BM; nN = N / BM; nwg = nM * nN; G = G_; c = c_; }
    __device__ bool next(int i, Unit& u) const {
        const long L = (long)i * G + c; if (L >= nwg) return false;
        int wgid = (int)L; { const int q = nwg / NXCD, r = nwg % NXCD, xcd = wgid % NXCD, off = wgid / NXCD; wgid = (xcd < r ? xcd * (q + 1) : r * (q + 1) + (xcd - r) * q) + off; }
        const int nig = WGM * nN, gid = wgid / nig, fm = gid * WGM, gsz = (nM - fm) < WGM ? (nM - fm) : WGM;
        u.pm = fm + ((wgid % nig) % gsz); u.pn = (wgid % nig) / gsz; u.pb = u.pn; return true;
    }
    __device__ __forceinline__ void a_ready(const Unit&) const {}
    __device__ __forceinline__ void done(const Unit&) const {}
};
struct InprojLastOrder {
    int G, c;
    __device__ bool next(int i, Unit& u) const {
        const int L = i * G + c; if (L >= 64 * 34 + 4 * 22) return false;
        if (L < 64 * 34) { const int g8 = L / (8 * 34), r = L % (8 * 34); u.pm = g8 * 8 + (r % 8); u.pn = r / 8; }
        else { const int r = L - 64 * 34; u.pm = 64 + (r & 3); int q = r >> 2; q += (q >= 8) ? 4 : 0; q += (q >= 24) ? 8 : 0; u.pn = q; }
        u.pb = u.pn; return true;
    }
    __device__ __forceinline__ void a_ready(const Unit&) const {}
    __device__ __forceinline__ void done(const Unit&) const {}
};
struct InprojOrder {
    int G, c;
    __device__ bool next(int i, Unit& u) const {
        constexpr int NC = 22;
        const int L = i * G + c; if (L >= 68 * NC) return false; int q;
        if (L < 64 * NC) { const int g8 = L / (8 * NC), r = L % (8 * NC); u.pm = g8 * 8 + (r % 8); q = r / 8; }
        else { const int r = L - 64 * NC; u.pm = 64 + (r & 3); q = r >> 2; }
        u.pn = q < 8 ? q : (q < 20 ? q + 4 : q + 12); u.pb = u.pn; return true;
    }
    __device__ __forceinline__ void a_ready(const Unit&) const {}
    __device__ __forceinline__ void done(const Unit&) const {}
};
template <bool LAST> struct LateInprojOrder {
    int G, c;
    __device__ bool next(int i, Unit& u) const {
        const int L = i * G + c; if (L >= (LAST ? 64 : 68) * 12) return false; int q;
        if (L < 64 * 12) { const int g8 = L / 96, r = L % 96; u.pm = g8 * 8 + (r & 7); q = r >> 3; } else { const int r = L - 64 * 12; u.pm = 64 + (r & 3); q = r >> 2; }
        u.pn = q < 4 ? 8 + q : 20 + q; u.pb = u.pn; return true;
    }
    __device__ __forceinline__ void a_ready(const Unit&) const {}
    __device__ __forceinline__ void done(const Unit&) const {}
};
struct CtxSliceOrder {
    int nS, G, c;
    __device__ bool next(int i, Unit& u) const { const int L = i * G + c; if (L >= 16 * nS) return false; const int s = L >> 4, r = L & 15; u.pm = 4 * s + (r >> 2); u.pn = r & 3; u.pb = 4 * s + (r & 3); return true; }
    __device__ __forceinline__ void a_ready(const Unit&) const {}
    __device__ __forceinline__ void done(const Unit&) const {}
};
struct MoeOrder {
    int ntiles, nN, nwg, G, c; const int* texp;
    int lo0, lo1, b4, b5;
    __device__ bool next(int i, Unit& u) const {
        const long L = (long)i * G + c; if (L >= nwg) return false;
        u.pm = (int)(L / nN); u.pn = (int)(L % nN); const int e = __builtin_amdgcn_readfirstlane(texp[u.pm]);
        u.pb = (e < 4 ? lo0 + e * lo1 : e == 4 ? b4 : e == 5 ? b5 : (e - 6) * lo1) + u.pn; return true;
    }
    __device__ __forceinline__ void a_ready(const Unit&) const {}
    __device__ __forceinline__ void done(const Unit&) const {}
};
template <class Epi, class Sched, bool ALIGN_EPI = false, bool SP2 = false, bool FP8 = false>
__device__ __forceinline__ void gemm_phase(PG8_LAS unsigned char* lds, const Gemm g, const Sched& S, const Epi& E) {
    int tid_ = threadIdx.x; asm volatile("" : "+v"(tid_));
    const int tid = tid_, wid = __builtin_amdgcn_readfirstlane(tid >> 6), lane = tid & 63, wr = wid >> 2, wc = wid & 3, fr = lane & 15, fq = lane >> 4;
    const int K = g.K, nt = K / BK;
    unsigned voffA[2], voffB[2];
#pragma unroll
    for (int i = 0; i < 2; ++i) { int R, C; stage_rc(tid * 16 + i * 8192, R, C); const int Rb = Epi::PERM ? ((R & ~31) + perm32(R & 31)) : R;
        voffA[i] = (unsigned)(R * K + C) * 2u; voffB[i] = (unsigned)(Rb * K + C) * 2u; }
    const size_t kstep = (size_t)(BK * 2);
    const size_t hstep = (size_t)HALF * K * 2;
    const size_t tstep = 2 * hstep;
    const unsigned ldsw = (unsigned)wid * 1024u;
    const int aoff = lds_byte(wr * 64 + fr, fq * 8), boff = lds_byte(wc * 32 + fr, fq * 8);
#define PG8_SA(b, h) (((b) * 2 + (h)) * HTB)
#define PG8_SB(b, h) ((4 + (b) * 2 + (h)) * HTB)
#define PG8_STAGE(bufoff, gbase, voff) do { _Pragma("unroll") for (int _i = 0; _i < 2; ++_i) \
        __builtin_amdgcn_global_load_lds((const unsigned*)((const char*)(gbase) + (voff)[_i]), (PG8_LAS unsigned*)(lds + (bufoff) + ldsw + _i * 8192), 16, 0, 0); } while (0)
#define PG8_LDA(dst, b, h) do { _Pragma("unroll") for (int m = 0; m < 4; ++m) { if constexpr (FP8) dst##8[m] = cat8(*(const PG8_LAS bf16x8*)(lds + PG8_SA(b, h) + aoff + m * 2048), *(const PG8_LAS bf16x8*)(lds + PG8_SA(b, h) + aoff + m * 2048 + 1024)); \
        else { _Pragma("unroll") for (int k = 0; k < 2; ++k) dst[m][k] = *(const PG8_LAS bf16x8*)(lds + PG8_SA(b, h) + aoff + m * 2048 + k * 1024); } } } while (0)
#define PG8_LDB(dst, b, h) do { _Pragma("unroll") for (int n = 0; n < 2; ++n) { if constexpr (FP8) dst##8[n] = cat8(*(const PG8_LAS bf16x8*)(lds + PG8_SB(b, h) + boff + n * 2048), *(const PG8_LAS bf16x8*)(lds + PG8_SB(b, h) + boff + n * 2048 + 1024)); \
        else { _Pragma("unroll") for (int k = 0; k < 2; ++k) dst[n][k] = *(const PG8_LAS bf16x8*)(lds + PG8_SB(b, h) + boff + n * 2048 + k * 1024); } } } while (0)
#define PG8_MMA(ai, bj, At, Bt) do { __builtin_amdgcn_s_setprio(1); if constexpr (FP8) { _Pragma("unroll") for (int m = 0; m < 4; ++m) _Pragma("unroll") for (int n = 0; n < 2; ++n) \
        mfma8_acc(acc[ai][bj][m][n], Bt##8[n], At##8[m]); } else { \
        _Pragma("unroll") for (int m = 0; m < 4; ++m) _Pragma("unroll") for (int n = 0; n < 2; ++n) _Pragma("unroll") for (int k = 0; k < 2; ++k) \
        acc[ai][bj][m][n] = __builtin_amdgcn_mfma_f32_16x16x32_bf16(Bt[n][k], At[m][k], acc[ai][bj][m][n], 0, 0, 0); } __builtin_amdgcn_s_setprio(0); } while (0)
#define PG8_WAIT_V(n) asm volatile("s_waitcnt vmcnt(" #n ")" ::: "memory")
#define PG8_WAIT_L(n) asm volatile("s_waitcnt lgkmcnt(" #n ")" ::: "memory")
#define PG8_BAR __builtin_amdgcn_s_barrier()
#define PG8_SCHED __builtin_amdgcn_sched_barrier(0)
    Unit cur, nxt; int ui = 0;
    if (!S.next(0, cur)) return;
    f32x4 acc[2][2][4][2];
#pragma unroll
    for (int a = 0; a < 2; ++a)
#pragma unroll
        for (int b = 0; b < 2; ++b)
#pragma unroll
            for (int m = 0; m < 4; ++m)
#pragma unroll
                for (int n = 0; n < 2; ++n) acc[a][b][m][n] = (f32x4){0.f, 0.f, 0.f, 0.f};
    bf16x8 At[4][2], B0[2][2], B1[2][2]; i32x8 At8[4], B08[2], B18[2];
    const char* cA = (const char*)g.A + (size_t)cur.pm * tstep; const char* cB = (const char*)g.Bt + (size_t)cur.pb * tstep;
    S.a_ready(cur);
    if constexpr (SP2) {
        PG8_STAGE(PG8_SB(0, 0), cB, voffB); PG8_STAGE(PG8_SB(0, 1), cB + hstep, voffB); PG8_STAGE(PG8_SA(0, 0), cA, voffA); PG8_STAGE(PG8_SA(0, 1), cA + hstep, voffA);
        if (wr == 1) PG8_BAR;
        PG8_WAIT_V(2); PG8_BAR;
        PG8_STAGE(PG8_SB(1, 0), cB + kstep, voffB); PG8_STAGE(PG8_SA(1, 0), cA + kstep, voffA); PG8_STAGE(PG8_SB(1, 1), cB + hstep + kstep, voffB);
        PG8_WAIT_V(6); PG8_BAR;
    } else {
        PG8_STAGE(PG8_SB(0, 0), cB, voffB); PG8_STAGE(PG8_SA(0, 0), cA, voffA); PG8_STAGE(PG8_SB(0, 1), cB + hstep, voffB); PG8_STAGE(PG8_SA(0, 1), cA + hstep, voffA);
        if (wr == 1) PG8_BAR;
        PG8_WAIT_V(4); PG8_BAR;
        PG8_STAGE(PG8_SB(1, 0), cB + kstep, voffB); PG8_STAGE(PG8_SA(1, 0), cA + kstep, voffA); PG8_STAGE(PG8_SB(1, 1), cB + hstep + kstep, voffB);
        PG8_WAIT_V(6); PG8_BAR;
    }
    for (;;) {
        const bool has_next = S.next(ui + 1, nxt);
        const char* nA = has_next ? (const char*)g.A + (size_t)nxt.pm * tstep : cA; const char* nB = has_next ? (const char*)g.Bt + (size_t)nxt.pb * tstep : cB;
        for (int t = 0; t < nt; t += 2) {
            const bool last = (t == nt - 2);
            const char* a1 = cA + (size_t)(t + 1) * kstep;
            const char* a2 = last ? nA : cA + (size_t)(t + 2) * kstep; const char* b2 = last ? nB : cB + (size_t)(t + 2) * kstep;
            const char* a3 = a2 + kstep; const char* b3 = b2 + kstep;
            if (last && has_next) S.a_ready(nxt);
            if constexpr (SP2) {
            PG8_LDB(B0, 0, 0); PG8_LDB(B1, 0, 1); PG8_SCHED; PG8_LDA(At, 0, 0); PG8_STAGE(PG8_SA(1, 1), a1 + hstep, voffA);
            PG8_WAIT_V(8); PG8_WAIT_L(0); PG8_BAR; PG8_MMA(0, 0, At, B0); PG8_MMA(0, 1, At, B1); PG8_BAR; PG8_SCHED;
            PG8_LDA(At, 0, 1); PG8_STAGE(PG8_SB(0, 0), b2, voffB); PG8_STAGE(PG8_SB(0, 1), b2 + hstep, voffB); PG8_STAGE(PG8_SA(0, 0), a2, voffA);
            PG8_WAIT_V(8); PG8_WAIT_L(0); PG8_BAR; PG8_MMA(1, 0, At, B0); PG8_MMA(1, 1, At, B1); PG8_BAR; PG8_SCHED;
            PG8_LDB(B0, 1, 0); PG8_LDB(B1, 1, 1); PG8_SCHED; PG8_LDA(At, 1, 0); PG8_STAGE(PG8_SA(0, 1), a2 + hstep, voffA);
            PG8_WAIT_V(8); PG8_WAIT_L(0); PG8_BAR; PG8_MMA(0, 0, At, B0); PG8_MMA(0, 1, At, B1); PG8_BAR; PG8_SCHED;
            PG8_LDA(At, 1, 1); PG8_STAGE(PG8_SB(1, 0), b3, voffB); PG8_STAGE(PG8_SB(1, 1), b3 + hstep, voffB); PG8_STAGE(PG8_SA(1, 0), a3, voffA);
            PG8_WAIT_V(8); PG8_WAIT_L(0); PG8_BAR; PG8_MMA(1, 0, At, B0); PG8_MMA(1, 1, At, B1); PG8_BAR; PG8_SCHED;
            } else {
            PG8_LDB(B0, 0, 0); PG8_SCHED; PG8_LDA(At, 0, 0); PG8_STAGE(PG8_SA(1, 1), a1 + hstep, voffA);
            PG8_WAIT_L(8); PG8_BAR; PG8_WAIT_L(0); PG8_MMA(0, 0, At, B0); PG8_BAR; PG8_SCHED;
            PG8_LDB(B1, 0, 1); PG8_STAGE(PG8_SB(0, 0), b2, voffB);
            PG8_BAR; PG8_WAIT_L(0); PG8_MMA(0, 1, At, B1); PG8_BAR;
            PG8_LDA(At, 0, 1); PG8_STAGE(PG8_SA(0, 0), a2, voffA);
            PG8_BAR; PG8_WAIT_L(0); PG8_MMA(1, 0, At, B0); PG8_BAR; PG8_SCHED;
            PG8_STAGE(PG8_SB(0, 1), b2 + hstep, voffB);
            PG8_WAIT_V(6); PG8_BAR; PG8_MMA(1, 1, At, B1); PG8_BAR;
            PG8_LDB(B0, 1, 0); PG8_SCHED; PG8_LDA(At, 1, 0); PG8_STAGE(PG8_SA(0, 1), a2 + hstep, voffA);
            PG8_WAIT_L(8); PG8_BAR; PG8_WAIT_L(0); PG8_MMA(0, 0, At, B0); PG8_BAR; PG8_SCHED;
            PG8_LDB(B1, 1, 1); PG8_STAGE(PG8_SB(1, 0), b3, voffB);
            PG8_BAR; PG8_WAIT_L(0); PG8_MMA(0, 1, At, B1); PG8_BAR;
            PG8_LDA(At, 1, 1); PG8_STAGE(PG8_SA(1, 0), a3, voffA);
            PG8_BAR; PG8_WAIT_L(0); PG8_MMA(1, 0, At, B0); PG8_BAR; PG8_SCHED;
            PG8_STAGE(PG8_SB(1, 1), b3 + hstep, voffB);
            PG8_WAIT_V(6); PG8_BAR; PG8_MMA(1, 1, At, B1); PG8_BAR;
            }
        }
        if constexpr (ALIGN_EPI) { if (wr == 0) PG8_BAR; }
        if constexpr (FP8) asm volatile("s_nop 15\n\ts_nop 15\n\ts_nop 15\n\ts_nop 15" ::: "memory");
        if constexpr (!Epi::AFTER_DRAIN) { E(acc, cur, wr, wc, fr, fq); S.done(cur); }
        if (!has_next) break;
#pragma unroll
        for (int a = 0; a < 2; ++a)
#pragma unroll
            for (int b = 0; b < 2; ++b)
#pragma unroll
                for (int m = 0; m < 4; ++m)
#pragma unroll
                    for (int n = 0; n < 2; ++n) acc[a][b][m][n] = (f32x4){0.f, 0.f, 0.f, 0.f};
        cur = nxt; cA = nA; cB = nB; ++ui;
        if constexpr (ALIGN_EPI) { if (wr == 1) PG8_BAR; }
    }
    PG8_WAIT_V(0);
    if constexpr (!ALIGN_EPI) { if (wr == 0) PG8_BAR; }
    PG8_BAR;
    if constexpr (Epi::AFTER_DRAIN) { E.fused(acc, cur, wr, wc, fr, fq, lds, wid, lane); S.done(cur); }
#undef PG8_SA
#undef PG8_SB
#undef PG8_STAGE
#undef PG8_LDA
#undef PG8_LDB
#undef PG8_MMA
#undef PG8_WAIT_V
#undef PG8_WAIT_L
#undef PG8_BAR
#undef PG8_SCHED
}

__device__ __forceinline__ u32x4 pack_acc8(const f32x4 v0, const f32x4 v1) { u32x4 w; w.x = cvt_pk_bf16(v0[0], v0[1]); w.y = cvt_pk_bf16(v0[2], v0[3]); w.z = cvt_pk_bf16(v1[0], v1[1]); w.w = cvt_pk_bf16(v1[2], v1[3]); return w; }
#define EPI_LOOP_BEGIN  _Pragma("unroll") for (int ai = 0; ai < 2; ++ai) _Pragma("unroll") for (int m = 0; m < 4; ++m) { const int rloc = ai * HALF + wr * 64 + m * 16 + fr; \
                        _Pragma("unroll") for (int bj = 0; bj < 2; ++bj) { const int cloc = bj * HALF + wc * 32 + 8 * fq; const f32x4 v0 = acc[ai][bj][m][0], v1 = acc[ai][bj][m][1];
#define EPI_LOOP_END    } asm volatile("" ::: "memory"); }

struct EpiInproj {
    static constexpr bool PERM = true, AFTER_DRAIN = false;
    GAS unsigned char* ws;
    __device__ __forceinline__ void operator()(const f32x4 (&acc)[2][2][4][2], const Unit& u, int wr, int wc, int fr, int fq) const {
        const int pn = u.pn; size_t off; int ld, ct;
        if (pn < 2) { off = WS_Q; ld = 512; ct = pn; } else if (pn < 4) { off = WS_K; ld = 512; ct = pn - 2; } else if (pn < 8) { off = WS_V; ld = 1024; ct = pn - 4; }
        else if (pn < 12) { off = WS_O; ld = 1024; ct = pn - 8; } else if (pn < 24) { off = WS_RKV; ld = 3072; ct = pn - 12; } else if (pn < 32) { off = WS_MGT; ld = 2048; ct = pn - 24; } else { off = WS_SM; ld = SMW * 2; ct = pn - 32; }
        const size_t row0 = (size_t)u.pm * BM;
        if (pn < 32) {
            bf16_t* base = (bf16_t*)(ws + off) + row0 * ld + ct * BM;
            EPI_LOOP_BEGIN
                *(u32x4*)(base + (size_t)rloc * ld + cloc) = pack_acc8(v0, v1);
            EPI_LOOP_END
        } else {
            float* sb = (float*)(ws + off) + row0 * SMW + ct * BM;
            EPI_LOOP_BEGIN
                float* p = sb + (size_t)rloc * SMW + cloc; *(f32x4*)p = v0; *(f32x4*)(p + 4) = v1;
            EPI_LOOP_END
        }
    }
};
struct EpiStore {
    static constexpr bool PERM = true, AFTER_DRAIN = false;
    bf16_t* C; int ldc;
    __device__ __forceinline__ void operator()(const f32x4 (&acc)[2][2][4][2], const Unit& u, int wr, int wc, int fr, int fq) const {
        const size_t row0 = (size_t)u.pm * BM; const int col0 = u.pn * BM;
        EPI_LOOP_BEGIN
            *(u32x4*)(C + (row0 + rloc) * ldc + col0 + cloc) = pack_acc8(v0, v1);
        EPI_LOOP_END
    }
};
template <int STEP> struct EpiMerge {
    static constexpr bool PERM = true, AFTER_DRAIN = false;
    const bf16_t* MGT; bf16_t* T1; bf16_t* OUT;
    __device__ __forceinline__ void operator()(const f32x4 (&acc)[2][2][4][2], const Unit& u, int wr, int wc, int fr, int fq) const {
        const size_t row0 = (size_t)u.pm * BM; const int col0 = u.pn * BM;
        EPI_LOOP_BEGIN
            const size_t row = row0 + rloc; const int col = col0 + cloc;
            const u32x4 gw = *(const u32x4*)(MGT + row * 2048 + (STEP ? 1024 : 0) + col); float g[8]; unpack8(gw, g);
            float o[8] = {v0[0], v0[1], v0[2], v0[3], v1[0], v1[1], v1[2], v1[3]};
#pragma unroll
            for (int j = 0; j < 8; ++j) o[j] *= sigmoidf_(g[j]);
            if (STEP) { const u32x4 tw = *(const u32x4*)(T1 + row * 1024 + col); float tt[8]; unpack8(tw, tt);
#pragma unroll
                for (int j = 0; j < 8; ++j) o[j] += tt[j]; }
            *(u32x4*)((STEP ? OUT : T1) + row * 1024 + col) = pack8(o);
        EPI_LOOP_END
    }
};
struct EpiResid {
    static constexpr bool PERM = true, AFTER_DRAIN = false;
    const float* src_lat; const float* src_ctx; float* dst_lat; float* dst_ctx; const float* gate;
    __device__ __forceinline__ void operator()(const f32x4 (&acc)[2][2][4][2], const Unit& u, int wr, int wc, int fr, int fq) const {
        const int row0 = u.pm * BM, col0 = u.pn * BM; const bool lat = row0 < RL;
        const float* sb = lat ? src_lat : src_ctx - (size_t)RL * D; float* db = lat ? dst_lat : dst_ctx - (size_t)RL * D;
        const float* gt = gate + (lat ? row0 / T : 4) * 6 * D;
        EPI_LOOP_BEGIN
            const size_t off = (size_t)(row0 + rloc) * D + col0 + cloc; const int col = col0 + cloc;
            const f32x4 g0 = *(const f32x4*)(gt + col), g1 = *(const f32x4*)(gt + col + 4), s0 = *(const f32x4*)(sb + off), s1 = *(const f32x4*)(sb + off + 4);
            *(f32x4*)(db + off) = s0 + g0 * v0; *(f32x4*)(db + off + 4) = s1 + g1 * v1;
        EPI_LOOP_END
    }
};
struct EpiSwiglu {
    static constexpr bool PERM = true, AFTER_DRAIN = false;
    bf16_t* HH; int ldc;
    __device__ __forceinline__ void operator()(const f32x4 (&acc)[2][2][4][2], const Unit& u, int wr, int wc, int fr, int fq) const {
        const size_t row0 = (size_t)u.pm * BM; const int col0 = u.pn * HALF + wc * 32 + 8 * fq;
#pragma unroll
        for (int ai = 0; ai < 2; ++ai)
#pragma unroll
            for (int m = 0; m < 4; ++m) { const int rloc = ai * HALF + wr * 64 + m * 16 + fr; float o[8];
#pragma unroll
                for (int n = 0; n < 2; ++n)
#pragma unroll
                    for (int j = 0; j < 4; ++j) o[4 * n + j] = siluf_(acc[ai][0][m][n][j]) * acc[ai][1][m][n][j];
                *(u32x4*)(HH + (row0 + rloc) * ldc + col0) = pack8(o); asm volatile("" ::: "memory"); }
    }
};

struct EpiSwigluCtx {
    static constexpr bool PERM = true, AFTER_DRAIN = false;
    bf16_t* HH; int ldc; bf16_t* HHc; int ctx_from;
    __device__ __forceinline__ void operator()(const f32x4 (&acc)[2][2][4][2], const Unit& u, int wr, int wc, int fr, int fq) const {
        const bool cx = u.pm >= ctx_from;
        const size_t offc = ((size_t)(u.pn >> 1) * 1024 + (size_t)(u.pm - ctx_from) * BM) * 256 + (u.pn & 1) * HALF + wc * 32 + 8 * fq + (size_t)(HHc - HH), offn = (size_t)u.pm * BM * ldc + u.pn * HALF + wc * 32 + 8 * fq;
        bf16_t* base = HH + (cx ? offc : offn); const int ld = cx ? 256 : ldc;
#pragma unroll
        for (int ai = 0; ai < 2; ++ai)
#pragma unroll
            for (int m = 0; m < 4; ++m) { const int rloc = ai * HALF + wr * 64 + m * 16 + fr; float o[8];
#pragma unroll
                for (int n = 0; n < 2; ++n)
#pragma unroll
                    for (int j = 0; j < 4; ++j) o[4 * n + j] = siluf_(acc[ai][0][m][n][j]) * acc[ai][1][m][n][j];
                *(u32x4*)(base + (size_t)rloc * ld) = pack8(o); asm volatile("" ::: "memory"); }
    }
};
struct EpiSlab {
    static constexpr bool PERM = true, AFTER_DRAIN = false;
    float* slab; const float* gate;
    __device__ __forceinline__ void operator()(const f32x4 (&acc)[2][2][4][2], const Unit& u, int wr, int wc, int fr, int fq) const {
        float* base = slab + ((size_t)(u.pm >> 2) * 1024 + (size_t)(u.pm & 3) * BM) * D + u.pn * BM;
        EPI_LOOP_BEGIN
            const int col = u.pn * BM + cloc; const f32x4 g0 = *(const f32x4*)(gate + col), g1 = *(const f32x4*)(gate + col + 4);
            float* p = base + (size_t)rloc * D + cloc; *(f32x4*)p = g0 * v0; *(f32x4*)(p + 4) = g1 * v1;
        EPI_LOOP_END
    }
};

struct EpiSwiglu8 {
    static constexpr bool PERM = true, AFTER_DRAIN = false;
    unsigned char* HH; int ldc;
    __device__ __forceinline__ void operator()(const f32x4 (&acc)[2][2][4][2], const Unit& u, int wr, int wc, int fr, int fq) const {
        const size_t row0 = (size_t)u.pm * BM; const int col0 = u.pn * HALF + wc * 32 + 8 * fq; const float is = 1.0f / W8S;
#pragma unroll
        for (int ai = 0; ai < 2; ++ai)
#pragma unroll
            for (int m = 0; m < 4; ++m) { const int rloc = ai * HALF + wr * 64 + m * 16 + fr; float o[8];
#pragma unroll
                for (int n = 0; n < 2; ++n)
#pragma unroll
                    for (int j = 0; j < 4; ++j) o[4 * n + j] = __builtin_amdgcn_fmed3f(siluf_(acc[ai][0][m][n][j] * is) * (acc[ai][1][m][n][j] * is), -448.0f, 448.0f);
                v2u w; w.x = (unsigned)__builtin_amdgcn_cvt_pk_fp8_f32(o[0], o[1], 0, false); w.x = (unsigned)__builtin_amdgcn_cvt_pk_fp8_f32(o[2], o[3], (int)w.x, true);
                w.y = (unsigned)__builtin_amdgcn_cvt_pk_fp8_f32(o[4], o[5], 0, false); w.y = (unsigned)__builtin_amdgcn_cvt_pk_fp8_f32(o[6], o[7], (int)w.y, true);
                *(v2u*)(HH + (row0 + rloc) * ldc + col0) = w; asm volatile("" ::: "memory"); }
    }
};
struct EpiStoreScaled {
    static constexpr bool PERM = true, AFTER_DRAIN = false;
    bf16_t* C; int ldc; float s;
    __device__ __forceinline__ void operator()(const f32x4 (&acc)[2][2][4][2], const Unit& u, int wr, int wc, int fr, int fq) const {
        const size_t row0 = (size_t)u.pm * BM; const int col0 = u.pn * BM;
        EPI_LOOP_BEGIN
            *(u32x4*)(C + (row0 + rloc) * ldc + col0 + cloc) = pack_acc8(v0 * s, v1 * s);
        EPI_LOOP_END
    }
};

}

struct Args { const GAS float* in[33]; GAS float* out; GAS unsigned char* ws; int ph_lo, ph_hi, li, pad; };
#define CAS __attribute__((address_space(4)))
#define INP(i) ((const float*)F.A->in[i])
constexpr int NWAVES = 8, NTHREADS = 512;
struct Frame {
    LAS unsigned char* lds; volatile LAS unsigned* MISC; gu32* ctl;
    int tid, lane, wave, G, bid;
    int cb, cg;
    GAS unsigned char* ws; GAS float* out;
    const CAS Args* A;
};
enum { I_X = 0, I_C, I_CTX, I_CCTX, I_WADA, I_BADA, I_GNM, I_GNF, I_WIN, I_BG, I_GMN, I_MU, I_W0, I_W2, I_A0, I_A2, I_G2, I_KK, I_KA, I_RK, I_LNW, I_LNB, I_WPM, I_WPR, I_WOUT,
       I_FFG, I_FFU, I_FFD, I_WR, I_EG, I_EU, I_ED, I_GF };

__device__ __forceinline__ void conv_item(const float* W, int ldw, int c0, int k0, bf16* dst, int ldd, int r0, LAS float* scr, int lane) {
#pragma unroll 8
    for (int i = 0; i < 32; ++i) { const int kk = 2 * i + (lane >> 5); scr[kk * 33 + (lane & 31)] = W[(size_t)(k0 + kk) * ldw + c0 + (lane & 31)]; }
    LDS_WAIT(); asm volatile("" ::: "memory");
    const int c = lane & 7;
#pragma unroll
    for (int j = 0; j < 4; ++j) { const int n = (lane >> 3) + 8 * j; const LAS float* s = scr + (8 * c) * 33 + n;
        v4u o; o.x = cvt_pk_bf16(s[0 * 33], s[1 * 33]); o.y = cvt_pk_bf16(s[2 * 33], s[3 * 33]); o.z = cvt_pk_bf16(s[4 * 33], s[5 * 33]); o.w = cvt_pk_bf16(s[6 * 33], s[7 * 33]);
        *(v4u*)(dst + (size_t)(r0 + n) * ldd + k0 + 8 * c) = o; }
    LDS_WAIT(); asm volatile("" ::: "memory");
}
__device__ __forceinline__ unsigned pk4_fp8(float a, float b, float c, float d) { int w = __builtin_amdgcn_cvt_pk_fp8_f32(a, b, 0, false); w = __builtin_amdgcn_cvt_pk_fp8_f32(c, d, w, true); return (unsigned)w; }
__device__ __forceinline__ void conv_item8(const float* W, int ldw, int c0, int k0, unsigned char* dst, int ldd, int r0, float scale, LAS float* scr, int lane) {
#pragma unroll 8
    for (int i = 0; i < 32; ++i) { const int kk = 2 * i + (lane >> 5); scr[kk * 33 + (lane & 31)] = __builtin_amdgcn_fmed3f(W[(size_t)(k0 + kk) * ldw + c0 + (lane & 31)] * scale, -448.0f, 448.0f); }
    LDS_WAIT(); asm volatile("" ::: "memory");
    const int c = lane & 3;
#pragma unroll
    for (int j = 0; j < 2; ++j) { const int n = (lane >> 2) + 16 * j; const LAS float* s = scr + (16 * c) * 33 + n;
        v4u o; o.x = pk4_fp8(s[0 * 33], s[1 * 33], s[2 * 33], s[3 * 33]); o.y = pk4_fp8(s[4 * 33], s[5 * 33], s[6 * 33], s[7 * 33]);
        o.z = pk4_fp8(s[8 * 33], s[9 * 33], s[10 * 33], s[11 * 33]); o.w = pk4_fp8(s[12 * 33], s[13 * 33], s[14 * 33], s[15 * 33]);
        *(v4u*)(dst + (size_t)(r0 + n) * ldd + k0 + 16 * c) = o; }
    LDS_WAIT(); asm volatile("" ::: "memory");
}
__device__ __forceinline__ void conv_seg8(Frame& F, const float* W, int ldw, int K, int c0, int ncols, unsigned char* dst, int ldd, int r0, float scale, int& rot) {
    LAS float* scr = (LAS float*)(F.lds + F.wave * 16384);
    const int NGW = F.cg * NWAVES, nblk = ncols / 32, nitems = (K / 64) * nblk;
    int gw = (F.cb * NWAVES + F.wave + rot) % NGW;
    for (int it = gw; it < nitems; it += NGW) { const int kb = it / nblk, nb = it % nblk; conv_item8(W, ldw, c0 + 32 * nb, 64 * kb, dst, ldd, r0 + 32 * nb, scale, scr, F.lane); }
    rot = (rot + nitems) % NGW;
}
__device__ __forceinline__ void conv_gu8(Frame& F, const float* Wg, const float* Wu, int ldw, int K, int ngroups, unsigned char* dst, float scale, int& rot) {
    LAS float* scr = (LAS float*)(F.lds + F.wave * 16384);
    const int NGW = F.cg * NWAVES, kblk = K / 64, nitems = ngroups * 2 * 4 * kblk;
    int gw = (F.cb * NWAVES + F.wave + rot) % NGW;
    for (int it = gw; it < nitems; it += NGW) { const int kb = it % kblk, r = it / kblk, nb = r & 3, which = (r >> 2) & 1, p = r >> 3;
        conv_item8(which ? Wu : Wg, ldw, 128 * p + 32 * nb, 64 * kb, dst, K, 256 * p + 128 * which + 32 * nb, scale, scr, F.lane); }
    rot = (rot + nitems) % NGW;
}
__device__ __forceinline__ void conv_ffd_dual(Frame& F, const float* W, bf16* dst, bf16* dsts, int& rot) {
    LAS float* scr = (LAS float*)(F.lds + F.wave * 16384);
    const int NGW = F.cg * NWAVES, nblk = D / 32, nitems = (FF / 64) * nblk; const int lane = F.lane;
    int gw = (F.cb * NWAVES + F.wave + rot) % NGW;
    for (int it = gw; it < nitems; it += NGW) { const int kb = it / nblk, nb = it % nblk, k0 = 64 * kb, c0 = 32 * nb;
#pragma unroll 8
        for (int i = 0; i < 32; ++i) { const int kk = 2 * i + (lane >> 5); scr[kk * 33 + (lane & 31)] = W[(size_t)(k0 + kk) * D + c0 + (lane & 31)]; }
        LDS_WAIT(); asm volatile("" ::: "memory");
        const int c = lane & 7;
#pragma unroll
        for (int j = 0; j < 4; ++j) { const int n = (lane >> 3) + 8 * j; const LAS float* s = scr + (8 * c) * 33 + n;
            v4u o; o.x = cvt_pk_bf16(s[0 * 33], s[1 * 33]); o.y = cvt_pk_bf16(s[2 * 33], s[3 * 33]); o.z = cvt_pk_bf16(s[4 * 33], s[5 * 33]); o.w = cvt_pk_bf16(s[6 * 33], s[7 * 33]);
            *(v4u*)(dst + (size_t)(c0 + n) * FF + k0 + 8 * c) = o;
            *(v4u*)(dsts + ((size_t)(k0 >> 8) * 1024 + c0 + n) * 256 + (k0 & 255) + 8 * c) = o; }
        LDS_WAIT(); asm volatile("" ::: "memory"); }
    rot = (rot + nitems) % NGW;
}
__device__ __forceinline__ void conv_seg(Frame& F, const float* W, int ldw, int K, int c0, int ncols, bf16* dst, int ldd, int r0, int& rot) {
    LAS float* scr = (LAS float*)(F.lds + F.wave * 16384);
    const int NGW = F.cg * NWAVES, nblk = ncols / 32, nitems = (K / 64) * nblk;
    int gw = (F.cb * NWAVES + F.wave + rot) % NGW;
    for (int it = gw; it < nitems; it += NGW) { const int kb = it / nblk, nb = it % nblk; conv_item(W, ldw, c0 + 32 * nb, 64 * kb, dst, ldd, r0 + 32 * nb, scr, F.lane); }
    rot = (rot + nitems) % NGW;
}
__device__ __forceinline__ void conv_gu(Frame& F, const float* Wg, const float* Wu, int ldw, int K, int ngroups, bf16* dst, int& rot) {
    LAS float* scr = (LAS float*)(F.lds + F.wave * 16384);
    const int NGW = F.cg * NWAVES, kblk = K / 64, nitems = ngroups * 2 * 4 * kblk;
    int gw = (F.cb * NWAVES + F.wave + rot) % NGW;
    for (int it = gw; it < nitems; it += NGW) { const int kb = it % kblk, r = it / kblk, nb = r & 3, which = (r >> 2) & 1, p = r >> 3;
        conv_item(which ? Wu : Wg, ldw, 128 * p + 32 * nb, 64 * kb, dst, K, 256 * p + 128 * which + 32 * nb, scr, F.lane); }
    rot = (rot + nitems) % NGW;
}
__device__ __forceinline__ void zero_bf16_rows(Frame& F, bf16* dst, size_t n16) {
    const v4u z = {0u, 0u, 0u, 0u};
    for (size_t i = (size_t)F.cb * NTHREADS + F.tid; i < n16; i += (size_t)F.cg * NTHREADS) ((v4u*)dst)[i] = z;
}
__device__ __forceinline__ void conv_win(Frame& F, int l) {
    int rot = 0; GAS unsigned char* ws = F.ws;
    bf16* WIN = (bf16*)(ws + WS_WIN); const float* win = INP(I_WIN) + (size_t)l * D * DIN;
    conv_seg(F, win, DIN, D, 0, 3072, WIN, D, 0, rot);
    conv_seg(F, win, DIN, D, 3104, 3072, WIN, D, 3072, rot);
    conv_seg(F, win, DIN, D, 6560, 2048, WIN, D, 6144, rot);
    conv_seg(F, win, DIN, D, 3072, 32, WIN, D, 8192, rot);
    conv_seg(F, win, DIN, D, 6176, 384, WIN, D, 8192 + 32, rot);
    zero_bf16_rows(F, WIN + (size_t)(8192 + 416) * D, (size_t)96 * D * 2 / 16);
}
__device__ __forceinline__ void conv_rest(Frame& F, int l) {
    int rot = 0; GAS unsigned char* ws = F.ws;
    conv_seg(F, INP(I_WPM) + (size_t)l * D * D, D, D, 0, D, (bf16*)(ws + WS_WPM), D, 0, rot);
    conv_seg(F, INP(I_WPR) + (size_t)l * D * D, D, D, 0, D, (bf16*)(ws + WS_WPR), D, 0, rot);
    conv_seg(F, INP(I_WOUT) + (size_t)l * D * D, D, D, 0, D, (bf16*)(ws + WS_WOUT), D, 0, rot);
    { bf16* WG2 = (bf16*)(ws + WS_WG2);
      conv_seg(F, INP(I_G2) + (size_t)l * 128 * RD, RD, 128, 0, RD, WG2, 256, 0, rot);
      for (int i = F.cb * NTHREADS + F.tid; i < 1024 * 16; i += F.cg * NTHREADS) { const int r = i >> 4, p = i & 15; *(v4u*)(WG2 + (size_t)r * 256 + 128 + 8 * p) = (v4u){0u, 0u, 0u, 0u}; } }
    { bf16* WL = (bf16*)(ws + WS_WLORA);
      for (int d = 0; d < 2; ++d) { conv_seg(F, INP(I_W2) + ((size_t)l * 2 + d) * 64 * RD, RD, 64, 0, RD, WL + (size_t)(0 * 2 + d) * RD * 64, 64, 0, rot);
                                    conv_seg(F, INP(I_A2) + ((size_t)l * 2 + d) * 64 * RD, RD, 64, 0, RD, WL + (size_t)(1 * 2 + d) * RD * 64, 64, 0, rot); } }
}
__device__ __forceinline__ void conv_ffn0(Frame& F) {
    int rot = 0; GAS unsigned char* ws = F.ws;
    conv_gu(F, INP(I_FFG), INP(I_FFU), FF, D, FF / 128, (bf16*)(ws + WS_WGU), rot);
    conv_ffd_dual(F, INP(I_FFD), (bf16*)(ws + WS_WDN), (bf16*)(ws + WS_WDNS), rot);
}
__device__ __forceinline__ void conv_experts(Frame& F, int e0, int e1) {
    int rot = 0;
    for (int e = e0; e < e1; ++e) {
        const size_t ogu = e < 4 ? WS_WEA + (size_t)e * 7 * MiB : e == 4 ? WS_WE4U : e == 5 ? WS_WE5U : WS_WEGU + (size_t)(e - 6) * 7 * MiB;
        const size_t odn = e < 4 ? WS_WEA + 28 * MiB + (size_t)e * 3584 * 1024 : e == 4 ? WS_WE4D : e == 5 ? WS_WE5D : WS_WEDN + (size_t)(e - 6) * 3584 * 1024;
        unsigned char* gu = (unsigned char*)F.ws + ogu; unsigned char* dn = (unsigned char*)F.ws + odn;
        conv_gu8(F, INP(I_EG) + (size_t)e * D * FE, INP(I_EU) + (size_t)e * D * FE, FE, D, FE / 128, gu, W8S, rot);
        conv_seg8(F, INP(I_ED) + (size_t)e * FE * D, D, FE, 0, D, dn, FE, 0, W8S, rot);
    }
}
__device__ __forceinline__ void mod_phase(Frame& F) {
    LAS float* sl = (LAS float*)F.lds;
    LAS float* part = sl + 5 * D;
    for (int i = F.tid; i < 5 * D; i += NTHREADS) { const int bb = i / D, k = i % D; const float v = bb < 4 ? INP(I_C)[bb * D + k] : INP(I_CCTX)[k]; sl[i] = siluf_(v); }
    __syncthreads();
    float* MOD = (float*)(F.ws + WS_MOD);
    for (int item = F.bid; item < NL * 6 * D / 64; item += F.G) {
        const int l = item / (6 * D / 64), c0 = (item % (6 * D / 64)) * 64; const float* w = INP(I_WADA) + (size_t)l * D * 6 * D + c0 + F.lane;
        float a[5] = {0.f, 0.f, 0.f, 0.f, 0.f};
        for (int k = F.wave * 128; k < F.wave * 128 + 128; ++k) { const float wv = w[(size_t)k * 6 * D];
#pragma unroll
            for (int bb = 0; bb < 5; ++bb) a[bb] += sl[bb * D + k] * wv; }
#pragma unroll
        for (int bb = 0; bb < 5; ++bb) part[(F.wave * 5 + bb) * 64 + F.lane] = a[bb];
        __syncthreads();
        if (F.tid < 5 * 64) { const int bb = F.tid / 64, c = F.tid % 64; float s = INP(I_BADA)[l * 6 * D + c0 + c];
#pragma unroll
            for (int w8 = 0; w8 < 8; ++w8) s += part[(w8 * 5 + bb) * 64 + c];
            MOD[((size_t)l * 5 + bb) * 6 * D + c0 + c] = s; }
        __syncthreads();
    }
}
__device__ __forceinline__ const float* xrow(const float* lat, const float* ctx, int g) { return g < RL ? lat + (size_t)g * D : ctx + (size_t)(g - RL) * D; }
__device__ __forceinline__ void normmod_rows(Frame& F, const float* lat, const float* ctx, const float* gain, const float* MODl, int off_sh, int off_sc, int nrows) {
    bf16* H = (bf16*)(F.ws + WS_H); const int gw = F.bid * NWAVES + F.wave, NW = F.G * NWAVES;
    f32x4 vnx[4];
    if (gw < nrows) { const float* x0 = xrow(lat, ctx, gw);
#pragma unroll
        for (int j = 0; j < 4; ++j) vnx[j] = *(const f32x4*)(x0 + 256 * j + 4 * F.lane); }
    for (int g = gw; g < nrows; g += NW) {
        const float* md = MODl + (g < RL ? g / T : 4) * 6 * D;
        f32x4 v[4]; float ss = 0.f;
#pragma unroll
        for (int j = 0; j < 4; ++j) v[j] = vnx[j];
        if (g + NW < nrows) { const float* x1 = xrow(lat, ctx, g + NW);
#pragma unroll
            for (int j = 0; j < 4; ++j) vnx[j] = *(const f32x4*)(x1 + 256 * j + 4 * F.lane); }
#pragma unroll
        for (int j = 0; j < 4; ++j) ss += (v[j].x * v[j].x + v[j].y * v[j].y) + (v[j].z * v[j].z + v[j].w * v[j].w);
        const float rstd = 1.0f / sqrtf(wave_sum(ss) * (1.0f / D) + NORM_EPS);
#pragma unroll
        for (int j = 0; j < 4; ++j) { const int c = 256 * j + 4 * F.lane;
            const f32x4 gn = *(const f32x4*)(gain + c), sc = *(const f32x4*)(md + off_sc + c), sh = *(const f32x4*)(md + off_sh + c);
            const f32x4 h = v[j] * rstd * gn * (1.0f + sc) + sh;
            v2u o; o.x = cvt_pk_bf16(h.x, h.y); o.y = cvt_pk_bf16(h.z, h.w); *(v2u*)(H + (size_t)g * D + c) = o; }
    }
}
template <bool ROUTER> __device__ __forceinline__ void normmod_phase(Frame& F, const float* lat, const float* ctx, const float* gain, const float* MODl, int off_sh, int off_sc, int nrows, const float* wrt) {
    bf16* H = (bf16*)(F.ws + WS_H);
    LAS unsigned* lcnt = (LAS unsigned*)F.lds;
    LAS int* rec = (LAS int*)(F.lds + 64);
    LAS float* recp = (LAS float*)(F.lds + 64 + 1024);
    const int ngroups = nrows / 64;
    for (int grp = F.bid; grp < ngroups; grp += F.G) {
        if (ROUTER) { if (F.tid < 16) lcnt[F.tid] = 0u; __syncthreads(); }
        f32x4 vnx[4];
        { const float* x0 = xrow(lat, ctx, grp * 64 + F.wave * 8);
#pragma unroll
          for (int j = 0; j < 4; ++j) vnx[j] = *(const f32x4*)(x0 + 256 * j + 4 * F.lane); }
        for (int rr = 0; rr < 8; ++rr) {
            const int lrow = F.wave * 8 + rr, g = grp * 64 + lrow; const float* md = MODl + (g < RL ? g / T : 4) * 6 * D;
            f32x4 v[4]; float ss = 0.f;
#pragma unroll
            for (int j = 0; j < 4; ++j) v[j] = vnx[j];
            if (rr + 1 < 8) { const float* x1 = xrow(lat, ctx, g + 1);
#pragma unroll
                for (int j = 0; j < 4; ++j) vnx[j] = *(const f32x4*)(x1 + 256 * j + 4 * F.lane); }
#pragma unroll
            for (int j = 0; j < 4; ++j) ss += (v[j].x * v[j].x + v[j].y * v[j].y) + (v[j].z * v[j].z + v[j].w * v[j].w);
            const float rstd = 1.0f / sqrtf(wave_sum(ss) * (1.0f / D) + NORM_EPS);
            float lg[NE];
            if (ROUTER) {
#pragma unroll
                for (int e = 0; e < NE; ++e) lg[e] = 0.f; }
#pragma unroll
            for (int j = 0; j < 4; ++j) { const int c = 256 * j + 4 * F.lane;
                const f32x4 gn = *(const f32x4*)(gain + c), sc = *(const f32x4*)(md + off_sc + c), sh = *(const f32x4*)(md + off_sh + c);
                const f32x4 h = v[j] * rstd * gn * (1.0f + sc) + sh;
                v2u o; o.x = cvt_pk_bf16(h.x, h.y); o.y = cvt_pk_bf16(h.z, h.w); *(v2u*)(H + (size_t)g * D + c) = o;
                if (ROUTER) {
#pragma unroll
                    for (int q = 0; q < 4; ++q) { const f32x4 w0 = *(const f32x4*)(wrt + (size_t)(c + q) * NE), w1 = *(const f32x4*)(wrt + (size_t)(c + q) * NE + 4); const float hv = h[q];
                        lg[0] += hv * w0.x; lg[1] += hv * w0.y; lg[2] += hv * w0.z; lg[3] += hv * w0.w; lg[4] += hv * w1.x; lg[5] += hv * w1.y; lg[6] += hv * w1.z; lg[7] += hv * w1.w; } }
            }
            if (ROUTER) {
#pragma unroll
                for (int e = 0; e < NE; ++e) lg[e] = wave_sum(lg[e]);
                int i0 = 0;
#pragma unroll
                for (int e = 1; e < NE; ++e) if (lg[e] > lg[i0]) i0 = e;
                int i1 = i0 == 0 ? 1 : 0;
#pragma unroll
                for (int e = 0; e < NE; ++e) if (e != i0 && lg[e] > lg[i1]) i1 = e;
                if (F.lane == 0) { const float e1 = __expf(lg[i1] - lg[i0]); const float p0 = 1.0f / (1.0f + e1);
                    rec[lrow * 4 + 0] = i0; rec[lrow * 4 + 1] = i1; rec[lrow * 4 + 2] = (int)atomicAdd((unsigned*)&lcnt[i0], 1u); rec[lrow * 4 + 3] = (int)atomicAdd((unsigned*)&lcnt[i1], 1u);
                    recp[lrow * 2 + 0] = p0; recp[lrow * 2 + 1] = e1 * p0; }
            }
        }
        if (ROUTER) {
            __syncthreads();
            if (F.tid < NE) lcnt[8 + F.tid] = __hip_atomic_fetch_add((unsigned*)(F.ctl + CW_ECNT + 64 * F.tid), lcnt[F.tid], RLX_AGENT);
            __syncthreads();
            if (F.tid < 64) { const int g = grp * 64 + F.tid; int* tk = (int*)(F.ws + WS_META) + (size_t)g * 8; const int e0 = rec[F.tid * 4], e1 = rec[F.tid * 4 + 1];
                tk[0] = e0; tk[1] = e1; tk[2] = (int)lcnt[8 + e0] + rec[F.tid * 4 + 2]; tk[3] = (int)lcnt[8 + e1] + rec[F.tid * 4 + 3];
                ((float*)tk)[4] = recp[F.tid * 2]; ((float*)tk)[5] = recp[F.tid * 2 + 1]; }
            __syncthreads();
        }
    }
}
__device__ __forceinline__ void subgrid_arrive(Frame& F, gu32* cnt) {
    asm volatile("s_waitcnt vmcnt(0)" ::: "memory"); __syncthreads();
    if (F.tid == 0) { __builtin_amdgcn_fence(__ATOMIC_RELEASE, "agent"); asm volatile("s_waitcnt vmcnt(0)" ::: "memory"); __hip_atomic_fetch_add(cnt, 1u, RLX_AGENT); }
}
__device__ __forceinline__ void subgrid_wait(Frame& F, gu32* cnt, unsigned n) {
    if (F.tid == 0) { unsigned sp = 0; while (__hip_atomic_load(cnt, RLX_AGENT) < n) { __builtin_amdgcn_s_sleep(2); if (++sp > (1u << 20)) break; }
        __builtin_amdgcn_fence(__ATOMIC_ACQUIRE, "agent"); asm volatile("s_waitcnt vmcnt(0)" ::: "memory"); }
    __syncthreads();
}
__device__ __forceinline__ void normmod_ctx_slabs(Frame& F, const float* XCp, const float* slab, const float* gain, const float* MODl, int off_sh, int off_sc) {
    bf16* H = (bf16*)(F.ws + WS_H); const float* md = MODl + 4 * 6 * D;
    for (int r = F.bid * NWAVES + F.wave; r < RC; r += F.G * NWAVES) {
        f32x4 v[4], p[NSL][4];
#pragma unroll
        for (int j = 0; j < 4; ++j) v[j] = *(const f32x4*)(XCp + (size_t)r * D + 256 * j + 4 * F.lane);
#pragma unroll
        for (int s_ = 0; s_ < NSL; ++s_)
#pragma unroll
            for (int j = 0; j < 4; ++j) p[s_][j] = *(const f32x4*)(slab + ((size_t)s_ * RC + r) * D + 256 * j + 4 * F.lane);
        float ss = 0.f;
#pragma unroll
        for (int j = 0; j < 4; ++j) {
#pragma unroll
            for (int s_ = 0; s_ < NSL; ++s_) v[j] += p[s_][j];
            ss += (v[j].x * v[j].x + v[j].y * v[j].y) + (v[j].z * v[j].z + v[j].w * v[j].w); }
        const float rstd = 1.0f / sqrtf(wave_sum(ss) * (1.0f / D) + NORM_EPS);
#pragma unroll
        for (int j = 0; j < 4; ++j) { const int c = 256 * j + 4 * F.lane;
            const f32x4 gn = *(const f32x4*)(gain + c), sc = *(const f32x4*)(md + off_sc + c), sh = *(const f32x4*)(md + off_sh + c);
            const f32x4 h = v[j] * rstd * gn * (1.0f + sc) + sh;
            v2u o; o.x = cvt_pk_bf16(h.x, h.y); o.y = cvt_pk_bf16(h.z, h.w); *(v2u*)(H + (size_t)(RL + r) * D + c) = o; }
    }
}
__device__ __forceinline__ void sg_phase(Frame& F, int l) {
    const float* SM = (const float*)(F.ws + WS_SM); bf16* SG = (bf16*)(F.ws + WS_SG); const float* mu = INP(I_MU) + l * RW + 3328;
    for (int i = F.cb * NTHREADS + F.tid; i < R * 32; i += F.cg * NTHREADS) { const int g = i >> 5, p = i & 31; float o[8];
        if (p < 16) { const int nb = nbrow(g, 3328); const float* a = SM + (size_t)g * SMW + 288 + 8 * p;
            const f32x4 a0 = *(const f32x4*)a, a1 = *(const f32x4*)(a + 4); f32x4 b0 = {0.f, 0.f, 0.f, 0.f}, b1 = b0;
            if (nb >= 0) { const float* bq = SM + (size_t)nb * SMW + 288 + 8 * p; b0 = *(const f32x4*)bq; b1 = *(const f32x4*)(bq + 4); }
#pragma unroll
            for (int j = 0; j < 4; ++j) { o[j] = sigmoidf_(a0[j] + (b0[j] - a0[j]) * mu[8 * p + j]); o[4 + j] = sigmoidf_(a1[j] + (b1[j] - a1[j]) * mu[8 * p + 4 + j]); }
        } else {
#pragma unroll
            for (int j = 0; j < 8; ++j) o[j] = 0.f; }
        *(v4u*)(SG + (size_t)g * 256 + 8 * p) = pack8(o); }
}

constexpr int ML_P = 72, ML_QS = 0, ML_KS = 64 * ML_P * 2, ML_KT = 2 * ML_KS, ML_VT = 3 * ML_KS, ML_STG = ML_VT + 80 * ML_P * 2, ML_PS = 2 * ML_STG, ML_CB = ML_PS + ML_KS, ML_GT = ML_CB + 80 * ML_P * 2, ML_END = ML_GT + 2 * 6 * 64 * 4;
static_assert(ML_END <= MISC_OFF, "mlstm LDS map");
template <int CTRL, int RMASK> __device__ __forceinline__ float dpp_get(float v, float old) { return __int_as_float(__builtin_amdgcn_update_dpp(__float_as_int(old), __float_as_int(v), CTRL, RMASK, 0xf, false)); }
__device__ __forceinline__ float wave_scan_add(float x) {
    x += dpp_get<0x111, 0xf>(x, 0.f); x += dpp_get<0x112, 0xf>(x, 0.f); x += dpp_get<0x114, 0xf>(x, 0.f); x += dpp_get<0x118, 0xf>(x, 0.f);
    x += dpp_get<0x142, 0xa>(x, 0.f); x += dpp_get<0x143, 0xc>(x, 0.f); return x;
}
__device__ __forceinline__ float wave_scan_max(float x) {
    const float ninf = -__builtin_inff();
    x = fmaxf(x, dpp_get<0x111, 0xf>(x, ninf)); x = fmaxf(x, dpp_get<0x112, 0xf>(x, ninf)); x = fmaxf(x, dpp_get<0x114, 0xf>(x, ninf)); x = fmaxf(x, dpp_get<0x118, 0xf>(x, ninf));
    x = fmaxf(x, dpp_get<0x142, 0xa>(x, ninf)); x = fmaxf(x, dpp_get<0x143, 0xc>(x, ninf)); return x;
}
__device__ __forceinline__ float lane63(float x) { return __int_as_float(__builtin_amdgcn_readlane(__float_as_int(x), 63)); }
__device__ __forceinline__ void mlstm_phase(Frame& F, int l, int first, int stride) {
    LAS unsigned char* L = F.lds;
    LAS bf16* Ps = (LAS bf16*)(L + ML_PS); LAS bf16* Cb = (LAS bf16*)(L + ML_CB); LAS float* GT = (LAS float*)(L + ML_GT);
    const bf16* Qg = (const bf16*)(F.ws + WS_Q); const bf16* Kg = (const bf16*)(F.ws + WS_K); const bf16* Vg = (const bf16*)(F.ws + WS_V); const float* SM = (const float*)(F.ws + WS_SM);
    bf16* HF = (bf16*)(F.ws + WS_HF); const float* bgate = INP(I_BG) + l * 4 * MH;
    const int tid = F.tid, lane = F.lane, wave = F.wave, r16 = lane & 15, quad = lane >> 4;
    for (int item = first; item < NB * 2 * MH * 2; item += stride) {
        const int vh = item & 1, h = (item >> 1) & 7, dir = (item >> 4) & 1, b = item >> 5;
        __syncthreads();
        for (int i = tid; i < 80 * ML_P; i += NTHREADS) { Cb[i] = 0; const bf16 v1 = (i >= 64 * ML_P) ? (bf16)0x3F80 : (bf16)0; ((LAS bf16*)(L + ML_VT))[i] = v1; ((LAS bf16*)(L + ML_STG + ML_VT))[i] = v1; }
        const float bgi = bgate[(2 * dir) * MH + h], bgf = bgate[(2 * dir + 1) * MH + h];
        const int ss_ = tid & 63, pc = tid >> 6;
        v4u rq, rk, rv;
        { const int g = row_of(b, tok(dir, ss_)); rq = *(const v4u*)(Qg + (size_t)g * 512 + h * 64 + pc * 8); rk = *(const v4u*)(Kg + (size_t)g * 512 + h * 64 + pc * 8);
          rv = *(const v4u*)(Vg + (size_t)g * 1024 + h * 128 + vh * 64 + pc * 8); }
        float m_run = 0.f, gi = 0.f, gf = 0.f;
        auto gate_tables = [&](int buf) {
            LAS float* G = GT + buf * 384;
            const float iv = CAP * fast_tanh((gi + bgi) * (1.0f / CAP)), lf = -fast_softplus(-CAP * fast_tanh((gf + bgf) * (1.0f / CAP)));
            const float bsum = wave_scan_add(lf), pmx = wave_scan_max(iv - bsum);
            const float inter = bsum + m_run, mt = fmaxf(inter, bsum + pmx);
            G[lane] = bsum - mt; G[64 + lane] = iv - bsum; G[128 + lane] = __expf(inter - mt); G[192 + lane] = __expf(-mt);
            const float blast = lane63(bsum), mnew = fmaxf(blast + m_run, blast + lane63(pmx));
            G[256 + lane] = __expf(blast - bsum + iv - mnew);
            if (lane == 0) G[320] = __expf(blast + m_run - mnew);
            m_run = mnew;
        };
        if (wave == 1) { { const int g = row_of(b, tok(dir, lane)); gi = SM[(size_t)g * SMW + (2 * dir) * MH + h]; gf = SM[(size_t)g * SMW + (2 * dir + 1) * MH + h]; }
            gate_tables(0);
            { const int g = row_of(b, tok(dir, 64 + lane)); gi = SM[(size_t)g * SMW + (2 * dir) * MH + h]; gf = SM[(size_t)g * SMW + (2 * dir + 1) * MH + h]; } }
        f32x4 CaccA = {0.f, 0.f, 0.f, 0.f}, CaccB = {0.f, 0.f, 0.f, 0.f}, Cacc2 = {0.f, 0.f, 0.f, 0.f};
        auto stage = [&](int buf) {
            LAS bf16* Qs = (LAS bf16*)(L + buf * ML_STG + ML_QS); LAS bf16* Ks = (LAS bf16*)(L + buf * ML_STG + ML_KS); LAS bf16* Kt = (LAS bf16*)(L + buf * ML_STG + ML_KT); LAS bf16* Vt = (LAS bf16*)(L + buf * ML_STG + ML_VT);
            *(v4u*)(Qs + ss_ * ML_P + pc * 8) = rq; *(v4u*)(Ks + ss_ * ML_P + pc * 8) = rk;
            const unsigned kw[4] = {rk.x, rk.y, rk.z, rk.w}, vw[4] = {rv.x, rv.y, rv.z, rv.w};
#pragma unroll
            for (int i = 0; i < 4; ++i) { Kt[(pc * 8 + 2 * i) * ML_P + ss_] = (bf16)(kw[i] & 0xffffu); Kt[(pc * 8 + 2 * i + 1) * ML_P + ss_] = (bf16)(kw[i] >> 16); }
#pragma unroll
            for (int i = 0; i < 4; ++i) { Vt[(pc * 8 + 2 * i) * ML_P + ss_] = (bf16)(vw[i] & 0xffffu); Vt[(pc * 8 + 2 * i + 1) * ML_P + ss_] = (bf16)(vw[i] >> 16); } };
        auto fetch = [&](int jn) { const int g = row_of(b, tok(dir, jn * 64 + ss_)); rq = *(const v4u*)(Qg + (size_t)g * 512 + h * 64 + pc * 8); rk = *(const v4u*)(Kg + (size_t)g * 512 + h * 64 + pc * 8);
            rv = *(const v4u*)(Vg + (size_t)g * 1024 + h * 128 + vh * 64 + pc * 8); };
        __syncthreads();
        stage(0); fetch(1);
        __syncthreads();
        for (int j = 0; j < NCH; ++j) {
            const LAS float* G = GT + (j & 1) * 384; const int sb_ = (j & 1) * ML_STG;
            LAS bf16* Qs = (LAS bf16*)(L + sb_ + ML_QS); LAS bf16* Ks = (LAS bf16*)(L + sb_ + ML_KS); LAS bf16* Kt = (LAS bf16*)(L + sb_ + ML_KT); LAS bf16* Vt = (LAS bf16*)(L + sb_ + ML_VT);
            if (j + 1 < NCH) { stage((j + 1) & 1); if (j + 2 < NCH) fetch(j + 2); }
            const int mt = wave >> 1, wv = wave & 1;
            if (wave == 1 && j + 1 < NCH) { gate_tables((j + 1) & 1);
                if (j + 2 < NCH) { const int g = row_of(b, tok(dir, (j + 2) * 64 + lane)); gi = SM[(size_t)g * SMW + (2 * dir) * MH + h]; gf = SM[(size_t)g * SMW + (2 * dir + 1) * MH + h]; } }
            const bf16x8 qa0 = *(const LAS bf16x8*)(Qs + (16 * mt + r16) * ML_P + quad * 8), qa1 = *(const LAS bf16x8*)(Qs + (16 * mt + r16) * ML_P + 32 + quad * 8);
            f32x4 accq[2], accqn = {0.f, 0.f, 0.f, 0.f};
#pragma unroll
            for (int vv = 0; vv < 2; ++vv) { const int vt = 2 * wv + vv; const f32x4 z = {0.f, 0.f, 0.f, 0.f};
                const bf16x8 c0 = *(const LAS bf16x8*)(Cb + (16 * vt + r16) * ML_P + quad * 8), c1 = *(const LAS bf16x8*)(Cb + (16 * vt + r16) * ML_P + 32 + quad * 8);
                accq[vv] = __builtin_amdgcn_mfma_f32_16x16x32_bf16(qa0, c0, z, 0, 0, 0); accq[vv] = __builtin_amdgcn_mfma_f32_16x16x32_bf16(qa1, c1, accq[vv], 0, 0, 0); }
            { const bf16x8 n0 = *(const LAS bf16x8*)(Cb + (64 + r16) * ML_P + quad * 8), n1 = *(const LAS bf16x8*)(Cb + (64 + r16) * ML_P + 32 + quad * 8);
              accqn = __builtin_amdgcn_mfma_f32_16x16x32_bf16(qa0, n0, accqn, 0, 0, 0); accqn = __builtin_amdgcn_mfma_f32_16x16x32_bf16(qa1, n1, accqn, 0, 0, 0); }
#pragma unroll
            for (int nn = 0; nn < 2; ++nn) { const int nt = 2 * wv + nn; f32x4 sacc = {0.f, 0.f, 0.f, 0.f};
                if (nt <= mt) { const bf16x8 k0 = *(const LAS bf16x8*)(Ks + (16 * nt + r16) * ML_P + quad * 8), k1 = *(const LAS bf16x8*)(Ks + (16 * nt + r16) * ML_P + 32 + quad * 8);
                    sacc = __builtin_amdgcn_mfma_f32_16x16x32_bf16(qa0, k0, sacc, 0, 0, 0); sacc = __builtin_amdgcn_mfma_f32_16x16x32_bf16(qa1, k1, sacc, 0, 0, 0); }
                const int s = 16 * nt + r16; const float wc_ = G[64 + s];
#pragma unroll
                for (int i = 0; i < 4; ++i) { const int t = 16 * mt + 4 * quad + i; const float p = (s <= t) ? sacc[i] * 0.125f * __expf(G[t] + wc_) : 0.f;
                    Ps[t * ML_P + s] = (bf16)(cvt_pk_bf16(p, 0.f) & 0xffffu); } }
            __syncthreads();
            { f32x4 acc[2] = {{0.f, 0.f, 0.f, 0.f}, {0.f, 0.f, 0.f, 0.f}}, accn = {0.f, 0.f, 0.f, 0.f};
#pragma unroll
              for (int ks = 0; ks < 2; ++ks) { if (ks == 1 && mt < 2) break;
                  const bf16x8 pa = *(const LAS bf16x8*)(Ps + (16 * mt + r16) * ML_P + 32 * ks + quad * 8);
                  const bf16x8 ob = *(const LAS bf16x8*)(Vt + (64 + r16) * ML_P + 32 * ks + quad * 8);
#pragma unroll
                  for (int vv = 0; vv < 2; ++vv) { const bf16x8 vb = *(const LAS bf16x8*)(Vt + (16 * (2 * wv + vv) + r16) * ML_P + 32 * ks + quad * 8); acc[vv] = __builtin_amdgcn_mfma_f32_16x16x32_bf16(pa, vb, acc[vv], 0, 0, 0); }
                  accn = __builtin_amdgcn_mfma_f32_16x16x32_bf16(pa, ob, accn, 0, 0, 0); }
#pragma unroll
              for (int i = 0; i < 4; ++i) { const int t = 16 * mt + 4 * quad + i; const float wi = G[128 + t] * 0.125f, dn = accn[i] + wi * accqn[i], inv = __builtin_amdgcn_rcpf(fmaxf(fabsf(dn), G[192 + t]));
                  const int g = row_of(b, tok(dir, j * 64 + t)); bf16* hf = HF + ((size_t)dir * R + g) * 1024 + h * 128 + vh * 64 + 32 * wv + r16;
                  hf[0] = (bf16)(cvt_pk_bf16((acc[0][i] + wi * accq[0][i]) * inv, 0.f) & 0xffffu); hf[16] = (bf16)(cvt_pk_bf16((acc[1][i] + wi * accq[1][i]) * inv, 0.f) & 0xffffu); } }
            { const float aold = G[320]; const int vm0 = wave >> 2, dnt = wave & 3;
              f32x4 d1a = {0.f, 0.f, 0.f, 0.f}, d1b = {0.f, 0.f, 0.f, 0.f}, d2 = {0.f, 0.f, 0.f, 0.f};
#pragma unroll
              for (int ks = 0; ks < 2; ++ks) {
                  const v4u kraw = *(const LAS v4u*)(Kt + (16 * dnt + r16) * ML_P + 32 * ks + quad * 8); float kf[8]; unpack8(kraw, kf);
                  const f32x4 a0 = *(const LAS f32x4*)&G[256 + 32 * ks + quad * 8], a1 = *(const LAS f32x4*)&G[256 + 32 * ks + quad * 8 + 4];
                  kf[0] *= a0.x; kf[1] *= a0.y; kf[2] *= a0.z; kf[3] *= a0.w; kf[4] *= a1.x; kf[5] *= a1.y; kf[6] *= a1.z; kf[7] *= a1.w;
                  const v4u kp = pack8(kf); const bf16x8 kb = __builtin_bit_cast(bf16x8, kp);
                  const bf16x8 va = *(const LAS bf16x8*)(Vt + (16 * vm0 + r16) * ML_P + 32 * ks + quad * 8), vb2 = *(const LAS bf16x8*)(Vt + (16 * (vm0 + 2) + r16) * ML_P + 32 * ks + quad * 8);
                  d1a = __builtin_amdgcn_mfma_f32_16x16x32_bf16(va, kb, d1a, 0, 0, 0); d1b = __builtin_amdgcn_mfma_f32_16x16x32_bf16(vb2, kb, d1b, 0, 0, 0);
                  if (wave < 4) { const bf16x8 oa = *(const LAS bf16x8*)(Vt + (64 + r16) * ML_P + 32 * ks + quad * 8); d2 = __builtin_amdgcn_mfma_f32_16x16x32_bf16(oa, kb, d2, 0, 0, 0); } }
              CaccA = CaccA * aold + d1a; CaccB = CaccB * aold + d1b;
#pragma unroll
              for (int i = 0; i < 4; ++i) { Cb[(16 * vm0 + 4 * quad + i) * ML_P + 16 * dnt + r16] = (bf16)(cvt_pk_bf16(CaccA[i], 0.f) & 0xffffu); Cb[(16 * (vm0 + 2) + 4 * quad + i) * ML_P + 16 * dnt + r16] = (bf16)(cvt_pk_bf16(CaccB[i], 0.f) & 0xffffu); }
              if (wave < 4) { Cacc2 = Cacc2 * aold + d2;
#pragma unroll
                  for (int i = 0; i < 4; ++i) Cb[(64 + 4 * quad + i) * ML_P + 16 * dnt + r16] = (bf16)(cvt_pk_bf16(Cacc2[i], 0.f) & 0xffffu); } }
            __syncthreads();
        }
    }
}

constexpr int RP = 72;
constexpr int RC_AB = 0, RC_BB = 9216, RC_KB = 18432, RC_RB = 27648, RC_BHT = 36864, RC_KHT = 46080, RC_ABT = 55296, RC_GAKT = 64512, RC_BONP = 67584;
constexpr int RC_TW = 55296, RC_AD = 90112;     static_assert(RC_TW + 9216 <= 64512 && RC_AD >= 80896 + 9216 && RC_AD + 9216 <= 99328, "TW / AD slots");
constexpr int RC_TW_OLD = 0, RC_AD_OLD = 9216;
constexpr int RC_KK16 = 71680, RC_K16 = 80896, RC_R16 = 99328;
constexpr int RC_GAB = 71680, RC_GAK = 75776, RC_HRB = 78848, RC_HRK = 81920, RC_TT = 84992, RC_SAT = 88064, RC_YO = 93184;
constexpr int RC_GL = 109568, RC_VT = 110592, RC_SB = 119808, RC_CONST = 129024, RC_W2T = 133120, RC_A2T = 142336, RC_END = 151552;
static_assert(RC_END <= MISC_OFF && RC_YO + 16384 <= RC_GL && RC_BONP + 1024 <= RC_KK16 && RC_TT + 3072 <= RC_SAT && RC_SAT + 5120 <= RC_YO, "rwkv LDS map");
struct RwPre { f32x4 lw[2], lwn[2], la[2], lan[2]; v4u r, rn, k, kn, v, vn; };
__device__ __forceinline__ void rw_prefetch(RwPre& P, const float* SM, const bf16* RKV, int b, int dir, int h, int j, int tid) {
    const int s = tid >> 3, p8 = (tid & 7) * 8;
    const int cr = h * 64 + p8, ck = 1024 + cr, cv = 2048 + cr;
    int g, nbS, nbR, nbK, nbV;
    if (j >= TC / 64) { const int jj = j - TC / 64, row = dir ? GW - 1 - jj : jj, col = dir ? GW - 1 - s : s; g = b * T + row * GW + col;
        const int nq0 = col > 0 ? g - 1 : -1, nq1 = col < GW - 1 ? g + 1 : -1, nq2 = row > 0 ? g - GW : -1, nq3 = row < T / GW - 1 ? g + GW : -1;
        const int qr = cr / (RW / 4), qk = ck / (RW / 4), qv = cv / (RW / 4);
        nbS = nq3; nbR = qr == 0 ? nq0 : nq1; nbK = qk == 1 ? nq1 : nq2; nbV = qv == 2 ? nq2 : nq3;
    } else { const int u = j * 64 + s, t = dir ? TC - 1 - u : u; g = RL + b * TC + t;
        const int prev = t > 0 ? g - 1 : -1, next = t < TC - 1 ? g + 1 : -1;
        nbS = next; nbR = prev; nbK = ck < RW / 2 ? prev : next; nbV = next; }
    { const float* a = SM + (size_t)g * SMW + 32 + 64 * dir + p8; const float* c = a + 128;
      P.lw[0] = *(const f32x4*)a; P.lw[1] = *(const f32x4*)(a + 4); P.la[0] = *(const f32x4*)c; P.la[1] = *(const f32x4*)(c + 4);
      const f32x4 z = {0.f, 0.f, 0.f, 0.f}; P.lwn[0] = z; P.lwn[1] = z; P.lan[0] = z; P.lan[1] = z;
      if (nbS >= 0) { const float* an = SM + (size_t)nbS * SMW + 32 + 64 * dir + p8; const float* cn = an + 128;
          P.lwn[0] = *(const f32x4*)an; P.lwn[1] = *(const f32x4*)(an + 4); P.lan[0] = *(const f32x4*)cn; P.lan[1] = *(const f32x4*)(cn + 4); } }
    const v4u z4 = {0u, 0u, 0u, 0u}; const bf16* own = RKV + (size_t)g * 3072 + cr;
    P.r = *(const v4u*)own; P.rn = nbR >= 0 ? *(const v4u*)(RKV + (size_t)nbR * 3072 + cr) : z4;
    P.k = *(const v4u*)(own + 1024); P.kn = nbK >= 0 ? *(const v4u*)(RKV + (size_t)nbK * 3072 + ck) : z4;
    P.v = *(const v4u*)(own + 2048); P.vn = nbV >= 0 ? *(const v4u*)(RKV + (size_t)nbV * 3072 + cv) : z4;
}
__device__ __forceinline__ bf16x8 lds_frag(const LAS bf16* p) { return *(const LAS bf16x8*)p; }
__device__ __forceinline__ bf16x8 lds_frag_k16(const LAS bf16* p, int quad) { const bf16x8 v = *(const LAS bf16x8*)p; const bf16x8 z = {0, 0, 0, 0, 0, 0, 0, 0}; return quad < 2 ? v : z; }
__device__ __forceinline__ bf16x8 lds_frag_perm(const LAS bf16* p) { const v2u lo = *(const LAS v2u*)p, hi = *(const LAS v2u*)(p + 16); const v4u w = {lo.x, lo.y, hi.x, hi.y}; return __builtin_bit_cast(bf16x8, w); }
__device__ __forceinline__ bf16x8 lds_frag_lo4(const LAS bf16* p) { const v2u lo = *(const LAS v2u*)p; const v4u w = {lo.x, lo.y, 0u, 0u}; return __builtin_bit_cast(bf16x8, w); }
__device__ __forceinline__ unsigned pk2(float lo, float hi) { typedef __bf16 bf2 __attribute__((ext_vector_type(2))); const bf2 v = {(__bf16)lo, (__bf16)hi}; return __builtin_bit_cast(unsigned, v); }
__device__ __forceinline__ bf16 f2b(float x) { return __builtin_bit_cast(unsigned short, (__bf16)x); }
__device__ __forceinline__ float b2f(bf16 x) { return __uint_as_float((unsigned)x << 16); }
__device__ __forceinline__ void scan16_mul4(float& x0, float& x1, float& x2, float& x3) {
#define SC_(n) "v_mul_f32_dpp %0, %0, %0 row_shr:" #n " row_mask:0xf bank_mask:0xf\n\tv_mul_f32_dpp %1, %1, %1 row_shr:" #n " row_mask:0xf bank_mask:0xf\n\tv_mul_f32_dpp %2, %2, %2 row_shr:" #n " row_mask:0xf bank_mask:0xf\n\tv_mul_f32_dpp %3, %3, %3 row_shr:" #n " row_mask:0xf bank_mask:0xf\n\t"
    asm volatile("s_nop 4\n\t" SC_(1) SC_(2) SC_(4) SC_(8) "s_nop 1" : "+v"(x0), "+v"(x1), "+v"(x2), "+v"(x3));
#undef SC_
}
__device__ __forceinline__ void st_pair(LAS bf16* p0, LAS bf16* p1, float a, float b) { const unsigned w = cvt_pk_bf16(a, b); *p0 = (bf16)(w & 0xffffu); *p1 = (bf16)(w >> 16); }
#define MFMA16(a, b, c) __builtin_amdgcn_mfma_f32_16x16x32_bf16(a, b, c, 0, 0, 0)
__device__ __forceinline__ void rwkv_phase(Frame& F, int l, int first, int stride) {
    LAS unsigned char* L = F.lds;
    LAS bf16* Ab = (LAS bf16*)(L + RC_AB); LAS bf16* Bb = (LAS bf16*)(L + RC_BB); LAS bf16* Kb = (LAS bf16*)(L + RC_KB); LAS bf16* Rb = (LAS bf16*)(L + RC_RB);
    LAS bf16* BhT = (LAS bf16*)(L + RC_BHT); LAS bf16* KhT = (LAS bf16*)(L + RC_KHT); LAS bf16* AbT = (LAS bf16*)(L + RC_ABT); LAS bf16* GAKT = (LAS bf16*)(L + RC_GAKT); LAS float* BONP = (LAS float*)(L + RC_BONP);
    LAS bf16* TW = (LAS bf16*)(L + RC_TW); LAS bf16* AD = (LAS bf16*)(L + RC_AD);
    LAS bf16* KK16 = (LAS bf16*)(L + RC_KK16); LAS bf16* K16 = (LAS bf16*)(L + RC_K16); LAS bf16* R16 = (LAS bf16*)(L + RC_R16);
    LAS float* GAB = (LAS float*)(L + RC_GAB); LAS bf16* GAK = (LAS bf16*)(L + RC_GAK); LAS bf16* HRB = (LAS bf16*)(L + RC_HRB); LAS bf16* HRK = (LAS bf16*)(L + RC_HRK); LAS bf16* TT = (LAS bf16*)(L + RC_TT);
    LAS bf16* SAt = (LAS bf16*)(L + RC_SAT); LAS bf16* YOb = (LAS bf16*)(L + RC_SB);     LAS float* GL = (LAS float*)(L + RC_GL);
    LAS bf16* Vt = (LAS bf16*)(L + RC_VT); LAS bf16* Sb = (LAS bf16*)(L + RC_SB); LAS float* CN = (LAS float*)(L + RC_CONST); LAS bf16* W2T = (LAS bf16*)(L + RC_W2T); LAS bf16* A2T = (LAS bf16*)(L + RC_A2T);
    const float* SM = (const float*)(F.ws + WS_SM); const bf16* RKV = (const bf16*)(F.ws + WS_RKV); bf16* YS = (bf16*)(F.ws + WS_YS); float* BON = (float*)(F.ws + WS_BON);
    const bf16* WL = (const bf16*)(F.ws + WS_WLORA);
    const int tid = F.tid, lane = F.lane, wave = F.wave;
    for (int item = first; item < NB * 2 * RH; item += stride) {
        const int h = item & 15, dir = (item >> 4) & 1, b = item >> 5;
        __syncthreads();
        if (tid < 64) { const float* mu = INP(I_MU) + l * RW; CN[tid] = mu[h * 64 + tid]; CN[64 + tid] = mu[1024 + h * 64 + tid]; CN[128 + tid] = mu[2048 + h * 64 + tid];
            CN[192 + tid] = mu[3072 + 64 * dir + tid]; CN[256 + tid] = mu[3200 + 64 * dir + tid];
            CN[320 + tid] = INP(I_KK)[l * RD + h * 64 + tid]; CN[384 + tid] = INP(I_KA)[l * RD + h * 64 + tid]; CN[448 + tid] = INP(I_RK)[l * RD + h * 64 + tid];
            CN[512 + tid] = INP(I_W0)[(l * 2 + dir) * RD + h * 64 + tid]; CN[576 + tid] = INP(I_A0)[(l * 2 + dir) * RD + h * 64 + tid]; }
        { const int n = tid >> 3, p8 = (tid & 7) * 8;
          *(v4u*)(W2T + n * 72 + p8) = *(const v4u*)(WL + ((size_t)(0 * 2 + dir) * RD + h * 64 + n) * 64 + p8);
          *(v4u*)(A2T + n * 72 + p8) = *(const v4u*)(WL + ((size_t)(1 * 2 + dir) * RD + h * 64 + n) * 64 + p8); }
        for (int i = tid; i < (RC_CONST - RC_GL) / 4; i += NTHREADS) ((LAS unsigned*)(L + RC_GL))[i] = 0u;
        f32x4 ST[4]; for (int kt = 0; kt < 4; ++kt) ST[kt] = (f32x4){0.f, 0.f, 0.f, 0.f};
        RwPre P; rw_prefetch(P, SM, RKV, b, dir, h, 0, tid);
        __syncthreads();
        auto store_chunk = [&](int jc) { int to = tid; const int s4 = to >> 3, q8 = (to & 7) * 8;
            *(v4u*)(YS + ((size_t)dir * R + row_of(b, tok(dir, jc * 64 + s4))) * RD + h * 64 + q8) = *(const LAS v4u*)(YOb + s4 * RP + q8); };
        for (int j = 0; j < NCH; ++j) {
            if (j > 0) store_chunk(j - 1);
            { int tl = tid; const int s = tl >> 3, p8 = (tl & 7) * 8;
              { float tw[8], ad[8]; const f32x4 muw[2] = {*(const f32x4*)&CN[192 + p8], *(const f32x4*)&CN[196 + p8]}, mua[2] = {*(const f32x4*)&CN[256 + p8], *(const f32x4*)&CN[260 + p8]};
#pragma unroll
                for (int i = 0; i < 8; ++i) { const float pw = P.lw[i >> 2][i & 3], pwn = P.lwn[i >> 2][i & 3], pa = P.la[i >> 2][i & 3], pan = P.lan[i >> 2][i & 3];
                    { const float e_ = __builtin_amdgcn_exp2f(2.8853901f * (pw + (pwn - pw) * muw[i >> 2][i & 3])); tw[i] = 1.0f - 2.0f * __builtin_amdgcn_rcpf(1.0f + e_); }     ad[i] = pa + (pan - pa) * mua[i >> 2][i & 3]; }
                *(v4u*)(TW + s * 72 + p8) = pack8(tw); *(v4u*)(AD + s * 72 + p8) = pack8(ad); }
              { float a[8], bq[8], o[8]; const f32x4 mur[2] = {*(const f32x4*)&CN[p8], *(const f32x4*)&CN[4 + p8]}, muk[2] = {*(const f32x4*)&CN[64 + p8], *(const f32x4*)&CN[68 + p8]};
                unpack8(P.r, a); unpack8(P.rn, bq);
#pragma unroll
                for (int i = 0; i < 8; ++i) o[i] = a[i] + (bq[i] - a[i]) * mur[i >> 2][i & 3];
                *(v4u*)(R16 + s * RP + p8) = pack8(o);
                unpack8(P.k, a); unpack8(P.kn, bq); float ssq = 0.f; const f32x4 kkc[2] = {*(const f32x4*)&CN[320 + p8], *(const f32x4*)&CN[324 + p8]};
#pragma unroll
                for (int i = 0; i < 8; ++i) { o[i] = a[i] + (bq[i] - a[i]) * muk[i >> 2][i & 3]; a[i] = o[i] * kkc[i >> 2][i & 3]; ssq += a[i] * a[i]; }
                *(v4u*)(K16 + s * RP + p8) = pack8(o);
                const float inv = fminf(__builtin_amdgcn_rsqf(red8(ssq)), 1e12f);
#pragma unroll
                for (int i = 0; i < 8; ++i) a[i] *= inv;
                *(v4u*)(KK16 + s * RP + p8) = pack8(a);
                { unpack8(P.v, a); unpack8(P.vn, bq); const f32x4 muv[2] = {*(const f32x4*)&CN[128 + p8], *(const f32x4*)&CN[132 + p8]};
#pragma unroll
                  for (int i = 0; i < 8; i += 2) st_pair(Vt + (p8 + i) * RP + s, Vt + (p8 + i + 1) * RP + s, a[i] + (bq[i] - a[i]) * muv[i >> 2][i & 3], a[i + 1] + (bq[i + 1] - a[i + 1]) * muv[(i + 1) >> 2][(i + 1) & 3]); } } }
            __syncthreads();
            if (j + 1 < NCH) rw_prefetch(P, SM, RKV, b, dir, h, j + 1, tid);
            { int lb = lane; const int r16 = lb & 15, quad = lb >> 4; const int c = wave >> 1, t = 16 * c + r16;
              const bf16x8 a0 = lds_frag(TW + t * 72 + quad * 8), a1 = lds_frag(TW + t * 72 + 32 + quad * 8);
              const bf16x8 d0 = lds_frag(AD + t * 72 + quad * 8), d1 = lds_frag(AD + t * 72 + 32 + quad * 8);
              f32x4 cw[2], ca[2];
#pragma unroll
              for (int nn = 0; nn < 2; ++nn) { const int nt = 2 * (wave & 1) + nn; const f32x4 z = {0.f, 0.f, 0.f, 0.f};
                  cw[nn] = MFMA16(lds_frag(W2T + (16 * nt + r16) * 72 + quad * 8), a0, z); cw[nn] = MFMA16(lds_frag(W2T + (16 * nt + r16) * 72 + 32 + quad * 8), a1, cw[nn]);
                  ca[nn] = MFMA16(lds_frag(A2T + (16 * nt + r16) * 72 + quad * 8), d0, z); ca[nn] = MFMA16(lds_frag(A2T + (16 * nt + r16) * 72 + 32 + quad * 8), d1, ca[nn]); }
              float bsum = 0.f; const int glsrc = ((lb & 48) | 15) << 2;
#pragma unroll
              for (int nn = 0; nn < 2; ++nn) { const int n0 = 16 * (2 * (wave & 1) + nn) + 4 * quad;
                  const f32x4 w0c = *(const LAS f32x4*)&CN[512 + n0], a0c = *(const LAS f32x4*)&CN[576 + n0], kac = *(const LAS f32x4*)&CN[384 + n0], rkc = *(const LAS f32x4*)&CN[448 + n0];
                  const v2u kkw = *(const LAS v2u*)(KK16 + t * RP + n0), kxw = *(const LAS v2u*)(K16 + t * RP + n0), rrw = *(const LAS v2u*)(R16 + t * RP + n0);
                  const float kk[4] = {bflo(kkw.x), bfhi(kkw.x), bflo(kkw.y), bfhi(kkw.y)}, kx[4] = {bflo(kxw.x), bfhi(kxw.x), bflo(kxw.y), bfhi(kxw.y)}, rr[4] = {bflo(rrw.x), bfhi(rrw.x), bflo(rrw.y), bfhi(rrw.y)};
                  float av[4], pin[4], pex[4], gl[4];
#pragma unroll
                  for (int i = 0; i < 4; ++i) { pin[i] = __builtin_amdgcn_exp2f(-0.87503524f * sigmoidf_(w0c[i] + cw[nn][i])); av[i] = sigmoidf_(a0c[i] + ca[nn][i]); }
                  scan16_mul4(pin[0], pin[1], pin[2], pin[3]);
#pragma unroll
                  for (int i = 0; i < 4; ++i) { pex[i] = dpp_one<0x111>(pin[i]); gl[i] = __int_as_float(__builtin_amdgcn_ds_bpermute(glsrc, __float_as_int(pin[i]))); }
                  float abv[4], rbv[4], bbv[4], kbv[4], bhv[4], khv[4];
#pragma unroll
                  for (int i = 0; i < 4; ++i) { const float kka = kk[i] * av[i], kd = kx[i] * (1.0f + (av[i] - 1.0f) * kac[i]), gi_ = __builtin_amdgcn_rcpf(pin[i]);
                      bbv[i] = kka * gi_; kbv[i] = kd * gi_; abv[i] = kk[i] * pex[i]; rbv[i] = rr[i] * pin[i]; bhv[i] = bbv[i] * gl[i]; khv[i] = kbv[i] * gl[i]; bsum += rr[i] * kd * rkc[i]; }
                  { v2u o; o.x = cvt_pk_bf16(abv[0], abv[1]); o.y = cvt_pk_bf16(abv[2], abv[3]); *(LAS v2u*)(Ab + t * RP + n0) = o;
                    o.x = cvt_pk_bf16(rbv[0], rbv[1]); o.y = cvt_pk_bf16(rbv[2], rbv[3]); *(LAS v2u*)(Rb + t * RP + n0) = o;
                    o.x = cvt_pk_bf16(bbv[0], bbv[1]); o.y = cvt_pk_bf16(bbv[2], bbv[3]); *(LAS v2u*)(Bb + t * RP + n0) = o;
                    o.x = cvt_pk_bf16(kbv[0], kbv[1]); o.y = cvt_pk_bf16(kbv[2], kbv[3]); *(LAS v2u*)(Kb + t * RP + n0) = o; }
#pragma unroll
                  for (int i = 0; i < 4; i += 2) { st_pair(BhT + (n0 + i) * RP + t, BhT + (n0 + i + 1) * RP + t, bhv[i], bhv[i + 1]); st_pair(KhT + (n0 + i) * RP + t, KhT + (n0 + i + 1) * RP + t, khv[i], khv[i + 1]); }
                  if (r16 == 15) { const f32x4 g4 = {gl[0], gl[1], gl[2], gl[3]}; *(LAS f32x4*)&GL[c * 64 + n0] = g4; }
              }
              bsum += __shfl_xor(bsum, 16); bsum += __shfl_xor(bsum, 32); if (quad == 0) BONP[t * 2 + (wave & 1)] = bsum; }
            __syncthreads();
            { int lf_ = lane; const int r16 = lf_ & 15, quad = lf_ >> 4; const int c = wave & 3, odd = wave >> 2; const LAS bf16* Asrc = odd ? Rb : Ab;     const f32x4 z = {0.f, 0.f, 0.f, 0.f};
              const bf16x8 a0 = lds_frag(Asrc + (16 * c + r16) * RP + quad * 8), a1 = lds_frag(Asrc + (16 * c + r16) * RP + 32 + quad * 8);
              f32x4 g1 = MFMA16(a0, lds_frag(Bb + (16 * c + r16) * RP + quad * 8), z); g1 = MFMA16(a1, lds_frag(Bb + (16 * c + r16) * RP + 32 + quad * 8), g1);
              f32x4 g2 = MFMA16(a0, lds_frag(Kb + (16 * c + r16) * RP + quad * 8), z); g2 = MFMA16(a1, lds_frag(Kb + (16 * c + r16) * RP + 32 + quad * 8), g2);
              if (wave == 7) { const float bs = BONP[lf_ * 2] + BONP[lf_ * 2 + 1]; BON[((size_t)dir * R + row_of(b, tok(dir, j * 64 + lf_))) * RH + h] = bs; }
              float v2m[4];
#pragma unroll
              for (int i = 0; i < 4; ++i) { const int t = 4 * quad + i; const bool keep = odd ? (r16 <= t) : (r16 < t); const float v1 = keep ? g1[i] : 0.f; v2m[i] = keep ? g2[i] : 0.f;
                  if (odd) { HRB[c * 384 + t * 24 + r16] = f2b(v1); HRK[c * 384 + t * 24 + r16] = f2b(v2m[i]); } else { GAB[c * 256 + t * 16 + r16] = v1; GAK[c * 384 + t * 24 + r16] = f2b(v2m[i]); } }
              if (!odd) { LDS_WAIT(); __builtin_amdgcn_wave_barrier();
                  float tj[16];
                  tj[0] = (r16 == 0) ? 1.0f : 0.f;
#pragma unroll
                  for (int i = 1; i < 16; ++i) { const LAS f32x4* gr = (const LAS f32x4*)(GAB + c * 256 + i * 16); float acc0 = (r16 == i) ? 1.0f : 0.f, acc1 = 0.f;
#pragma unroll
                      for (int q = 0; q < (i + 3) / 4; ++q) { const f32x4 g4 = gr[q];
#pragma unroll
                          for (int e = 0; e < 4; ++e) { const int jj = 4 * q + e; if (jj < i) { if (jj & 1) acc1 -= g4[e] * tj[jj]; else acc0 -= g4[e] * tj[jj]; } } }
                      tj[i] = acc0 + acc1; }
                  if (quad == 0) {
#pragma unroll
                      for (int i = 0; i < 16; i += 2) st_pair(TT + c * 384 + i * 24 + r16, TT + c * 384 + (i + 1) * 24 + r16, tj[i], tj[i + 1]); } } }
            __syncthreads();
            if (wave < 4) {
                int lc = lane; const int r16 = lc & 15, quad = lc >> 4, vnt = wave;
#pragma unroll
                for (int c = 0; c < 4; ++c) {
                    bf16x8 sb[2];
#pragma unroll
                    for (int ks = 0; ks < 2; ++ks) { v4u w; w.x = pk2(ST[2 * ks][0], ST[2 * ks][1]); w.y = pk2(ST[2 * ks][2], ST[2 * ks][3]); w.z = pk2(ST[2 * ks + 1][0], ST[2 * ks + 1][1]); w.w = pk2(ST[2 * ks + 1][2], ST[2 * ks + 1][3]); sb[ks] = __builtin_bit_cast(bf16x8, w); }
                    const v2u vmw = *(const LAS v2u*)(Vt + (16 * vnt + r16) * RP + 16 * c + 4 * quad); const v4u vm4 = {vmw.x, vmw.y, 0u, 0u}; const bf16x8 vmb = __builtin_bit_cast(bf16x8, vm4);
                    f32x4 sa = {0.f, 0.f, 0.f, 0.f}, yy = {0.f, 0.f, 0.f, 0.f};
#pragma unroll
                    for (int ks = 0; ks < 2; ++ks) { sa = MFMA16(lds_frag_perm(Ab + (16 * c + r16) * RP + 32 * ks + 4 * quad), sb[ks], sa); yy = MFMA16(lds_frag_perm(Rb + (16 * c + r16) * RP + 32 * ks + 4 * quad), sb[ks], yy); }
                    sa = MFMA16(lds_frag_lo4(GAK + c * 384 + r16 * 24 + 4 * quad), vmb, sa); yy = MFMA16(lds_frag_lo4(HRK + c * 384 + r16 * 24 + 4 * quad), vmb, yy);
                    { const v4u sr4 = {pk2(sa[0], sa[1]), pk2(sa[2], sa[3]), 0u, 0u}; const f32x4 z0 = {0.f, 0.f, 0.f, 0.f};
                      sa = MFMA16(lds_frag_lo4(TT + c * 384 + r16 * 24 + 4 * quad), __builtin_bit_cast(bf16x8, sr4), z0); }
                    const v4u sa4 = {pk2(sa[0], sa[1]), pk2(sa[2], sa[3]), 0u, 0u}; const bf16x8 sab = __builtin_bit_cast(bf16x8, sa4);
                    const f32x4 z = {0.f, 0.f, 0.f, 0.f};
                    const f32x4 dy = MFMA16(lds_frag_lo4(HRB + c * 384 + r16 * 24 + 4 * quad), sab, z);
#pragma unroll
                    for (int i = 0; i < 4; i += 2) st_pair(YOb + (16 * c + 4 * quad + i) * RP + 16 * vnt + r16, YOb + (16 * c + 4 * quad + i + 1) * RP + 16 * vnt + r16, yy[i] - dy[i], yy[i + 1] - dy[i + 1]);
#pragma unroll
                    for (int kt = 0; kt < 4; ++kt) { const f32x4 e_ = MFMA16(lds_frag_lo4(BhT + (16 * kt + r16) * RP + 16 * c + 4 * quad), sab, z), d_ = MFMA16(lds_frag_lo4(KhT + (16 * kt + r16) * RP + 16 * c + 4 * quad), vmb, z);
                        const f32x4 gl4 = *(const LAS f32x4*)&GL[c * 64 + 16 * kt + 4 * quad]; ST[kt] = ST[kt] * gl4 + d_ - e_; }
                }
            }
            __syncthreads();
        }
        store_chunk(NCH - 1);
    }
}
template <int PART> __device__ __forceinline__ void finish_phase(Frame& F, int l, int nrows, int first, int stride) {
    const bf16* HF = (const bf16*)(F.ws + WS_HF); const bf16* O = (const bf16*)(F.ws + WS_O); bf16* HM = (bf16*)(F.ws + WS_HM);
    const bf16* YS = (const bf16*)(F.ws + WS_YS); const bf16* RKV = (const bf16*)(F.ws + WS_RKV); const bf16* Gb = (const bf16*)(F.ws + WS_HF);     const float* BON = (const float*)(F.ws + WS_BON); bf16* YR = (bf16*)(F.ws + WS_YR);
    const int lane = F.lane, c0 = lane * 16;
    float k1[16], k2[16], k3[16];
    { const float* p1 = PART == 0 ? INP(I_GMN) + l * 1024 + c0 : INP(I_LNW) + l * RD + c0; const float* p2 = INP(I_LNB) + l * RD + c0; const float* p3 = INP(I_MU) + l * RW + 2048 + c0;
#pragma unroll
      for (int q = 0; q < 4; ++q) { const f32x4 t1 = *(const f32x4*)(p1 + 4 * q); k1[4 * q] = t1.x; k1[4 * q + 1] = t1.y; k1[4 * q + 2] = t1.z; k1[4 * q + 3] = t1.w;
          if (PART == 1) { const f32x4 t2 = *(const f32x4*)(p2 + 4 * q), t3 = *(const f32x4*)(p3 + 4 * q); k2[4 * q] = t2.x; k2[4 * q + 1] = t2.y; k2[4 * q + 2] = t2.z; k2[4 * q + 3] = t2.w; k3[4 * q] = t3.x; k3[4 * q + 1] = t3.y; k3[4 * q + 2] = t3.z; k3[4 * q + 3] = t3.w; } } }
    const bf16* S0 = PART == 0 ? HF : YS;
    int g = first * NWAVES + F.wave; const int gstep = stride * NWAVES;
    v4u n0 = {0u, 0u, 0u, 0u}, n1 = n0, n2 = n0, n3 = n0;
    if (g < nrows) { n0 = *(const v4u*)(S0 + (size_t)g * 1024 + c0); n1 = *(const v4u*)(S0 + ((size_t)R + g) * 1024 + c0); n2 = *(const v4u*)(S0 + (size_t)g * 1024 + c0 + 8); n3 = *(const v4u*)(S0 + ((size_t)R + g) * 1024 + c0 + 8); }
    for (; g < nrows; g += gstep) {
        const v4u c_0 = n0, c_1 = n1, c_2 = n2, c_3 = n3;
        { const int gn = g + gstep; if (gn < nrows) { n0 = *(const v4u*)(S0 + (size_t)gn * 1024 + c0); n1 = *(const v4u*)(S0 + ((size_t)R + gn) * 1024 + c0); n2 = *(const v4u*)(S0 + (size_t)gn * 1024 + c0 + 8); n3 = *(const v4u*)(S0 + ((size_t)R + gn) * 1024 + c0 + 8); } }
        float y[16], a[8], bq[8];
        unpack8(c_0, a); unpack8(c_1, bq);
#pragma unroll
        for (int i = 0; i < 8; ++i) y[i] = a[i] + bq[i];
        unpack8(c_2, a); unpack8(c_3, bq);
#pragma unroll
        for (int i = 0; i < 8; ++i) y[8 + i] = a[i] + bq[i];
        if (PART == 0) {
            float ss = 0.f;
#pragma unroll
            for (int i = 0; i < 16; ++i) ss += y[i] * y[i];
            const float rs = 1.0f / sqrtf(red8(ss) * (1.0f / DV) + NORM_EPS);
            float og[16]; unpack8(*(const v4u*)(O + (size_t)g * 1024 + c0), a); unpack8(*(const v4u*)(O + (size_t)g * 1024 + c0 + 8), bq);
#pragma unroll
            for (int i = 0; i < 8; ++i) { og[i] = a[i]; og[8 + i] = bq[i]; }
            float o1[8], o2[8];
#pragma unroll
            for (int i = 0; i < 8; ++i) { o1[i] = y[i] * rs * k1[i] * sigmoidf_(og[i]); o2[i] = y[8 + i] * rs * k1[8 + i] * sigmoidf_(og[8 + i]); }
            *(v4u*)(HM + (size_t)g * 1024 + c0) = pack8(o1); *(v4u*)(HM + (size_t)g * 1024 + c0 + 8) = pack8(o2);
        }
        if (PART == 1) {
            float sm_ = 0.f;
#pragma unroll
            for (int i = 0; i < 16; ++i) sm_ += y[i];
            const float mean = red4(sm_) * (1.0f / RN); float vs = 0.f;
#pragma unroll
            for (int i = 0; i < 16; ++i) { const float dl = y[i] - mean; vs += dl * dl; }
            const float rs = 1.0f / sqrtf(red4(vs) * (1.0f / RN) + GN_EPS);
            const int hh = lane >> 2; const float bon = BON[(size_t)g * RH + hh] + BON[((size_t)R + g) * RH + hh];
            float vm[16], gg[16];
#pragma unroll
            for (int half = 0; half < 2; ++half) { const int rw = 2048 + c0 + 8 * half, nb = nbrow(g, rw); unpack8(*(const v4u*)(RKV + (size_t)g * 3072 + rw), a);
                if (nb >= 0) unpack8(*(const v4u*)(RKV + (size_t)nb * 3072 + rw), bq); else {
#pragma unroll
                    for (int i = 0; i < 8; ++i) bq[i] = 0.f; }
#pragma unroll
                for (int i = 0; i < 8; ++i) vm[8 * half + i] = a[i] + (bq[i] - a[i]) * k3[8 * half + i];
                unpack8(*(const v4u*)(Gb + (size_t)g * RD + c0 + 8 * half), a);
#pragma unroll
                for (int i = 0; i < 8; ++i) gg[8 * half + i] = a[i]; }
            float o1[8], o2[8];
#pragma unroll
            for (int i = 0; i < 8; ++i) { o1[i] = ((y[i] - mean) * rs * k1[i] + k2[i] + bon * vm[i]) * gg[i]; o2[i] = ((y[8 + i] - mean) * rs * k1[8 + i] + k2[8 + i] + bon * vm[8 + i]) * gg[8 + i]; }
            *(v4u*)(YR + (size_t)g * RD + c0) = pack8(o1); *(v4u*)(YR + (size_t)g * RD + c0 + 8) = pack8(o2);
        }
    }
}
struct MoeMeta { int off[NE + 1]; };
__device__ __forceinline__ MoeMeta moe_meta(Frame& F) {
    MoeMeta m; int o = 0;
#pragma unroll
    for (int e = 0; e < NE; ++e) { m.off[e] = o; const unsigned c = __hip_atomic_load((unsigned*)(F.ctl + CW_ECNT + 64 * e), RLX_AGENT); o += (int)((c + 255u) & ~255u); }
    m.off[NE] = o; return m;
}
__device__ __forceinline__ void gather_phase(Frame& F) {
    const MoeMeta m = moe_meta(F);
    if (F.bid == 0 && F.tid < MAXSLOT / 256) { int e = 0;
#pragma unroll
        for (int q = 1; q <= NE - 1; ++q) e += ((int)F.tid * 256 >= m.off[q]) ? 1 : 0;
        ((int*)(F.ws + WS_META + 768 * 1024))[F.tid] = e; }
    const bf16* H = (const bf16*)(F.ws + WS_H); unsigned char* HG = (unsigned char*)(F.ws + WS_HG);
    for (int w = F.bid * NWAVES + F.wave; w < RL * 2; w += F.G * NWAVES) { const int g = w >> 1, k = w & 1; int* tk = (int*)(F.ws + WS_META) + (size_t)g * 8; const int e = tk[k], pos = tk[2 + k];
        int base = 0;
#pragma unroll
        for (int q = 0; q < NE; ++q) base = (e == q) ? m.off[q] : base;
        const int slot = base + pos; if (F.lane == 0) tk[6 + k] = slot;
        const v4u* src = (const v4u*)(H + (size_t)g * D); float a[8], c8[8];
        unpack8(src[2 * F.lane], a); unpack8(src[2 * F.lane + 1], c8);
#pragma unroll
        for (int i = 0; i < 8; ++i) { a[i] = __builtin_amdgcn_fmed3f(a[i], -448.0f, 448.0f); c8[i] = __builtin_amdgcn_fmed3f(c8[i], -448.0f, 448.0f); }
        v4u o; o.x = pk4_fp8(a[0], a[1], a[2], a[3]); o.y = pk4_fp8(a[4], a[5], a[6], a[7]); o.z = pk4_fp8(c8[0], c8[1], c8[2], c8[3]); o.w = pk4_fp8(c8[4], c8[5], c8[6], c8[7]);
        *(v4u*)(HG + (size_t)slot * D + 16 * F.lane) = o; }
}
__device__ __forceinline__ void final_phase(Frame& F, const float* MODl) {
    const bf16* Y2 = (const bf16*)(F.ws + WS_Y2); const float* gfp = INP(I_GF);
    f32x4 gf[4];
#pragma unroll
    for (int j = 0; j < 4; ++j) gf[j] = *(const f32x4*)(gfp + 256 * j + 4 * F.lane);
    int g = F.bid * NWAVES + F.wave; const int gstep = F.G * NWAVES;
    int s0n = 0, s1n = 0; float p0n = 0.f, p1n = 0.f;
    if (g < RL) { const int* tk = (const int*)(F.ws + WS_META) + (size_t)g * 8; s0n = tk[6]; s1n = tk[7]; p0n = ((const float*)tk)[4]; p1n = ((const float*)tk)[5]; }
    for (; g < RL; g += gstep) {
        const int s0 = s0n, s1 = s1n; const float p0 = p0n, p1 = p1n;
        float* xr = (float*)F.out + (size_t)g * D; const float* gt = MODl + (g / T) * 6 * D + 5 * D; f32x4 x[4], gq[4]; v2u ya[4], yb[4];
#pragma unroll
        for (int j = 0; j < 4; ++j) { const int c = 256 * j + 4 * F.lane; x[j] = *(const f32x4*)(xr + c); gq[j] = *(const f32x4*)(gt + c); ya[j] = *(const v2u*)(Y2 + (size_t)s0 * D + c); yb[j] = *(const v2u*)(Y2 + (size_t)s1 * D + c); }
        { const int gn = g + gstep; if (gn < RL) { const int* tk = (const int*)(F.ws + WS_META) + (size_t)gn * 8; s0n = tk[6]; s1n = tk[7]; p0n = ((const float*)tk)[4]; p1n = ((const float*)tk)[5]; } }
        f32x4 v[4]; float ss = 0.f;
#pragma unroll
        for (int j = 0; j < 4; ++j) { const v2u a = ya[j], bq = yb[j];
            f32x4 y; y.x = p0 * bflo(a.x) + p1 * bflo(bq.x); y.y = p0 * bfhi(a.x) + p1 * bfhi(bq.x); y.z = p0 * bflo(a.y) + p1 * bflo(bq.y); y.w = p0 * bfhi(a.y) + p1 * bfhi(bq.y);
            v[j] = x[j] + gq[j] * y; ss += (v[j].x * v[j].x + v[j].y * v[j].y) + (v[j].z * v[j].z + v[j].w * v[j].w); }
        const float rstd = 1.0f / sqrtf(wave_sum(ss) * (1.0f / D) + NORM_EPS);
#pragma unroll
        for (int j = 0; j < 4; ++j) { const int c = 256 * j + 4 * F.lane; *(f32x4*)(xr + c) = v[j] * rstd * gf[j]; }
    }
}

#ifndef MK_SPLIT
#define MK_SPLIT 0
#endif
constexpr int PPL = 12, NPHASE = 1 + NL * PPL + 1;
__device__ __forceinline__ GAS unsigned char* launder_ws(GAS unsigned char* p) { asm volatile("" : "+s"(p)); return p; }
__device__ __forceinline__ const CAS Args* launder_args(const CAS Args* p) { asm volatile("" : "+s"(p)); return p; }
__device__ __forceinline__ void grid_barrier(unsigned* barw, unsigned x, volatile LAS unsigned* st) { XcdBarrier b; b.bar = barw; b.x = x; b.st = st; xcd_barrier(b); }
#define IN(k) (lo <= (k) && (k) < hi)
#define SEAM(k) do { if (IN(k) && IN((k) + 1)) grid_barrier(bar.bar, bar.x, bar.st); } while (0)
#define PH_BEGIN { int t_ = threadIdx.x; asm volatile("" : "+v"(t_)); F.tid = t_; F.lane = t_ & 63; F.wave = __builtin_amdgcn_readfirstlane(t_ >> 6); int b_ = blockIdx.x; asm volatile("" : "+s"(b_)); F.bid = b_; F.cb = b_; F.cg = F.G; } \
        GAS unsigned char* ws = launder_ws(args.ws); F.ws = ws; F.A = launder_args((const CAS Args*)__builtin_amdgcn_kernarg_segment_ptr()); float* MOD = (float*)(ws + WS_MOD); float* XC = (float*)(ws + WS_XC); bf16* Hb = (bf16*)(ws + WS_H); \
        const float* MODl = MOD + (size_t)l * 5 * 6 * D; const float* xl = l == 0 ? INP(I_X) : (const float*)F.out; const float* xc = l == 0 ? INP(I_CTX) : XC; (void)MODl; (void)xl; (void)xc; (void)Hb;
template <int l> __device__ __forceinline__ void layer_body(Frame& F, const Args& args, const int lo, const int hi, const XcdBarrier& bar) {
        const int p0 = 1 + l * PPL; const bool last = (l == NL - 1);
        const int Mrows = last ? RL : R;
        if (IN(p0 + 0)) { PH_BEGIN if (l == 0) normmod_rows(F, xl, xc, INP(I_GNM) + l * D, MODl, 0, D, R);
            else { normmod_ctx_slabs(F, xc, (const float*)(ws + WS_S2), INP(I_GNM) + l * D, MODl, 0, D); normmod_rows(F, xl, xc, INP(I_GNM) + l * D, MODl, 0, D, RL); conv_rest(F, l); } }
        SEAM(p0 + 0);
        if (IN(p0 + 1)) { PH_BEGIN pg8::Gemm g{Hb, (const bf16*)(ws + WS_WIN), R, NPAD, D}; pg8::EpiInproj E{ws};
            pg8::InprojOrder S; S.G = F.G; S.c = F.bid; pg8::gemm_phase<pg8::EpiInproj, pg8::InprojOrder, true, true>(F.lds, g, S, E); }
        if (IN(p0 + 1) && IN(p0 + 3)) grid_barrier(bar.bar, bar.x, bar.st);
        if (IN(p0 + 3)) { PH_BEGIN const int nR = F.G / 2;
            if (F.bid < nR) rwkv_phase(F, l, F.bid, nR);
            else { F.cb = F.bid - nR; F.cg = F.G - nR; gu32* sub = F.ctl + CW_SUB + 64 * l;
                   sg_phase(F, l); subgrid_arrive(F, sub);
                   mlstm_phase(F, l, F.cb, F.cg); subgrid_arrive(F, sub + 128); } }
        if (IN(p0 + 3)) { PH_BEGIN const int nR = F.G / 2;
            if (F.bid >= nR) { F.cb = F.bid - nR; F.cg = F.G - nR; gu32* sub = F.ctl + CW_SUB + 64 * l;
                pg8::Gemm g{Hb, (const bf16*)(ws + WS_WIN), R, NPAD, D}; pg8::EpiInproj E{ws};
                pg8::LateInprojOrder<last> S; S.G = F.cg; S.c = (F.cb + 64) % F.cg;
                pg8::gemm_phase<pg8::EpiInproj, pg8::LateInprojOrder<last>, true, true>(F.lds, g, S, E);
                subgrid_arrive(F, sub + 384); } }
        if (IN(p0 + 3)) { PH_BEGIN const int nR = F.G / 2;
            if (F.bid >= nR) { F.cb = F.bid - nR; F.cg = F.G - nR; gu32* sub = F.ctl + CW_SUB + 64 * l;
                if (!last) { conv_ffn0(F); conv_experts(F, 1, 4); } else { conv_experts(F, 0, 1); conv_experts(F, 4, 5); }
                subgrid_wait(F, sub, (unsigned)F.cg); subgrid_wait(F, sub + 128, (unsigned)F.cg); subgrid_wait(F, sub + 384, (unsigned)F.cg);
                finish_phase<0>(F, l, Mrows, F.cb, F.cg); subgrid_arrive(F, sub + 256);
                if (!last) conv_win(F, l + 1); else conv_experts(F, 5, 6);
                subgrid_wait(F, sub + 256, (unsigned)F.cg); } }
        if (IN(p0 + 3)) { PH_BEGIN const int nR = F.G / 2;
            if (F.bid >= nR) { int kg = 256; asm volatile("" : "+s"(kg));
                pg8::Gemm g{(const bf16*)(ws + WS_SG), (const bf16*)(ws + WS_WG2), R, RD, kg}; pg8::StaticOrder S; S.init(Mrows, RD, F.G - nR, F.bid - nR);
                pg8::EpiStore E{(bf16*)(ws + WS_HF), RD};
                pg8::gemm_phase<pg8::EpiStore, pg8::StaticOrder, true, true>(F.lds, g, S, E); } }
        if (IN(p0 + 3)) { PH_BEGIN const int nR = F.G / 2;
            if (F.bid >= nR) {
                pg8::Gemm g{(const bf16*)(ws + WS_HM), (const bf16*)(ws + WS_WPM), Mrows, D, D}; pg8::StaticOrder S; S.init(Mrows, D, F.G - nR, F.bid - nR);
                pg8::EpiMerge<0> E{(const bf16*)(ws + WS_MGT), (bf16*)(ws + WS_T1), nullptr};
                pg8::gemm_phase<pg8::EpiMerge<0>, pg8::StaticOrder, true, true>(F.lds, g, S, E); } }
        SEAM(p0 + 3);
        if (IN(p0 + 4)) { PH_BEGIN finish_phase<1>(F, l, Mrows, F.bid, F.G); }
        if (IN(p0 + 4) && IN(p0 + 6)) grid_barrier(bar.bar, bar.x, bar.st);
        if (IN(p0 + 6)) { PH_BEGIN pg8::Gemm g{(const bf16*)(ws + WS_YR), (const bf16*)(ws + WS_WPR), Mrows, D, D}; pg8::StaticOrder S; S.init(Mrows, D, F.G, F.bid);
            pg8::EpiMerge<1> E{(const bf16*)(ws + WS_MGT), (bf16*)(ws + WS_T1), Hb};
            pg8::gemm_phase<pg8::EpiMerge<1>, pg8::StaticOrder, true, true>(F.lds, g, S, E); }
        SEAM(p0 + 6);
        if (IN(p0 + 7)) { PH_BEGIN pg8::Gemm g{Hb, (const bf16*)(ws + WS_WOUT), Mrows, D, D}; pg8::StaticOrder S; S.init(Mrows, D, F.G, F.bid);
            pg8::EpiResid E{xl, xc, (float*)F.out, XC, MODl + 2 * D};
            pg8::gemm_phase<pg8::EpiResid, pg8::StaticOrder, true, true>(F.lds, g, S, E); }
        SEAM(p0 + 7);
        if (IN(p0 + 8)) { PH_BEGIN if (!last) normmod_rows(F, (const float*)F.out, XC, INP(I_GNF) + l * D, MODl, 3 * D, 4 * D, Mrows);
                          else normmod_phase<true>(F, (const float*)F.out, XC, INP(I_GNF) + l * D, MODl, 3 * D, 4 * D, Mrows, INP(I_WR)); }
        SEAM(p0 + 8);
        if (!last) {
            if (IN(p0 + 9)) { PH_BEGIN pg8::Gemm g{Hb, (const bf16*)(ws + WS_WGU), Mrows, 2 * FF, D}; pg8::StaticOrder S; S.init(Mrows, 2 * FF, F.G, F.bid);
                pg8::EpiSwigluCtx E{(bf16*)(ws + WS_HH0), FF, (bf16*)(ws + WS_HH0) + (size_t)RL * FF, RL / 256};
                pg8::gemm_phase<pg8::EpiSwigluCtx, pg8::StaticOrder, true, true>(F.lds, g, S, E); }
            SEAM(p0 + 9);
            if (IN(p0 + 10)) { PH_BEGIN pg8::Gemm g{(const bf16*)(ws + WS_HH0), (const bf16*)(ws + WS_WDN), RL, D, FF}; pg8::StaticOrder S; S.init(RL, D, F.G, F.bid);
                pg8::EpiResid E{(const float*)F.out, XC, (float*)F.out, XC, MODl + 5 * D};
                pg8::gemm_phase<pg8::EpiResid, pg8::StaticOrder, true, true>(F.lds, g, S, E); }
            if (IN(p0 + 10)) { PH_BEGIN int kg = 256; asm volatile("" : "+s"(kg));
                pg8::Gemm g{(const bf16*)(ws + WS_HH0) + (size_t)RL * FF, (const bf16*)(ws + WS_WDNS), RC, D, kg}; pg8::CtxSliceOrder S; S.nS = NSL; S.G = F.G; S.c = (F.bid + 128) % F.G;
                pg8::EpiSlab E{(float*)(ws + WS_S2), MODl + 4 * 6 * D + 5 * D};
                pg8::gemm_phase<pg8::EpiSlab, pg8::CtxSliceOrder, true, true>(F.lds, g, S, E); }
            if (IN(p0 + 10) && IN(p0 + 12)) grid_barrier(bar.bar, bar.x, bar.st);
        } else {
            if (IN(p0 + 9)) { PH_BEGIN conv_experts(F, 6, NE); gather_phase(F); }
            SEAM(p0 + 9);
            if (IN(p0 + 10)) { PH_BEGIN const MoeMeta mm = moe_meta(F); pg8::MoeOrder S; S.ntiles = mm.off[NE] / 256; S.nN = 2 * FE / 256; S.nwg = S.ntiles * S.nN; S.G = F.G; S.c = F.bid; S.texp = (const int*)(ws + WS_META + 768 * 1024);
                S.lo0 = (int)((WS_WEA - WS_WEGU) / (256 * 1024)); S.lo1 = 28; S.b4 = -(int)((WS_WEGU - WS_WE4U) / (256 * 1024)); S.b5 = -(int)((WS_WEGU - WS_WE5U) / (256 * 1024));
                int ke = D / 2; asm volatile("" : "+s"(ke));
                pg8::Gemm g{(const bf16*)(ws + WS_HG), (const bf16*)(ws + WS_WEGU), 0, 2 * FE, ke}; pg8::EpiSwiglu8 E{(unsigned char*)(ws + WS_HHE), FE};
                pg8::gemm_phase<pg8::EpiSwiglu8, pg8::MoeOrder, true, true, true>(F.lds, g, S, E); }
            SEAM(p0 + 10);
            if (IN(p0 + 11)) { PH_BEGIN const MoeMeta mm = moe_meta(F); pg8::MoeOrder S; S.ntiles = mm.off[NE] / 256; S.nN = D / 256; S.nwg = S.ntiles * S.nN; S.G = F.G; S.c = F.bid; S.texp = (const int*)(ws + WS_META + 768 * 1024);
                S.lo0 = (int)((WS_WEA + 28 * MiB - WS_WEDN) / (896 * 1024)); S.lo1 = 4; S.b4 = -(int)((WS_WEDN - WS_WE4D) / (896 * 1024)); S.b5 = -(int)((WS_WEDN - WS_WE5D) / (896 * 1024));
                int ke = FE / 2; asm volatile("" : "+s"(ke));
                pg8::Gemm g{(const bf16*)(ws + WS_HHE), (const bf16*)(ws + WS_WEDN), 0, D, ke}; pg8::EpiStoreScaled E{(bf16*)(ws + WS_Y2), D, 1.0f / W8S};
                pg8::gemm_phase<pg8::EpiStoreScaled, pg8::MoeOrder, true, true, true>(F.lds, g, S, E); }
            SEAM(p0 + 11);
        }
    }
__global__ void __launch_bounds__(NTHREADS, 2) mk_fwd(Args args) {
    extern __shared__ __attribute__((aligned(16))) unsigned char lds[];
    Frame F;
    F.lds = (LAS unsigned char*)lds; F.MISC = (volatile LAS unsigned*)(F.lds + MISC_OFF);
    F.tid = threadIdx.x; F.lane = F.tid & 63; F.wave = __builtin_amdgcn_readfirstlane(F.tid >> 6); F.G = gridDim.x; F.bid = blockIdx.x;
    F.ws = args.ws; F.out = args.out; F.ctl = (gu32*)(args.ws + WS_CTL);
    F.A = (const CAS Args*)__builtin_amdgcn_kernarg_segment_ptr();
    if (F.tid < 64) F.MISC[F.tid] = 0u;
    __syncthreads();
    const int lo = args.ph_lo, hi = args.ph_hi;
    XcdBarrier bar; bar.bar = (unsigned*)(F.ctl + CW_BAR) + args.li * XCD_BAR_WORDS; bar.x = 0; bar.st = nullptr;
    if (hi - lo > 1) bar = xcd_barrier_post((unsigned*)(F.ctl + CW_BAR) + args.li * XCD_BAR_WORDS, F.MISC + 8);

    if (IN(0)) { const int l = 0; PH_BEGIN mod_phase(F); conv_win(F, 0); conv_rest(F, 0); }
    SEAM(0);

    layer_body<0>(F, args, lo, hi, bar);
    layer_body<1>(F, args, lo, hi, bar);
    if (IN(NPHASE - 1)) { const int l = NL - 1; PH_BEGIN final_phase(F, MODl); }
#undef IN
#undef SEAM
}

extern "C" void kernel_launch(void* const* d_in, const int* in_sizes, int n_in, void* d_out, int out_size, void* d_ws, size_t ws_size, hipStream_t stream) {
    static int grid = 0;
    if (grid == 0) {
        if (n_in != 33 || out_size != RL * D || ws_size < WS_NEED) { fprintf(stderr, "kernel_launch: unexpected problem (n_in %d, out %d, ws %zu < %zu)\n", n_in, out_size, ws_size, (size_t)WS_NEED); grid = -1; return; }
        int dev = 0, cus = 0, per_cu = 0;
        if (hipGetDevice(&dev) != hipSuccess || hipDeviceGetAttribute(&cus, hipDeviceAttributeMultiprocessorCount, dev) != hipSuccess) { grid = -1; return; }
        if (hipFuncSetAttribute((const void*)mk_fwd, hipFuncAttributeMaxDynamicSharedMemorySize, LDS_BYTES) != hipSuccess) { fprintf(stderr, "kernel_launch: hipFuncSetAttribute failed\n"); grid = -1; return; }
        if (hipOccupancyMaxActiveBlocksPerMultiprocessor(&per_cu, (const void*)mk_fwd, NTHREADS, LDS_BYTES) != hipSuccess || per_cu < 1) { fprintf(stderr, "kernel_launch: occupancy query says %d\n", per_cu); grid = -1; (void)hipGetLastError(); return; }
        grid = cus;
    }
    if (grid < 0) return;
    (void)hipMemsetAsync((char*)d_ws + WS_CTL, 0, CTL_ZERO_BYTES, stream);
    Args a{};
    for (int i = 0; i < 33; ++i) a.in[i] = (const GAS float*)d_in[i];
    a.out = (GAS float*)d_out; a.ws = (GAS unsigned char*)d_ws;
#if MK_SPLIT
    for (int p = 0; p < NPHASE; ++p) { a.ph_lo = p; a.ph_hi = p + 1; hipLaunchKernelGGL(mk_fwd, dim3(grid), dim3(NTHREADS), LDS_BYTES, stream, a); }
#elif defined(PROBE_PH)
    a.ph_lo = 0; a.ph_hi = PROBE_PH + 1; a.li = 0; hipLaunchKernelGGL(mk_fwd, dim3(grid), dim3(NTHREADS), LDS_BYTES, stream, a);
    for (int r = 0; r < PROBE_N; ++r) { a.ph_lo = PROBE_PH; a.ph_hi = PROBE_PH + 1; hipLaunchKernelGGL(mk_fwd, dim3(grid), dim3(NTHREADS), LDS_BYTES, stream, a); }
    a.ph_lo = PROBE_PH + 1; a.ph_hi = NPHASE; a.li = 1; hipLaunchKernelGGL(mk_fwd, dim3(grid), dim3(NTHREADS), LDS_BYTES, stream, a);
#else
    a.ph_lo = 0; a.ph_hi = NPHASE;
    hipLaunchKernelGGL(mk_fwd, dim3(grid), dim3(NTHREADS), LDS_BYTES, stream, a);
#endif
}
```

```cpp
#include <hip/hip_runtime.h>
#include <cstdio>
#include <cstdint>

#define GAS __attribute__((address_space(1)))
#define LAS __attribute__((address_space(3)))
typedef unsigned short bf16;
typedef unsigned v4u __attribute__((ext_vector_type(4)));
typedef unsigned v2u __attribute__((ext_vector_type(2)));
typedef float f32x4 __attribute__((ext_vector_type(4)));
typedef float f32x2 __attribute__((ext_vector_type(2)));
typedef short bf16x8 __attribute__((ext_vector_type(8)));
typedef GAS unsigned gu32;
#define RLX_AGENT __ATOMIC_RELAXED, __HIP_MEMORY_SCOPE_AGENT
#define LDS_WAIT() asm volatile("s_waitcnt lgkmcnt(0)" ::: "memory")
#define VM_WAIT() asm volatile("s_waitcnt vmcnt(0)" ::: "memory")

constexpr int D = 1024, NB = 4, T = 4096, GW = 64, TC = 256, NL = 2;
constexpr int RL = NB * T, RC = NB * TC, R = RL + RC;
constexpr int MH = 8, DQK = 64, DV = 128, LCH = 64;
constexpr int RH = 16, RN = 64, RD = 1024;
constexpr int RW = 3456, DIN = 8608, NPAD = 8704;
constexpr int FF = 2816, NE = 8, FE = 3584;
constexpr int TB = T + TC, NCH = TB / LCH;
constexpr int SMW = 512;
constexpr float NORM_EPS = 1e-6f, GN_EPS = 64e-5f, CAP = 15.0f;
constexpr int MAXSLOT = 2 * RL + NE * 256;

constexpr size_t MiB = 1u << 20;
constexpr size_t WS_CTL = 0, CTL_ZERO_BYTES = 1 * MiB;
constexpr size_t WS_MOD = 1 * MiB, WS_XC = 2 * MiB, WS_META = 6 * MiB, WS_BON = 7 * MiB, WS_SG = 10 * MiB;
constexpr size_t WS_WIN = 19 * MiB, WS_WPM = 36 * MiB, WS_WPR = 38 * MiB, WS_WOUT = 40 * MiB, WS_WG2 = 42 * MiB, WS_WLORA = 43 * MiB, WS_WGU = 44 * MiB, WS_WDN = 55 * MiB;
constexpr size_t WS_H = 61 * MiB;
constexpr size_t WS_Q = 95 * MiB, WS_K = 112 * MiB, WS_V = 129 * MiB, WS_O = 163 * MiB, WS_RKV = 197 * MiB, WS_MGT = 299 * MiB, WS_SM = 367 * MiB;
constexpr size_t WS_HF = 401 * MiB, WS_YS = 469 * MiB, WS_END = 537 * MiB;
constexpr size_t WS_HM = WS_Q, WS_YR = WS_V, WS_T1 = WS_O;
constexpr size_t WS_HH0 = WS_Q;
constexpr size_t WS_WEGU = 95 * MiB, WS_WEDN = 152 * MiB, WS_HG = 179 * MiB, WS_Y2 = 213 * MiB, WS_HHE = 281 * MiB;
constexpr size_t WS_WEA = 537 * MiB;
constexpr size_t WS_WE4D = 45440 * 1024ull, WS_WE4U = 48 * MiB, WS_WE5D = 19 * MiB, WS_WE5U = 23040 * 1024ull;
static_assert(WS_WE4D >= WS_WGU && WS_WE4D + 3584 * 1024 <= WS_WE4U && WS_WE4U + 7 * MiB <= WS_H && WS_WE5D >= WS_WIN && WS_WE5D + 3584 * 1024 <= WS_WE5U && WS_WE5U + 7 * MiB <= WS_WPM, "early expert buffers");
static_assert((WS_WEGU - WS_WE4U) % (256 * 1024) == 0 && (WS_WEGU - WS_WE5U) % (256 * 1024) == 0 && (WS_WEDN - WS_WE4D) % (896 * 1024) == 0 && (WS_WEDN - WS_WE5D) % (896 * 1024) == 0, "expert weight tiles");
static_assert((WS_WEA - WS_WEGU) % (256 * 1024) == 0 && (WS_WEA + 28 * MiB - WS_WEDN) % (896 * 1024) == 0, "expert weight tiles");
static_assert(WS_HHE + (size_t)MAXSLOT * FE <= 401 * MiB && WS_Y2 + (size_t)MAXSLOT * D * 2 <= WS_HHE && WS_HG + (size_t)MAXSLOT * D <= WS_Y2, "ws map");
constexpr float W8S = 64.0f;
constexpr size_t WS_WDNS = 538 * MiB, WS_S2 = 200 * MiB;
constexpr int NSL = FF / 256;
constexpr size_t WS_NEED = 579 * MiB;
constexpr int CW_BAR = 4096;
constexpr int CW_ECNT = 16384;
constexpr int CW_SUB = 20480;
constexpr int LDS_BYTES = 159744;
constexpr int MISC_OFF = LDS_BYTES - 256;

__device__ __forceinline__ unsigned cvt_pk_bf16(float lo, float hi) { unsigned r; asm volatile("v_cvt_pk_bf16_f32 %0, %1, %2" : "=v"(r) : "v"(lo), "v"(hi)); return r; }
__device__ __forceinline__ float bflo(unsigned w) { return __uint_as_float(w << 16); }
__device__ __forceinline__ float bfhi(unsigned w) { return __uint_as_float(w & 0xffff0000u); }
__device__ __forceinline__ void unpack8(const v4u w, float (&f)[8]) { f[0] = bflo(w.x); f[1] = bfhi(w.x); f[2] = bflo(w.y); f[3] = bfhi(w.y); f[4] = bflo(w.z); f[5] = bfhi(w.z); f[6] = bflo(w.w); f[7] = bfhi(w.w); }
__device__ __forceinline__ v4u pack8(const float (&f)[8]) { v4u w; w.x = cvt_pk_bf16(f[0], f[1]); w.y = cvt_pk_bf16(f[2], f[3]); w.z = cvt_pk_bf16(f[4], f[5]); w.w = cvt_pk_bf16(f[6], f[7]); return w; }
__device__ __forceinline__ float sigmoidf_(float x) { return __builtin_amdgcn_rcpf(1.0f + __expf(-x)); }
__device__ __forceinline__ float siluf_(float x) { return x * sigmoidf_(x); }
__device__ __forceinline__ float softplusf_(float x) { return fmaxf(x, 0.f) + log1pf(expf(-fabsf(x))); }
__device__ __forceinline__ float fast_tanh(float x) { const float e = __expf(2.0f * x); return 1.0f - 2.0f * __builtin_amdgcn_rcpf(1.0f + e); }
__device__ __forceinline__ float fast_softplus(float x) { return fmaxf(x, 0.f) + __logf(1.0f + __expf(-fabsf(x))); }
template <int CTRL> __device__ __forceinline__ float dpp_add(float v) { const int t = __builtin_amdgcn_update_dpp(0, __float_as_int(v), CTRL, 0xf, 0xf, false); return v + __int_as_float(t); }
template <int CTRL> __device__ __forceinline__ float dpp_one(float v) { return __int_as_float(__builtin_amdgcn_update_dpp(0x3f800000, __float_as_int(v), CTRL, 0xf, 0xf, false)); }
__device__ __forceinline__ float red4(float v) { v = dpp_add<0xB1>(v); return dpp_add<0x4E>(v); }
__device__ __forceinline__ float red8(float v) { return dpp_add<0x141>(red4(v)); }
__device__ __forceinline__ float red16(float v) { return dpp_add<0x140>(red8(v)); }
__device__ __forceinline__ float wave_sum(float v) { v = red16(v); v += __shfl_xor(v, 16); return v + __shfl_xor(v, 32); }
__device__ __forceinline__ int row_of(int b, int lr) { return lr < T ? b * T + lr : RL + b * TC + (lr - T); }
__device__ __forceinline__ int tok(int dir, int u) { if (u < TC) return T + (dir ? TC - 1 - u : u); const int tt = u - TC; return dir ? T - 1 - tt : tt; }
__device__ __forceinline__ int chunk_row(int b, int dir, int jc, int t) {
    const int base = jc < TC / 64 ? RL + b * TC + (dir ? TC - 1 - jc * 64 : jc * 64) : b * T + (dir ? T - 1 - (jc - TC / 64) * 64 : (jc - TC / 64) * 64);
    return dir ? base - t : base + t;
}
__device__ __forceinline__ int nbrow(int g, int rwidx) {
    if (g < RL) { const int t = g & (T - 1), row = t >> 6, col = t & 63, q = rwidx / (RW / 4);
        if (q == 0) return col > 0 ? g - 1 : -1; if (q == 1) return col < GW - 1 ? g + 1 : -1; if (q == 2) return row > 0 ? g - GW : -1; return row < T / GW - 1 ? g + GW : -1; }
    const int t = (g - RL) & (TC - 1); if (rwidx < RW / 2) return t > 0 ? g - 1 : -1; return t < TC - 1 ? g + 1 : -1;
}

#define XB_TMO      128
#define XB_XCNT(j)  (256  + 64 * (j))
#define XB_XSUB(j)  (1280 + 64 * (j))
#define XB_XGEN(j)  (2304 + 64 * (j))
#define XB_TOP      3328
#define XB_TOPGEN   3392
#define XCD_BAR_WORDS 3456
#define XB_SPIN_CAP (1u << 18)
__device__ __forceinline__ unsigned xb_ld(unsigned* p)              { return __hip_atomic_load(p, __ATOMIC_RELAXED, __HIP_MEMORY_SCOPE_AGENT); }
__device__ __forceinline__ unsigned xb_add(unsigned* p, unsigned v) { return __hip_atomic_fetch_add(p, v, __ATOMIC_RELAXED, __HIP_MEMORY_SCOPE_AGENT); }
__device__ __forceinline__ unsigned xb_xcc_id() { return (unsigned)__builtin_amdgcn_s_getreg((3 << 11) | 20) & 0xFu; }
#define XB_SPIN(cond, bar) do { unsigned _sp = 0; while (cond) { __builtin_amdgcn_s_sleep(1); \
    if ((++_sp & 255u) == 0u) { if (xb_ld(&(bar)[XB_TMO])) break; if (_sp > XB_SPIN_CAP) { atomicAdd(&(bar)[XB_TMO], 1u); break; } } } } while (0)
struct XcdBarrier { unsigned* bar; unsigned x; volatile LAS unsigned* st; };
__device__ __forceinline__ XcdBarrier xcd_barrier_post(unsigned* bar, volatile LAS unsigned* st) {
    XcdBarrier b; b.bar = bar; b.x = xb_xcc_id(); b.st = st;
    if (threadIdx.x == 0) (void)xb_add(&bar[XB_XCNT(b.x)], 1u);
    return b;
}
__device__ __forceinline__ void xcd_barrier_complete(unsigned* bar, unsigned x, unsigned& nloc, unsigned& nx) {
    const unsigned G = gridDim.x * gridDim.y * gridDim.z;
    unsigned sum, cnt, mine, sp = 0u;
    for (;;) {
        sum = 0u; cnt = 0u; mine = 0u;
#pragma unroll
        for (unsigned j = 0; j < 16; ++j) { const unsigned c = xb_ld(&bar[XB_XCNT(j)]); sum += c; cnt += (c > 0u) ? 1u : 0u; mine = (j == x) ? c : mine; }
        if (sum == G) break;
        __builtin_amdgcn_s_sleep(1);
        if ((++sp & 255u) == 0u) { if (xb_ld(&bar[XB_TMO])) break; if (sp > XB_SPIN_CAP) { atomicAdd(&bar[XB_TMO], 1u); break; } }
    }
    nloc = mine > 0u ? mine : 1u; nx = cnt > 0u ? cnt : 1u;
}
__device__ __forceinline__ void xcd_barrier(const XcdBarrier& b) {
    asm volatile("s_waitcnt vmcnt(0)" ::: "memory");
    __syncthreads();
    if (threadIdx.x == 0) {
        unsigned* bar = b.bar;
        __builtin_amdgcn_s_waitcnt(0);
        unsigned nloc = b.st[0], nx = b.st[1];
        if (nloc == 0u) { xcd_barrier_complete(bar, b.x, nloc, nx); b.st[0] = nloc; b.st[1] = nx; }
        const unsigned old = xb_add(&bar[XB_XSUB(b.x)], 1u);
        const unsigned gen = old / nloc;
        if (old + 1u == (gen + 1u) * nloc) {
            __builtin_amdgcn_fence(__ATOMIC_RELEASE, "agent");
            asm volatile("s_waitcnt vmcnt(0)" ::: "memory");
            const unsigned og = xb_add(&bar[XB_TOP], 1u);
            const unsigned tg = og / nx;
            if (og + 1u == (tg + 1u) * nx) xb_add(&bar[XB_TOPGEN], 1u);
            else XB_SPIN(xb_ld(&bar[XB_TOPGEN]) == tg, bar);
            __builtin_amdgcn_fence(__ATOMIC_ACQUIRE, "agent");
            xb_add(&bar[XB_XGEN(b.x)], 1u);
            asm volatile("s_waitcnt vmcnt(0)" ::: "memory");
        } else {
            XB_SPIN(xb_ld(&bar[XB_XGEN(b.x)]) == gen, bar);
            __builtin_amdgcn_fence(__ATOMIC_ACQUIRE, "agent");
            asm volatile("s_waitcnt vmcnt(0)" ::: "memory");
        }
    }
    __syncthreads();
}

namespace pg8 {
#define PG8_LAS __attribute__((address_space(3)))
typedef unsigned short bf16_t;
typedef unsigned u32x4 __attribute__((ext_vector_type(4)));
constexpr int BM = 256, BK = 64, HALF = 128, HTB = HALF * BK * 2, STAGE_BYTES = 8 * HTB, NXCD = 8, WGM = 8;
__host__ __device__ __forceinline__ int lds_byte(int r, int c) { const int st = (r >> 4) * 2 + (c >> 5), rr = r & 15, cc = c & 31, ob = rr * 64 + cc * 2; return st * 1024 + (ob ^ (((ob >> 9) & 1) << 5)); }
__host__ __device__ __forceinline__ void stage_rc(int b, int& R_, int& C) { const int st = b / 1024, sb = b % 1024, swz = sb ^ (((sb >> 9) & 1) << 5); R_ = (st >> 1) * 16 + swz / 64; C = (st & 1) * 32 + (swz % 64) / 2; }
__host__ __device__ __forceinline__ int perm32(int rho) { const int n = rho >> 4, i = rho & 15; return 8 * (i >> 2) + 4 * n + (i & 3); }
typedef int i32x8 __attribute__((ext_vector_type(8))); typedef int i32x4 __attribute__((ext_vector_type(4)));
__device__ __forceinline__ i32x8 cat8(bf16x8 lo, bf16x8 hi) { return __builtin_shufflevector(__builtin_bit_cast(i32x4, lo), __builtin_bit_cast(i32x4, hi), 0, 1, 2, 3, 4, 5, 6, 7); }
__device__ __forceinline__ void mfma8_acc(f32x4& acc, const i32x8 a, const i32x8 b) {
#if defined(__HIP_DEVICE_COMPILE__)
    const int one = 0x7F7F7F7F;
    asm volatile("v_mfma_scale_f32_16x16x128_f8f6f4 %0, %1, %2, %0, %3, %3 op_sel_hi:[0,0,0]" : "+v"(acc) : "v"(a), "v"(b), "v"(one));
#endif
}
struct Unit { int pm, pn, pb; };
struct Gemm { const bf16_t* A; const bf16_t* Bt; int M, N, K; };
struct StaticOrder {
    int nM, nN, nwg, G, c;
    __device__ void init(int M, int N, int G_, int c_) { nM = M / BM; nN = N / BM; nwg = nM * nN; G = G_; c = c_; }
    __device__ bool next(int i, Unit& u) const {
        const long L = (long)i * G + c; if (L >= nwg) return false;
        int wgid = (int)L; { const int q = nwg / NXCD, r = nwg % NXCD, xcd = wgid % NXCD, off = wgid / NXCD; wgid = (xcd < r ? xcd * (q + 1) : r * (q + 1) + (xcd - r) * q) + off; }
        const int nig = WGM * nN, gid = wgid / nig, fm = gid * WGM, gsz = (nM - fm) < WGM ? (nM - fm) : WGM;
        u.pm = fm + ((wgid % nig) % gsz); u.pn = (wgid % nig) / gsz; u.pb = u.pn; return true;
    }
    __device__ __forceinline__ void a_ready(const Unit&) const {}
    __device__ __forceinline__ void done(const Unit&) const {}
};
__device__ __forceinline__ int xcd_remap(int L, int nwg) { const int q = nwg / NXCD, r = nwg % NXCD, xcd = L % NXCD, off = L / NXCD; return (xcd < r ? xcd * (q + 1) : r * (q + 1) + (xcd - r) * q) + off; }
struct InprojLastOrder {
    int G, c;
    __device__ bool next(int i, Unit& u) const {
        const int L = i * G + c; if (L >= 64 * 34 + 4 * 22) return false;
        if (L < 64 * 34) { const int g8 = L / (8 * 34), r = L % (8 * 34); u.pm = g8 * 8 + (r % 8); u.pn = r / 8; }
        else { const int r = L - 64 * 34; u.pm = 64 + (r & 3); int q = r >> 2; q += (q >= 8) ? 4 : 0; q += (q >= 24) ? 8 : 0; u.pn = q; }
        u.pb = u.pn; return true;
    }
    __device__ __forceinline__ void a_ready(const Unit&) const {}
    __device__ __forceinline__ void done(const Unit&) const {}
};
struct InprojOrder {
    int G, c;
    __device__ bool next(int i, Unit& u) const {
        constexpr int NC = 22;
        const int L = i * G + c; if (L >= 68 * NC) return false; int q;
        if (L < 64 * NC) { const int g8 = L / (8 * NC), r = L % (8 * NC); u.pm = g8 * 8 + (r % 8); q = r / 8; }
        else { const int r = L - 64 * NC; u.pm = 64 + (r & 3); q = r >> 2; }
        u.pn = q < 8 ? q : (q < 20 ? q + 4 : q + 12); u.pb = u.pn; return true;
    }
    __device__ __forceinline__ void a_ready(const Unit&) const {}
    __device__ __forceinline__ void done(const Unit&) const {}
};
template <bool LAST> struct InprojOrder26 {
    int G, c;
    __device__ bool next(int i, Unit& u) const {
        constexpr int NC = 26, NTOT = 64 * NC + 4 * (LAST ? 22 : NC);
        const int L0 = i * G + c; if (L0 >= NTOT) return false; const int L = xcd_remap(L0, NTOT); int q;
        if (L < 64 * NC) { const int g8 = L / (8 * NC), r = L % (8 * NC); u.pm = g8 * 8 + (r % 8); q = r / 8; }
        else { const int r = L - 64 * NC; u.pm = 64 + (r & 3); q = r >> 2; if (LAST) q += (q >= 8) ? 4 : 0; }
        u.pn = q < 24 ? q : q + 8; u.pb = u.pn; return true;
    }
    __device__ __forceinline__ void a_ready(const Unit&) const {}
    __device__ __forceinline__ void done(const Unit&) const {}
};
template <bool LAST> struct MgtOrder {
    int G, c;
    __device__ bool next(int i, Unit& u) const {
        const int L0 = i * G + c; if (L0 >= (LAST ? 512 : 544)) return false; const int L = xcd_remap(L0, LAST ? 512 : 544);
        if (L < 512) { const int g8 = L >> 6, r = L & 63; u.pm = g8 * 8 + (r & 7); u.pn = 24 + (r >> 3); } else { const int r = L - 512; u.pm = 64 + (r & 3); u.pn = 24 + (r >> 2); }
        u.pb = u.pn; return true;
    }
    __device__ __forceinline__ void a_ready(const Unit&) const {}
    __device__ __forceinline__ void done(const Unit&) const {}
};
template <bool LAST> struct LateInprojOrder {
    int G, c;
    __device__ bool next(int i, Unit& u) const {
        const int L = i * G + c; if (L >= (LAST ? 64 : 68) * 12) return false; int q;
        if (L < 64 * 12) { const int g8 = L / 96, r = L % 96; u.pm = g8 * 8 + (r & 7); q = r >> 3; } else { const int r = L - 64 * 12; u.pm = 64 + (r & 3); q = r >> 2; }
        u.pn = q < 4 ? 8 + q : 20 + q; u.pb = u.pn; return true;
    }
    __device__ __forceinline__ void a_ready(const Unit&) const {}
    __device__ __forceinline__ void done(const Unit&) const {}
};
struct CtxSliceOrder {
    int nS, G, c;
    __device__ bool next(int i, Unit& u) const { const int L = i * G + c; if (L >= 16 * nS) return false; const int s = L >> 4, r = L & 15; u.pm = 4 * s + (r >> 2); u.pn = r & 3; u.pb = 4 * s + (r & 3); return true; }
    __device__ __forceinline__ void a_ready(const Unit&) const {}
    __device__ __forceinline__ void done(const Unit&) const {}
};
struct MoeOrder {
    int ntiles, nN, nwg, G, c; const int* texp;
    int lo0, lo1, b4, b5;
    __device__ bool next(int i, Unit& u) const {
        const long L = (long)i * G + c; if (L >= nwg) return false;
        { const int wgid = xcd_remap((int)L, nwg), nig = WGM * nN, gid = wgid / nig, fm = gid * WGM, gsz = (ntiles - fm) < WGM ? (ntiles - fm) : WGM;
          u.pm = fm + ((wgid % nig) % gsz); u.pn = (wgid % nig) / gsz; }
        const int e = __builtin_amdgcn_readfirstlane(texp[u.pm]);
        u.pb = (e < 4 ? lo0 + e * lo1 : e == 4 ? b4 : e == 5 ? b5 : (e - 6) * lo1) + u.pn; return true;
    }
    __device__ __forceinline__ void a_ready(const Unit&) const {}
    __device__ __forceinline__ void done(const Unit&) const {}
};
template <class Epi, class Sched, bool ALIGN_EPI = false, bool SP2 = false, bool FP8 = false>
__device__ __forceinline__ void gemm_phase(PG8_LAS unsigned char* lds, const Gemm g, const Sched& S, const Epi& E) {
    int tid_ = threadIdx.x; asm volatile("" : "+v"(tid_));
    const int tid = tid_, wid = __builtin_amdgcn_readfirstlane(tid >> 6), lane = tid & 63, wr = wid >> 2, wc = wid & 3, fr = lane & 15, fq = lane >> 4;
    const int K = g.K, nt = K / BK;
    unsigned voffA[2], voffB[2];
#pragma unroll
    for (int i = 0; i < 2; ++i) { int R, C; stage_rc(tid * 16 + i * 8192, R, C); const int Rb = Epi::PERM ? ((R & ~31) + perm32(R & 31)) : R;
        voffA[i] = (unsigned)(R * K + C) * 2u; voffB[i] = (unsigned)(Rb * K + C) * 2u; }
    const size_t kstep = (size_t)(BK * 2);
    const size_t hstep = (size_t)HALF * K * 2;
    const size_t tstep = 2 * hstep;
    const unsigned ldsw = (unsigned)wid * 1024u;
    const int aoff = lds_byte(wr * 64 + fr, fq * 8), boff = lds_byte(wc * 32 + fr, fq * 8);
#define PG8_SA(b, h) (((b) * 2 + (h)) * HTB)
#define PG8_SB(b, h) ((4 + (b) * 2 + (h)) * HTB)
#define PG8_STAGE(bufoff, gbase, voff) do { _Pragma("unroll") for (int _i = 0; _i < 2; ++_i) \
        __builtin_amdgcn_global_load_lds((const unsigned*)((const char*)(gbase) + (voff)[_i]), (PG8_LAS unsigned*)(lds + (bufoff) + ldsw + _i * 8192), 16, 0, 0); } while (0)
#define PG8_LDA(dst, b, h) do { _Pragma("unroll") for (int m = 0; m < 4; ++m) { if constexpr (FP8) dst##8[m] = cat8(*(const PG8_LAS bf16x8*)(lds + PG8_SA(b, h) + aoff + m * 2048), *(const PG8_LAS bf16x8*)(lds + PG8_SA(b, h) + aoff + m * 2048 + 1024)); \
        else { _Pragma("unroll") for (int k = 0; k < 2; ++k) dst[m][k] = *(const PG8_LAS bf16x8*)(lds + PG8_SA(b, h) + aoff + m * 2048 + k * 1024); } } } while (0)
#define PG8_LDB(dst, b, h) do { _Pragma("unroll") for (int n = 0; n < 2; ++n) { if constexpr (FP8) dst##8[n] = cat8(*(const PG8_LAS bf16x8*)(lds + PG8_SB(b, h) + boff + n * 2048), *(const PG8_LAS bf16x8*)(lds + PG8_SB(b, h) + boff + n * 2048 + 1024)); \
        else { _Pragma("unroll") for (int k = 0; k < 2; ++k) dst[n][k] = *(const PG8_LAS bf16x8*)(lds + PG8_SB(b, h) + boff + n * 2048 + k * 1024); } } } while (0)
#define PG8_MMA(ai, bj, At, Bt) do { __builtin_amdgcn_s_setprio(1); if constexpr (FP8) { _Pragma("unroll") for (int m = 0; m < 4; ++m) _Pragma("unroll") for (int n = 0; n < 2; ++n) \
        mfma8_acc(acc[ai][bj][m][n], Bt##8[n], At##8[m]); } else { \
        _Pragma("unroll") for (int m = 0; m < 4; ++m) _Pragma("unroll") for (int n = 0; n < 2; ++n) _Pragma("unroll") for (int k = 0; k < 2; ++k) \
        acc[ai][bj][m][n] = __builtin_amdgcn_mfma_f32_16x16x32_bf16(Bt[n][k], At[m][k], acc[ai][bj][m][n], 0, 0, 0); } __builtin_amdgcn_s_setprio(0); } while (0)
#define PG8_WAIT_V(n) asm volatile("s_waitcnt vmcnt(" #n ")" ::: "memory")
#define PG8_WAIT_L(n) asm volatile("s_waitcnt lgkmcnt(" #n ")" ::: "memory")
#define PG8_BAR __builtin_amdgcn_s_barrier()
#define PG8_SCHED __builtin_amdgcn_sched_barrier(0)
    Unit cur, nxt; int ui = 0;
    if (!S.next(0, cur)) return;
    f32x4 acc[2][2][4][2];
#pragma unroll
    for (int a = 0; a < 2; ++a)
#pragma unroll
        for (int b = 0; b < 2; ++b)
#pragma unroll
            for (int m = 0; m < 4; ++m)
#pragma unroll
                for (int n = 0; n < 2; ++n) acc[a][b][m][n] = (f32x4){0.f, 0.f, 0.f, 0.f};
    bf16x8 At[4][2], B0[2][2], B1[2][2]; i32x8 At8[4], B08[2], B18[2];
    const char* cA = (const char*)g.A + (size_t)cur.pm * tstep; const char* cB = (const char*)g.Bt + (size_t)cur.pb * tstep;
    S.a_ready(cur);
    if constexpr (SP2) {
        PG8_STAGE(PG8_SB(0, 0), cB, voffB); PG8_STAGE(PG8_SB(0, 1), cB + hstep, voffB); PG8_STAGE(PG8_SA(0, 0), cA, voffA); PG8_STAGE(PG8_SA(0, 1), cA + hstep, voffA);
        if (wr == 1) PG8_BAR;
        PG8_WAIT_V(2); PG8_BAR;
        PG8_STAGE(PG8_SB(1, 0), cB + kstep, voffB); PG8_STAGE(PG8_SA(1, 0), cA + kstep, voffA); PG8_STAGE(PG8_SB(1, 1), cB + hstep + kstep, voffB);
        PG8_WAIT_V(6); PG8_BAR;
    } else {
        PG8_STAGE(PG8_SB(0, 0), cB, voffB); PG8_STAGE(PG8_SA(0, 0), cA, voffA); PG8_STAGE(PG8_SB(0, 1), cB + hstep, voffB); PG8_STAGE(PG8_SA(0, 1), cA + hstep, voffA);
        if (wr == 1) PG8_BAR;
        PG8_WAIT_V(4); PG8_BAR;
        PG8_STAGE(PG8_SB(1, 0), cB + kstep, voffB); PG8_STAGE(PG8_SA(1, 0), cA + kstep, voffA); PG8_STAGE(PG8_SB(1, 1), cB + hstep + kstep, voffB);
        PG8_WAIT_V(6); PG8_BAR;
    }
    for (;;) {
        const bool has_next = S.next(ui + 1, nxt);
        const char* nA = has_next ? (const char*)g.A + (size_t)nxt.pm * tstep : cA; const char* nB = has_next ? (const char*)g.Bt + (size_t)nxt.pb * tstep : cB;
        for (int t = 0; t < nt; t += 2) {
            const bool last = (t == nt - 2);
            const char* a1 = cA + (size_t)(t + 1) * kstep;
            const char* a2 = last ? nA : cA + (size_t)(t + 2) * kstep; const char* b2 = last ? nB : cB + (size_t)(t + 2) * kstep;
            const char* a3 = a2 + kstep; const char* b3 = b2 + kstep;
            if (last && has_next) S.a_ready(nxt);
            if constexpr (SP2) {
            PG8_LDB(B0, 0, 0); PG8_LDB(B1, 0, 1); PG8_SCHED; PG8_LDA(At, 0, 0); PG8_STAGE(PG8_SA(1, 1), a1 + hstep, voffA);
            PG8_WAIT_V(8); PG8_WAIT_L(0); PG8_BAR; PG8_MMA(0, 0, At, B0); PG8_MMA(0, 1, At, B1); PG8_BAR; PG8_SCHED;
            PG8_LDA(At, 0, 1); PG8_STAGE(PG8_SB(0, 0), b2, voffB); PG8_STAGE(PG8_SB(0, 1), b2 + hstep, voffB); PG8_STAGE(PG8_SA(0, 0), a2, voffA);
            PG8_WAIT_V(8); PG8_WAIT_L(0); PG8_BAR; PG8_MMA(1, 0, At, B0); PG8_MMA(1, 1, At, B1); PG8_BAR; PG8_SCHED;
            PG8_LDB(B0, 1, 0); PG8_LDB(B1, 1, 1); PG8_SCHED; PG8_LDA(At, 1, 0); PG8_STAGE(PG8_SA(0, 1), a2 + hstep, voffA);
            PG8_WAIT_V(8); PG8_WAIT_L(0); PG8_BAR; PG8_MMA(0, 0, At, B0); PG8_MMA(0, 1, At, B1); PG8_BAR; PG8_SCHED;
            PG8_LDA(At, 1, 1); PG8_STAGE(PG8_SB(1, 0), b3, voffB); PG8_STAGE(PG8_SB(1, 1), b3 + hstep, voffB); PG8_STAGE(PG8_SA(1, 0), a3, voffA);
            PG8_WAIT_V(8); PG8_WAIT_L(0); PG8_BAR; PG8_MMA(1, 0, At, B0); PG8_MMA(1, 1, At, B1); PG8_BAR; PG8_SCHED;
            } else {
            PG8_LDB(B0, 0, 0); PG8_SCHED; PG8_LDA(At, 0, 0); PG8_STAGE(PG8_SA(1, 1), a1 + hstep, voffA);
            PG8_WAIT_L(8); PG8_BAR; PG8_WAIT_L(0); PG8_MMA(0, 0, At, B0); PG8_BAR; PG8_SCHED;
            PG8_LDB(B1, 0, 1); PG8_STAGE(PG8_SB(0, 0), b2, voffB);
            PG8_BAR; PG8_WAIT_L(0); PG8_MMA(0, 1, At, B1); PG8_BAR;
            PG8_LDA(At, 0, 1); PG8_STAGE(PG8_SA(0, 0), a2, voffA);
            PG8_BAR; PG8_WAIT_L(0); PG8_MMA(1, 0, At, B0); PG8_BAR; PG8_SCHED;
            PG8_STAGE(PG8_SB(0, 1), b2 + hstep, voffB);
            PG8_WAIT_V(6); PG8_BAR; PG8_MMA(1, 1, At, B1); PG8_BAR;
            PG8_LDB(B0, 1, 0); PG8_SCHED; PG8_LDA(At, 1, 0); PG8_STAGE(PG8_SA(0, 1), a2 + hstep, voffA);
            PG8_WAIT_L(8); PG8_BAR; PG8_WAIT_L(0); PG8_MMA(0, 0, At, B0); PG8_BAR; PG8_SCHED;
            PG8_LDB(B1, 1, 1); PG8_STAGE(PG8_SB(1, 0), b3, voffB);
            PG8_BAR; PG8_WAIT_L(0); PG8_MMA(0, 1, At, B1); PG8_BAR;
            PG8_LDA(At, 1, 1); PG8_STAGE(PG8_SA(1, 0), a3, voffA);
            PG8_BAR; PG8_WAIT_L(0); PG8_MMA(1, 0, At, B0); PG8_BAR; PG8_SCHED;
            PG8_STAGE(PG8_SB(1, 1), b3 + hstep, voffB);
            PG8_WAIT_V(6); PG8_BAR; PG8_MMA(1, 1, At, B1); PG8_BAR;
            }
        }
        if constexpr (ALIGN_EPI) { if (wr == 0) PG8_BAR; }
        if constexpr (FP8) asm volatile("s_nop 15\n\ts_nop 15\n\ts_nop 15\n\ts_nop 15" ::: "memory");
        if constexpr (!Epi::AFTER_DRAIN) { E(acc, cur, wr, wc, fr, fq); S.done(cur); }
        if (!has_next) break;
#pragma unroll
        for (int a = 0; a < 2; ++a)
#pragma unroll
            for (int b = 0; b < 2; ++b)
#pragma unroll
                for (int m = 0; m < 4; ++m)
#pragma unroll
                    for (int n = 0; n < 2; ++n) acc[a][b][m][n] = (f32x4){0.f, 0.f, 0.f, 0.f};
        cur = nxt; cA = nA; cB = nB; ++ui;
        if constexpr (ALIGN_EPI) { if (wr == 1) PG8_BAR; }
    }
    PG8_WAIT_V(0);
    if constexpr (!ALIGN_EPI) { if (wr == 0) PG8_BAR; }
    PG8_BAR;
    if constexpr (Epi::AFTER_DRAIN) { E.fused(acc, cur, wr, wc, fr, fq, lds, wid, lane); S.done(cur); }
#undef PG8_SA
#undef PG8_SB
#undef PG8_STAGE
#undef PG8_LDA
#undef PG8_LDB
#undef PG8_MMA
#undef PG8_WAIT_V
#undef PG8_WAIT_L
#undef PG8_BAR
#undef PG8_SCHED
}

__device__ __forceinline__ u32x4 pack_acc8(const f32x4 v0, const f32x4 v1) { u32x4 w; w.x = cvt_pk_bf16(v0[0], v0[1]); w.y = cvt_pk_bf16(v0[2], v0[3]); w.z = cvt_pk_bf16(v1[0], v1[1]); w.w = cvt_pk_bf16(v1[2], v1[3]); return w; }
#define EPI_LOOP_BEGIN  _Pragma("unroll") for (int ai = 0; ai < 2; ++ai) _Pragma("unroll") for (int m = 0; m < 4; ++m) { const int rloc = ai * HALF + wr * 64 + m * 16 + fr; \
                        _Pragma("unroll") for (int bj = 0; bj < 2; ++bj) { const int cloc = bj * HALF + wc * 32 + 8 * fq; const f32x4 v0 = acc[ai][bj][m][0], v1 = acc[ai][bj][m][1];
#define EPI_LOOP_END    } asm volatile("" ::: "memory"); }

struct EpiInproj {
    static constexpr bool PERM = true, AFTER_DRAIN = false;
    GAS unsigned char* ws;
    __device__ __forceinline__ void operator()(const f32x4 (&acc)[2][2][4][2], const Unit& u, int wr, int wc, int fr, int fq) const {
        const int pn = u.pn; size_t off; int ld, ct;
        if (pn < 2) { off = WS_Q; ld = 512; ct = pn; } else if (pn < 4) { off = WS_K; ld = 512; ct = pn - 2; } else if (pn < 8) { off = WS_V; ld = 1024; ct = pn - 4; }
        else if (pn < 12) { off = WS_O; ld = 1024; ct = pn - 8; } else if (pn < 24) { off = WS_RKV; ld = 3072; ct = pn - 12; } else if (pn < 32) { off = WS_MGT; ld = 2048; ct = pn - 24; } else { off = WS_SM; ld = SMW * 2; ct = pn - 32; }
        const size_t row0 = (size_t)u.pm * BM;
        if (pn < 32) {
            bf16_t* base = (bf16_t*)(ws + off) + row0 * ld + ct * BM;
            EPI_LOOP_BEGIN
                *(u32x4*)(base + (size_t)rloc * ld + cloc) = pack_acc8(v0, v1);
            EPI_LOOP_END
        } else {
            float* sb = (float*)(ws + off) + row0 * SMW + ct * BM;
            EPI_LOOP_BEGIN
                float* p = sb + (size_t)rloc * SMW + cloc; *(f32x4*)p = v0; *(f32x4*)(p + 4) = v1;
            EPI_LOOP_END
        }
    }
};
struct EpiStore {
    static constexpr bool PERM = true, AFTER_DRAIN = false;
    bf16_t* C; int ldc;
    __device__ __forceinline__ void operator()(const f32x4 (&acc)[2][2][4][2], const Unit& u, int wr, int wc, int fr, int fq) const {
        const size_t row0 = (size_t)u.pm * BM; const int col0 = u.pn * BM;
        EPI_LOOP_BEGIN
            *(u32x4*)(C + (row0 + rloc) * ldc + col0 + cloc) = pack_acc8(v0, v1);
        EPI_LOOP_END
    }
};
template <int STEP> struct EpiMerge {
    static constexpr bool PERM = true, AFTER_DRAIN = false;
    const bf16_t* MGT; bf16_t* T1; bf16_t* OUT;
    __device__ __forceinline__ void operator()(const f32x4 (&acc)[2][2][4][2], const Unit& u, int wr, int wc, int fr, int fq) const {
        const size_t row0 = (size_t)u.pm * BM; const int col0 = u.pn * BM;
        EPI_LOOP_BEGIN
            const size_t row = row0 + rloc; const int col = col0 + cloc;
            const u32x4 gw = *(const u32x4*)(MGT + row * 2048 + (STEP ? 1024 : 0) + col); float g[8]; unpack8(gw, g);
            float o[8] = {v0[0], v0[1], v0[2], v0[3], v1[0], v1[1], v1[2], v1[3]};
#pragma unroll
            for (int j = 0; j < 8; ++j) o[j] *= sigmoidf_(g[j]);
            if (STEP) { const u32x4 tw = *(const u32x4*)(T1 + row * 1024 + col); float tt[8]; unpack8(tw, tt);
#pragma unroll
                for (int j = 0; j < 8; ++j) o[j] += tt[j]; }
            *(u32x4*)((STEP ? OUT : T1) + row * 1024 + col) = pack8(o);
        EPI_LOOP_END
    }
};
struct EpiResid {
    static constexpr bool PERM = true, AFTER_DRAIN = false;
    const float* src_lat; const float* src_ctx; float* dst_lat; float* dst_ctx; const float* gate;
    __device__ __forceinline__ void operator()(const f32x4 (&acc)[2][2][4][2], const Unit& u, int wr, int wc, int fr, int fq) const {
        const int row0 = u.pm * BM, col0 = u.pn * BM; const bool lat = row0 < RL;
        const float* sb = lat ? src_lat : src_ctx - (size_t)RL * D; float* db = lat ? dst_lat : dst_ctx - (size_t)RL * D;
        const float* gt = gate + (lat ? row0 / T : 4) * 6 * D;
        EPI_LOOP_BEGIN
            const size_t off = (size_t)(row0 + rloc) * D + col0 + cloc; const int col = col0 + cloc;
            const f32x4 g0 = *(const f32x4*)(gt + col), g1 = *(const f32x4*)(gt + col + 4), s0 = *(const f32x4*)(sb + off), s1 = *(const f32x4*)(sb + off + 4);
            *(f32x4*)(db + off) = s0 + g0 * v0; *(f32x4*)(db + off + 4) = s1 + g1 * v1;
        EPI_LOOP_END
    }
};
struct EpiSwiglu {
    static constexpr bool PERM = true, AFTER_DRAIN = false;
    bf16_t* HH; int ldc;
    __device__ __forceinline__ void operator()(const f32x4 (&acc)[2][2][4][2], const Unit& u, int wr, int wc, int fr, int fq) const {
        const size_t row0 = (size_t)u.pm * BM; const int col0 = u.pn * HALF + wc * 32 + 8 * fq;
#pragma unroll
        for (int ai = 0; ai < 2; ++ai)
#pragma unroll
            for (int m = 0; m < 4; ++m) { const int rloc = ai * HALF + wr * 64 + m * 16 + fr; float o[8];
#pragma unroll
                for (int n = 0; n < 2; ++n)
#pragma unroll
                    for (int j = 0; j < 4; ++j) o[4 * n + j] = siluf_(acc[ai][0][m][n][j]) * acc[ai][1][m][n][j];
                *(u32x4*)(HH + (row0 + rloc) * ldc + col0) = pack8(o); asm volatile("" ::: "memory"); }
    }
};

struct EpiSwigluCtx {
    static constexpr bool PERM = true, AFTER_DRAIN = false;
    bf16_t* HH; int ldc; bf16_t* HHc; int ctx_from;
    __device__ __forceinline__ void operator()(const f32x4 (&acc)[2][2][4][2], const Unit& u, int wr, int wc, int fr, int fq) const {
        const bool cx = u.pm >= ctx_from;
        const size_t offc = ((size_t)(u.pn >> 1) * 1024 + (size_t)(u.pm - ctx_from) * BM) * 256 + (u.pn & 1) * HALF + wc * 32 + 8 * fq + (size_t)(HHc - HH), offn = (size_t)u.pm * BM * ldc + u.pn * HALF + wc * 32 + 8 * fq;
        bf16_t* base = HH + (cx ? offc : offn); const int ld = cx ? 256 : ldc;
#pragma unroll
        for (int ai = 0; ai < 2; ++ai)
#pragma unroll
            for (int m = 0; m < 4; ++m) { const int rloc = ai * HALF + wr * 64 + m * 16 + fr; float o[8];
#pragma unroll
                for (int n = 0; n < 2; ++n)
#pragma unroll
                    for (int j = 0; j < 4; ++j) o[4 * n + j] = siluf_(acc[ai][0][m][n][j]) * acc[ai][1][m][n][j];
                *(u32x4*)(base + (size_t)rloc * ld) = pack8(o); asm volatile("" ::: "memory"); }
    }
};
struct EpiSlab {
    static constexpr bool PERM = true, AFTER_DRAIN = false;
    float* slab; const float* gate;
    __device__ __forceinline__ void operator()(const f32x4 (&acc)[2][2][4][2], const Unit& u, int wr, int wc, int fr, int fq) const {
        float* base = slab + ((size_t)(u.pm >> 2) * 1024 + (size_t)(u.pm & 3) * BM) * D + u.pn * BM;
        EPI_LOOP_BEGIN
            const int col = u.pn * BM + cloc; const f32x4 g0 = *(const f32x4*)(gate + col), g1 = *(const f32x4*)(gate + col + 4);
            float* p = base + (size_t)rloc * D + cloc; *(f32x4*)p = g0 * v0; *(f32x4*)(p + 4) = g1 * v1;
        EPI_LOOP_END
    }
};

struct EpiSwiglu8 {
    static constexpr bool PERM = true, AFTER_DRAIN = false;
    unsigned char* HH; int ldc;
    __device__ __forceinline__ void operator()(const f32x4 (&acc)[2][2][4][2], const Unit& u, int wr, int wc, int fr, int fq) const {
        const size_t row0 = (size_t)u.pm * BM; const int col0 = u.pn * HALF + wc * 32 + 8 * fq; const float is = 1.0f / W8S;
#pragma unroll
        for (int ai = 0; ai < 2; ++ai)
#pragma unroll
            for (int m = 0; m < 4; ++m) { const int rloc = ai * HALF + wr * 64 + m * 16 + fr; float o[8];
#pragma unroll
                for (int n = 0; n < 2; ++n)
#pragma unroll
                    for (int j = 0; j < 4; ++j) o[4 * n + j] = __builtin_amdgcn_fmed3f(siluf_(acc[ai][0][m][n][j] * is) * (acc[ai][1][m][n][j] * is), -448.0f, 448.0f);
                v2u w; w.x = (unsigned)__builtin_amdgcn_cvt_pk_fp8_f32(o[0], o[1], 0, false); w.x = (unsigned)__builtin_amdgcn_cvt_pk_fp8_f32(o[2], o[3], (int)w.x, true);
                w.y = (unsigned)__builtin_amdgcn_cvt_pk_fp8_f32(o[4], o[5], 0, false); w.y = (unsigned)__builtin_amdgcn_cvt_pk_fp8_f32(o[6], o[7], (int)w.y, true);
                *(v2u*)(HH + (row0 + rloc) * ldc + col0) = w; asm volatile("" ::: "memory"); }
    }
};
struct EpiStoreScaled {
    static constexpr bool PERM = true, AFTER_DRAIN = false;
    bf16_t* C; int ldc; float s;
    __device__ __forceinline__ void operator()(const f32x4 (&acc)[2][2][4][2], const Unit& u, int wr, int wc, int fr, int fq) const {
        const size_t row0 = (size_t)u.pm * BM; const int col0 = u.pn * BM;
        EPI_LOOP_BEGIN
            *(u32x4*)(C + (row0 + rloc) * ldc + col0 + cloc) = pack_acc8(v0 * s, v1 * s);
        EPI_LOOP_END
    }
};

}

struct Args { const GAS float* in[33]; GAS float* out; GAS unsigned char* ws; int ph_lo, ph_hi, li, pad; };
#define CAS __attribute__((address_space(4)))
#define INP(i) ((const float*)F.A->in[i])
constexpr int NWAVES = 8, NTHREADS = 512;
struct Frame {
    LAS unsigned char* lds; volatile LAS unsigned* MISC; gu32* ctl;
    int tid, lane, wave, G, bid;
    int cb, cg;
    GAS unsigned char* ws; GAS float* out;
    const CAS Args* A;
};
enum { I_X = 0, I_C, I_CTX, I_CCTX, I_WADA, I_BADA, I_GNM, I_GNF, I_WIN, I_BG, I_GMN, I_MU, I_W0, I_W2, I_A0, I_A2, I_G2, I_KK, I_KA, I_RK, I_LNW, I_LNB, I_WPM, I_WPR, I_WOUT,
       I_FFG, I_FFU, I_FFD, I_WR, I_EG, I_EU, I_ED, I_GF };

typedef short cv_s16x4 __attribute__((ext_vector_type(4)));
constexpr int CVP = 40;
__device__ __forceinline__ void conv_park(const float* W, int ldw, int c0, int k0, LAS bf16* X, int lane, float scale, bool clamp) {
    const int r = lane >> 3, cg = lane & 7; f32x4 v[8];
#pragma unroll
    for (int i = 0; i < 8; ++i) v[i] = *(const f32x4*)(W + (size_t)(k0 + r + 8 * i) * ldw + c0 + 4 * cg);
#pragma unroll
    for (int i = 0; i < 8; ++i) { f32x4 t = v[i] * scale; if (clamp) { t.x = __builtin_amdgcn_fmed3f(t.x, -448.0f, 448.0f); t.y = __builtin_amdgcn_fmed3f(t.y, -448.0f, 448.0f); t.z = __builtin_amdgcn_fmed3f(t.z, -448.0f, 448.0f); t.w = __builtin_amdgcn_fmed3f(t.w, -448.0f, 448.0f); }
        v2u o; o.x = cvt_pk_bf16(t.x, t.y); o.y = cvt_pk_bf16(t.z, t.w); *(LAS v2u*)(X + (r + 8 * i) * CVP + 4 * cg) = o; }
    LDS_WAIT(); asm volatile("" ::: "memory");
}
__device__ __forceinline__ v2u conv_tr(const LAS bf16* X, int krow, int ncol, int i16) {
    return __builtin_bit_cast(v2u, __builtin_amdgcn_ds_read_tr16_b64_v4i16((LAS cv_s16x4*)(X + (krow + (i16 >> 2)) * CVP + ncol + 4 * (i16 & 3))));
}
__device__ __forceinline__ void conv_item(const float* W, int ldw, int c0, int k0, bf16* dst, int ldd, int r0, LAS float* scr, int lane) {
    LAS bf16* X = (LAS bf16*)scr; conv_park(W, ldw, c0, k0, X, lane, 1.0f, false);
    const int g = lane >> 4, i16 = lane & 15;
#pragma unroll
    for (int j = 0; j < 4; ++j) { const int n = 16 * (j & 1) + i16, k8 = 8 * (g + 4 * (j >> 1));
        const v2u a = conv_tr(X, k8, 16 * (j & 1), i16), b = conv_tr(X, k8 + 4, 16 * (j & 1), i16); const v4u o = {a.x, a.y, b.x, b.y};
        *(v4u*)(dst + (size_t)(r0 + n) * ldd + k0 + k8) = o; }
    LDS_WAIT(); asm volatile("" ::: "memory");
}
__device__ __forceinline__ unsigned pk4_fp8(float a, float b, float c, float d) { int w = __builtin_amdgcn_cvt_pk_fp8_f32(a, b, 0, false); w = __builtin_amdgcn_cvt_pk_fp8_f32(c, d, w, true); return (unsigned)w; }
__device__ __forceinline__ void conv_item8(const float* W, int ldw, int c0, int k0, unsigned char* dst, int ldd, int r0, float scale, LAS float* scr, int lane) {
    LAS bf16* X = (LAS bf16*)scr; conv_park(W, ldw, c0, k0, X, lane, scale, true);
    const int g = lane >> 4, i16 = lane & 15;
#pragma unroll
    for (int j = 0; j < 2; ++j) { const int n = 16 * j + i16, k16 = 16 * g; v4u o;
#pragma unroll
        for (int q = 0; q < 4; ++q) { const v2u a = conv_tr(X, k16 + 4 * q, 16 * j, i16); o[q] = pk4_fp8(bflo(a.x), bfhi(a.x), bflo(a.y), bfhi(a.y)); }
        *(v4u*)(dst + (size_t)(r0 + n) * ldd + k0 + k16) = o; }
    LDS_WAIT(); asm volatile("" ::: "memory");
}
__device__ __forceinline__ void conv_seg8(Frame& F, const float* W, int ldw, int K, int c0, int ncols, unsigned char* dst, int ldd, int r0, float scale, int& rot) {
    LAS float* scr = (LAS float*)(F.lds + F.wave * 16384);
    const int NGW = F.cg * NWAVES, nblk = ncols / 32, nitems = (K / 64) * nblk;
    int gw = (F.cb * NWAVES + F.wave + rot) % NGW;
    for (int it = gw; it < nitems; it += NGW) { const int kb = it / nblk, nb = it % nblk; conv_item8(W, ldw, c0 + 32 * nb, 64 * kb, dst, ldd, r0 + 32 * nb, scale, scr, F.lane); }
    rot = (rot + nitems) % NGW;
}
__device__ __forceinline__ void conv_gu8(Frame& F, const float* Wg, const float* Wu, int ldw, int K, int ngroups, unsigned char* dst, float scale, int& rot) {
    LAS float* scr = (LAS float*)(F.lds + F.wave * 16384);
    const int NGW = F.cg * NWAVES, kblk = K / 64, nitems = ngroups * 2 * 4 * kblk;
    int gw = (F.cb * NWAVES + F.wave + rot) % NGW;
    for (int it = gw; it < nitems; it += NGW) { const int kb = it % kblk, r = it / kblk, nb = r & 3, which = (r >> 2) & 1, p = r >> 3;
        conv_item8(which ? Wu : Wg, ldw, 128 * p + 32 * nb, 64 * kb, dst, K, 256 * p + 128 * which + 32 * nb, scale, scr, F.lane); }
    rot = (rot + nitems) % NGW;
}
__device__ __forceinline__ void conv_ffd_dual(Frame& F, const float* W, bf16* dst, bf16* dsts, int& rot) {
    LAS float* scr = (LAS float*)(F.lds + F.wave * 16384);
    const int NGW = F.cg * NWAVES, nblk = D / 32, nitems = (FF / 64) * nblk; const int lane = F.lane;
    int gw = (F.cb * NWAVES + F.wave + rot) % NGW;
    for (int it = gw; it < nitems; it += NGW) { const int kb = it / nblk, nb = it % nblk, k0 = 64 * kb, c0 = 32 * nb;
        LAS bf16* X = (LAS bf16*)scr; conv_park(W, D, c0, k0, X, lane, 1.0f, false);
        const int g = lane >> 4, i16 = lane & 15;
#pragma unroll
        for (int j = 0; j < 4; ++j) { const int n = 16 * (j & 1) + i16, k8 = 8 * (g + 4 * (j >> 1));
            const v2u a = conv_tr(X, k8, 16 * (j & 1), i16), b = conv_tr(X, k8 + 4, 16 * (j & 1), i16); const v4u o = {a.x, a.y, b.x, b.y};
            *(v4u*)(dst + (size_t)(c0 + n) * FF + k0 + k8) = o;
            *(v4u*)(dsts + ((size_t)(k0 >> 8) * 1024 + c0 + n) * 256 + (k0 & 255) + k8) = o; }
        LDS_WAIT(); asm volatile("" ::: "memory"); }
    rot = (rot + nitems) % NGW;
}
__device__ __forceinline__ void conv_seg(Frame& F, const float* W, int ldw, int K, int c0, int ncols, bf16* dst, int ldd, int r0, int& rot) {
    LAS float* scr = (LAS float*)(F.lds + F.wave * 16384);
    const int NGW = F.cg * NWAVES, nblk = ncols / 32, nitems = (K / 64) * nblk;
    int gw = (F.cb * NWAVES + F.wave + rot) % NGW;
    for (int it = gw; it < nitems; it += NGW) { const int kb = it / nblk, nb = it % nblk; conv_item(W, ldw, c0 + 32 * nb, 64 * kb, dst, ldd, r0 + 32 * nb, scr, F.lane); }
    rot = (rot + nitems) % NGW;
}
__device__ __forceinline__ void conv_gu(Frame& F, const float* Wg, const float* Wu, int ldw, int K, int ngroups, bf16* dst, int& rot) {
    LAS float* scr = (LAS float*)(F.lds + F.wave * 16384);
    const int NGW = F.cg * NWAVES, kblk = K / 64, nitems = ngroups * 2 * 4 * kblk;
    int gw = (F.cb * NWAVES + F.wave + rot) % NGW;
    for (int it = gw; it < nitems; it += NGW) { const int kb = it % kblk, r = it / kblk, nb = r & 3, which = (r >> 2) & 1, p = r >> 3;
        conv_item(which ? Wu : Wg, ldw, 128 * p + 32 * nb, 64 * kb, dst, K, 256 * p + 128 * which + 32 * nb, scr, F.lane); }
    rot = (rot + nitems) % NGW;
}
__device__ __forceinline__ void zero_bf16_rows(Frame& F, bf16* dst, size_t n16) {
    const v4u z = {0u, 0u, 0u, 0u};
    for (size_t i = (size_t)F.cb * NTHREADS + F.tid; i < n16; i += (size_t)F.cg * NTHREADS) ((v4u*)dst)[i] = z;
}
__device__ __forceinline__ void conv_win(Frame& F, int l) {
    int rot = 0; GAS unsigned char* ws = F.ws;
    bf16* WIN = (bf16*)(ws + WS_WIN); const float* win = INP(I_WIN) + (size_t)l * D * DIN;
    conv_seg(F, win, DIN, D, 0, 3072, WIN, D, 0, rot);
    conv_seg(F, win, DIN, D, 3104, 3072, WIN, D, 3072, rot);
    conv_seg(F, win, DIN, D, 6560, 2048, WIN, D, 6144, rot);
    conv_seg(F, win, DIN, D, 3072, 32, WIN, D, 8192, rot);
    conv_seg(F, win, DIN, D, 6176, 384, WIN, D, 8192 + 32, rot);
    zero_bf16_rows(F, WIN + (size_t)(8192 + 416) * D, (size_t)96 * D * 2 / 16);
}
__device__ __forceinline__ void conv_rest(Frame& F, int l) {
    int rot = 0; GAS unsigned char* ws = F.ws;
    conv_seg(F, INP(I_WPM) + (size_t)l * D * D, D, D, 0, D, (bf16*)(ws + WS_WPM), D, 0, rot);
    conv_seg(F, INP(I_WPR) + (size_t)l * D * D, D, D, 0, D, (bf16*)(ws + WS_WPR), D, 0, rot);
    conv_seg(F, INP(I_WOUT) + (size_t)l * D * D, D, D, 0, D, (bf16*)(ws + WS_WOUT), D, 0, rot);
    { bf16* WG2 = (bf16*)(ws + WS_WG2);
      conv_seg(F, INP(I_G2) + (size_t)l * 128 * RD, RD, 128, 0, RD, WG2, 256, 0, rot);
      for (int i = F.cb * NTHREADS + F.tid; i < 1024 * 16; i += F.cg * NTHREADS) { const int r = i >> 4, p = i & 15; *(v4u*)(WG2 + (size_t)r * 256 + 128 + 8 * p) = (v4u){0u, 0u, 0u, 0u}; } }
    { bf16* WL = (bf16*)(ws + WS_WLORA);
      for (int d = 0; d < 2; ++d) { conv_seg(F, INP(I_W2) + ((size_t)l * 2 + d) * 64 * RD, RD, 64, 0, RD, WL + (size_t)(0 * 2 + d) * RD * 64, 64, 0, rot);
                                    conv_seg(F, INP(I_A2) + ((size_t)l * 2 + d) * 64 * RD, RD, 64, 0, RD, WL + (size_t)(1 * 2 + d) * RD * 64, 64, 0, rot); } }
}
__device__ __forceinline__ void conv_ffn0(Frame& F) {
    int rot = 0; GAS unsigned char* ws = F.ws;
    conv_gu(F, INP(I_FFG), INP(I_FFU), FF, D, FF / 128, (bf16*)(ws + WS_WGU), rot);
    conv_ffd_dual(F, INP(I_FFD), (bf16*)(ws + WS_WDN), (bf16*)(ws + WS_WDNS), rot);
}
__device__ __forceinline__ void conv_experts(Frame& F, int e0, int e1) {
    int rot = 0;
    for (int e = e0; e < e1; ++e) {
        const size_t ogu = e < 4 ? WS_WEA + (size_t)e * 7 * MiB : e == 4 ? WS_WE4U : e == 5 ? WS_WE5U : WS_WEGU + (size_t)(e - 6) * 7 * MiB;
        const size_t odn = e < 4 ? WS_WEA + 28 * MiB + (size_t)e * 3584 * 1024 : e == 4 ? WS_WE4D : e == 5 ? WS_WE5D : WS_WEDN + (size_t)(e - 6) * 3584 * 1024;
        unsigned char* gu = (unsigned char*)F.ws + ogu; unsigned char* dn = (unsigned char*)F.ws + odn;
        conv_gu8(F, INP(I_EG) + (size_t)e * D * FE, INP(I_EU) + (size_t)e * D * FE, FE, D, FE / 128, gu, W8S, rot);
        conv_seg8(F, INP(I_ED) + (size_t)e * FE * D, D, FE, 0, D, dn, FE, 0, W8S, rot);
    }
}
__device__ __forceinline__ void mod_phase(Frame& F) {
    LAS float* sl = (LAS float*)F.lds;
    LAS float* part = sl + 5 * D;
    for (int i = F.tid; i < 5 * D; i += NTHREADS) { const int bb = i / D, k = i % D; const float v = bb < 4 ? INP(I_C)[bb * D + k] : INP(I_CCTX)[k]; sl[i] = siluf_(v); }
    __syncthreads();
    float* MOD = (float*)(F.ws + WS_MOD);
    for (int item = F.bid; item < NL * 6 * D / 64; item += F.G) {
        const int l = item / (6 * D / 64), c0 = (item % (6 * D / 64)) * 64; const float* w = INP(I_WADA) + (size_t)l * D * 6 * D + c0 + F.lane;
        float a[5] = {0.f, 0.f, 0.f, 0.f, 0.f};
#pragma unroll 16
        for (int k = F.wave * 128; k < F.wave * 128 + 128; ++k) { const float wv = w[(size_t)k * 6 * D];
#pragma unroll
            for (int bb = 0; bb < 5; ++bb) a[bb] += sl[bb * D + k] * wv; }
#pragma unroll
        for (int bb = 0; bb < 5; ++bb) part[(F.wave * 5 + bb) * 64 + F.lane] = a[bb];
        __syncthreads();
        if (F.tid < 5 * 64) { const int bb = F.tid / 64, c = F.tid % 64; float s = INP(I_BADA)[l * 6 * D + c0 + c];
#pragma unroll
            for (int w8 = 0; w8 < 8; ++w8) s += part[(w8 * 5 + bb) * 64 + c];
            MOD[((size_t)l * 5 + bb) * 6 * D + c0 + c] = s; }
        __syncthreads();
    }
}
__device__ __forceinline__ const float* xrow(const float* lat, const float* ctx, int g) { return g < RL ? lat + (size_t)g * D : ctx + (size_t)(g - RL) * D; }
__device__ __forceinline__ void normmod_rows(Frame& F, const float* lat, const float* ctx, const float* gain, const float* MODl, int off_sh, int off_sc, int nrows) {
    bf16* H = (bf16*)(F.ws + WS_H); const int gw = F.bid * NWAVES + F.wave, NW = F.G * NWAVES;
    f32x4 vnx[4];
    if (gw < nrows) { const float* x0 = xrow(lat, ctx, gw);
#pragma unroll
        for (int j = 0; j < 4; ++j) vnx[j] = *(const f32x4*)(x0 + 256 * j + 4 * F.lane); }
    for (int g = gw; g < nrows; g += NW) {
        const float* md = MODl + (g < RL ? g / T : 4) * 6 * D;
        f32x4 v[4]; float ss = 0.f;
#pragma unroll
        for (int j = 0; j < 4; ++j) v[j] = vnx[j];
        if (g + NW < nrows) { const float* x1 = xrow(lat, ctx, g + NW);
#pragma unroll
            for (int j = 0; j < 4; ++j) vnx[j] = *(const f32x4*)(x1 + 256 * j + 4 * F.lane); }
#pragma unroll
        for (int j = 0; j < 4; ++j) ss += (v[j].x * v[j].x + v[j].y * v[j].y) + (v[j].z * v[j].z + v[j].w * v[j].w);
        const float rstd = 1.0f / sqrtf(wave_sum(ss) * (1.0f / D) + NORM_EPS);
#pragma unroll
        for (int j = 0; j < 4; ++j) { const int c = 256 * j + 4 * F.lane;
            const f32x4 gn = *(const f32x4*)(gain + c), sc = *(const f32x4*)(md + off_sc + c), sh = *(const f32x4*)(md + off_sh + c);
            const f32x4 h = v[j] * rstd * gn * (1.0f + sc) + sh;
            v2u o; o.x = cvt_pk_bf16(h.x, h.y); o.y = cvt_pk_bf16(h.z, h.w); *(v2u*)(H + (size_t)g * D + c) = o; }
    }
}
template <bool ROUTER> __device__ __forceinline__ void normmod_phase(Frame& F, const float* lat, const float* ctx, const float* gain, const float* MODl, int off_sh, int off_sc, int nrows, const float* wrt) {
    bf16* H = (bf16*)(F.ws + WS_H);
    LAS unsigned* lcnt = (LAS unsigned*)F.lds;
    LAS int* rec = (LAS int*)(F.lds + 64);
    LAS float* recp = (LAS float*)(F.lds + 64 + 1024);
    const int ngroups = nrows / 64;
    for (int grp = F.bid; grp < ngroups; grp += F.G) {
        if (ROUTER) { if (F.tid < 16) lcnt[F.tid] = 0u; __syncthreads(); }
        f32x4 vnx[4];
        { const float* x0 = xrow(lat, ctx, grp * 64 + F.wave * 8);
#pragma unroll
          for (int j = 0; j < 4; ++j) vnx[j] = *(const f32x4*)(x0 + 256 * j + 4 * F.lane); }
        for (int rr = 0; rr < 8; ++rr) {
            const int lrow = F.wave * 8 + rr, g = grp * 64 + lrow; const float* md = MODl + (g < RL ? g / T : 4) * 6 * D;
            f32x4 v[4]; float ss = 0.f;
#pragma unroll
            for (int j = 0; j < 4; ++j) v[j] = vnx[j];
            if (rr + 1 < 8) { const float* x1 = xrow(lat, ctx, g + 1);
#pragma unroll
                for (int j = 0; j < 4; ++j) vnx[j] = *(const f32x4*)(x1 + 256 * j + 4 * F.lane); }
#pragma unroll
            for (int j = 0; j < 4; ++j) ss += (v[j].x * v[j].x + v[j].y * v[j].y) + (v[j].z * v[j].z + v[j].w * v[j].w);
            const float rstd = 1.0f / sqrtf(wave_sum(ss) * (1.0f / D) + NORM_EPS);
            float lg[NE];
            if (ROUTER) {
#pragma unroll
                for (int e = 0; e < NE; ++e) lg[e] = 0.f; }
#pragma unroll
            for (int j = 0; j < 4; ++j) { const int c = 256 * j + 4 * F.lane;
                const f32x4 gn = *(const f32x4*)(gain + c), sc = *(const f32x4*)(md + off_sc + c), sh = *(const f32x4*)(md + off_sh + c);
                const f32x4 h = v[j] * rstd * gn * (1.0f + sc) + sh;
                if (ROUTER) *(unsigned*)((unsigned char*)H + (size_t)g * D + c) = pk4_fp8(__builtin_amdgcn_fmed3f(h.x, -448.0f, 448.0f), __builtin_amdgcn_fmed3f(h.y, -448.0f, 448.0f), __builtin_amdgcn_fmed3f(h.z, -448.0f, 448.0f), __builtin_amdgcn_fmed3f(h.w, -448.0f, 448.0f));
                else { v2u o; o.x = cvt_pk_bf16(h.x, h.y); o.y = cvt_pk_bf16(h.z, h.w); *(v2u*)(H + (size_t)g * D + c) = o; }
                if (ROUTER) {
#pragma unroll
                    for (int q = 0; q < 4; ++q) { const f32x4 w0 = *(const f32x4*)(wrt + (size_t)(c + q) * NE), w1 = *(const f32x4*)(wrt + (size_t)(c + q) * NE + 4); const float hv = h[q];
                        lg[0] += hv * w0.x; lg[1] += hv * w0.y; lg[2] += hv * w0.z; lg[3] += hv * w0.w; lg[4] += hv * w1.x; lg[5] += hv * w1.y; lg[6] += hv * w1.z; lg[7] += hv * w1.w; } }
            }
            if (ROUTER) {
#pragma unroll
                for (int e = 0; e < NE; ++e) lg[e] = wave_sum(lg[e]);
                int i0 = 0;
#pragma unroll
                for (int e = 1; e < NE; ++e) if (lg[e] > lg[i0]) i0 = e;
                int i1 = i0 == 0 ? 1 : 0;
#pragma unroll
                for (int e = 0; e < NE; ++e) if (e != i0 && lg[e] > lg[i1]) i1 = e;
                if (F.lane == 0) { const float e1 = __expf(lg[i1] - lg[i0]); const float p0 = 1.0f / (1.0f + e1);
                    rec[lrow * 4 + 0] = i0; rec[lrow * 4 + 1] = i1; rec[lrow * 4 + 2] = (int)atomicAdd((unsigned*)&lcnt[i0], 1u); rec[lrow * 4 + 3] = (int)atomicAdd((unsigned*)&lcnt[i1], 1u);
                    recp[lrow * 2 + 0] = p0; recp[lrow * 2 + 1] = e1 * p0; }
            }
        }
        if (ROUTER) {
            __syncthreads();
            if (F.tid < NE) lcnt[8 + F.tid] = __hip_atomic_fetch_add((unsigned*)(F.ctl + CW_ECNT + 64 * F.tid), lcnt[F.tid], RLX_AGENT);
            __syncthreads();
            if (F.tid < 64) { const int g = grp * 64 + F.tid; int* tk = (int*)(F.ws + WS_META) + (size_t)g * 8; const int e0 = rec[F.tid * 4], e1 = rec[F.tid * 4 + 1];
                tk[0] = e0; tk[1] = e1; tk[2] = (int)lcnt[8 + e0] + rec[F.tid * 4 + 2]; tk[3] = (int)lcnt[8 + e1] + rec[F.tid * 4 + 3];
                ((float*)tk)[4] = recp[F.tid * 2]; ((float*)tk)[5] = recp[F.tid * 2 + 1]; }
            __syncthreads();
        }
    }
}
__device__ __forceinline__ void subgrid_arrive(Frame& F, gu32* cnt) {
    asm volatile("s_waitcnt vmcnt(0)" ::: "memory"); __syncthreads();
    if (F.tid == 0) { __builtin_amdgcn_fence(__ATOMIC_RELEASE, "agent"); asm volatile("s_waitcnt vmcnt(0)" ::: "memory"); __hip_atomic_fetch_add(cnt, 1u, RLX_AGENT); }
}
__device__ __forceinline__ void subgrid_wait(Frame& F, gu32* cnt, unsigned n) {
    if (F.tid == 0) { unsigned sp = 0; while (__hip_atomic_load(cnt, RLX_AGENT) < n) { __builtin_amdgcn_s_sleep(2); if (++sp > (1u << 20)) break; }
        __builtin_amdgcn_fence(__ATOMIC_ACQUIRE, "agent"); asm volatile("s_waitcnt vmcnt(0)" ::: "memory"); }
    __syncthreads();
}
__device__ __forceinline__ void normmod_ctx_slabs(Frame& F, const float* XCp, const float* slab, const float* gain, const float* MODl, int off_sh, int off_sc) {
    bf16* H = (bf16*)(F.ws + WS_H); const float* md = MODl + 4 * 6 * D;
    for (int r = F.bid * NWAVES + F.wave; r < RC; r += F.G * NWAVES) {
        f32x4 v[4], p[NSL][4];
#pragma unroll
        for (int j = 0; j < 4; ++j) v[j] = *(const f32x4*)(XCp + (size_t)r * D + 256 * j + 4 * F.lane);
#pragma unroll
        for (int s_ = 0; s_ < NSL; ++s_)
#pragma unroll
            for (int j = 0; j < 4; ++j) p[s_][j] = *(const f32x4*)(slab + ((size_t)s_ * RC + r) * D + 256 * j + 4 * F.lane);
        float ss = 0.f;
#pragma unroll
        for (int j = 0; j < 4; ++j) {
#pragma unroll
            for (int s_ = 0; s_ < NSL; ++s_) v[j] += p[s_][j];
            ss += (v[j].x * v[j].x + v[j].y * v[j].y) + (v[j].z * v[j].z + v[j].w * v[j].w); }
        const float rstd = 1.0f / sqrtf(wave_sum(ss) * (1.0f / D) + NORM_EPS);
#pragma unroll
        for (int j = 0; j < 4; ++j) { const int c = 256 * j + 4 * F.lane;
            const f32x4 gn = *(const f32x4*)(gain + c), sc = *(const f32x4*)(md + off_sc + c), sh = *(const f32x4*)(md + off_sh + c);
            const f32x4 h = v[j] * rstd * gn * (1.0f + sc) + sh;
            v2u o; o.x = cvt_pk_bf16(h.x, h.y); o.y = cvt_pk_bf16(h.z, h.w); *(v2u*)(H + (size_t)(RL + r) * D + c) = o; }
    }
}
__device__ __forceinline__ void sg_phase(Frame& F, int l) {
    const float* SM = (const float*)(F.ws + WS_SM); bf16* SG = (bf16*)(F.ws + WS_SG); const float* mu = INP(I_MU) + l * RW + 3328;
    for (int i = F.cb * NTHREADS + F.tid; i < R * 32; i += F.cg * NTHREADS) { const int g = i >> 5, p = i & 31; float o[8];
        if (p < 16) { const int nb = nbrow(g, 3328); const float* a = SM + (size_t)g * SMW + 288 + 8 * p;
            const f32x4 a0 = *(const f32x4*)a, a1 = *(const f32x4*)(a + 4); f32x4 b0 = {0.f, 0.f, 0.f, 0.f}, b1 = b0;
            if (nb >= 0) { const float* bq = SM + (size_t)nb * SMW + 288 + 8 * p; b0 = *(const f32x4*)bq; b1 = *(const f32x4*)(bq + 4); }
#pragma unroll
            for (int j = 0; j < 4; ++j) { o[j] = sigmoidf_(a0[j] + (b0[j] - a0[j]) * mu[8 * p + j]); o[4 + j] = sigmoidf_(a1[j] + (b1[j] - a1[j]) * mu[8 * p + 4 + j]); }
        } else {
#pragma unroll
            for (int j = 0; j < 8; ++j) o[j] = 0.f; }
        *(v4u*)(SG + (size_t)g * 256 + 8 * p) = pack8(o); }
}

constexpr int ML_CP = 88;
constexpr int ML_P = 72, ML_QS = 0, ML_KS = 64 * ML_P * 2, ML_VS = 2 * ML_KS, ML_STG = 3 * ML_KS, ML_PS = 2 * ML_STG, ML_CB = ML_PS + ML_KS, ML_GT = ML_CB + 80 * ML_P * 2, ML_END = ML_GT + 2 * 6 * 64 * 4;
static_assert(ML_END <= MISC_OFF, "mlstm LDS map");
template <int CTRL, int RMASK> __device__ __forceinline__ float dpp_get(float v, float old) { return __int_as_float(__builtin_amdgcn_update_dpp(__float_as_int(old), __float_as_int(v), CTRL, RMASK, 0xf, false)); }
__device__ __forceinline__ float wave_scan_add(float x) {
    x += dpp_get<0x111, 0xf>(x, 0.f); x += dpp_get<0x112, 0xf>(x, 0.f); x += dpp_get<0x114, 0xf>(x, 0.f); x += dpp_get<0x118, 0xf>(x, 0.f);
    x += dpp_get<0x142, 0xa>(x, 0.f); x += dpp_get<0x143, 0xc>(x, 0.f); return x;
}
__device__ __forceinline__ float wave_scan_max(float x) {
    const float ninf = -__builtin_inff();
    x = fmaxf(x, dpp_get<0x111, 0xf>(x, ninf)); x = fmaxf(x, dpp_get<0x112, 0xf>(x, ninf)); x = fmaxf(x, dpp_get<0x114, 0xf>(x, ninf)); x = fmaxf(x, dpp_get<0x118, 0xf>(x, ninf));
    x = fmaxf(x, dpp_get<0x142, 0xa>(x, ninf)); x = fmaxf(x, dpp_get<0x143, 0xc>(x, ninf)); return x;
}
__device__ __forceinline__ float lane63(float x) { return __int_as_float(__builtin_amdgcn_readlane(__float_as_int(x), 63)); }
typedef short s16x4 __attribute__((ext_vector_type(4)));
template <int PITCH = ML_P> __device__ __forceinline__ bf16x8 tr_frag(const LAS bf16* X, int r0, int c0, int r16, int quad) {
    const LAS bf16* p = X + (r0 + 8 * quad + (r16 >> 2)) * PITCH + c0 + 4 * (r16 & 3);
    const s16x4 a = __builtin_amdgcn_ds_read_tr16_b64_v4i16((LAS s16x4*)p), b = __builtin_amdgcn_ds_read_tr16_b64_v4i16((LAS s16x4*)(p + 4 * PITCH));
    const bf16x8 f = {a.x, a.y, a.z, a.w, b.x, b.y, b.z, b.w}; return f;
}
__device__ __forceinline__ void mlstm_phase(Frame& F, int l, int first, int stride) {
    LAS unsigned char* L = F.lds;
    LAS bf16* Ps = (LAS bf16*)(L + ML_PS); LAS bf16* Cb = (LAS bf16*)(L + ML_CB); LAS float* GT = (LAS float*)(L + ML_GT);
    const bf16* Qg = (const bf16*)(F.ws + WS_Q); const bf16* Kg = (const bf16*)(F.ws + WS_K); const bf16* Vg = (const bf16*)(F.ws + WS_V); const float* SM = (const float*)(F.ws + WS_SM);
    bf16* HF = (bf16*)(F.ws + WS_HF); const float* bgate = INP(I_BG) + l * 4 * MH;
    const int tid = F.tid, lane = F.lane, wave = F.wave, r16 = lane & 15, quad = lane >> 4;
    for (int item = first; item < NB * 2 * MH * 2; item += stride) {
        const int vh = item & 1, h = (item >> 1) & 7, dir = (item >> 4) & 1, b = item >> 5;
        __syncthreads();
        for (int i = tid; i < 64 * ML_CP; i += NTHREADS) Cb[i] = 0;
        const float bgi = bgate[(2 * dir) * MH + h], bgf = bgate[(2 * dir + 1) * MH + h];
        const int ss_ = tid & 63, pc = tid >> 6;
        v4u rq, rk, rv;
        { const int g = chunk_row(b, dir, 0, ss_); rq = *(const v4u*)(Qg + (size_t)g * 512 + h * 64 + pc * 8); rk = *(const v4u*)(Kg + (size_t)g * 512 + h * 64 + pc * 8);
          rv = *(const v4u*)(Vg + (size_t)g * 1024 + h * 128 + vh * 64 + pc * 8); }
        float m_run = 0.f, gi = 0.f, gf = 0.f;
        auto gate_tables = [&](int buf) {
            LAS float* G = GT + buf * 384;
            const float iv = CAP * fast_tanh((gi + bgi) * (1.0f / CAP)), lf = -fast_softplus(-CAP * fast_tanh((gf + bgf) * (1.0f / CAP)));
            const float bsum = wave_scan_add(lf), pmx = wave_scan_max(iv - bsum);
            const float inter = bsum + m_run, mt = fmaxf(inter, bsum + pmx);
            G[lane] = bsum - mt; G[64 + lane] = iv - bsum; G[128 + lane] = __expf(inter - mt); G[192 + lane] = __expf(-mt);
            const float blast = lane63(bsum), mnew = fmaxf(blast + m_run, blast + lane63(pmx));
            G[256 + lane] = __expf(blast - bsum + iv - mnew);
            if (lane == 0) G[320] = __expf(blast + m_run - mnew);
            m_run = mnew;
        };
        if (wave == 1) { { const int g = chunk_row(b, dir, 0, lane); gi = SM[(size_t)g * SMW + (2 * dir) * MH + h]; gf = SM[(size_t)g * SMW + (2 * dir + 1) * MH + h]; }
            gate_tables(0);
            { const int g = chunk_row(b, dir, 1, lane); gi = SM[(size_t)g * SMW + (2 * dir) * MH + h]; gf = SM[(size_t)g * SMW + (2 * dir + 1) * MH + h]; } }
        f32x4 CaccA = {0.f, 0.f, 0.f, 0.f}, CaccB = {0.f, 0.f, 0.f, 0.f}, Cacc2 = {0.f, 0.f, 0.f, 0.f};
        auto stage = [&](int buf) {
            LAS bf16* Qs = (LAS bf16*)(L + buf * ML_STG + ML_QS); LAS bf16* Ks = (LAS bf16*)(L + buf * ML_STG + ML_KS); LAS bf16* Vs = (LAS bf16*)(L + buf * ML_STG + ML_VS);
            *(v4u*)(Qs + ss_ * ML_P + pc * 8) = rq; *(v4u*)(Ks + ss_ * ML_P + pc * 8) = rk; *(v4u*)(Vs + ss_ * ML_P + pc * 8) = rv; };
        auto fetch = [&](int jn) { const int g = chunk_row(b, dir, jn, ss_); rq = *(const v4u*)(Qg + (size_t)g * 512 + h * 64 + pc * 8); rk = *(const v4u*)(Kg + (size_t)g * 512 + h * 64 + pc * 8);
            rv = *(const v4u*)(Vg + (size_t)g * 1024 + h * 128 + vh * 64 + pc * 8); };
        __syncthreads();
        stage(0); fetch(1);
        __syncthreads();
        for (int j = 0; j < NCH; ++j) {
            const LAS float* G = GT + (j & 1) * 384; const int sb_ = (j & 1) * ML_STG;
            LAS bf16* Qs = (LAS bf16*)(L + sb_ + ML_QS); LAS bf16* Ks = (LAS bf16*)(L + sb_ + ML_KS); LAS bf16* Vs = (LAS bf16*)(L + sb_ + ML_VS); const bf16x8 ones = {0x3F80, 0x3F80, 0x3F80, 0x3F80, 0x3F80, 0x3F80, 0x3F80, 0x3F80};
            if (j + 1 < NCH) { stage((j + 1) & 1); if (j + 2 < NCH) fetch(j + 2); }
            const int mt = wave >> 1, wv = wave & 1;
            if (wave == 1 && j + 1 < NCH) { gate_tables((j + 1) & 1);
                if (j + 2 < NCH) { const int g = chunk_row(b, dir, j + 2, lane); gi = SM[(size_t)g * SMW + (2 * dir) * MH + h]; gf = SM[(size_t)g * SMW + (2 * dir + 1) * MH + h]; } }
            const bf16x8 qa0 = *(const LAS bf16x8*)(Qs + (16 * mt + r16) * ML_P + quad * 8), qa1 = *(const LAS bf16x8*)(Qs + (16 * mt + r16) * ML_P + 32 + quad * 8);
            f32x4 accq[2], accqn = {0.f, 0.f, 0.f, 0.f};
#pragma unroll
            for (int vv = 0; vv < 2; ++vv) { const int vt = 2 * wv + vv; const f32x4 z = {0.f, 0.f, 0.f, 0.f};
                const bf16x8 c0 = tr_frag<ML_CP>(Cb, 0, 16 * vt, r16, quad), c1 = tr_frag<ML_CP>(Cb, 32, 16 * vt, r16, quad);
                accq[vv] = __builtin_amdgcn_mfma_f32_16x16x32_bf16(qa0, c0, z, 0, 0, 0); accq[vv] = __builtin_amdgcn_mfma_f32_16x16x32_bf16(qa1, c1, accq[vv], 0, 0, 0); }
            { const bf16x8 n0 = tr_frag<ML_CP>(Cb, 0, 64, r16, quad), n1 = tr_frag<ML_CP>(Cb, 32, 64, r16, quad);
              accqn = __builtin_amdgcn_mfma_f32_16x16x32_bf16(qa0, n0, accqn, 0, 0, 0); accqn = __builtin_amdgcn_mfma_f32_16x16x32_bf16(qa1, n1, accqn, 0, 0, 0); }
#pragma unroll
            for (int nn = 0; nn < 2; ++nn) { const int nt = 2 * wv + nn; f32x4 sacc = {0.f, 0.f, 0.f, 0.f};
                if (nt <= mt) { const bf16x8 k0 = *(const LAS bf16x8*)(Ks + (16 * nt + r16) * ML_P + quad * 8), k1 = *(const LAS bf16x8*)(Ks + (16 * nt + r16) * ML_P + 32 + quad * 8);
                    sacc = __builtin_amdgcn_mfma_f32_16x16x32_bf16(qa0, k0, sacc, 0, 0, 0); sacc = __builtin_amdgcn_mfma_f32_16x16x32_bf16(qa1, k1, sacc, 0, 0, 0); }
                const int s = 16 * nt + r16; const float wc_ = G[64 + s];
                float pv[4];
#pragma unroll
                for (int i = 0; i < 4; ++i) { const int t = 16 * mt + 4 * quad + i; pv[i] = (s <= t) ? sacc[i] * 0.125f * __expf(G[t] + wc_) : 0.f; }
                { v2u o; o.x = cvt_pk_bf16(pv[0], pv[1]); o.y = cvt_pk_bf16(pv[2], pv[3]); *(LAS v2u*)(Ps + s * ML_P + 16 * mt + 4 * quad) = o; } }
            __syncthreads();
            { f32x4 acc[2] = {{0.f, 0.f, 0.f, 0.f}, {0.f, 0.f, 0.f, 0.f}}, accn = {0.f, 0.f, 0.f, 0.f};
#pragma unroll
              for (int ks = 0; ks < 2; ++ks) { if (ks == 1 && mt < 2) break;
                  const bf16x8 pa = tr_frag(Ps, 32 * ks, 16 * mt, r16, quad);
#pragma unroll
                  for (int vv = 0; vv < 2; ++vv) { const bf16x8 vb = tr_frag(Vs, 32 * ks, 16 * (2 * wv + vv), r16, quad); acc[vv] = __builtin_amdgcn_mfma_f32_16x16x32_bf16(pa, vb, acc[vv], 0, 0, 0); }
                  accn = __builtin_amdgcn_mfma_f32_16x16x32_bf16(pa, ones, accn, 0, 0, 0); }
#pragma unroll
              for (int i = 0; i < 4; ++i) { const int t = 16 * mt + 4 * quad + i; const float wi = G[128 + t] * 0.125f, dn = accn[i] + wi * accqn[i], inv = __builtin_amdgcn_rcpf(fmaxf(fabsf(dn), G[192 + t]));
                  const int g = chunk_row(b, dir, j, t); bf16* hf = HF + ((size_t)dir * R + g) * 1024 + h * 128 + vh * 64 + 32 * wv + r16;
                  hf[0] = (bf16)(cvt_pk_bf16((acc[0][i] + wi * accq[0][i]) * inv, 0.f) & 0xffffu); hf[16] = (bf16)(cvt_pk_bf16((acc[1][i] + wi * accq[1][i]) * inv, 0.f) & 0xffffu); } }
            { const float aold = G[320]; const int vm0 = wave >> 2, dnt = wave & 3;
              f32x4 d1a = {0.f, 0.f, 0.f, 0.f}, d1b = {0.f, 0.f, 0.f, 0.f}, d2 = {0.f, 0.f, 0.f, 0.f};
#pragma unroll
              for (int ks = 0; ks < 2; ++ks) {
                  const v4u kraw = __builtin_bit_cast(v4u, tr_frag(Ks, 32 * ks, 16 * dnt, r16, quad)); float kf[8]; unpack8(kraw, kf);
                  const f32x4 a0 = *(const LAS f32x4*)&G[256 + 32 * ks + quad * 8], a1 = *(const LAS f32x4*)&G[256 + 32 * ks + quad * 8 + 4];
                  kf[0] *= a0.x; kf[1] *= a0.y; kf[2] *= a0.z; kf[3] *= a0.w; kf[4] *= a1.x; kf[5] *= a1.y; kf[6] *= a1.z; kf[7] *= a1.w;
                  const v4u kp = pack8(kf); const bf16x8 kb = __builtin_bit_cast(bf16x8, kp);
                  const bf16x8 va = tr_frag(Vs, 32 * ks, 16 * vm0, r16, quad), vb2 = tr_frag(Vs, 32 * ks, 16 * (vm0 + 2), r16, quad);
                  d1a = __builtin_amdgcn_mfma_f32_16x16x32_bf16(va, kb, d1a, 0, 0, 0); d1b = __builtin_amdgcn_mfma_f32_16x16x32_bf16(vb2, kb, d1b, 0, 0, 0);
                  if (wave < 4) d2 = __builtin_amdgcn_mfma_f32_16x16x32_bf16(ones, kb, d2, 0, 0, 0); }
              CaccA = CaccA * aold + d1a; CaccB = CaccB * aold + d1b;
              { v2u o; o.x = cvt_pk_bf16(CaccA[0], CaccA[1]); o.y = cvt_pk_bf16(CaccA[2], CaccA[3]); *(LAS v2u*)(Cb + (16 * dnt + r16) * ML_CP + 16 * vm0 + 4 * quad) = o;
                o.x = cvt_pk_bf16(CaccB[0], CaccB[1]); o.y = cvt_pk_bf16(CaccB[2], CaccB[3]); *(LAS v2u*)(Cb + (16 * dnt + r16) * ML_CP + 16 * (vm0 + 2) + 4 * quad) = o; }
              if (wave < 4) { Cacc2 = Cacc2 * aold + d2;
                  v2u o; o.x = cvt_pk_bf16(Cacc2[0], Cacc2[1]); o.y = cvt_pk_bf16(Cacc2[2], Cacc2[3]); *(LAS v2u*)(Cb + (16 * dnt + r16) * ML_CP + 64 + 4 * quad) = o; } }
            __syncthreads();
        }
    }
}

constexpr int RP = 72;
constexpr int RC_AB = 0, RC_BB = 9216, RC_KB = 18432, RC_RB = 27648, RC_BHT = 36864, RC_KHT = 46080, RC_ABT = 55296, RC_GAKT = 64512, RC_BONP = 67584;
constexpr int RC_TW = 55296, RC_AD = 90112;     static_assert(RC_TW + 9216 <= 64512 && RC_AD >= 80896 + 9216 && RC_AD + 9216 <= 99328, "TW / AD slots");
constexpr int RC_TW_OLD = 0, RC_AD_OLD = 9216;
constexpr int RC_KK16 = 71680, RC_K16 = 80896, RC_R16 = 99328;
constexpr int RC_GAB = 71680, RC_GAK = 75776, RC_HRB = 78848, RC_HRK = 81920, RC_TT = 84992, RC_SAT = 88064, RC_YO = 93184;
constexpr int RC_GL = 109568, RC_VT = 110592, RC_SB = 119808, RC_CONST = 129024, RC_W2T = 133120, RC_A2T = 142336, RC_END = 151552;
static_assert(RC_END <= MISC_OFF && RC_YO + 16384 <= RC_GL && RC_BONP + 1024 <= RC_KK16 && RC_TT + 3072 <= RC_SAT && RC_SAT + 5120 <= RC_YO, "rwkv LDS map");
struct RwPre { f32x4 lw[2], lwn[2], la[2], lan[2]; v4u r, rn, k, kn, v, vn; };
__device__ __forceinline__ void rw_prefetch(RwPre& P, const float* SM, const bf16* RKV, int b, int dir, int h, int j, int tid) {
    const int s = tid >> 3, p8 = (tid & 7) * 8;
    const int cr = h * 64 + p8, ck = 1024 + cr, cv = 2048 + cr;
    int g, nbS, nbR, nbK, nbV;
    if (j >= TC / 64) { const int jj = j - TC / 64, row = dir ? GW - 1 - jj : jj, col = dir ? GW - 1 - s : s; g = b * T + row * GW + col;
        const int nq0 = col > 0 ? g - 1 : -1, nq1 = col < GW - 1 ? g + 1 : -1, nq2 = row > 0 ? g - GW : -1, nq3 = row < T / GW - 1 ? g + GW : -1;
        const int qr = cr / (RW / 4), qk = ck / (RW / 4), qv = cv / (RW / 4);
        nbS = nq3; nbR = qr == 0 ? nq0 : nq1; nbK = qk == 1 ? nq1 : nq2; nbV = qv == 2 ? nq2 : nq3;
    } else { const int u = j * 64 + s, t = dir ? TC - 1 - u : u; g = RL + b * TC + t;
        const int prev = t > 0 ? g - 1 : -1, next = t < TC - 1 ? g + 1 : -1;
        nbS = next; nbR = prev; nbK = ck < RW / 2 ? prev : next; nbV = next; }
    { const float* a = SM + (size_t)g * SMW + 32 + 64 * dir + p8; const float* c = a + 128;
      P.lw[0] = *(const f32x4*)a; P.lw[1] = *(const f32x4*)(a + 4); P.la[0] = *(const f32x4*)c; P.la[1] = *(const f32x4*)(c + 4);
      const f32x4 z = {0.f, 0.f, 0.f, 0.f}; P.lwn[0] = z; P.lwn[1] = z; P.lan[0] = z; P.lan[1] = z;
      if (nbS >= 0) { const float* an = SM + (size_t)nbS * SMW + 32 + 64 * dir + p8; const float* cn = an + 128;
          P.lwn[0] = *(const f32x4*)an; P.lwn[1] = *(const f32x4*)(an + 4); P.lan[0] = *(const f32x4*)cn; P.lan[1] = *(const f32x4*)(cn + 4); } }
    const v4u z4 = {0u, 0u, 0u, 0u}; const bf16* own = RKV + (size_t)g * 3072 + cr;
    P.r = *(const v4u*)own; P.rn = nbR >= 0 ? *(const v4u*)(RKV + (size_t)nbR * 3072 + cr) : z4;
    P.k = *(const v4u*)(own + 1024); P.kn = nbK >= 0 ? *(const v4u*)(RKV + (size_t)nbK * 3072 + ck) : z4;
    P.v = *(const v4u*)(own + 2048); P.vn = nbV >= 0 ? *(const v4u*)(RKV + (size_t)nbV * 3072 + cv) : z4;
}
__device__ __forceinline__ bf16x8 lds_frag(const LAS bf16* p) { return *(const LAS bf16x8*)p; }
__device__ __forceinline__ bf16x8 lds_frag_k16(const LAS bf16* p, int quad) { const bf16x8 v = *(const LAS bf16x8*)p; const bf16x8 z = {0, 0, 0, 0, 0, 0, 0, 0}; return quad < 2 ? v : z; }
__device__ __forceinline__ bf16x8 lds_frag_perm(const LAS bf16* p) { const v2u lo = *(const LAS v2u*)p, hi = *(const LAS v2u*)(p + 16); const v4u w = {lo.x, lo.y, hi.x, hi.y}; return __builtin_bit_cast(bf16x8, w); }
__device__ __forceinline__ bf16x8 lds_frag_lo4(const LAS bf16* p) { const v2u lo = *(const LAS v2u*)p; const v4u w = {lo.x, lo.y, 0u, 0u}; return __builtin_bit_cast(bf16x8, w); }
__device__ __forceinline__ unsigned pk2(float lo, float hi) { typedef __bf16 bf2 __attribute__((ext_vector_type(2))); const bf2 v = {(__bf16)lo, (__bf16)hi}; return __builtin_bit_cast(unsigned, v); }
__device__ __forceinline__ bf16 f2b(float x) { return __builtin_bit_cast(unsigned short, (__bf16)x); }
__device__ __forceinline__ float b2f(bf16 x) { return __uint_as_float((unsigned)x << 16); }
__device__ __forceinline__ void scan16_mul4(float& x0, float& x1, float& x2, float& x3) {
#define SC_(n) "v_mul_f32_dpp %0, %0, %0 row_shr:" #n " row_mask:0xf bank_mask:0xf\n\tv_mul_f32_dpp %1, %1, %1 row_shr:" #n " row_mask:0xf bank_mask:0xf\n\tv_mul_f32_dpp %2, %2, %2 row_shr:" #n " row_mask:0xf bank_mask:0xf\n\tv_mul_f32_dpp %3, %3, %3 row_shr:" #n " row_mask:0xf bank_mask:0xf\n\t"
    asm volatile("s_nop 4\n\t" SC_(1) SC_(2) SC_(4) SC_(8) "s_nop 1" : "+v"(x0), "+v"(x1), "+v"(x2), "+v"(x3));
#undef SC_
}
__device__ __forceinline__ void st_pair(LAS bf16* p0, LAS bf16* p1, float a, float b) { const unsigned w = cvt_pk_bf16(a, b); *p0 = (bf16)(w & 0xffffu); *p1 = (bf16)(w >> 16); }
typedef short s16x4 __attribute__((ext_vector_type(4)));
__device__ __forceinline__ v2u tr_raw4(const LAS bf16* X, int t0, int c0, int r16) {
    return __builtin_bit_cast(v2u, __builtin_amdgcn_ds_read_tr16_b64_v4i16((LAS s16x4*)(X + (t0 + (r16 >> 2)) * RP + c0 + 4 * (r16 & 3))));
}
__device__ __forceinline__ bf16x8 tr_lo4(const LAS bf16* X, int t0, int c0, int r16) {
    const s16x4 a = __builtin_amdgcn_ds_read_tr16_b64_v4i16((LAS s16x4*)(X + (t0 + (r16 >> 2)) * RP + c0 + 4 * (r16 & 3)));
    const bf16x8 f = {a.x, a.y, a.z, a.w, 0, 0, 0, 0}; return f;
}
#define MFMA16(a, b, c) __builtin_amdgcn_mfma_f32_16x16x32_bf16(a, b, c, 0, 0, 0)
__device__ __forceinline__ void rwkv_phase(Frame& F, int l, int first, int stride) {
    LAS unsigned char* L = F.lds;
    LAS bf16* Ab = (LAS bf16*)(L + RC_AB); LAS bf16* Bb = (LAS bf16*)(L + RC_BB); LAS bf16* Kb = (LAS bf16*)(L + RC_KB); LAS bf16* Rb = (LAS bf16*)(L + RC_RB);
    LAS bf16* BhT = (LAS bf16*)(L + RC_BHT); LAS bf16* KhT = (LAS bf16*)(L + RC_KHT); LAS bf16* AbT = (LAS bf16*)(L + RC_ABT); LAS bf16* GAKT = (LAS bf16*)(L + RC_GAKT); LAS float* BONP = (LAS float*)(L + RC_BONP);
    LAS bf16* TW = (LAS bf16*)(L + RC_TW); LAS bf16* AD = (LAS bf16*)(L + RC_AD);
    LAS bf16* KK16 = (LAS bf16*)(L + RC_KK16); LAS bf16* K16 = (LAS bf16*)(L + RC_K16); LAS bf16* R16 = (LAS bf16*)(L + RC_R16);
    LAS float* GAB = (LAS float*)(L + RC_GAB); LAS bf16* GAK = (LAS bf16*)(L + RC_GAK); LAS bf16* HRB = (LAS bf16*)(L + RC_HRB); LAS bf16* HRK = (LAS bf16*)(L + RC_HRK); LAS bf16* TT = (LAS bf16*)(L + RC_TT);
    LAS bf16* SAt = (LAS bf16*)(L + RC_SAT); LAS bf16* YOb = (LAS bf16*)(L + RC_SB);     LAS float* GL = (LAS float*)(L + RC_GL);
    LAS bf16* Vt = (LAS bf16*)(L + RC_VT); LAS bf16* Sb = (LAS bf16*)(L + RC_SB); LAS float* CN = (LAS float*)(L + RC_CONST); LAS bf16* W2T = (LAS bf16*)(L + RC_W2T); LAS bf16* A2T = (LAS bf16*)(L + RC_A2T);
    const float* SM = (const float*)(F.ws + WS_SM); const bf16* RKV = (const bf16*)(F.ws + WS_RKV); bf16* YS = (bf16*)(F.ws + WS_YS); float* BON = (float*)(F.ws + WS_BON);
    const bf16* WL = (const bf16*)(F.ws + WS_WLORA);
    const int tid = F.tid, lane = F.lane, wave = F.wave;
    for (int item = first; item < NB * 2 * RH; item += stride) {
        const int h = item & 15, dir = (item >> 4) & 1, b = item >> 5;
        __syncthreads();
        if (tid < 64) { const float* mu = INP(I_MU) + l * RW; CN[tid] = mu[h * 64 + tid]; CN[64 + tid] = mu[1024 + h * 64 + tid]; CN[128 + tid] = mu[2048 + h * 64 + tid];
            CN[192 + tid] = mu[3072 + 64 * dir + tid]; CN[256 + tid] = mu[3200 + 64 * dir + tid];
            CN[320 + tid] = INP(I_KK)[l * RD + h * 64 + tid]; CN[384 + tid] = INP(I_KA)[l * RD + h * 64 + tid]; CN[448 + tid] = INP(I_RK)[l * RD + h * 64 + tid];
            CN[512 + tid] = INP(I_W0)[(l * 2 + dir) * RD + h * 64 + tid]; CN[576 + tid] = INP(I_A0)[(l * 2 + dir) * RD + h * 64 + tid]; }
        { const int n = tid >> 3, p8 = (tid & 7) * 8;
          *(v4u*)(W2T + n * 72 + p8) = *(const v4u*)(WL + ((size_t)(0 * 2 + dir) * RD + h * 64 + n) * 64 + p8);
          *(v4u*)(A2T + n * 72 + p8) = *(const v4u*)(WL + ((size_t)(1 * 2 + dir) * RD + h * 64 + n) * 64 + p8); }
        for (int i = tid; i < (RC_CONST - RC_GL) / 4; i += NTHREADS) ((LAS unsigned*)(L + RC_GL))[i] = 0u;
        f32x4 ST[4]; for (int kt = 0; kt < 4; ++kt) ST[kt] = (f32x4){0.f, 0.f, 0.f, 0.f};
        RwPre P; rw_prefetch(P, SM, RKV, b, dir, h, 0, tid);
        __syncthreads();
        auto store_chunk = [&](int jc) { int to = tid; const int s4 = to >> 3, q8 = (to & 7) * 8;
            *(v4u*)(YS + ((size_t)dir * R + chunk_row(b, dir, jc, s4)) * RD + h * 64 + q8) = *(const LAS v4u*)(YOb + s4 * RP + q8); };
        for (int j = 0; j < NCH; ++j) {
            if (j > 0) store_chunk(j - 1);
            { int tl = tid; const int s = tl >> 3, p8 = (tl & 7) * 8;
              { float tw[8], ad[8]; const f32x4 muw[2] = {*(const f32x4*)&CN[192 + p8], *(const f32x4*)&CN[196 + p8]}, mua[2] = {*(const f32x4*)&CN[256 + p8], *(const f32x4*)&CN[260 + p8]};
#pragma unroll
                for (int i = 0; i < 8; ++i) { const float pw = P.lw[i >> 2][i & 3], pwn = P.lwn[i >> 2][i & 3], pa = P.la[i >> 2][i & 3], pan = P.lan[i >> 2][i & 3];
                    { const float e_ = __builtin_amdgcn_exp2f(2.8853901f * (pw + (pwn - pw) * muw[i >> 2][i & 3])); tw[i] = 1.0f - 2.0f * __builtin_amdgcn_rcpf(1.0f + e_); }     ad[i] = pa + (pan - pa) * mua[i >> 2][i & 3]; }
                *(v4u*)(TW + s * 72 + p8) = pack8(tw); *(v4u*)(AD + s * 72 + p8) = pack8(ad); }
              { float a[8], bq[8], o[8]; const f32x4 mur[2] = {*(const f32x4*)&CN[p8], *(const f32x4*)&CN[4 + p8]}, muk[2] = {*(const f32x4*)&CN[64 + p8], *(const f32x4*)&CN[68 + p8]};
                unpack8(P.r, a); unpack8(P.rn, bq);
#pragma unroll
                for (int i = 0; i < 8; i += 2) { const f32x2 a2 = {a[i], a[i + 1]}, b2 = {bq[i], bq[i + 1]}, m2 = {mur[i >> 2][i & 3], mur[i >> 2][(i & 3) + 1]}; const f32x2 o2 = a2 + (b2 - a2) * m2; o[i] = o2.x; o[i + 1] = o2.y; }
                *(v4u*)(R16 + s * RP + p8) = pack8(o);
                unpack8(P.k, a); unpack8(P.kn, bq); float ssq = 0.f; const f32x4 kkc[2] = {*(const f32x4*)&CN[320 + p8], *(const f32x4*)&CN[324 + p8]};
#pragma unroll
                for (int i = 0; i < 8; i += 2) { const f32x2 a2 = {a[i], a[i + 1]}, b2 = {bq[i], bq[i + 1]}, m2 = {muk[i >> 2][i & 3], muk[i >> 2][(i & 3) + 1]}, c2 = {kkc[i >> 2][i & 3], kkc[i >> 2][(i & 3) + 1]};
                  const f32x2 o2 = a2 + (b2 - a2) * m2, k2 = o2 * c2, q2 = k2 * k2; o[i] = o2.x; o[i + 1] = o2.y; a[i] = k2.x; a[i + 1] = k2.y; ssq += q2.x + q2.y; }
                *(v4u*)(K16 + s * RP + p8) = pack8(o);
                const float inv = fminf(__builtin_amdgcn_rsqf(red8(ssq)), 1e12f);
#pragma unroll
                for (int i = 0; i < 8; ++i) a[i] *= inv;
                *(v4u*)(KK16 + s * RP + p8) = pack8(a);
                { unpack8(P.v, a); unpack8(P.vn, bq); const f32x4 muv[2] = {*(const f32x4*)&CN[128 + p8], *(const f32x4*)&CN[132 + p8]};
#pragma unroll
                  for (int i = 0; i < 8; ++i) o[i] = a[i] + (bq[i] - a[i]) * muv[i >> 2][i & 3];
                  *(v4u*)(Vt + s * RP + p8) = pack8(o); } } }
            __syncthreads();
            if (j + 1 < NCH) rw_prefetch(P, SM, RKV, b, dir, h, j + 1, tid);
            { int lb = lane; const int r16 = lb & 15, quad = lb >> 4; const int c = wave >> 1, t = 16 * c + r16;
              const bf16x8 a0 = lds_frag(TW + t * 72 + quad * 8), a1 = lds_frag(TW + t * 72 + 32 + quad * 8);
              const bf16x8 d0 = lds_frag(AD + t * 72 + quad * 8), d1 = lds_frag(AD + t * 72 + 32 + quad * 8);
              f32x4 cw[2], ca[2];
#pragma unroll
              for (int nn = 0; nn < 2; ++nn) { const int nt = 2 * (wave & 1) + nn; const f32x4 z = {0.f, 0.f, 0.f, 0.f};
                  cw[nn] = MFMA16(lds_frag(W2T + (16 * nt + r16) * 72 + quad * 8), a0, z); cw[nn] = MFMA16(lds_frag(W2T + (16 * nt + r16) * 72 + 32 + quad * 8), a1, cw[nn]);
                  ca[nn] = MFMA16(lds_frag(A2T + (16 * nt + r16) * 72 + quad * 8), d0, z); ca[nn] = MFMA16(lds_frag(A2T + (16 * nt + r16) * 72 + 32 + quad * 8), d1, ca[nn]); }
              float bsum = 0.f; const int glsrc = ((lb & 48) | 15) << 2;
#pragma unroll
              for (int nn = 0; nn < 2; ++nn) { const int n0 = 16 * (2 * (wave & 1) + nn) + 4 * quad;
                  const f32x4 w0c = *(const LAS f32x4*)&CN[512 + n0], a0c = *(const LAS f32x4*)&CN[576 + n0], kac = *(const LAS f32x4*)&CN[384 + n0], rkc = *(const LAS f32x4*)&CN[448 + n0];
                  const v2u kkw = *(const LAS v2u*)(KK16 + t * RP + n0), kxw = *(const LAS v2u*)(K16 + t * RP + n0), rrw = *(const LAS v2u*)(R16 + t * RP + n0);
                  const float kk[4] = {bflo(kkw.x), bfhi(kkw.x), bflo(kkw.y), bfhi(kkw.y)}, kx[4] = {bflo(kxw.x), bfhi(kxw.x), bflo(kxw.y), bfhi(kxw.y)}, rr[4] = {bflo(rrw.x), bfhi(rrw.x), bflo(rrw.y), bfhi(rrw.y)};
                  float av[4], pin[4], pex[4], gl[4];
#pragma unroll
                  for (int i = 0; i < 4; ++i) { pin[i] = __builtin_amdgcn_exp2f(-0.87503524f * sigmoidf_(w0c[i] + cw[nn][i])); av[i] = sigmoidf_(a0c[i] + ca[nn][i]); }
                  scan16_mul4(pin[0], pin[1], pin[2], pin[3]);
#pragma unroll
                  for (int i = 0; i < 4; ++i) { pex[i] = dpp_one<0x111>(pin[i]); gl[i] = __int_as_float(__builtin_amdgcn_ds_bpermute(glsrc, __float_as_int(pin[i]))); }
                  float abv[4], rbv[4], bbv[4], kbv[4], bhv[4], khv[4];
#pragma unroll
                  for (int i = 0; i < 4; i += 2) {
                      const f32x2 kk2 = {kk[i], kk[i + 1]}, kx2 = {kx[i], kx[i + 1]}, rr2 = {rr[i], rr[i + 1]}, av2 = {av[i], av[i + 1]}, pin2 = {pin[i], pin[i + 1]}, pex2 = {pex[i], pex[i + 1]}, gl2 = {gl[i], gl[i + 1]};
                      const f32x2 kac2 = {kac[i], kac[i + 1]}, rkc2 = {rkc[i], rkc[i + 1]}, gi2 = {__builtin_amdgcn_rcpf(pin[i]), __builtin_amdgcn_rcpf(pin[i + 1])};
                      const f32x2 kka2 = kk2 * av2, kd2 = kx2 * ((av2 - 1.0f) * kac2 + 1.0f), bb2 = kka2 * gi2, kb2 = kd2 * gi2, ab2 = kk2 * pex2, rb2 = rr2 * pin2, bh2 = (0.0f - bb2) * gl2  , kh2 = kb2 * gl2, bs2 = rr2 * kd2 * rkc2;
                      bbv[i] = bb2.x; bbv[i + 1] = bb2.y; kbv[i] = kb2.x; kbv[i + 1] = kb2.y; abv[i] = ab2.x; abv[i + 1] = ab2.y; rbv[i] = rb2.x; rbv[i + 1] = rb2.y;
                      bhv[i] = bh2.x; bhv[i + 1] = bh2.y; khv[i] = kh2.x; khv[i + 1] = kh2.y; bsum += bs2.x + bs2.y; }
                  { v2u o; o.x = cvt_pk_bf16(abv[0], abv[1]); o.y = cvt_pk_bf16(abv[2], abv[3]); *(LAS v2u*)(Ab + t * RP + n0) = o;
                    o.x = cvt_pk_bf16(rbv[0], rbv[1]); o.y = cvt_pk_bf16(rbv[2], rbv[3]); *(LAS v2u*)(Rb + t * RP + n0) = o;
                    o.x = cvt_pk_bf16(bbv[0], bbv[1]); o.y = cvt_pk_bf16(bbv[2], bbv[3]); *(LAS v2u*)(Bb + t * RP + n0) = o;
                    o.x = cvt_pk_bf16(kbv[0], kbv[1]); o.y = cvt_pk_bf16(kbv[2], kbv[3]); *(LAS v2u*)(Kb + t * RP + n0) = o; }
                  { v2u o; o.x = cvt_pk_bf16(bhv[0], bhv[1]); o.y = cvt_pk_bf16(bhv[2], bhv[3]); *(LAS v2u*)(BhT + t * RP + n0) = o;
                    o.x = cvt_pk_bf16(khv[0], khv[1]); o.y = cvt_pk_bf16(khv[2], khv[3]); *(LAS v2u*)(KhT + t * RP + n0) = o; }
                  if (r16 == 15) { const f32x4 g4 = {gl[0], gl[1], gl[2], gl[3]}; *(LAS f32x4*)&GL[c * 64 + n0] = g4; }
              }
              bsum += __shfl_xor(bsum, 16); bsum += __shfl_xor(bsum, 32); if (quad == 0) BONP[t * 2 + (wave & 1)] = bsum; }
            __syncthreads();
            { int lf_ = lane; const int r16 = lf_ & 15, quad = lf_ >> 4; const int c = wave & 3, odd = wave >> 2; const LAS bf16* Asrc = odd ? Rb : Ab;     const f32x4 z = {0.f, 0.f, 0.f, 0.f};
              const bf16x8 a0 = lds_frag(Asrc + (16 * c + r16) * RP + quad * 8), a1 = lds_frag(Asrc + (16 * c + r16) * RP + 32 + quad * 8);
              f32x4 g1 = MFMA16(a0, lds_frag(Bb + (16 * c + r16) * RP + quad * 8), z); g1 = MFMA16(a1, lds_frag(Bb + (16 * c + r16) * RP + 32 + quad * 8), g1);
              f32x4 g2 = MFMA16(a0, lds_frag(Kb + (16 * c + r16) * RP + quad * 8), z); g2 = MFMA16(a1, lds_frag(Kb + (16 * c + r16) * RP + 32 + quad * 8), g2);
              if (wave == 7) { const float bs = BONP[lf_ * 2] + BONP[lf_ * 2 + 1]; BON[((size_t)dir * R + chunk_row(b, dir, j, lf_)) * RH + h] = bs; }
              float v2m[4];
#pragma unroll
              for (int i = 0; i < 4; ++i) { const int t = 4 * quad + i; const bool keep = odd ? (r16 <= t) : (r16 < t); const float v1 = keep ? g1[i] : 0.f; v2m[i] = keep ? g2[i] : 0.f;
                  if (odd) { HRB[c * 384 + t * 24 + r16] = f2b(-v1)  ; HRK[c * 384 + t * 24 + r16] = f2b(v2m[i]); } else { GAB[c * 256 + t * 16 + r16] = v1; GAK[c * 384 + t * 24 + r16] = f2b(v2m[i]); } }
              if (!odd) { LDS_WAIT(); __builtin_amdgcn_wave_barrier();
                  float tj[16];
                  tj[0] = (r16 == 0) ? 1.0f : 0.f;
#pragma unroll
                  for (int i = 1; i < 16; ++i) { const LAS f32x4* gr = (const LAS f32x4*)(GAB + c * 256 + i * 16); float acc0 = (r16 == i) ? 1.0f : 0.f, acc1 = 0.f;
#pragma unroll
                      for (int q = 0; q < (i + 3) / 4; ++q) { const f32x4 g4 = gr[q];
#pragma unroll
                          for (int e = 0; e < 4; ++e) { const int jj = 4 * q + e; if (jj < i) { if (jj & 1) acc1 -= g4[e] * tj[jj]; else acc0 -= g4[e] * tj[jj]; } } }
                      tj[i] = acc0 + acc1; }
                  if (quad == 0) {
#pragma unroll
                      for (int i = 0; i < 16; i += 2) st_pair(TT + c * 384 + i * 24 + r16, TT + c * 384 + (i + 1) * 24 + r16, tj[i], tj[i + 1]); } } }
            __syncthreads();
            if (wave < 4) {
                int lc = lane; const int r16 = lc & 15, quad = lc >> 4, vnt = wave;
#pragma unroll
                for (int c = 0; c < 4; ++c) {
                    bf16x8 sb[2];
#pragma unroll
                    for (int ks = 0; ks < 2; ++ks) { v4u w; w.x = pk2(ST[2 * ks][0], ST[2 * ks][1]); w.y = pk2(ST[2 * ks][2], ST[2 * ks][3]); w.z = pk2(ST[2 * ks + 1][0], ST[2 * ks + 1][1]); w.w = pk2(ST[2 * ks + 1][2], ST[2 * ks + 1][3]); sb[ks] = __builtin_bit_cast(bf16x8, w); }
                    const v2u vmw = tr_raw4(Vt, 16 * c + 4 * quad, 16 * vnt, r16); const v4u vm4 = {vmw.x, vmw.y, 0u, 0u}; const bf16x8 vmb = __builtin_bit_cast(bf16x8, vm4);
                    f32x4 sa = {0.f, 0.f, 0.f, 0.f}, yy = {0.f, 0.f, 0.f, 0.f};
#pragma unroll
                    for (int ks = 0; ks < 2; ++ks) { sa = MFMA16(lds_frag_perm(Ab + (16 * c + r16) * RP + 32 * ks + 4 * quad), sb[ks], sa); yy = MFMA16(lds_frag_perm(Rb + (16 * c + r16) * RP + 32 * ks + 4 * quad), sb[ks], yy); }
                    sa = MFMA16(lds_frag_lo4(GAK + c * 384 + r16 * 24 + 4 * quad), vmb, sa);
                    { const v4u sr4 = {pk2(sa[0], sa[1]), pk2(sa[2], sa[3]), 0u, 0u}; const f32x4 z0 = {0.f, 0.f, 0.f, 0.f};
                      sa = MFMA16(lds_frag_lo4(TT + c * 384 + r16 * 24 + 4 * quad), __builtin_bit_cast(bf16x8, sr4), z0); }
                    const v4u vs4 = {vmw.x, vmw.y, pk2(sa[0], sa[1]), pk2(sa[2], sa[3])}; const bf16x8 vsb = __builtin_bit_cast(bf16x8, vs4);
                    { const v2u hk = *(const LAS v2u*)(HRK + c * 384 + r16 * 24 + 4 * quad), hb = *(const LAS v2u*)(HRB + c * 384 + r16 * 24 + 4 * quad); const v4u ha = {hk.x, hk.y, hb.x, hb.y};
                      yy = MFMA16(__builtin_bit_cast(bf16x8, ha), vsb, yy); }
#pragma unroll
                    for (int i = 0; i < 4; i += 2) { const unsigned w = pk2(yy[i], yy[i + 1]);
                        YOb[(16 * c + 4 * quad + i) * RP + 16 * vnt + r16] = (bf16)(w & 0xffffu); YOb[(16 * c + 4 * quad + i + 1) * RP + 16 * vnt + r16] = (bf16)(w >> 16); }
#pragma unroll
                    for (int kt = 0; kt < 4; ++kt) { const v2u kh = tr_raw4(KhT, 16 * c + 4 * quad, 16 * kt, r16), bh = tr_raw4(BhT, 16 * c + 4 * quad, 16 * kt, r16); const v4u ka = {kh.x, kh.y, bh.x, bh.y};
                        const f32x4 gl4 = *(const LAS f32x4*)&GL[c * 64 + 16 * kt + 4 * quad]; ST[kt] = MFMA16(__builtin_bit_cast(bf16x8, ka), vsb, ST[kt] * gl4); }
                }
            }
            __syncthreads();
        }
        store_chunk(NCH - 1);
    }
}
template <int PART> __device__ __forceinline__ void finish_phase(Frame& F, int l, int nrows, int first, int stride) {
    const bf16* HF = (const bf16*)(F.ws + WS_HF); const bf16* O = (const bf16*)(F.ws + WS_O); bf16* HM = (bf16*)(F.ws + WS_HM);
    const bf16* YS = (const bf16*)(F.ws + WS_YS); const bf16* RKV = (const bf16*)(F.ws + WS_RKV); const bf16* Gb = (const bf16*)(F.ws + WS_HF);     const float* BON = (const float*)(F.ws + WS_BON); bf16* YR = (bf16*)(F.ws + WS_YR);
    const int lane = F.lane, c0 = lane * 16;
    float k1[16], k2[16], k3[16];
    { const float* p1 = PART == 0 ? INP(I_GMN) + l * 1024 + c0 : INP(I_LNW) + l * RD + c0; const float* p2 = INP(I_LNB) + l * RD + c0; const float* p3 = INP(I_MU) + l * RW + 2048 + c0;
#pragma unroll
      for (int q = 0; q < 4; ++q) { const f32x4 t1 = *(const f32x4*)(p1 + 4 * q); k1[4 * q] = t1.x; k1[4 * q + 1] = t1.y; k1[4 * q + 2] = t1.z; k1[4 * q + 3] = t1.w;
          if (PART == 1) { const f32x4 t2 = *(const f32x4*)(p2 + 4 * q), t3 = *(const f32x4*)(p3 + 4 * q); k2[4 * q] = t2.x; k2[4 * q + 1] = t2.y; k2[4 * q + 2] = t2.z; k2[4 * q + 3] = t2.w; k3[4 * q] = t3.x; k3[4 * q + 1] = t3.y; k3[4 * q + 2] = t3.z; k3[4 * q + 3] = t3.w; } } }
    const bf16* S0 = PART == 0 ? HF : YS;
    int g = first * NWAVES + F.wave; const int gstep = stride * NWAVES;
    const v4u z4 = {0u, 0u, 0u, 0u};
    v4u n0 = z4, n1 = z4, n2 = z4, n3 = z4, e0 = z4, e1 = z4, e2 = z4, e3 = z4, e4 = z4, e5 = z4; float eb0 = 0.f, eb1 = 0.f;
    auto fetch = [&](int gn) {
        n0 = *(const v4u*)(S0 + (size_t)gn * 1024 + c0); n1 = *(const v4u*)(S0 + ((size_t)R + gn) * 1024 + c0); n2 = *(const v4u*)(S0 + (size_t)gn * 1024 + c0 + 8); n3 = *(const v4u*)(S0 + ((size_t)R + gn) * 1024 + c0 + 8);
        if (PART == 0) { e0 = *(const v4u*)(O + (size_t)gn * 1024 + c0); e1 = *(const v4u*)(O + (size_t)gn * 1024 + c0 + 8); }
        if (PART == 1) { const int hh = lane >> 2; eb0 = BON[(size_t)gn * RH + hh]; eb1 = BON[((size_t)R + gn) * RH + hh];
            e0 = *(const v4u*)(RKV + (size_t)gn * 3072 + 2048 + c0); e1 = *(const v4u*)(RKV + (size_t)gn * 3072 + 2048 + c0 + 8);
            const int nb0 = nbrow(gn, 2048 + c0), nb1 = nbrow(gn, 2048 + c0 + 8);
            e2 = nb0 >= 0 ? *(const v4u*)(RKV + (size_t)nb0 * 3072 + 2048 + c0) : z4; e3 = nb1 >= 0 ? *(const v4u*)(RKV + (size_t)nb1 * 3072 + 2048 + c0 + 8) : z4;
            e4 = *(const v4u*)(Gb + (size_t)gn * RD + c0); e5 = *(const v4u*)(Gb + (size_t)gn * RD + c0 + 8); } };
    if (g < nrows) fetch(g);
    for (; g < nrows; g += gstep) {
        const v4u c_0 = n0, c_1 = n1, c_2 = n2, c_3 = n3, x0 = e0, x1 = e1, x2 = e2, x3 = e3, x4 = e4, x5 = e5; const float xb0 = eb0, xb1 = eb1;
        { const int gn = g + gstep; if (gn < nrows) fetch(gn); }
        float y[16], a[8], bq[8];
        unpack8(c_0, a); unpack8(c_1, bq);
#pragma unroll
        for (int i = 0; i < 8; ++i) y[i] = a[i] + bq[i];
        unpack8(c_2, a); unpack8(c_3, bq);
#pragma unroll
        for (int i = 0; i < 8; ++i) y[8 + i] = a[i] + bq[i];
        if (PART == 0) {
            float ss = 0.f;
#pragma unroll
            for (int i = 0; i < 16; ++i) ss += y[i] * y[i];
            const float rs = 1.0f / sqrtf(red8(ss) * (1.0f / DV) + NORM_EPS);
            float og[16]; unpack8(x0, a); unpack8(x1, bq);
#pragma unroll
            for (int i = 0; i < 8; ++i) { og[i] = a[i]; og[8 + i] = bq[i]; }
            float o1[8], o2[8];
#pragma unroll
            for (int i = 0; i < 8; ++i) { o1[i] = y[i] * rs * k1[i] * sigmoidf_(og[i]); o2[i] = y[8 + i] * rs * k1[8 + i] * sigmoidf_(og[8 + i]); }
            *(v4u*)(HM + (size_t)g * 1024 + c0) = pack8(o1); *(v4u*)(HM + (size_t)g * 1024 + c0 + 8) = pack8(o2);
        }
        if (PART == 1) {
            float sm_ = 0.f;
#pragma unroll
            for (int i = 0; i < 16; ++i) sm_ += y[i];
            const float mean = red4(sm_) * (1.0f / RN); float vs = 0.f;
#pragma unroll
            for (int i = 0; i < 16; ++i) { const float dl = y[i] - mean; vs += dl * dl; }
            const float rs = 1.0f / sqrtf(red4(vs) * (1.0f / RN) + GN_EPS);
            const float bon = xb0 + xb1;
            float vm[16], gg[16];
#pragma unroll
            for (int half = 0; half < 2; ++half) { unpack8(half ? x1 : x0, a); unpack8(half ? x3 : x2, bq);
#pragma unroll
                for (int i = 0; i < 8; ++i) vm[8 * half + i] = a[i] + (bq[i] - a[i]) * k3[8 * half + i];
                unpack8(half ? x5 : x4, a);
#pragma unroll
                for (int i = 0; i < 8; ++i) gg[8 * half + i] = a[i]; }
            float o1[8], o2[8];
#pragma unroll
            for (int i = 0; i < 8; ++i) { o1[i] = ((y[i] - mean) * rs * k1[i] + k2[i] + bon * vm[i]) * gg[i]; o2[i] = ((y[8 + i] - mean) * rs * k1[8 + i] + k2[8 + i] + bon * vm[8 + i]) * gg[8 + i]; }
            *(v4u*)(YR + (size_t)g * RD + c0) = pack8(o1); *(v4u*)(YR + (size_t)g * RD + c0 + 8) = pack8(o2);
        }
    }
}
struct MoeMeta { int off[NE + 1]; };
__device__ __forceinline__ MoeMeta moe_meta(Frame& F) {
    MoeMeta m; int o = 0;
#pragma unroll
    for (int e = 0; e < NE; ++e) { m.off[e] = o; const unsigned c = __hip_atomic_load((unsigned*)(F.ctl + CW_ECNT + 64 * e), RLX_AGENT); o += (int)((c + 255u) & ~255u); }
    m.off[NE] = o; return m;
}
__device__ __forceinline__ void gather_phase(Frame& F) {
    const MoeMeta m = moe_meta(F);
    if (F.bid == 0 && F.tid < MAXSLOT / 256) { int e = 0;
#pragma unroll
        for (int q = 1; q <= NE - 1; ++q) e += ((int)F.tid * 256 >= m.off[q]) ? 1 : 0;
        ((int*)(F.ws + WS_META + 768 * 1024))[F.tid] = e; }
    const bf16* H = (const bf16*)(F.ws + WS_H); unsigned char* HG = (unsigned char*)(F.ws + WS_HG);
    for (int g = F.bid * NWAVES + F.wave; g < RL; g += F.G * NWAVES) {
        int* tk = (int*)(F.ws + WS_META) + (size_t)g * 8; const int e0 = tk[0], e1 = tk[1], p0 = tk[2], p1 = tk[3];
        const v4u o = *(const v4u*)((const unsigned char*)H + (size_t)g * D + 16 * F.lane);
        int b0 = 0, b1 = 0;
#pragma unroll
        for (int q = 0; q < NE; ++q) { b0 = (e0 == q) ? m.off[q] : b0; b1 = (e1 == q) ? m.off[q] : b1; }
        const int s0 = b0 + p0, s1 = b1 + p1; if (F.lane == 0) { tk[6] = s0; tk[7] = s1; }
        *(v4u*)(HG + (size_t)s0 * D + 16 * F.lane) = o; *(v4u*)(HG + (size_t)s1 * D + 16 * F.lane) = o; }
}
__device__ __forceinline__ void final_phase(Frame& F, const float* MODl) {
    const bf16* Y2 = (const bf16*)(F.ws + WS_Y2); const float* gfp = INP(I_GF);
    f32x4 gf[4];
#pragma unroll
    for (int j = 0; j < 4; ++j) gf[j] = *(const f32x4*)(gfp + 256 * j + 4 * F.lane);
    int g = F.bid * NWAVES + F.wave; const int gstep = F.G * NWAVES;
    int s0n = 0, s1n = 0; float p0n = 0.f, p1n = 0.f;
    if (g < RL) { const int* tk = (const int*)(F.ws + WS_META) + (size_t)g * 8; s0n = tk[6]; s1n = tk[7]; p0n = ((const float*)tk)[4]; p1n = ((const float*)tk)[5]; }
    for (; g < RL; g += gstep) {
        const int s0 = s0n, s1 = s1n; const float p0 = p0n, p1 = p1n;
        float* xr = (float*)F.out + (size_t)g * D; const float* gt = MODl + (g / T) * 6 * D + 5 * D; f32x4 x[4], gq[4]; v2u ya[4], yb[4];
#pragma unroll
        for (int j = 0; j < 4; ++j) { const int c = 256 * j + 4 * F.lane; x[j] = *(const f32x4*)(xr + c); gq[j] = *(const f32x4*)(gt + c); ya[j] = *(const v2u*)(Y2 + (size_t)s0 * D + c); yb[j] = *(const v2u*)(Y2 + (size_t)s1 * D + c); }
        { const int gn = g + gstep; if (gn < RL) { const int* tk = (const int*)(F.ws + WS_META) + (size_t)gn * 8; s0n = tk[6]; s1n = tk[7]; p0n = ((const float*)tk)[4]; p1n = ((const float*)tk)[5]; } }
        f32x4 v[4]; float ss = 0.f;
#pragma unroll
        for (int j = 0; j < 4; ++j) { const v2u a = ya[j], bq = yb[j];
            f32x4 y; y.x = p0 * bflo(a.x) + p1 * bflo(bq.x); y.y = p0 * bfhi(a.x) + p1 * bfhi(bq.x); y.z = p0 * bflo(a.y) + p1 * bflo(bq.y); y.w = p0 * bfhi(a.y) + p1 * bfhi(bq.y);
            v[j] = x[j] + gq[j] * y; ss += (v[j].x * v[j].x + v[j].y * v[j].y) + (v[j].z * v[j].z + v[j].w * v[j].w); }
        const float rstd = 1.0f / sqrtf(wave_sum(ss) * (1.0f / D) + NORM_EPS);
#pragma unroll
        for (int j = 0; j < 4; ++j) { const int c = 256 * j + 4 * F.lane; *(f32x4*)(xr + c) = v[j] * rstd * gf[j]; }
    }
}

#ifndef MK_SPLIT
#define MK_SPLIT 0
#endif
constexpr int PPL = 12, NPHASE = 1 + NL * PPL + 1;
__device__ __forceinline__ GAS unsigned char* launder_ws(GAS unsigned char* p) { asm volatile("" : "+s"(p)); return p; }
__device__ __forceinline__ const CAS Args* launder_args(const CAS Args* p) { asm volatile("" : "+s"(p)); return p; }
__device__ __forceinline__ void grid_barrier(unsigned* barw, unsigned x, volatile LAS unsigned* st) { XcdBarrier b; b.bar = barw; b.x = x; b.st = st; xcd_barrier(b); }
#define IN(k) (lo <= (k) && (k) < hi)
#define SEAM(k) do { if (IN(k) && IN((k) + 1)) grid_barrier(bar.bar, bar.x, bar.st); } while (0)
#define PH_BEGIN { int t_ = threadIdx.x; asm volatile("" : "+v"(t_)); F.tid = t_; F.lane = t_ & 63; F.wave = __builtin_amdgcn_readfirstlane(t_ >> 6); int b_ = blockIdx.x; asm volatile("" : "+s"(b_)); F.bid = b_; F.cb = b_; F.cg = F.G; } \
        GAS unsigned char* ws = launder_ws(args.ws); F.ws = ws; F.A = launder_args((const CAS Args*)__builtin_amdgcn_kernarg_segment_ptr()); float* MOD = (float*)(ws + WS_MOD); float* XC = (float*)(ws + WS_XC); bf16* Hb = (bf16*)(ws + WS_H); \
        const float* MODl = MOD + (size_t)l * 5 * 6 * D; const float* xl = l == 0 ? INP(I_X) : (const float*)F.out; const float* xc = l == 0 ? INP(I_CTX) : XC; (void)MODl; (void)xl; (void)xc; (void)Hb;
template <int l> __device__ __forceinline__ void layer_body(Frame& F, const Args& args, const int lo, const int hi, const XcdBarrier& bar) {
        const int p0 = 1 + l * PPL; const bool last = (l == NL - 1);
        const int Mrows = last ? RL : R;
        if (IN(p0 + 0)) { PH_BEGIN if (l == 0) normmod_rows(F, xl, xc, INP(I_GNM) + l * D, MODl, 0, D, R);
            else { normmod_ctx_slabs(F, xc, (const float*)(ws + WS_S2), INP(I_GNM) + l * D, MODl, 0, D); normmod_rows(F, xl, xc, INP(I_GNM) + l * D, MODl, 0, D, RL); conv_rest(F, l); } }
        SEAM(p0 + 0);
        if (IN(p0 + 1)) { PH_BEGIN pg8::Gemm g{Hb, (const bf16*)(ws + WS_WIN), R, NPAD, D}; pg8::EpiInproj E{ws};
            pg8::InprojOrder26<last> S; S.G = F.G; S.c = F.bid; pg8::gemm_phase<pg8::EpiInproj, pg8::InprojOrder26<last>, true, true>(F.lds, g, S, E); }
        if (IN(p0 + 1) && IN(p0 + 3)) grid_barrier(bar.bar, bar.x, bar.st);
        if (IN(p0 + 3)) { PH_BEGIN const int nR = F.G / 2;
            if (F.bid < nR) rwkv_phase(F, l, F.bid, nR);
            else { F.cb = F.bid - nR; F.cg = F.G - nR; gu32* sub = F.ctl + CW_SUB + 64 * l;
                   sg_phase(F, l); subgrid_arrive(F, sub);
                   mlstm_phase(F, l, F.cb, F.cg); subgrid_arrive(F, sub + 128); } }
        if (IN(p0 + 3)) { PH_BEGIN const int nR = F.G / 2;
            if (F.bid >= nR) { F.cb = F.bid - nR; F.cg = F.G - nR; gu32* sub = F.ctl + CW_SUB + 64 * l;
                pg8::Gemm g{Hb, (const bf16*)(ws + WS_WIN), R, NPAD, D}; pg8::EpiInproj E{ws};
                pg8::MgtOrder<last> S; S.G = F.cg; S.c = (F.cb + 64) % F.cg;
                pg8::gemm_phase<pg8::EpiInproj, pg8::MgtOrder<last>, true, true>(F.lds, g, S, E);
                subgrid_arrive(F, sub + 384); } }
        if (IN(p0 + 3)) { PH_BEGIN const int nR = F.G / 2;
            if (F.bid >= nR) { F.cb = F.bid - nR; F.cg = F.G - nR; gu32* sub = F.ctl + CW_SUB + 64 * l;
                if (!last) conv_ffn0(F); else conv_experts(F, 0, 5);
                subgrid_wait(F, sub, (unsigned)F.cg); subgrid_wait(F, sub + 128, (unsigned)F.cg); subgrid_wait(F, sub + 384, (unsigned)F.cg);
                finish_phase<0>(F, l, Mrows, F.cb, F.cg); subgrid_arrive(F, sub + 256);
                if (!last) conv_win(F, l + 1); else conv_experts(F, 5, 6);
                subgrid_wait(F, sub + 256, (unsigned)F.cg); } }
        if (IN(p0 + 3)) { PH_BEGIN const int nR = F.G / 2;
            if (F.bid >= nR) {
                pg8::Gemm g{(const bf16*)(ws + WS_HM), (const bf16*)(ws + WS_WPM), Mrows, D, D}; pg8::StaticOrder S; S.init(Mrows, D, F.G - nR, F.bid - nR);
                pg8::EpiMerge<0> E{(const bf16*)(ws + WS_MGT), (bf16*)(ws + WS_T1), nullptr};
                pg8::gemm_phase<pg8::EpiMerge<0>, pg8::StaticOrder, true, true>(F.lds, g, S, E); } }
        if (IN(p0 + 3)) { PH_BEGIN const int nR = F.G / 2;
            if (F.bid >= nR) { int kg = 256; asm volatile("" : "+s"(kg));
                pg8::Gemm g{(const bf16*)(ws + WS_SG), (const bf16*)(ws + WS_WG2), R, RD, kg}; pg8::StaticOrder S; S.init(Mrows, RD, F.G - nR, (F.bid - nR + 32) % (F.G - nR));
                pg8::EpiStore E{(bf16*)(ws + WS_HF), RD};
                pg8::gemm_phase<pg8::EpiStore, pg8::StaticOrder, true, true>(F.lds, g, S, E); } }
        SEAM(p0 + 3);
        if (IN(p0 + 4)) { PH_BEGIN finish_phase<1>(F, l, Mrows, F.bid, F.G); }
        if (IN(p0 + 4) && IN(p0 + 6)) grid_barrier(bar.bar, bar.x, bar.st);
        if (IN(p0 + 6)) { PH_BEGIN pg8::Gemm g{(const bf16*)(ws + WS_YR), (const bf16*)(ws + WS_WPR), Mrows, D, D}; pg8::StaticOrder S; S.init(Mrows, D, F.G, F.bid);
            pg8::EpiMerge<1> E{(const bf16*)(ws + WS_MGT), (bf16*)(ws + WS_T1), Hb};
            pg8::gemm_phase<pg8::EpiMerge<1>, pg8::StaticOrder, true, true>(F.lds, g, S, E); }
        SEAM(p0 + 6);
        if (IN(p0 + 7)) { PH_BEGIN pg8::Gemm g{Hb, (const bf16*)(ws + WS_WOUT), Mrows, D, D}; pg8::StaticOrder S; S.init(Mrows, D, F.G, F.bid);
            pg8::EpiResid E{xl, xc, (float*)F.out, XC, MODl + 2 * D};
            pg8::gemm_phase<pg8::EpiResid, pg8::StaticOrder, true, true>(F.lds, g, S, E); }
        SEAM(p0 + 7);
        if (IN(p0 + 8)) { PH_BEGIN if (!last) normmod_rows(F, (const float*)F.out, XC, INP(I_GNF) + l * D, MODl, 3 * D, 4 * D, Mrows);
                          else normmod_phase<true>(F, (const float*)F.out, XC, INP(I_GNF) + l * D, MODl, 3 * D, 4 * D, Mrows, INP(I_WR)); }
        SEAM(p0 + 8);
        if (!last) {
            if (IN(p0 + 9)) { PH_BEGIN pg8::Gemm g{Hb, (const bf16*)(ws + WS_WGU), Mrows, 2 * FF, D}; pg8::StaticOrder S; S.init(Mrows, 2 * FF, F.G, F.bid);
                pg8::EpiSwigluCtx E{(bf16*)(ws + WS_HH0), FF, (bf16*)(ws + WS_HH0) + (size_t)RL * FF, RL / 256};
                pg8::gemm_phase<pg8::EpiSwigluCtx, pg8::StaticOrder, true, true>(F.lds, g, S, E); }
            SEAM(p0 + 9);
            if (IN(p0 + 10)) { PH_BEGIN pg8::Gemm g{(const bf16*)(ws + WS_HH0), (const bf16*)(ws + WS_WDN), RL, D, FF}; pg8::StaticOrder S; S.init(RL, D, F.G, F.bid);
                pg8::EpiResid E{(const float*)F.out, XC, (float*)F.out, XC, MODl + 5 * D};
                pg8::gemm_phase<pg8::EpiResid, pg8::StaticOrder, true, true>(F.lds, g, S, E); }
            if (IN(p0 + 10)) { PH_BEGIN int kg = 256; asm volatile("" : "+s"(kg));
                pg8::Gemm g{(const bf16*)(ws + WS_HH0) + (size_t)RL * FF, (const bf16*)(ws + WS_WDNS), RC, D, kg}; pg8::CtxSliceOrder S; S.nS = NSL; S.G = F.G; S.c = (F.bid + 128) % F.G;
                pg8::EpiSlab E{(float*)(ws + WS_S2), MODl + 4 * 6 * D + 5 * D};
                pg8::gemm_phase<pg8::EpiSlab, pg8::CtxSliceOrder, true, true>(F.lds, g, S, E); }
            if (IN(p0 + 10) && IN(p0 + 12)) grid_barrier(bar.bar, bar.x, bar.st);
        } else {
            if (IN(p0 + 9)) { PH_BEGIN conv_experts(F, 6, NE); gather_phase(F); }
            SEAM(p0 + 9);
            if (IN(p0 + 10)) { PH_BEGIN const MoeMeta mm = moe_meta(F); pg8::MoeOrder S; S.ntiles = mm.off[NE] / 256; S.nN = 2 * FE / 256; S.nwg = S.ntiles * S.nN; S.G = F.G; S.c = F.bid; S.texp = (const int*)(ws + WS_META + 768 * 1024);
                S.lo0 = (int)((WS_WEA - WS_WEGU) / (256 * 1024)); S.lo1 = 28; S.b4 = -(int)((WS_WEGU - WS_WE4U) / (256 * 1024)); S.b5 = -(int)((WS_WEGU - WS_WE5U) / (256 * 1024));
                int ke = D / 2; asm volatile("" : "+s"(ke));
                pg8::Gemm g{(const bf16*)(ws + WS_HG), (const bf16*)(ws + WS_WEGU), 0, 2 * FE, ke}; pg8::EpiSwiglu8 E{(unsigned char*)(ws + WS_HHE), FE};
                pg8::gemm_phase<pg8::EpiSwiglu8, pg8::MoeOrder, true, true, true>(F.lds, g, S, E); }
            SEAM(p0 + 10);
            if (IN(p0 + 11)) { PH_BEGIN const MoeMeta mm = moe_meta(F); pg8::MoeOrder S; S.ntiles = mm.off[NE] / 256; S.nN = D / 256; S.nwg = S.ntiles * S.nN; S.G = F.G; S.c = F.bid; S.texp = (const int*)(ws + WS_META + 768 * 1024);
                S.lo0 = (int)((WS_WEA + 28 * MiB - WS_WEDN) / (896 * 1024)); S.lo1 = 4; S.b4 = -(int)((WS_WEDN - WS_WE4D) / (896 * 1024)); S.b5 = -(int)((WS_WEDN - WS_WE5D) / (896 * 1024));
                int ke = FE / 2; asm volatile("" : "+s"(ke));
                pg8::Gemm g{(const bf16*)(ws + WS_HHE), (const bf16*)(ws + WS_WEDN), 0, D, ke}; pg8::EpiStoreScaled E{(bf16*)(ws + WS_Y2), D, 1.0f / W8S};
                pg8::gemm_phase<pg8::EpiStoreScaled, pg8::MoeOrder, true, true, true>(F.lds, g, S, E); }
            SEAM(p0 + 11);
        }
    }
__global__ void __launch_bounds__(NTHREADS, 2) mk_fwd(Args args) {
    extern __shared__ __attribute__((aligned(16))) unsigned char lds[];
    Frame F;
    F.lds = (LAS unsigned char*)lds; F.MISC = (volatile LAS unsigned*)(F.lds + MISC_OFF);
    F.tid = threadIdx.x; F.lane = F.tid & 63; F.wave = __builtin_amdgcn_readfirstlane(F.tid >> 6); F.G = gridDim.x; F.bid = blockIdx.x;
    F.ws = args.ws; F.out = args.out; F.ctl = (gu32*)(args.ws + WS_CTL);
    F.A = (const CAS Args*)__builtin_amdgcn_kernarg_segment_ptr();
    if (F.tid < 64) F.MISC[F.tid] = 0u;
    __syncthreads();
    const int lo = args.ph_lo, hi = args.ph_hi;
    XcdBarrier bar; bar.bar = (unsigned*)(F.ctl + CW_BAR) + args.li * XCD_BAR_WORDS; bar.x = 0; bar.st = nullptr;
    if (hi - lo > 1) bar = xcd_barrier_post((unsigned*)(F.ctl + CW_BAR) + args.li * XCD_BAR_WORDS, F.MISC + 8);

    if (IN(0)) { const int l = 0; PH_BEGIN mod_phase(F); conv_win(F, 0); conv_rest(F, 0); }
    SEAM(0);

    layer_body<0>(F, args, lo, hi, bar);
    layer_body<1>(F, args, lo, hi, bar);
    if (IN(NPHASE - 1)) { const int l = NL - 1; PH_BEGIN final_phase(F, MODl); }
#undef IN
#undef SEAM
}

extern "C" void kernel_launch(void* const* d_in, const int* in_sizes, int n_in, void* d_out, int out_size, void* d_ws, size_t ws_size, hipStream_t stream) {
    static int grid = 0;
    if (grid == 0) {
        if (n_in != 33 || out_size != RL * D || ws_size < WS_NEED) { fprintf(stderr, "kernel_launch: unexpected problem (n_in %d, out %d, ws %zu < %zu)\n", n_in, out_size, ws_size, (size_t)WS_NEED); grid = -1; return; }
        int dev = 0, cus = 0, per_cu = 0;
        if (hipGetDevice(&dev) != hipSuccess || hipDeviceGetAttribute(&cus, hipDeviceAttributeMultiprocessorCount, dev) != hipSuccess) { grid = -1; return; }
        if (hipFuncSetAttribute((const void*)mk_fwd, hipFuncAttributeMaxDynamicSharedMemorySize, LDS_BYTES) != hipSuccess) { fprintf(stderr, "kernel_launch: hipFuncSetAttribute failed\n"); grid = -1; return; }
        if (hipOccupancyMaxActiveBlocksPerMultiprocessor(&per_cu, (const void*)mk_fwd, NTHREADS, LDS_BYTES) != hipSuccess || per_cu < 1) { fprintf(stderr, "kernel_launch: occupancy query says %d\n", per_cu); grid = -1; (void)hipGetLastError(); return; }
        grid = cus;
    }
    if (grid < 0) return;
    (void)hipMemsetAsync((char*)d_ws + WS_CTL, 0, CTL_ZERO_BYTES, stream);
    Args a{};
    for (int i = 0; i < 33; ++i) a.in[i] = (const GAS float*)d_in[i];
    a.out = (GAS float*)d_out; a.ws = (GAS unsigned char*)d_ws;
#if MK_SPLIT
    for (int p = 0; p < NPHASE; ++p) { a.ph_lo = p; a.ph_hi = p + 1; hipLaunchKernelGGL(mk_fwd, dim3(grid), dim3(NTHREADS), LDS_BYTES, stream, a); }
#elif defined(PROBE_PH)
    a.ph_lo = 0; a.ph_hi = PROBE_PH + 1; a.li = 0; hipLaunchKernelGGL(mk_fwd, dim3(grid), dim3(NTHREADS), LDS_BYTES, stream, a);
    for (int r = 0; r < PROBE_N; ++r) { a.ph_lo = PROBE_PH; a.ph_hi = PROBE_PH + 1; hipLaunchKernelGGL(mk_fwd, dim3(grid), dim3(NTHREADS), LDS_BYTES, stream, a); }
    a.ph_lo = PROBE_PH + 1; a.ph_hi = NPHASE; a.li = 1; hipLaunchKernelGGL(mk_fwd, dim3(grid), dim3(NTHREADS), LDS_BYTES, stream, a);
#else
    a.ph_lo = 0; a.ph_hi = NPHASE;
    hipLaunchKernelGGL(mk_fwd, dim3(grid), dim3(NTHREADS), LDS_BYTES, stream, a);
#endif
}
```
